# Optimizing an MI355X kernel written in HIP

```python
import jax, jax.numpy as jnp
from jax import lax
import numpy as np

D_MODEL = 1024
BATCH = 2
SEQ = 8192
DEPTH = 1

HEAD_DIM = 64
MOBA_HEADS = 8
FOX_HEADS = 8
A_WIDTH = MOBA_HEADS * HEAD_DIM
B_WIDTH = FOX_HEADS * HEAD_DIM
ROPE_DIM = HEAD_DIM // 4
ROPE_THETA = 500000.0
MOBA_BLOCK = 256
MOBA_TOPK = 3
MOBA_Q_CHUNK = 64
Q_BLOCK = 128
FORGET_BIAS_CENTER = 3.0
PEER_HEADS = 8
PEER_NKEYS = 128
PEER_NEXPERTS = PEER_NKEYS * PEER_NKEYS
PEER_KEY_DIM = 256
PEER_HALF = PEER_KEY_DIM // 2
PEER_TOPK = 16
PEER_TOKEN_CHUNK = 128
IN_COLS = 3 * A_WIDTH + 3 * B_WIDTH + FOX_HEADS + 2 * D_MODEL
RMS_EPS = 1e-6

kernel_name = "moba_fox_gated_peer_hybrid"


def rms_norm(x, g):
    xf = x.astype(jnp.float32)
    y = xf * lax.rsqrt(jnp.mean(xf * xf, axis=-1, keepdims=True) + RMS_EPS)
    return (y * g.astype(jnp.float32)).astype(x.dtype)


def partial_rope(x, pos):
    half = ROPE_DIM // 2
    inv_freq = jnp.power(ROPE_THETA, -jnp.arange(half, dtype=jnp.float32) / half)
    ang = pos.astype(jnp.float32)[:, None] * inv_freq[None, :]
    cos = jnp.cos(ang).astype(x.dtype)
    sin = jnp.sin(ang).astype(x.dtype)
    x1 = x[..., :half]
    x2 = x[..., half:ROPE_DIM]
    return jnp.concatenate([x1 * cos - x2 * sin, x1 * sin + x2 * cos, x[..., ROPE_DIM:]], axis=-1)


def moba_attention(q, k, v):
    B, H, S, dh = q.shape
    L = MOBA_BLOCK
    nb = -(-S // L)
    pad = nb * L - S
    k_blk = jnp.pad(k, ((0, 0), (0, 0), (0, pad), (0, 0))).reshape(B, H, nb, L, dh)
    v_blk = jnp.pad(v, ((0, 0), (0, 0), (0, pad), (0, 0))).reshape(B, H, nb, L, dh)
    k_mean = jnp.mean(k_blk.astype(jnp.float32), axis=3).astype(k.dtype)
    scale = dh ** -0.5
    qpos = jnp.arange(S)
    gate = jnp.einsum('bhsd,bhnd->bhsn', q, k_mean).astype(jnp.float32)
    past = jnp.arange(nb)[None, :] < (qpos // L)[:, None]
    gate = jnp.where(past, gate, -jnp.inf)
    kk = min(MOBA_TOPK, nb)
    top_val, top_idx = lax.top_k(gate, kk)
    sel_valid = jnp.isfinite(top_val)
    C = MOBA_Q_CHUNK
    nq = S // C
    q_c = q.reshape(B, H, nq, C, dh).transpose(2, 0, 1, 3, 4)
    idx_c = top_idx.reshape(B, H, nq, C, kk).transpose(2, 0, 1, 3, 4)
    val_c = sel_valid.reshape(B, H, nq, C, kk).transpose(2, 0, 1, 3, 4)
    take_blocks = jax.vmap(jax.vmap(lambda tab, ix: tab[ix]))

    def step(args):
        ci, qi, ii, vi = args
        q0 = ci * C
        own = q0 // L
        ks = take_blocks(k_blk, ii)
        vs = take_blocks(v_blk, ii)
        s_sel = jnp.einsum('bhcd,bhcjld->bhcjl', qi, ks).astype(jnp.float32) * scale
        s_sel = jnp.where(vi[..., None], s_sel, -jnp.inf).reshape(B, H, C, kk * L)
        k_own = lax.dynamic_index_in_dim(k_blk, own, axis=2, keepdims=False)
        v_own = lax.dynamic_index_in_dim(v_blk, own, axis=2, keepdims=False)
        s_own = jnp.einsum('bhcd,bhld->bhcl', qi, k_own).astype(jnp.float32) * scale
        causal = (own * L + jnp.arange(L))[None, :] <= (q0 + jnp.arange(C))[:, None]
        s_own = jnp.where(causal, s_own, -jnp.inf)
        p = jax.nn.softmax(jnp.concatenate([s_sel, s_own], axis=-1), axis=-1)
        p_sel = p[..., :kk * L].reshape(B, H, C, kk, L).astype(v.dtype)
        p_own = p[..., kk * L:].astype(v.dtype)
        return (jnp.einsum('bhcjl,bhcjld->bhcd', p_sel, vs)
                + jnp.einsum('bhcl,bhld->bhcd', p_own, v_own))

    out = lax.map(step, (jnp.arange(nq), q_c, idx_c, val_c))
    return out.transpose(1, 2, 0, 3, 4).reshape(B, H, S, dh)


def forgetting_attention(q, k, v, log_f):
    B, H, S, dh = q.shape
    scale = dh ** -0.5
    c = jnp.cumsum(log_f, axis=-1)
    nq = S // Q_BLOCK
    q_c = q.reshape(B, H, nq, Q_BLOCK, dh).transpose(2, 0, 1, 3, 4)
    c_c = c.reshape(B, H, nq, Q_BLOCK).transpose(2, 0, 1, 3)
    kpos = jnp.arange(S)

    def step(args):
        ci, qi, cq = args
        s = (jnp.einsum('bhqd,bhkd->bhqk', qi, k).astype(jnp.float32) * scale
             + cq[..., None] - c[:, :, None, :])
        qpos = ci * Q_BLOCK + jnp.arange(Q_BLOCK)
        s = jnp.where(kpos[None, :] <= qpos[:, None], s, -jnp.inf)
        p = jax.nn.softmax(s, axis=-1).astype(v.dtype)
        return jnp.einsum('bhqk,bhkd->bhqd', p, v)

    out = lax.map(step, (jnp.arange(nq), q_c, c_c))
    return out.transpose(1, 2, 0, 3, 4).reshape(B, H, S, dh)


def hybrid_mixer(xn, w_in, b_forget, w_branch_a, w_branch_b, w_out):
    B, S, _ = xn.shape
    proj = xn @ w_in
    cuts = [A_WIDTH, 2 * A_WIDTH, 3 * A_WIDTH,
            3 * A_WIDTH + B_WIDTH, 3 * A_WIDTH + 2 * B_WIDTH, 3 * A_WIDTH + 3 * B_WIDTH,
            3 * A_WIDTH + 3 * B_WIDTH + FOX_HEADS, 3 * A_WIDTH + 3 * B_WIDTH + FOX_HEADS + D_MODEL]
    qa, ka, va, qb, kb, vb, f_logit, g_a, g_b = jnp.split(proj, cuts, axis=-1)

    def heads(t, n):
        return t.reshape(B, S, n, HEAD_DIM).transpose(0, 2, 1, 3)

    pos = jnp.arange(S)
    ya = moba_attention(partial_rope(heads(qa, MOBA_HEADS), pos),
                        partial_rope(heads(ka, MOBA_HEADS), pos),
                        heads(va, MOBA_HEADS))
    ya = ya.transpose(0, 2, 1, 3).reshape(B, S, A_WIDTH) @ w_branch_a
    log_f = jax.nn.log_sigmoid((f_logit + b_forget).astype(jnp.float32)).transpose(0, 2, 1)
    yb = forgetting_attention(heads(qb, FOX_HEADS), heads(kb, FOX_HEADS), heads(vb, FOX_HEADS), log_f)
    yb = yb.transpose(0, 2, 1, 3).reshape(B, S, B_WIDTH) @ w_branch_b
    merged = jax.nn.sigmoid(g_a) * ya + jax.nn.sigmoid(g_b) * yb
    return merged @ w_out


def peer_ffn(xn, w_peer_q, sub_keys, expert_u, expert_v):
    B, S, D = xn.shape
    T = B * S
    xt = xn.reshape(T, D)
    qh = (xt @ w_peer_q).reshape(T, PEER_HEADS, 2, PEER_HALF)
    s = jnp.einsum('thpd,hpnd->thpn', qh, sub_keys).astype(jnp.float32)
    sv, si = lax.top_k(s, PEER_TOPK)
    cand = (sv[:, :, 0, :, None] + sv[:, :, 1, None, :]).reshape(T, PEER_HEADS, PEER_TOPK * PEER_TOPK)
    cand_idx = (si[:, :, 0, :, None] * PEER_NKEYS + si[:, :, 1, None, :]).reshape(T, PEER_HEADS, PEER_TOPK * PEER_TOPK)
    best, pick = lax.top_k(cand, PEER_TOPK)
    expert_idx = jnp.take_along_axis(cand_idx, pick, axis=-1)
    gates = jax.nn.softmax(best, axis=-1)
    C = PEER_TOKEN_CHUNK
    n_chunks = T // C

    def step(args):
        xc, ic, gc = args
        u = expert_u[ic]
        hval = jnp.einsum('cd,chkd->chk', xc, u).astype(jnp.float32)
        a = (gc * jax.nn.gelu(hval, approximate=False)).astype(xc.dtype)
        return jnp.einsum('chk,chkd->cd', a, expert_v[ic])

    out = lax.map(step, (xt.reshape(n_chunks, C, D),
                         expert_idx.reshape(n_chunks, C, PEER_HEADS, PEER_TOPK),
                         gates.reshape(n_chunks, C, PEER_HEADS, PEER_TOPK)))
    return out.reshape(B, S, D)


def setup_inputs(seed: int = 0) -> dict:
    key = jax.random.key(seed)
    ks = jax.random.split(key, 14)
    f32 = jnp.float32

    def nrm(k, shape, scale):
        return jax.random.normal(k, shape, f32) * scale

    return {
        "x": nrm(ks[0], (BATCH, SEQ, D_MODEL), 1.0),
        "norm_mix_g": 1.0 + nrm(ks[1], (DEPTH, D_MODEL), 0.02),
        "w_in": nrm(ks[2], (DEPTH, D_MODEL, IN_COLS), D_MODEL ** -0.5),
        "b_forget": FORGET_BIAS_CENTER + nrm(ks[3], (DEPTH, FOX_HEADS), 0.5),
        "w_branch_a": nrm(ks[4], (DEPTH, A_WIDTH, D_MODEL), A_WIDTH ** -0.5),
        "w_branch_b": nrm(ks[5], (DEPTH, B_WIDTH, D_MODEL), B_WIDTH ** -0.5),
        "w_out": nrm(ks[6], (DEPTH, D_MODEL, D_MODEL), D_MODEL ** -0.5),
        "norm_ffn_g": 1.0 + nrm(ks[7], (DEPTH, D_MODEL), 0.02),
        "w_peer_q": nrm(ks[8], (DEPTH, D_MODEL, PEER_HEADS * PEER_KEY_DIM), D_MODEL ** -0.5),
        "peer_sub_keys": nrm(ks[9], (DEPTH, PEER_HEADS, 2, PEER_NKEYS, PEER_HALF), PEER_HALF ** -0.5),
        "peer_expert_u": nrm(ks[10], (DEPTH, PEER_NEXPERTS, D_MODEL), D_MODEL ** -0.5),
        "peer_expert_v": nrm(ks[11], (DEPTH, PEER_NEXPERTS, D_MODEL), PEER_HEADS ** -0.5),
        "norm_final_g": 1.0 + nrm(ks[12], (D_MODEL,), 0.02),
    }


def reference(x, norm_mix_g, w_in, b_forget, w_branch_a, w_branch_b, w_out, norm_ffn_g,
              w_peer_q, peer_sub_keys, peer_expert_u, peer_expert_v, norm_final_g):
    h = x
    for l in range(DEPTH):
        h = h + hybrid_mixer(rms_norm(h, norm_mix_g[l]), w_in[l], b_forget[l],
                             w_branch_a[l], w_branch_b[l], w_out[l])
        h = h + peer_ffn(rms_norm(h, norm_ffn_g[l]), w_peer_q[l], peer_sub_keys[l],
                         peer_expert_u[l], peer_expert_v[l])
    return rms_norm(h, norm_final_g)
```

```cpp
#include <hip/hip_runtime.h>
#include <cstdio>
#include <cstdint>
#include <cmath>

constexpr int Bn = 2, S = 8192, D = 1024, T = Bn * S;
constexpr int HD = 64, NH = 8;
constexpr int INC = 5128;
constexpr int LBLK = 256, NBLK = S / LBLK;
constexpr int PH = 8, PNK = 128, PHALF = 128, PK = 16, PQC = PH * 2 * PHALF;
constexpr float EPS = 1e-6f;

typedef unsigned short bf16_t;
typedef float f32x4 __attribute__((ext_vector_type(4)));
typedef unsigned u32x2 __attribute__((ext_vector_type(2)));
typedef unsigned u32x4 __attribute__((ext_vector_type(4)));

__device__ __forceinline__ float bf2f(bf16_t v) { return __uint_as_float((unsigned)v << 16); }
__device__ __forceinline__ unsigned f2bf(float f) { unsigned u = __float_as_uint(f); return (u + 0x7fffu + ((u >> 16) & 1u)) >> 16; }
__device__ __forceinline__ unsigned pk2(float lo, float hi) { return f2bf(lo) | (f2bf(hi) << 16); }
__device__ __forceinline__ float wave_sum(float v) {
#pragma unroll
    for (int o = 1; o < 64; o <<= 1) v += __shfl_xor(v, o);
    return v;
}

constexpr size_t MiB = 1u << 20;
constexpr size_t WS_XN = 1 * MiB;
constexpr size_t WS_QKV = 33 * MiB;
constexpr size_t WS_G = 129 * MiB;
constexpr size_t WS_LOGF = 193 * MiB;
constexpr size_t WS_C = 194 * MiB;
constexpr size_t WS_KMEAN = 195 * MiB;
constexpr size_t WS_SEL = 196 * MiB;
constexpr size_t WS_O = 197 * MiB;
constexpr size_t WS_MERGED = 33 * MiB;
constexpr size_t WS_PQ = 129 * MiB;
constexpr size_t WS_IDX = 97 * MiB;
constexpr size_t WS_GATE = 105 * MiB;

struct P {
    const float *x, *g_mix, *w_in, *b_f, *w_a, *w_b, *w_out, *g_ffn, *w_pq, *sk, *eu, *ev, *g_fin;
    float* out; unsigned char* ws;
};

__device__ __forceinline__ float log_sigmoid(float z) { return z >= 0.f ? -log1pf(expf(-z)) : z - log1pf(expf(z)); }

__device__ void phase_norm1(const P& p) {
    const int lane = threadIdx.x & 63, gw = (blockIdx.x * blockDim.x + threadIdx.x) >> 6, nw = (gridDim.x * blockDim.x) >> 6;
    bf16_t* XN = (bf16_t*)(p.ws + WS_XN); float* LOGF = (float*)(p.ws + WS_LOGF);
    for (int row = gw; row < T; row += nw) {
        const f32x4* xr = (const f32x4*)(p.x + (size_t)row * D);
        f32x4 v[4]; float ss = 0.f;
#pragma unroll
        for (int j = 0; j < 4; ++j) { v[j] = xr[lane + 64 * j]; ss += v[j].x * v[j].x + v[j].y * v[j].y + v[j].z * v[j].z + v[j].w * v[j].w; }
        ss = wave_sum(ss);
        const float rstd = rsqrtf(ss * (1.f / D) + EPS);
        float fs[8];
#pragma unroll
        for (int f = 0; f < 8; ++f) fs[f] = 0.f;
#pragma unroll
        for (int j = 0; j < 4; ++j) {
            const f32x4 g = ((const f32x4*)p.g_mix)[lane + 64 * j];
            v[j].x *= rstd * g.x; v[j].y *= rstd * g.y; v[j].z *= rstd * g.z; v[j].w *= rstd * g.w;
            u32x2 o; o.x = pk2(v[j].x, v[j].y); o.y = pk2(v[j].z, v[j].w);
            *(u32x2*)(XN + (size_t)row * D + 4 * (lane + 64 * j)) = o;
#pragma unroll
            for (int c = 0; c < 4; ++c) {
                const int col = 4 * (lane + 64 * j) + c;
                const f32x4 w0 = *(const f32x4*)(p.w_in + (size_t)col * INC + 3072), w1 = *(const f32x4*)(p.w_in + (size_t)col * INC + 3076);
                const float xv = v[j][c];
                fs[0] += xv * w0.x; fs[1] += xv * w0.y; fs[2] += xv * w0.z; fs[3] += xv * w0.w;
                fs[4] += xv * w1.x; fs[5] += xv * w1.y; fs[6] += xv * w1.z; fs[7] += xv * w1.w;
            }
        }
#pragma unroll
        for (int f = 0; f < 8; ++f) fs[f] = wave_sum(fs[f]);
        float z = fs[0];
#pragma unroll
        for (int f = 1; f < 8; ++f) z = (lane == f) ? fs[f] : z;
        if (lane < 8) LOGF[(size_t)row * 8 + lane] = log_sigmoid(z + p.b_f[lane]);
    }
}

__device__ void phase_cumsum(const P& p) {
    const int lane = threadIdx.x & 63, gw = (blockIdx.x * blockDim.x + threadIdx.x) >> 6;
    if (gw >= Bn * NH) return;
    const int b = gw >> 3, h = gw & 7;
    const float* LOGF = (const float*)(p.ws + WS_LOGF); float* C = (float*)(p.ws + WS_C);
    float carry = 0.f;
    for (int i = 0; i < S / 64; ++i) {
        const int s = i * 64 + lane;
        float v = LOGF[((size_t)b * S + s) * 8 + h];
#pragma unroll
        for (int o = 1; o < 64; o <<= 1) { const float t = __shfl_up(v, o); if (lane >= o) v += t; }
        v += carry;
        C[(size_t)gw * S + s] = v;
        carry = __shfl(v, 63);
    }
}

__device__ __forceinline__ float ldA(const bf16_t* A, size_t i) { return bf2f(A[i]); }
__device__ __forceinline__ float ldA(const float* A, size_t i) { return A[i]; }

template <class AT, class Epi>
__device__ void gemm_naive(float* lds, const AT* A, int lda, const float* Bm, int ldb, int M, int N, int K, const Epi& epi) {
    float* As = lds; float* Bs = lds + 16 * 132;
    const int tid = threadIdx.x, ty = tid >> 4, tx = tid & 15;
    const int ntm = M / 128, ntn = N / 128;
    for (int tile = blockIdx.x; tile < ntm * ntn; tile += gridDim.x) {
        const int tm = tile / ntn, tn = tile % ntn;
        float acc[4][8];
#pragma unroll
        for (int i = 0; i < 4; ++i)
#pragma unroll
            for (int j = 0; j < 8; ++j) acc[i][j] = 0.f;
        for (int k0 = 0; k0 < K; k0 += 16) {
            { const int r = tid >> 2, kk = (tid & 3) * 4; const size_t base = (size_t)(tm * 128 + r) * lda + k0 + kk;
#pragma unroll
              for (int c = 0; c < 4; ++c) As[(kk + c) * 132 + r] = ldA(A, base + c); }
            { const int kk = tid >> 5, c4 = (tid & 31) * 4; const f32x4 bv = *(const f32x4*)(Bm + (size_t)(k0 + kk) * ldb + tn * 128 + c4);
              *(f32x4*)(Bs + kk * 132 + c4) = bv; }
            __syncthreads();
#pragma unroll
            for (int kk = 0; kk < 16; ++kk) {
                const f32x4 a = *(const f32x4*)(As + kk * 132 + ty * 4);
                const f32x4 b0 = *(const f32x4*)(Bs + kk * 132 + tx * 8), b1 = *(const f32x4*)(Bs + kk * 132 + tx * 8 + 4);
#pragma unroll
                for (int i = 0; i < 4; ++i) {
                    acc[i][0] += a[i] * b0.x; acc[i][1] += a[i] * b0.y; acc[i][2] += a[i] * b0.z; acc[i][3] += a[i] * b0.w;
                    acc[i][4] += a[i] * b1.x; acc[i][5] += a[i] * b1.y; acc[i][6] += a[i] * b1.z; acc[i][7] += a[i] * b1.w;
                }
            }
            __syncthreads();
        }
#pragma unroll
        for (int i = 0; i < 4; ++i) epi(tm * 128 + ty * 4 + i, tn * 128 + tx * 8, acc[i]);
    }
}

struct EpiBf16Store { bf16_t* O; int ldo; bool sig;
    __device__ void operator()(int row, int col, const float (&v)[8]) const {
        float w[8];
#pragma unroll
        for (int j = 0; j < 8; ++j) w[j] = sig ? 1.f / (1.f + expf(-v[j])) : v[j];
        u32x4 o; o.x = pk2(w[0], w[1]); o.y = pk2(w[2], w[3]); o.z = pk2(w[4], w[5]); o.w = pk2(w[6], w[7]);
        *(u32x4*)(O + (size_t)row * ldo + col) = o; } };
struct EpiMerge { float* Mg; const bf16_t* G; int goff; bool add;
    __device__ void operator()(int row, int col, const float (&v)[8]) const {
#pragma unroll
        for (int j = 0; j < 8; ++j) { const float g = bf2f(G[(size_t)row * 2048 + goff + col + j]); float* m = Mg + (size_t)row * D + col + j; *m = add ? (*m + g * v[j]) : g * v[j]; } } };
struct EpiResid { const float* X; float* O;
    __device__ void operator()(int row, int col, const float (&v)[8]) const {
#pragma unroll
        for (int j = 0; j < 8; ++j) O[(size_t)row * D + col + j] = X[(size_t)row * D + col + j] + v[j]; } };

__device__ void phase_rope(const P& p) {
    bf16_t* QKV = (bf16_t*)(p.ws + WS_QKV);
    const size_t n = (size_t)T * 16 * 8;
    for (size_t it = (size_t)blockIdx.x * blockDim.x + threadIdx.x; it < n; it += (size_t)gridDim.x * blockDim.x) {
        const int i = it & 7, hh = (it >> 3) & 15, t = (int)(it >> 7);
        const int base = (hh >> 3) * 512 + (hh & 7) * 64;
        const int pos = t & (S - 1);
        const float inv_freq = powf(500000.0f, -(float)i / 8.0f);
        const float ang = (float)pos * inv_freq;
        const float c = cosf(ang), s = sinf(ang);
        bf16_t* r = QKV + (size_t)t * 3072 + base;
        const float x1 = bf2f(r[i]), x2 = bf2f(r[i + 8]);
        r[i] = (bf16_t)f2bf(x1 * c - x2 * s); r[i + 8] = (bf16_t)f2bf(x1 * s + x2 * c);
    }
}

__device__ void phase_kmean(const P& p) {
    const bf16_t* QKV = (const bf16_t*)(p.ws + WS_QKV); float* KM = (float*)(p.ws + WS_KMEAN);
    const int n = Bn * NH * NBLK * HD;
    for (int it = blockIdx.x * blockDim.x + threadIdx.x; it < n; it += gridDim.x * blockDim.x) {
        const int d = it & 63, nb = (it >> 6) & 31, bh = it >> 11, b = bh >> 3, h = bh & 7;
        float s = 0.f;
        for (int r = 0; r < LBLK; ++r) s += bf2f(QKV[((size_t)b * S + nb * LBLK + r) * 3072 + 512 + h * 64 + d]);
        KM[it] = s * (1.f / LBLK);
    }
}
__device__ void phase_gate(const P& p) {
    const bf16_t* QKV = (const bf16_t*)(p.ws + WS_QKV); const float* KM = (const float*)(p.ws + WS_KMEAN); unsigned* SEL = (unsigned*)(p.ws + WS_SEL);
    const int n = Bn * NH * S;
    for (int it = blockIdx.x * blockDim.x + threadIdx.x; it < n; it += gridDim.x * blockDim.x) {
        const int s = it & (S - 1), bh = it >> 13, b = bh >> 3, h = bh & 7, nq = s >> 8;
        float q[64];
        const bf16_t* qr = QKV + ((size_t)b * S + s) * 3072 + h * 64;
#pragma unroll
        for (int d = 0; d < 64; ++d) q[d] = bf2f(qr[d]);
        float v0 = -INFINITY, v1 = -INFINITY, v2 = -INFINITY; int i0 = -1, i1 = -1, i2 = -1;
        for (int nb = 0; nb < nq; ++nb) {
            const float* km = KM + ((size_t)bh * 32 + nb) * 64; float g = 0.f;
#pragma unroll
            for (int d = 0; d < 64; ++d) g += q[d] * km[d];
            if (g > v0) { v2 = v1; i2 = i1; v1 = v0; i1 = i0; v0 = g; i0 = nb; }
            else if (g > v1) { v2 = v1; i2 = i1; v1 = g; i1 = nb; }
            else if (g > v2) { v2 = g; i2 = nb; }
        }
        unsigned m = 0; if (i0 >= 0) m |= 1u << i0; if (i1 >= 0) m |= 1u << i1; if (i2 >= 0) m |= 1u << i2;
        SEL[it] = m;
    }
}

__device__ void phase_moba(const P& p) {
    const bf16_t* QKV = (const bf16_t*)(p.ws + WS_QKV); const unsigned* SEL = (const unsigned*)(p.ws + WS_SEL); bf16_t* O = (bf16_t*)(p.ws + WS_O);
    const int n = Bn * NH * S;
    for (int it = blockIdx.x * blockDim.x + threadIdx.x; it < n; it += gridDim.x * blockDim.x) {
        const int s = it & (S - 1), bh = it >> 13, b = bh >> 3, h = bh & 7, nq = s >> 8;
        float q[64], o[64];
        const bf16_t* qr = QKV + ((size_t)b * S + s) * 3072 + h * 64;
#pragma unroll
        for (int d = 0; d < 64; ++d) { q[d] = bf2f(qr[d]) * 0.125f; o[d] = 0.f; }
        float m = -INFINITY, l = 0.f;
        unsigned mask = SEL[it] | (1u << nq);
        while (mask) {
            const int j = __builtin_ctz(mask); mask &= mask - 1;
            const int kend = (j == nq) ? (s - nq * LBLK + 1) : LBLK;
            for (int kk = 0; kk < kend; ++kk) {
                const bf16_t* kr = QKV + ((size_t)b * S + j * LBLK + kk) * 3072 + 512 + h * 64;
                float sc = 0.f;
#pragma unroll
                for (int d8 = 0; d8 < 8; ++d8) { const u32x4 w = *(const u32x4*)(kr + d8 * 8);
#pragma unroll
                    for (int e = 0; e < 4; ++e) { sc += q[d8 * 8 + 2 * e] * __uint_as_float(w[e] << 16) + q[d8 * 8 + 2 * e + 1] * __uint_as_float(w[e] & 0xffff0000u); } }
                if (sc > m) { const float f = __expf(m - sc); l *= f;
#pragma unroll
                    for (int d = 0; d < 64; ++d) o[d] *= f;
                    m = sc; }
                const float pe = __expf(sc - m); l += pe;
                const bf16_t* vr = kr + 512;
#pragma unroll
                for (int d8 = 0; d8 < 8; ++d8) { const u32x4 w = *(const u32x4*)(vr + d8 * 8);
#pragma unroll
                    for (int e = 0; e < 4; ++e) { o[d8 * 8 + 2 * e] += pe * __uint_as_float(w[e] << 16); o[d8 * 8 + 2 * e + 1] += pe * __uint_as_float(w[e] & 0xffff0000u); } }
            }
        }
        const float rl = 1.f / l;
        bf16_t* orow = O + ((size_t)b * S + s) * D + h * 64;
#pragma unroll
        for (int d8 = 0; d8 < 8; ++d8) { u32x4 w;
#pragma unroll
            for (int e = 0; e < 4; ++e) w[e] = pk2(o[d8 * 8 + 2 * e] * rl, o[d8 * 8 + 2 * e + 1] * rl);
            *(u32x4*)(orow + d8 * 8) = w; }
    }
}

__device__ void phase_fox(float* lds, const P& p) {
    const bf16_t* QKV = (const bf16_t*)(p.ws + WS_QKV); const float* C = (const float*)(p.ws + WS_C); bf16_t* O = (bf16_t*)(p.ws + WS_O);
    float* Ks = lds; float* Vs = lds + 64 * 64; float* Cs = lds + 2 * 64 * 64;
    const int tid = threadIdx.x;
    const int nunits = Bn * NH * (S / 512);
    for (int uu = blockIdx.x; uu < nunits; uu += gridDim.x) {
        const int u = nunits - 1 - uu;
        const int qc = u / (Bn * NH), bh = u % (Bn * NH), b = bh >> 3, h = bh & 7;
        const int s = qc * 512 + tid;
        float q[64], o[64];
        const bf16_t* qr = QKV + ((size_t)b * S + s) * 3072 + 1536 + h * 64;
#pragma unroll
        for (int d = 0; d < 64; ++d) { q[d] = bf2f(qr[d]) * 0.125f; o[d] = 0.f; }
        const float cq = C[(size_t)bh * S + s];
        float m = -INFINITY, l = 0.f;
        const int ntile = (qc + 1) * 8;
        for (int t = 0; t < ntile; ++t) {
            __syncthreads();
            { const int r = tid >> 3, ch = tid & 7; const bf16_t* kr = QKV + ((size_t)b * S + t * 64 + r) * 3072 + 2048 + h * 64 + ch * 8;
              const u32x4 kw = *(const u32x4*)kr, vw = *(const u32x4*)(kr + 512);
#pragma unroll
              for (int e = 0; e < 4; ++e) { Ks[r * 64 + ch * 8 + 2 * e] = __uint_as_float(kw[e] << 16); Ks[r * 64 + ch * 8 + 2 * e + 1] = __uint_as_float(kw[e] & 0xffff0000u);
                  Vs[r * 64 + ch * 8 + 2 * e] = __uint_as_float(vw[e] << 16); Vs[r * 64 + ch * 8 + 2 * e + 1] = __uint_as_float(vw[e] & 0xffff0000u); }
              if (tid < 64) Cs[tid] = C[(size_t)bh * S + t * 64 + tid]; }
            __syncthreads();
            for (int kk = 0; kk < 64; ++kk) {
                const int kpos = t * 64 + kk;
                if (kpos > qc * 512 + 511) break;
                float sc = 0.f;
#pragma unroll
                for (int d4 = 0; d4 < 16; ++d4) { const f32x4 kv = *(const f32x4*)(Ks + kk * 64 + d4 * 4); sc += q[d4 * 4] * kv.x + q[d4 * 4 + 1] * kv.y + q[d4 * 4 + 2] * kv.z + q[d4 * 4 + 3] * kv.w; }
                sc += cq - Cs[kk];
                if (kpos <= s) {
                    if (sc > m) { const float f = __expf(m - sc); l *= f;
#pragma unroll
                        for (int d = 0; d < 64; ++d) o[d] *= f;
                        m = sc; }
                    const float pe = __expf(sc - m); l += pe;
#pragma unroll
                    for (int d4 = 0; d4 < 16; ++d4) { const f32x4 vv = *(const f32x4*)(Vs + kk * 64 + d4 * 4); o[d4 * 4] += pe * vv.x; o[d4 * 4 + 1] += pe * vv.y; o[d4 * 4 + 2] += pe * vv.z; o[d4 * 4 + 3] += pe * vv.w; }
                }
            }
        }
        const float rl = 1.f / l;
        bf16_t* orow = O + ((size_t)b * S + s) * D + 512 + h * 64;
#pragma unroll
        for (int d8 = 0; d8 < 8; ++d8) { u32x4 w;
#pragma unroll
            for (int e = 0; e < 4; ++e) w[e] = pk2(o[d8 * 8 + 2 * e] * rl, o[d8 * 8 + 2 * e + 1] * rl);
            *(u32x4*)(orow + d8 * 8) = w; }
    }
}

__device__ void phase_norm2(const P& p) {
    const int lane = threadIdx.x & 63, gw = (blockIdx.x * blockDim.x + threadIdx.x) >> 6, nw = (gridDim.x * blockDim.x) >> 6;
    bf16_t* XN = (bf16_t*)(p.ws + WS_XN);
    for (int row = gw; row < T; row += nw) {
        const f32x4* xr = (const f32x4*)(p.out + (size_t)row * D);
        f32x4 v[4]; float ss = 0.f;
#pragma unroll
        for (int j = 0; j < 4; ++j) { v[j] = xr[lane + 64 * j]; ss += v[j].x * v[j].x + v[j].y * v[j].y + v[j].z * v[j].z + v[j].w * v[j].w; }
        ss = wave_sum(ss);
        const float rstd = rsqrtf(ss * (1.f / D) + EPS);
#pragma unroll
        for (int j = 0; j < 4; ++j) {
            const f32x4 g = ((const f32x4*)p.g_ffn)[lane + 64 * j];
            u32x2 o; o.x = pk2(v[j].x * rstd * g.x, v[j].y * rstd * g.y); o.y = pk2(v[j].z * rstd * g.z, v[j].w * rstd * g.w);
            *(u32x2*)(XN + (size_t)row * D + 4 * (lane + 64 * j)) = o;
        }
    }
}

__device__ void phase_peer_topk(float* lds, const P& p) {
    const int lane = threadIdx.x & 63, wib = threadIdx.x >> 6, gw = (blockIdx.x * blockDim.x + threadIdx.x) >> 6, nw = (gridDim.x * blockDim.x) >> 6;
    const bf16_t* PQ = (const bf16_t*)(p.ws + WS_PQ); int* IDX = (int*)(p.ws + WS_IDX); float* GATE = (float*)(p.ws + WS_GATE);
    float* wl = lds + wib * 64;
    for (int it = gw; it < T * PH; it += nw) {
        const int t = it >> 3, h = it & 7;
        float sc[2][2];
#pragma unroll
        for (int pp = 0; pp < 2; ++pp) {
            const bf16_t* qr = PQ + (size_t)t * PQC + h * 256 + pp * 128;
#pragma unroll
            for (int half = 0; half < 2; ++half) {
                const int nn = lane + 64 * half;
                const float* kr = p.sk + ((size_t)(h * 2 + pp) * PNK + nn) * PHALF;
                float a = 0.f;
                for (int d = 0; d < PHALF; d += 4) { const f32x4 kv = *(const f32x4*)(kr + d); a += bf2f(qr[d]) * kv.x + bf2f(qr[d + 1]) * kv.y + bf2f(qr[d + 2]) * kv.z + bf2f(qr[d + 3]) * kv.w; }
                sc[pp][half] = a;
            }
        }
#pragma unroll
        for (int pp = 0; pp < 2; ++pp) {
            float v0 = sc[pp][0], v1 = sc[pp][1];
            for (int r = 0; r < PK; ++r) {
                float bv; int bi; if (v0 >= v1) { bv = v0; bi = lane; } else { bv = v1; bi = lane + 64; }
#pragma unroll
                for (int o = 32; o >= 1; o >>= 1) { const float ov = __shfl_xor(bv, o); const int oi = __shfl_xor(bi, o); if (ov > bv || (ov == bv && oi < bi)) { bv = ov; bi = oi; } }
                if (lane == 0) { wl[pp * 16 + r] = bv; wl[32 + pp * 16 + r] = __int_as_float(bi); }
                if (bi == lane) v0 = -INFINITY; if (bi == lane + 64) v1 = -INFINITY;
            }
        }
        __builtin_amdgcn_s_waitcnt(0xc07f);
        float cv[4];
        { const int i = lane >> 2;
#pragma unroll
          for (int k = 0; k < 4; ++k) cv[k] = wl[i] + wl[16 + (lane & 3) * 4 + k]; }
        float best0 = 0.f, sum = 0.f, mybest = 0.f; int myidx = 0;
        for (int r = 0; r < PK; ++r) {
            float bv = cv[0]; int bi = 4 * lane;
#pragma unroll
            for (int k = 1; k < 4; ++k) if (cv[k] > bv) { bv = cv[k]; bi = 4 * lane + k; }
#pragma unroll
            for (int o = 32; o >= 1; o >>= 1) { const float ov = __shfl_xor(bv, o); const int oi = __shfl_xor(bi, o); if (ov > bv || (ov == bv && oi < bi)) { bv = ov; bi = oi; } }
            if (r == 0) best0 = bv;
            sum += __expf(bv - best0);
            if (lane == r) { mybest = bv; myidx = __float_as_int(wl[32 + (bi >> 4)]) * PNK + __float_as_int(wl[48 + (bi & 15)]); }
            if ((bi >> 2) == lane) {
#pragma unroll
                for (int k = 0; k < 4; ++k) if ((bi & 3) == k) cv[k] = -INFINITY; }
        }
        if (lane < PK) { IDX[(size_t)it * PK + lane] = myidx; GATE[(size_t)it * PK + lane] = __expf(mybest - best0) / sum; }
        __builtin_amdgcn_s_waitcnt(0xc07f);
    }
}

__device__ __forceinline__ float gelu_exact(float x) { return 0.5f * x * (1.f + erff(x * 0.70710678118654752f)); }
__device__ void phase_experts(const P& p) {
    const int lane = threadIdx.x & 63, gw = (blockIdx.x * blockDim.x + threadIdx.x) >> 6, nw = (gridDim.x * blockDim.x) >> 6;
    const bf16_t* XN = (const bf16_t*)(p.ws + WS_XN); const int* IDX = (const int*)(p.ws + WS_IDX); const float* GATE = (const float*)(p.ws + WS_GATE);
    for (int t = gw; t < T; t += nw) {
        f32x4 xr[4], acc[4];
#pragma unroll
        for (int j = 0; j < 4; ++j) { const u32x2 w = *(const u32x2*)(XN + (size_t)t * D + 4 * (lane + 64 * j));
            xr[j].x = __uint_as_float(w.x << 16); xr[j].y = __uint_as_float(w.x & 0xffff0000u); xr[j].z = __uint_as_float(w.y << 16); xr[j].w = __uint_as_float(w.y & 0xffff0000u);
            acc[j] = (f32x4){0.f, 0.f, 0.f, 0.f}; }
        for (int k = 0; k < PH * PK; k += 2) {
            const int e0 = IDX[(size_t)t * 128 + k], e1 = IDX[(size_t)t * 128 + k + 1];
            const float g0 = GATE[(size_t)t * 128 + k], g1 = GATE[(size_t)t * 128 + k + 1];
            const f32x4* u0 = (const f32x4*)(p.eu + (size_t)e0 * D); const f32x4* u1 = (const f32x4*)(p.eu + (size_t)e1 * D);
            const f32x4* w0 = (const f32x4*)(p.ev + (size_t)e0 * D); const f32x4* w1 = (const f32x4*)(p.ev + (size_t)e1 * D);
            f32x4 a0[4], a1[4], b0[4], b1[4];
#pragma unroll
            for (int j = 0; j < 4; ++j) { a0[j] = u0[lane + 64 * j]; a1[j] = u1[lane + 64 * j]; b0[j] = w0[lane + 64 * j]; b1[j] = w1[lane + 64 * j]; }
            float d0 = 0.f, d1 = 0.f;
#pragma unroll
            for (int j = 0; j < 4; ++j) { d0 += xr[j].x * a0[j].x + xr[j].y * a0[j].y + xr[j].z * a0[j].z + xr[j].w * a0[j].w; d1 += xr[j].x * a1[j].x + xr[j].y * a1[j].y + xr[j].z * a1[j].z + xr[j].w * a1[j].w; }
            d0 = wave_sum(d0); d1 = wave_sum(d1);
            const float c0 = g0 * gelu_exact(d0), c1 = g1 * gelu_exact(d1);
#pragma unroll
            for (int j = 0; j < 4; ++j) acc[j] += c0 * b0[j] + c1 * b1[j];
        }
        f32x4* orow = (f32x4*)(p.out + (size_t)t * D);
        float ss = 0.f;
#pragma unroll
        for (int j = 0; j < 4; ++j) { acc[j] += orow[lane + 64 * j]; ss += acc[j].x * acc[j].x + acc[j].y * acc[j].y + acc[j].z * acc[j].z + acc[j].w * acc[j].w; }
        ss = wave_sum(ss);
        const float rstd = rsqrtf(ss * (1.f / D) + EPS);
#pragma unroll
        for (int j = 0; j < 4; ++j) { const f32x4 g = ((const f32x4*)p.g_fin)[lane + 64 * j]; f32x4 o = acc[j] * rstd; o.x *= g.x; o.y *= g.y; o.z *= g.z; o.w *= g.w; orow[lane + 64 * j] = o; }
    }
}

constexpr int NT = 512;
__global__ void __launch_bounds__(NT) k_norm1(P p) { phase_norm1(p); }
__global__ void __launch_bounds__(NT) k_cumsum(P p) { phase_cumsum(p); }
__global__ void __launch_bounds__(NT) k_gemm_qkv(P p) { __shared__ float lds[2 * 16 * 132];
    gemm_naive(lds, (const bf16_t*)(p.ws + WS_XN), D, p.w_in, INC, T, 3072, D, EpiBf16Store{(bf16_t*)(p.ws + WS_QKV), 3072, false}); }
__global__ void __launch_bounds__(NT) k_gemm_g(P p) { __shared__ float lds[2 * 16 * 132];
    gemm_naive(lds, (const bf16_t*)(p.ws + WS_XN), D, p.w_in + 3080, INC, T, 2048, D, EpiBf16Store{(bf16_t*)(p.ws + WS_G), 2048, true}); }
__global__ void __launch_bounds__(NT) k_rope(P p) { phase_rope(p); }
__global__ void __launch_bounds__(NT) k_kmean(P p) { phase_kmean(p); }
__global__ void __launch_bounds__(NT) k_gate(P p) { phase_gate(p); }
__global__ void __launch_bounds__(NT) k_moba(P p) { phase_moba(p); }
__global__ void __launch_bounds__(NT) k_fox(P p) { __shared__ float lds[2 * 64 * 64 + 64]; phase_fox(lds, p); }
__global__ void __launch_bounds__(NT) k_gemm_a(P p) { __shared__ float lds[2 * 16 * 132];
    gemm_naive(lds, (const bf16_t*)(p.ws + WS_O), D, p.w_a, D, T, D, 512, EpiMerge{(float*)(p.ws + WS_MERGED), (const bf16_t*)(p.ws + WS_G), 0, false}); }
__global__ void __launch_bounds__(NT) k_gemm_b(P p) { __shared__ float lds[2 * 16 * 132];
    gemm_naive(lds, (const bf16_t*)(p.ws + WS_O) + 512, D, p.w_b, D, T, D, 512, EpiMerge{(float*)(p.ws + WS_MERGED), (const bf16_t*)(p.ws + WS_G), 1024, true}); }
__global__ void __launch_bounds__(NT) k_gemm_out(P p) { __shared__ float lds[2 * 16 * 132];
    gemm_naive(lds, (const float*)(p.ws + WS_MERGED), D, p.w_out, D, T, D, D, EpiResid{p.x, p.out}); }
__global__ void __launch_bounds__(NT) k_norm2(P p) { phase_norm2(p); }
__global__ void __launch_bounds__(NT) k_gemm_pq(P p) { __shared__ float lds[2 * 16 * 132];
    gemm_naive(lds, (const bf16_t*)(p.ws + WS_XN), D, p.w_pq, PQC, T, PQC, D, EpiBf16Store{(bf16_t*)(p.ws + WS_PQ), PQC, false}); }
__global__ void __launch_bounds__(NT) k_peer_topk(P p) { __shared__ float lds[8 * 64]; phase_peer_topk(lds, p); }
__global__ void __launch_bounds__(NT) k_experts(P p) { phase_experts(p); }

extern "C" void kernel_launch(void* const* d_in, const int* in_sizes, int n_in, void* d_out, int out_size, void* d_ws, size_t ws_size, hipStream_t stream) {
    P p{};
    p.x = (const float*)d_in[0]; p.g_mix = (const float*)d_in[1]; p.w_in = (const float*)d_in[2]; p.b_f = (const float*)d_in[3];
    p.w_a = (const float*)d_in[4]; p.w_b = (const float*)d_in[5]; p.w_out = (const float*)d_in[6]; p.g_ffn = (const float*)d_in[7];
    p.w_pq = (const float*)d_in[8]; p.sk = (const float*)d_in[9]; p.eu = (const float*)d_in[10]; p.ev = (const float*)d_in[11]; p.g_fin = (const float*)d_in[12];
    p.out = (float*)d_out; p.ws = (unsigned char*)d_ws;
    const dim3 blk(NT); const int G = 1024;
    k_norm1<<<G, blk, 0, stream>>>(p);
    k_cumsum<<<2, blk, 0, stream>>>(p);
    k_gemm_qkv<<<G, blk, 0, stream>>>(p);
    k_gemm_g<<<G, blk, 0, stream>>>(p);
    k_rope<<<G, blk, 0, stream>>>(p);
    k_kmean<<<64, blk, 0, stream>>>(p);
    k_gate<<<256, blk, 0, stream>>>(p);
    k_moba<<<256, blk, 0, stream>>>(p);
    k_fox<<<256, blk, 0, stream>>>(p);
    k_gemm_a<<<G, blk, 0, stream>>>(p);
    k_gemm_b<<<G, blk, 0, stream>>>(p);
    k_gemm_out<<<G, blk, 0, stream>>>(p);
    k_norm2<<<G, blk, 0, stream>>>(p);
    k_gemm_pq<<<G, blk, 0, stream>>>(p);
    k_peer_topk<<<G, blk, 0, stream>>>(p);
    k_experts<<<G, blk, 0, stream>>>(p);
}
```

```cpp
#include <hip/hip_runtime.h>
#include <cstdio>
#include <cstdint>
#include <cmath>

constexpr int Bn = 2, S = 8192, D = 1024, T = Bn * S;
constexpr int HD = 64, NH = 8;
constexpr int INC = 5128;
constexpr int LBLK = 256, NBLK = S / LBLK;
constexpr int PH = 8, PNK = 128, PHALF = 128, PK = 16, PQC = PH * 2 * PHALF;
constexpr float EPS = 1e-6f;
constexpr float LOG2E = 1.4426950408889634f;
constexpr float C2 = 0.125f * LOG2E;

typedef unsigned short bf16_t;
typedef float f32x4 __attribute__((ext_vector_type(4)));
typedef unsigned u32x2 __attribute__((ext_vector_type(2)));
typedef unsigned u32x4 __attribute__((ext_vector_type(4)));
#define LAS __attribute__((address_space(3)))

__device__ __forceinline__ float bf2f(bf16_t v) { return __uint_as_float((unsigned)v << 16); }
__device__ __forceinline__ unsigned f2bf(float f) { unsigned u = __float_as_uint(f); return (u + 0x7fffu + ((u >> 16) & 1u)) >> 16; }
__device__ __forceinline__ unsigned pk2(float lo, float hi) { return f2bf(lo) | (f2bf(hi) << 16); }
#define WS_DPP(v, ctrl) ((v) + __builtin_bit_cast(float, __builtin_amdgcn_update_dpp(0, __builtin_bit_cast(int, (v)), (ctrl), 0xf, 0xf, true)))
#define WM_DPP(v, ctrl) fmaxf((v), __builtin_bit_cast(float, __builtin_amdgcn_update_dpp(0, __builtin_bit_cast(int, (v)), (ctrl), 0xf, 0xf, true)))
__device__ __forceinline__ float wave_sum_fast(float v) {
    v = WS_DPP(v, 0xB1); v = WS_DPP(v, 0x4E); v = WS_DPP(v, 0x141); v = WS_DPP(v, 0x140);
    const int iv = __builtin_bit_cast(int, v);
    return (__builtin_bit_cast(float, __builtin_amdgcn_readlane(iv, 0)) + __builtin_bit_cast(float, __builtin_amdgcn_readlane(iv, 16))) + (__builtin_bit_cast(float, __builtin_amdgcn_readlane(iv, 32)) + __builtin_bit_cast(float, __builtin_amdgcn_readlane(iv, 48)));
}
__device__ __forceinline__ float wave_max_fast(float v) {
    v = WM_DPP(v, 0xB1); v = WM_DPP(v, 0x4E); v = WM_DPP(v, 0x141); v = WM_DPP(v, 0x140);
    const int iv = __builtin_bit_cast(int, v);
    return fmaxf(fmaxf(__builtin_bit_cast(float, __builtin_amdgcn_readlane(iv, 0)), __builtin_bit_cast(float, __builtin_amdgcn_readlane(iv, 16))), fmaxf(__builtin_bit_cast(float, __builtin_amdgcn_readlane(iv, 32)), __builtin_bit_cast(float, __builtin_amdgcn_readlane(iv, 48))));
}
__device__ __forceinline__ int otid() { int t = threadIdx.x; asm volatile("" : "+v"(t)); return t; }

constexpr size_t MiB = 1u << 20, KiB = 1u << 10;
constexpr size_t CTL_ZERO_BYTES = 65536;
constexpr size_t WS_ROPE = 1 * MiB;
constexpr size_t WS_C = 1 * MiB + 512 * KiB;
constexpr size_t WS_LOGF = 2 * MiB;
constexpr size_t WS_KMP = 2 * MiB + 512 * KiB;
constexpr size_t WS_MCNT = 40 * KiB;
constexpr size_t WS_FKN = 2 * MiB + 768 * KiB;
constexpr size_t WS_FQN = WS_FKN + 32 * KiB;
constexpr size_t WS_MG1 = 44 * KiB;
constexpr size_t WS_SEL3 = 4 * MiB + 512 * KiB;
constexpr size_t WS_MLIST = 5 * MiB;
constexpr size_t WS_MLSE = 13 * MiB;
constexpr size_t WS_MP2 = 23 * MiB, WS_MP3 = 39 * MiB;
constexpr size_t WS_MP0 = 215 * MiB, WS_MP1 = 231 * MiB;
constexpr size_t WS_WSUM = 3 * MiB;
constexpr size_t WS_WIN = 5 * MiB;
constexpr size_t WS_WA = 15 * MiB, WS_WB = 16 * MiB;
constexpr size_t WS_WOUT = 17 * MiB;
constexpr size_t WS_WPQ = 19 * MiB;
constexpr size_t WS_XN = 23 * MiB;
constexpr size_t WS_QKV = 55 * MiB;
constexpr size_t SLOT = (size_t)T * 512;
constexpr size_t WS_G = 151 * MiB;
constexpr size_t WS_MERGED = 215 * MiB;
constexpr size_t WS_PQ = 151 * MiB;
constexpr size_t WS_IDX = 215 * MiB;
constexpr size_t WS_GATE = 223 * MiB;
constexpr size_t WS_SK = 247 * MiB;
constexpr size_t WS_RSSP = 3 * MiB + 512 * KiB;
constexpr size_t WS_EU = 87 * MiB;
constexpr size_t WS_EV = 103 * MiB;
constexpr size_t ESLICE = (size_t)16384 * 128;
constexpr size_t WS_A = 231 * MiB;
constexpr size_t WS_H8 = 55 * MiB;
constexpr size_t WS_HSC = 71 * MiB;
constexpr size_t WS_USC = 119 * MiB;
constexpr size_t WS_VSC = 119 * MiB + 64 * KiB;

struct P {
    const float *x, *g_mix, *w_in, *b_f, *w_a, *w_b, *w_out, *g_ffn, *w_pq, *sk, *eu, *ev, *g_fin;
    float* out; unsigned char* ws;
};

namespace pg8 {
#define PG8_LAS __attribute__((address_space(3)))
typedef unsigned short bf16_t;
typedef short bf16x8 __attribute__((ext_vector_type(8)));
typedef int i32x4 __attribute__((ext_vector_type(4))); typedef int i32x8 __attribute__((ext_vector_type(8)));
typedef float f32x4 __attribute__((ext_vector_type(4)));
typedef unsigned u32x4 __attribute__((ext_vector_type(4)));
constexpr int BM = 256, BK = 64, HALF = 128, HTB = HALF * BK * 2  , STAGE_BYTES = 8 * HTB, NXCD = 8, WGM = 8;

__host__ __device__ __forceinline__ int lds_byte(int r, int c) { const int st = (r >> 4) * 2 + (c >> 5), rr = r & 15, cc = c & 31, ob = rr * 64 + cc * 2; return st * 1024 + (ob ^ (((ob >> 9) & 1) << 5)); }
__host__ __device__ __forceinline__ void stage_rc(int b, int& R, int& C) { const int st = b / 1024, sb = b % 1024, swz = sb ^ (((sb >> 9) & 1) << 5); R = (st >> 1) * 16 + swz / 64; C = (st & 1) * 32 + (swz % 64) / 2; }
__host__ __device__ __forceinline__ int perm32(int rho) { const int n = rho >> 4, i = rho & 15; return 8 * (i >> 2) + 4 * n + (i & 3); }

struct Unit { int pm, pn; };
struct Gemm { const bf16_t* A; const bf16_t* Bt; int M, N, K; };

struct StaticOrder {
    int nM, nN, nwg, G, c;
    __host__ __device__ void init(int M, int N, int G_, int c_) { nM = M / BM; nN = N / BM; nwg = nM * nN; G = G_; c = c_; }
    __host__ __device__ bool next(int i, Unit& u) const {
        const long L = (long)i * G + c; if (L >= nwg) return false;
        int wgid = (int)L; { const int q = nwg / NXCD, r = nwg % NXCD, xcd = wgid % NXCD, off = wgid / NXCD; wgid = (xcd < r ? xcd * (q + 1) : r * (q + 1) + (xcd - r) * q) + off; }
        const int nig = WGM * nN, gid = wgid / nig, fm = gid * WGM, gsz = (nM - fm) < WGM ? (nM - fm) : WGM;
        u.pm = fm + ((wgid % nig) % gsz); u.pn = (wgid % nig) / gsz; return true;
    }
    __device__ __forceinline__ void a_ready(const Unit&) const {}
    __device__ __forceinline__ void done(const Unit&) const {}
};

__device__ __forceinline__ unsigned cvt_pk_bf16(float lo, float hi) { unsigned r; asm volatile("v_cvt_pk_bf16_f32 %0, %1, %2" : "=v"(r) : "v"(lo), "v"(hi)); return r; }

typedef float f32x2_t __attribute__((ext_vector_type(2))); typedef __bf16 bf16x2_t __attribute__((ext_vector_type(2)));
__device__ __forceinline__ unsigned cvtpk_c(float lo, float hi) { f32x2_t v = {lo, hi}; bf16x2_t b = __builtin_convertvector(v, bf16x2_t); return __builtin_bit_cast(unsigned, b); }
__device__ __forceinline__ u32x4 pack8(const f32x4& v0, const f32x4& v1) { u32x4 w; w.x = cvtpk_c(v0[0], v0[1]); w.y = cvtpk_c(v0[2], v0[3]); w.z = cvtpk_c(v1[0], v1[1]); w.w = cvtpk_c(v1[2], v1[3]); return w; }
__device__ __forceinline__ void unpack8(const u32x4& w, f32x4& v0, f32x4& v1) {
    v0[0] = __uint_as_float(w.x << 16); v0[1] = __uint_as_float(w.x & 0xffff0000u); v0[2] = __uint_as_float(w.y << 16); v0[3] = __uint_as_float(w.y & 0xffff0000u);
    v1[0] = __uint_as_float(w.z << 16); v1[1] = __uint_as_float(w.z & 0xffff0000u); v1[2] = __uint_as_float(w.w << 16); v1[3] = __uint_as_float(w.w & 0xffff0000u); }

struct EpiProj {
    static constexpr bool PERM = true, AFTER_DRAIN = false;
    bf16_t* QKV; bf16_t* G; const float* ROPE; float* KMP; float* FKN; float* FQN;
    __device__ __forceinline__ void operator()(const f32x4 (&acc)[2][2][4][2], const Unit& u, int wr, int wc, int fr, int fq) const {
        const int pn = u.pn, row0 = u.pm * BM + wr * 64 + fr;
        if (pn < 12) {
            const int typ = pn >> 1;
            const int slot = (typ == 0) ? 0 : (typ == 3) ? 1 : (typ < 3) ? typ + 1 : typ;
            bf16_t* base = QKV + (size_t)slot * ((size_t)16384 * 512);
            const int colt = (pn & 1) * 256, col0 = colt + wc * 32 + 8 * fq;
            const float sc = (typ == 0 || typ == 3) ? 0.18033688011112042f : 1.0f;
            const bool rope = (typ < 2) && ((wc & 1) == 0);
            const float sgn = (fq == 0) ? -1.f : 1.f; const bool rl = fq < 2;
            f32x4 ks[2][2];
#pragma unroll
            for (int bj = 0; bj < 2; ++bj) { ks[bj][0] = (f32x4){0.f, 0.f, 0.f, 0.f}; ks[bj][1] = (f32x4){0.f, 0.f, 0.f, 0.f}; }
            const bool nrm = (typ == 3 || typ == 4);
            float nmx[2][2] = {{0.f, 0.f}, {0.f, 0.f}};
#pragma unroll
            for (int ai = 0; ai < 2; ++ai)
#pragma unroll
                for (int m = 0; m < 4; ++m) {
                    const int row = row0 + ai * HALF + m * 16;
                    f32x4 c0 = (f32x4){1.f, 1.f, 1.f, 1.f}, c1 = c0, s0 = (f32x4){0.f, 0.f, 0.f, 0.f}, s1 = s0;
                    if (rope) { const f32x4* rp = (const f32x4*)(ROPE + (size_t)(row & 8191) * 16); c0 = rp[0]; c1 = rp[1]; s0 = rp[2]; s1 = rp[3]; }
#pragma unroll
                    for (int bj = 0; bj < 2; ++bj) {
                        f32x4 v0 = acc[ai][bj][m][0], v1 = acc[ai][bj][m][1];
                        if (rope) {
                            f32x4 p0, p1;
#pragma unroll
                            for (int e = 0; e < 4; ++e) { p0[e] = __shfl_xor(v0[e], 16); p1[e] = __shfl_xor(v1[e], 16); }
                            if (rl) { v0 = v0 * c0 + sgn * (p0 * s0); v1 = v1 * c1 + sgn * (p1 * s1); }
                        }
                        if (typ == 1) { ks[bj][0] += v0; ks[bj][1] += v1; }
                        v0 = v0 * sc; v1 = v1 * sc;
                        *(u32x4*)(base + (size_t)row * 512 + col0 + bj * HALF) = pack8(v0, v1);
                        if (nrm) { float ss = ((v0[0] * v0[0] + v0[1] * v0[1]) + (v0[2] * v0[2] + v0[3] * v0[3])) + ((v1[0] * v1[0] + v1[1] * v1[1]) + (v1[2] * v1[2] + v1[3] * v1[3]));
                            { const auto r_ = __builtin_amdgcn_permlane16_swap(__float_as_uint(ss), __float_as_uint(ss), false, false); ss = __uint_as_float(r_[0]) + __uint_as_float(r_[1]); }
                            { const auto r_ = __builtin_amdgcn_permlane32_swap(__float_as_uint(ss), __float_as_uint(ss), false, false); ss = __uint_as_float(r_[0]) + __uint_as_float(r_[1]); }
                            nmx[ai][bj] = fmaxf(nmx[ai][bj], ss); }
                    }
                }
            if (nrm) {
                const int b = u.pm >> 5, nb = u.pm & 31;
#pragma unroll
                for (int bj = 0; bj < 2; ++bj) { const int head = (colt + 128 * bj + 32 * wc) >> 6;
                    float a0 = nmx[0][bj], a1 = nmx[1][bj];
                    a0 = WM_DPP(a0, 0xB1); a0 = WM_DPP(a0, 0x4E); a0 = WM_DPP(a0, 0x141); a0 = WM_DPP(a0, 0x140); a1 = WM_DPP(a1, 0xB1); a1 = WM_DPP(a1, 0x4E); a1 = WM_DPP(a1, 0x141); a1 = WM_DPP(a1, 0x140);
                    if (fr == 0 && fq == 0) {
                        if (typ == 4) { float* d = FKN + ((size_t)(b * 8 + head) * 128 + 4 * nb + wr) * 2 + (wc & 1); d[0] = a0; d[4] = a1; }
                        else FQN[(((size_t)(b * 8 + head) * 32 + nb) * 2 + wr) * 2 + (wc & 1)] = fmaxf(a0, a1); } }
            }
            if (typ == 1) {
#pragma unroll
                for (int bj = 0; bj < 2; ++bj)
#pragma unroll
                    for (int n = 0; n < 2; ++n)
#pragma unroll
                        for (int e = 0; e < 4; ++e) { float v = ks[bj][n][e]; v = WS_DPP(v, 0xB1); v = WS_DPP(v, 0x4E); v = WS_DPP(v, 0x141); v = WS_DPP(v, 0x140); ks[bj][n][e] = v; }
                if (fr == 0) {
                    const int b = u.pm >> 5, nb = u.pm & 31;
#pragma unroll
                    for (int bj = 0; bj < 2; ++bj) { const int head = (colt + 128 * bj + 32 * wc) >> 6, d = 32 * (wc & 1) + 8 * fq;
                        float* dst = KMP + ((((size_t)wr * 16 + b * 8 + head) * 32 + nb) * 64 + d); *(f32x4*)dst = ks[bj][0]; *(f32x4*)(dst + 4) = ks[bj][1]; }
                }
            }
        } else {
            const int gi = pn - 12; bf16_t* base = G + (size_t)(gi >> 2) * ((size_t)16384 * 1024);
            const int col0 = (gi & 3) * 256 + wc * 32 + 8 * fq;
#pragma unroll
            for (int ai = 0; ai < 2; ++ai)
#pragma unroll
                for (int m = 0; m < 4; ++m) { const int row = row0 + ai * HALF + m * 16;
#pragma unroll
                    for (int bj = 0; bj < 2; ++bj) { f32x4 v0 = acc[ai][bj][m][0], v1 = acc[ai][bj][m][1];
#pragma unroll
                        for (int e = 0; e < 4; ++e) { v0[e] = __builtin_amdgcn_rcpf(1.f + __builtin_amdgcn_exp2f(-1.4426950408889634f * v0[e])); v1[e] = __builtin_amdgcn_rcpf(1.f + __builtin_amdgcn_exp2f(-1.4426950408889634f * v1[e])); }
                        *(u32x4*)(base + (size_t)row * 1024 + col0 + bj * HALF) = pack8(v0, v1); } }
        }
    }
};
struct EpiMerge {
    static constexpr bool PERM = true, AFTER_DRAIN = false;
    bf16_t* Mg; const bf16_t* Gt; bool first;
    __device__ __forceinline__ void operator()(const f32x4 (&acc)[2][2][4][2], const Unit& u, int wr, int wc, int fr, int fq) const {
        const int row0 = u.pm * BM + wr * 64 + fr, col0 = u.pn * BM + wc * 32 + 8 * fq;
#pragma unroll
        for (int ai = 0; ai < 2; ++ai)
#pragma unroll
            for (int m = 0; m < 4; ++m) { const size_t off = (size_t)(row0 + ai * HALF + m * 16) * 1024 + col0;
#pragma unroll
                for (int bj = 0; bj < 2; ++bj) { f32x4 g0, g1; unpack8(*(const u32x4*)(Gt + off + bj * HALF), g0, g1);
                    f32x4 v0 = g0 * acc[ai][bj][m][0], v1 = g1 * acc[ai][bj][m][1];
                    if (!first) { f32x4 o0, o1; unpack8(*(const u32x4*)(Mg + off + bj * HALF), o0, o1); v0 += o0; v1 += o1; }
                    *(u32x4*)(Mg + off + bj * HALF) = pack8(v0, v1); } }
    }
};
struct EpiOut {
    static constexpr bool PERM = true, AFTER_DRAIN = false;
    const float* X; float* O; bf16_t* Hb; float* RSSP;
    __device__ __forceinline__ void operator()(const f32x4 (&acc)[2][2][4][2], const Unit& u, int wr, int wc, int fr, int fq) const {
        const int row0 = u.pm * BM + wr * 64 + fr, col0 = u.pn * BM + wc * 32 + 8 * fq;
#pragma unroll
        for (int ai = 0; ai < 2; ++ai)
#pragma unroll
            for (int m = 0; m < 4; ++m) { const int row = row0 + ai * HALF + m * 16; const size_t off = (size_t)row * 1024 + col0; float ss = 0.f;
#pragma unroll
                for (int bj = 0; bj < 2; ++bj) { const f32x4 x0 = *(const f32x4*)(X + off + bj * HALF), x1 = *(const f32x4*)(X + off + bj * HALF + 4);
                    const f32x4 h0 = x0 + acc[ai][bj][m][0], h1 = x1 + acc[ai][bj][m][1];
                    *(u32x4*)(Hb + off + bj * HALF) = pack8(h0, h1);
                    ss += (h0[0] * h0[0] + h0[1] * h0[1]) + (h0[2] * h0[2] + h0[3] * h0[3]) + (h1[0] * h1[0] + h1[1] * h1[1]) + (h1[2] * h1[2] + h1[3] * h1[3]); }
                ss += __shfl_xor(ss, 16); ss += __shfl_xor(ss, 32);
                if (fq == 0) RSSP[(size_t)row * 16 + u.pn * 4 + wc] = ss; }
    }
};
struct EpiStore {
    static constexpr bool PERM = true, AFTER_DRAIN = false;
    bf16_t* O; int ldc;
    __device__ __forceinline__ void operator()(const f32x4 (&acc)[2][2][4][2], const Unit& u, int wr, int wc, int fr, int fq) const {
        const int row0 = u.pm * BM + wr * 64 + fr, col0 = u.pn * BM + wc * 32 + 8 * fq;
#pragma unroll
        for (int ai = 0; ai < 2; ++ai)
#pragma unroll
            for (int m = 0; m < 4; ++m)
#pragma unroll
                for (int bj = 0; bj < 2; ++bj) *(u32x4*)(O + (size_t)(row0 + ai * HALF + m * 16) * ldc + col0 + bj * HALF) = pack8(acc[ai][bj][m][0], acc[ai][bj][m][1]);
    }
};

template <class Epi, class Sched, bool ALIGN_EPI = false, bool SP2 = false, bool F8 = false>
__device__ __forceinline__ void gemm_phase(PG8_LAS unsigned char* lds, const Gemm g, const Sched& S, const Epi& E) {
    const int tid = otid(), wid = __builtin_amdgcn_readfirstlane(tid >> 6), lane = tid & 63, wr = wid >> 2, wc = wid & 3, fr = lane & 15, fq = lane >> 4;
    int K_ = g.K; if constexpr (F8) asm volatile("" : "+s"(K_));
    const int K = K_, nt = K / BK;
    unsigned voffA[2], voffB[2];
#pragma unroll
    for (int i = 0; i < 2; ++i) { int R, C; stage_rc(tid * 16 + i * 8192, R, C); const int Rb = Epi::PERM ? ((R & ~31) + perm32(R & 31)) : R;
        voffA[i] = (unsigned)(R * K + C) * 2u; voffB[i] = (unsigned)(Rb * K + C) * 2u; }
    const size_t kstep = (size_t)(BK * 2);
    const size_t hstep = (size_t)HALF * K * 2;
    const size_t tstep = 2 * hstep;
    const unsigned ldsw = (unsigned)wid * 1024u;
    const int aoff = lds_byte(wr * 64 + fr, fq * 8), boff = lds_byte(wc * 32 + fr, fq * 8);
#define PG8_SA(b, h) (((b) * 2 + (h)) * HTB)
#define PG8_SB(b, h) ((4 + (b) * 2 + (h)) * HTB)
#define PG8_STAGE(bufoff, gbase, voff) do { _Pragma("unroll") for (int _i = 0; _i < 2; ++_i) \
        __builtin_amdgcn_global_load_lds((const unsigned*)((const char*)(gbase) + (voff)[_i]), (PG8_LAS unsigned*)(lds + (bufoff) + ldsw + _i * 8192), 16, 0, 0); } while (0)
#define PG8_LDA(dst, b, h) do { _Pragma("unroll") for (int m = 0; m < 4; ++m) { \
        if constexpr (F8) dst##8[m] = __builtin_shufflevector(*(const PG8_LAS i32x4*)(lds + PG8_SA(b, h) + aoff + m * 2048), *(const PG8_LAS i32x4*)(lds + PG8_SA(b, h) + aoff + m * 2048 + 1024), 0, 1, 2, 3, 4, 5, 6, 7); \
        else { _Pragma("unroll") for (int k = 0; k < 2; ++k) dst[m][k] = *(const PG8_LAS bf16x8*)(lds + PG8_SA(b, h) + aoff + m * 2048 + k * 1024); } } } while (0)
#define PG8_LDB(dst, b, h) do { _Pragma("unroll") for (int n = 0; n < 2; ++n) { \
        if constexpr (F8) dst##8[n] = __builtin_shufflevector(*(const PG8_LAS i32x4*)(lds + PG8_SB(b, h) + boff + n * 2048), *(const PG8_LAS i32x4*)(lds + PG8_SB(b, h) + boff + n * 2048 + 1024), 0, 1, 2, 3, 4, 5, 6, 7); \
        else { _Pragma("unroll") for (int k = 0; k < 2; ++k) dst[n][k] = *(const PG8_LAS bf16x8*)(lds + PG8_SB(b, h) + boff + n * 2048 + k * 1024); } } } while (0)
#define PG8_MMA(ai, bj, At, Bt) do { __builtin_amdgcn_s_setprio(1); _Pragma("unroll") for (int m = 0; m < 4; ++m) _Pragma("unroll") for (int n = 0; n < 2; ++n) { \
        if constexpr (F8) asm volatile("v_mfma_scale_f32_16x16x128_f8f6f4 %0, %1, %2, %0, %3, %4 op_sel_hi:[0,0,0]" : "+v"(acc[ai][bj][m][n]) : "v"(Bt##8[n]), "v"(At##8[m]), "v"(f8sb), "v"(f8sa)); \
        else { _Pragma("unroll") for (int k = 0; k < 2; ++k) acc[ai][bj][m][n] = __builtin_amdgcn_mfma_f32_16x16x32_bf16(Bt[n][k], At[m][k], acc[ai][bj][m][n], 0, 0, 0); } } \
        __builtin_amdgcn_s_setprio(0); } while (0)
#define PG8_WAIT_V(n) asm volatile("s_waitcnt vmcnt(" #n ")" ::: "memory")
#define PG8_WAIT_L(n) asm volatile("s_waitcnt lgkmcnt(" #n ")" ::: "memory")
#define PG8_BAR __builtin_amdgcn_s_barrier()
#define PG8_SCHED __builtin_amdgcn_sched_barrier(0)
    Unit cur, nxt; int ui = 0;
    if (!S.next(0, cur)) return;
    f32x4 acc[2][2][4][2];
#pragma unroll
    for (int a = 0; a < 2; ++a)
#pragma unroll
        for (int b = 0; b < 2; ++b)
#pragma unroll
            for (int m = 0; m < 4; ++m)
#pragma unroll
                for (int n = 0; n < 2; ++n) acc[a][b][m][n] = (f32x4){0.f, 0.f, 0.f, 0.f};
    bf16x8 At[4][2], B0[2][2], B1[2][2]; i32x8 At8[4], B08[2], B18[2];
    const int f8sb = 0x79797979, f8sa = 0x7d7d7d7d;
    const char* cA = (const char*)g.A + (size_t)cur.pm * tstep; const char* cB = (const char*)g.Bt + (size_t)cur.pn * tstep;
    S.a_ready(cur);
    if constexpr (SP2) {
        PG8_STAGE(PG8_SB(0, 0), cB, voffB); PG8_STAGE(PG8_SB(0, 1), cB + hstep, voffB); PG8_STAGE(PG8_SA(0, 0), cA, voffA); PG8_STAGE(PG8_SA(0, 1), cA + hstep, voffA);
        if (wr == 1) PG8_BAR;
        PG8_WAIT_V(2); PG8_BAR;
        PG8_STAGE(PG8_SB(1, 0), cB + kstep, voffB); PG8_STAGE(PG8_SA(1, 0), cA + kstep, voffA); PG8_STAGE(PG8_SB(1, 1), cB + hstep + kstep, voffB);
        PG8_WAIT_V(6); PG8_BAR;
    } else {
        PG8_STAGE(PG8_SB(0, 0), cB, voffB); PG8_STAGE(PG8_SA(0, 0), cA, voffA); PG8_STAGE(PG8_SB(0, 1), cB + hstep, voffB); PG8_STAGE(PG8_SA(0, 1), cA + hstep, voffA);
        if (wr == 1) PG8_BAR;
        PG8_WAIT_V(4); PG8_BAR;
        PG8_STAGE(PG8_SB(1, 0), cB + kstep, voffB); PG8_STAGE(PG8_SA(1, 0), cA + kstep, voffA); PG8_STAGE(PG8_SB(1, 1), cB + hstep + kstep, voffB);
        PG8_WAIT_V(6); PG8_BAR;
    }
    for (;;) {
        const bool has_next = S.next(ui + 1, nxt);
        const char* nA = has_next ? (const char*)g.A + (size_t)nxt.pm * tstep : cA; const char* nB = has_next ? (const char*)g.Bt + (size_t)nxt.pn * tstep : cB;
        for (int t = 0; t < nt; t += 2) {
            const bool last = (t == nt - 2);
            const char* a1 = cA + (size_t)(t + 1) * kstep;
            const char* a2 = last ? nA : cA + (size_t)(t + 2) * kstep; const char* b2 = last ? nB : cB + (size_t)(t + 2) * kstep;
            const char* a3 = a2 + kstep; const char* b3 = b2 + kstep;
            if (last && has_next) S.a_ready(nxt);
            if constexpr (SP2) {
            PG8_LDB(B0, 0, 0); PG8_LDB(B1, 0, 1); PG8_SCHED; PG8_LDA(At, 0, 0); PG8_STAGE(PG8_SA(1, 1), a1 + hstep, voffA);
            PG8_WAIT_V(8); PG8_WAIT_L(0); PG8_BAR; PG8_MMA(0, 0, At, B0); PG8_MMA(0, 1, At, B1); PG8_BAR; PG8_SCHED;
            PG8_LDA(At, 0, 1); PG8_STAGE(PG8_SB(0, 0), b2, voffB); PG8_STAGE(PG8_SB(0, 1), b2 + hstep, voffB); PG8_STAGE(PG8_SA(0, 0), a2, voffA);
            PG8_WAIT_V(8); PG8_WAIT_L(0); PG8_BAR; PG8_MMA(1, 0, At, B0); PG8_MMA(1, 1, At, B1); PG8_BAR; PG8_SCHED;
            PG8_LDB(B0, 1, 0); PG8_LDB(B1, 1, 1); PG8_SCHED; PG8_LDA(At, 1, 0); PG8_STAGE(PG8_SA(0, 1), a2 + hstep, voffA);
            PG8_WAIT_V(8); PG8_WAIT_L(0); PG8_BAR; PG8_MMA(0, 0, At, B0); PG8_MMA(0, 1, At, B1); PG8_BAR; PG8_SCHED;
            PG8_LDA(At, 1, 1); PG8_STAGE(PG8_SB(1, 0), b3, voffB); PG8_STAGE(PG8_SB(1, 1), b3 + hstep, voffB); PG8_STAGE(PG8_SA(1, 0), a3, voffA);
            PG8_WAIT_V(8); PG8_WAIT_L(0); PG8_BAR; PG8_MMA(1, 0, At, B0); PG8_MMA(1, 1, At, B1); PG8_BAR; PG8_SCHED;
            } else {
            PG8_LDB(B0, 0, 0); PG8_SCHED; PG8_LDA(At, 0, 0); PG8_STAGE(PG8_SA(1, 1), a1 + hstep, voffA);
            PG8_WAIT_L(8); PG8_BAR; PG8_WAIT_L(0); PG8_MMA(0, 0, At, B0); PG8_BAR; PG8_SCHED;
            PG8_LDB(B1, 0, 1); PG8_STAGE(PG8_SB(0, 0), b2, voffB);
            PG8_BAR; PG8_WAIT_L(0); PG8_MMA(0, 1, At, B1); PG8_BAR;
            PG8_LDA(At, 0, 1); PG8_STAGE(PG8_SA(0, 0), a2, voffA);
            PG8_BAR; PG8_WAIT_L(0); PG8_MMA(1, 0, At, B0); PG8_BAR; PG8_SCHED;
            PG8_STAGE(PG8_SB(0, 1), b2 + hstep, voffB);
            PG8_WAIT_V(6); PG8_BAR; PG8_MMA(1, 1, At, B1); PG8_BAR;
            PG8_LDB(B0, 1, 0); PG8_SCHED; PG8_LDA(At, 1, 0); PG8_STAGE(PG8_SA(0, 1), a2 + hstep, voffA);
            PG8_WAIT_L(8); PG8_BAR; PG8_WAIT_L(0); PG8_MMA(0, 0, At, B0); PG8_BAR; PG8_SCHED;
            PG8_LDB(B1, 1, 1); PG8_STAGE(PG8_SB(1, 0), b3, voffB);
            PG8_BAR; PG8_WAIT_L(0); PG8_MMA(0, 1, At, B1); PG8_BAR;
            PG8_LDA(At, 1, 1); PG8_STAGE(PG8_SA(1, 0), a3, voffA);
            PG8_BAR; PG8_WAIT_L(0); PG8_MMA(1, 0, At, B0); PG8_BAR; PG8_SCHED;
            PG8_STAGE(PG8_SB(1, 1), b3 + hstep, voffB);
            PG8_WAIT_V(6); PG8_BAR; PG8_MMA(1, 1, At, B1); PG8_BAR;
            }
        }
        if constexpr (ALIGN_EPI) { if (wr == 0) PG8_BAR; }
        if constexpr (F8) {
            asm volatile("s_nop 15\n\ts_nop 15" ::: "memory");
#pragma unroll
            for (int a_ = 0; a_ < 2; ++a_)
#pragma unroll
                for (int b_ = 0; b_ < 2; ++b_)
                    asm volatile("" : "+v"(acc[a_][b_][0][0]), "+v"(acc[a_][b_][0][1]), "+v"(acc[a_][b_][1][0]), "+v"(acc[a_][b_][1][1]), "+v"(acc[a_][b_][2][0]), "+v"(acc[a_][b_][2][1]), "+v"(acc[a_][b_][3][0]), "+v"(acc[a_][b_][3][1])); }
        if constexpr (!Epi::AFTER_DRAIN) { E(acc, cur, wr, wc, fr, fq); S.done(cur); }
        if (!has_next) break;
#pragma unroll
        for (int a = 0; a < 2; ++a)
#pragma unroll
            for (int b = 0; b < 2; ++b)
#pragma unroll
                for (int m = 0; m < 4; ++m)
#pragma unroll
                    for (int n = 0; n < 2; ++n) acc[a][b][m][n] = (f32x4){0.f, 0.f, 0.f, 0.f};
        cur = nxt; cA = nA; cB = nB; ++ui;
        if constexpr (ALIGN_EPI) { if (wr == 1) PG8_BAR; }
    }
    PG8_WAIT_V(0);
    if constexpr (!ALIGN_EPI) { if (wr == 0) PG8_BAR; }
    PG8_BAR;
    if constexpr (Epi::AFTER_DRAIN) { E.fused(acc, cur, wr, wc, fr, fq, lds, wid, lane); S.done(cur); }
#undef PG8_SA
#undef PG8_SB
#undef PG8_STAGE
#undef PG8_LDA
#undef PG8_LDB
#undef PG8_MMA
#undef PG8_WAIT_V
#undef PG8_WAIT_L
#undef PG8_BAR
#undef PG8_SCHED
}
}


__device__ __forceinline__ float log_sigmoid(float z) { return z >= 0.f ? -log1pf(expf(-z)) : z - log1pf(expf(z)); }
constexpr float XN8_SCALE = 4.0f, WIN8_SCALE = 64.0f;
__device__ __forceinline__ unsigned pk4_fp8(float a, float b, float c, float d) { int w = __builtin_amdgcn_cvt_pk_fp8_f32(a, b, 0, false); w = __builtin_amdgcn_cvt_pk_fp8_f32(c, d, w, true); return (unsigned)w; }
__device__ __forceinline__ void p0_transpose_item8(const float* W, int ldw, int K, int ncols, unsigned char* WT, int row_off, LAS float* scr, int item, int lane, float scale) {
    const int nblk = ncols / 32, kb = item / nblk, nb = item % nblk, k0 = 64 * kb, n0 = 32 * nb;
#pragma unroll 8
    for (int i = 0; i < 32; ++i) { const int kk = 2 * i + (lane >> 5); scr[kk * 33 + (lane & 31)] = W[(size_t)(k0 + kk) * ldw + n0 + (lane & 31)] * scale; }
    asm volatile("s_waitcnt lgkmcnt(0)" ::: "memory");
    const int c = lane & 7;
#pragma unroll
    for (int j = 0; j < 4; ++j) { const int n = (lane >> 3) + 8 * j; const LAS float* s = scr + (8 * c) * 33 + n;
        u32x2 o; o.x = pk4_fp8(s[0 * 33], s[1 * 33], s[2 * 33], s[3 * 33]); o.y = pk4_fp8(s[4 * 33], s[5 * 33], s[6 * 33], s[7 * 33]);
        *(u32x2*)(WT + (size_t)(row_off + n0 + n) * K + k0 + 8 * c) = o; }
    asm volatile("s_waitcnt lgkmcnt(0)" ::: "memory");
}
__device__ __forceinline__ void p0_transpose_item(const float* W, int ldw, int K, int ncols, bf16_t* WT, int row_off, LAS float* scr, int item, int lane, const float* ksc = nullptr) {
    const int nblk = ncols / 32, kb = item / nblk, nb = item % nblk, k0 = 64 * kb, n0 = 32 * nb;
#pragma unroll 8
    for (int i = 0; i < 32; ++i) { const int kk = 2 * i + (lane >> 5); scr[kk * 33 + (lane & 31)] = W[(size_t)(k0 + kk) * ldw + n0 + (lane & 31)] * (ksc ? ksc[k0 + kk] : 1.0f); }
    asm volatile("s_waitcnt lgkmcnt(0)" ::: "memory");
    const int c = lane & 7;
#pragma unroll
    for (int j = 0; j < 4; ++j) { const int n = (lane >> 3) + 8 * j; const LAS float* s = scr + (8 * c) * 33 + n;
        u32x4 o; o.x = pk2(s[0 * 33], s[1 * 33]); o.y = pk2(s[2 * 33], s[3 * 33]); o.z = pk2(s[4 * 33], s[5 * 33]); o.w = pk2(s[6 * 33], s[7 * 33]);
        *(u32x4*)(WT + (size_t)(row_off + n0 + n) * K + k0 + 8 * c) = o; }
    asm volatile("s_waitcnt lgkmcnt(0)" ::: "memory");
}
__device__ __forceinline__ void phase_prologue(LAS unsigned char* ldsb, const P& p) {
    const int TID = otid();
    const int lane = TID & 63, wave = TID >> 6, gw = blockIdx.x * 8 + wave, nw = gridDim.x * 8;
    LAS float* scr = (LAS float*)(ldsb + wave * 16384);
    constexpr int I1 = 16 * 96, I2 = 16 * 64, IA = 8 * 32, IO = 16 * 32, IQ = 16 * 64;
    for (int it = gw; it < I1 + I2 + 2 * IA + IO + IQ; it += nw) {
        int r = it;
        if (r < I1) { p0_transpose_item8(p.w_in, INC, D, 3072, p.ws + WS_WIN, 0, scr, r, lane, WIN8_SCALE); continue; } r -= I1;
        if (r < I2) { p0_transpose_item8(p.w_in + 3080, INC, D, 2048, p.ws + WS_WIN, 3072, scr, r, lane, WIN8_SCALE); continue; } r -= I2;
        if (r < IA) { p0_transpose_item(p.w_a, D, 512, 1024, (bf16_t*)(p.ws + WS_WA), 0, scr, r, lane); continue; } r -= IA;
        if (r < IA) { p0_transpose_item(p.w_b, D, 512, 1024, (bf16_t*)(p.ws + WS_WB), 0, scr, r, lane); continue; } r -= IA;
        if (r < IO) { p0_transpose_item(p.w_out, D, D, 1024, (bf16_t*)(p.ws + WS_WOUT), 0, scr, r, lane); continue; } r -= IO;
        p0_transpose_item(p.w_pq, PQC, D, 2048, (bf16_t*)(p.ws + WS_WPQ), 0, scr, r, lane, p.g_ffn);
    }
    { u32x4* SKo = (u32x4*)(p.ws + WS_SK);
      for (int c = blockIdx.x * 512 + TID; c < PH * 2 * PNK * PHALF / 8; c += gridDim.x * 512) { const f32x4 a0 = *(const f32x4*)(p.sk + (size_t)c * 8), a1 = *(const f32x4*)(p.sk + (size_t)c * 8 + 4);
          u32x4 o; o.x = pk2(a0.x, a0.y); o.y = pk2(a0.z, a0.w); o.z = pk2(a1.x, a1.y); o.w = pk2(a1.z, a1.w); SKo[c] = o; } }
    { float* ROPE = (float*)(p.ws + WS_ROPE);
      for (int it = blockIdx.x * 512 + TID; it < S * 8; it += gridDim.x * 512) { const int i = it & 7, pos = it >> 3;
          const float inv_freq = powf(500000.0f, -(float)i / 8.0f); const float ang = (float)pos * inv_freq;
          ROPE[pos * 16 + i] = cosf(ang); ROPE[pos * 16 + 8 + i] = sinf(ang); } }
    __syncthreads();
    { LAS float* WFt = (LAS float*)ldsb;
      for (int i = TID; i < 2 * D; i += 512) { const int col = i >> 1, half = i & 1; const f32x4 w = *(const f32x4*)(p.w_in + (size_t)col * INC + 3072 + 4 * half);
          WFt[(4 * half + 0) * D + col] = w.x; WFt[(4 * half + 1) * D + col] = w.y; WFt[(4 * half + 2) * D + col] = w.z; WFt[(4 * half + 3) * D + col] = w.w; } }
    __syncthreads();
    bf16_t* XN = (bf16_t*)(p.ws + WS_XN); float* LOGF = (float*)(p.ws + WS_LOGF); const LAS float* WFt = (const LAS float*)ldsb;
    float wsum = 0.f;
    for (int r8 = 0; r8 < 8; ++r8) {
        const int row = gw * 8 + r8;
        const f32x4* xr = (const f32x4*)(p.x + (size_t)row * D);
        f32x4 v[4]; float ss = 0.f;
#pragma unroll
        for (int j = 0; j < 4; ++j) { v[j] = xr[lane + 64 * j]; ss += v[j].x * v[j].x + v[j].y * v[j].y + v[j].z * v[j].z + v[j].w * v[j].w; }
        ss = wave_sum_fast(ss);
        const float rstd = rsqrtf(ss * (1.f / D) + EPS);
        float fs[8];
#pragma unroll
        for (int f = 0; f < 8; ++f) fs[f] = 0.f;
#pragma unroll
        for (int j = 0; j < 4; ++j) {
            const f32x4 g = ((const f32x4*)p.g_mix)[lane + 64 * j];
            v[j].x *= rstd * g.x; v[j].y *= rstd * g.y; v[j].z *= rstd * g.z; v[j].w *= rstd * g.w;
            *(unsigned*)((unsigned char*)XN + (size_t)row * D + 4 * (lane + 64 * j)) = pk4_fp8(v[j].x * XN8_SCALE, v[j].y * XN8_SCALE, v[j].z * XN8_SCALE, v[j].w * XN8_SCALE);
#pragma unroll
            for (int f = 0; f < 8; ++f) { const f32x4 w = *(const LAS f32x4*)(WFt + f * D + 4 * (lane + 64 * j)); fs[f] += (v[j].x * w.x + v[j].y * w.y) + (v[j].z * w.z + v[j].w * w.w); }
        }
#pragma unroll
        for (int f = 0; f < 8; ++f) fs[f] = wave_sum_fast(fs[f]);
        float z = fs[0];
#pragma unroll
        for (int f = 1; f < 8; ++f) z = (lane == f) ? fs[f] : z;
        if (lane < 8) { const float lf = log_sigmoid(z + p.b_f[lane]); LOGF[(size_t)row * 8 + lane] = lf; wsum += lf; }
    }
    if (lane < 8) ((float*)(p.ws + WS_WSUM))[gw * 8 + lane] = wsum;
}

__device__ __forceinline__ void phase_cumsum(const P& p) {
    const int TID = otid();
    const int lane = TID & 63, gw = blockIdx.x * 8 + (TID >> 6), b = gw >> 10, w0 = b << 10, h = lane & 7, j = lane >> 3;
    const float* WSUM = (const float*)(p.ws + WS_WSUM); const float* LOGF = (const float*)(p.ws + WS_LOGF); float* C = (float*)(p.ws + WS_C);
    float part = 0.f;
    { float p1 = 0.f, p2 = 0.f, p3 = 0.f; int w = w0 + j;
      for (; w + 24 < gw; w += 32) { part += WSUM[w * 8 + h]; p1 += WSUM[(w + 8) * 8 + h]; p2 += WSUM[(w + 16) * 8 + h]; p3 += WSUM[(w + 24) * 8 + h]; }
      for (; w < gw; w += 8) part += WSUM[w * 8 + h];
      part = (part + p1) + (p2 + p3); }
    part += __shfl_xor(part, 8); part += __shfl_xor(part, 16); part += __shfl_xor(part, 32);
    if (lane < 8) { float run = part;
#pragma unroll
        for (int r = 0; r < 8; ++r) { const int row = gw * 8 + r; run += LOGF[(size_t)row * 8 + h]; C[(size_t)(b * 8 + h) * S + (row & (S - 1))] = run * LOG2E; } }
}

#include <hip/hip_bf16.h>
namespace attn {
using bf16=__hip_bfloat16;
using bf16x8=__attribute__((ext_vector_type(8)))short;
using s16x4=__attribute__((ext_vector_type(4)))short;
using f32x16=__attribute__((ext_vector_type(16)))float;
using f32x4=__attribute__((ext_vector_type(4)))float;
using u32x4=__attribute__((ext_vector_type(4)))unsigned;
constexpr int SEQ=8192,D=64,DM=512;
constexpr int NW=8,QBLK=32,QB=QBLK*NW,KVBLK=64;
__device__ __forceinline__ int crow(int r,int hi){return (r&3)+8*(r>>2)+4*hi;}
#define SBAR() __builtin_amdgcn_sched_barrier(0)
__device__ __forceinline__ void cmask(f32x16&p0,f32x16&p1,int jb,int qrel,int hi){
  const float NEG=-INFINITY; int kb=64*jb+4*hi;
  #pragma unroll
  for(int r=0;r<16;++r){int kv=kb+(r&3)+8*(r>>2); if(kv>qrel)p0[r]=NEG; if(kv+32>qrel)p1[r]=NEG;}
}
constexpr int KSUM_P1=16*32*64;
constexpr int NSLOT=3, SLOTB=8192;
constexpr int LDS_K=0, LDS_V=NSLOT*SLOTB, LDS_WS=2*NSLOT*SLOTB, LDS_OST=LDS_WS+NW*64*4, LDS_CK=LDS_OST+NW*4096, LDS_BYTES=LDS_CK+SEQ*4;
__device__ __forceinline__ void glds16(const void*gsrc,unsigned lds_dst){unsigned keep;
  asm volatile("s_mov_b32 %0, m0\n\ts_mov_b32 m0, %2\n\ts_nop 0\n\tglobal_load_lds_dwordx4 %1, off\n\ts_mov_b32 m0, %0":"=&s"(keep):"v"(gsrc),"s"(lds_dst):"memory");}
typedef float f32x2_t __attribute__((ext_vector_type(2))); typedef __bf16 bf16x2_t __attribute__((ext_vector_type(2)));
__device__ __forceinline__ unsigned cvtpk_s(float lo,float hi){f32x2_t v={lo,hi};bf16x2_t b=__builtin_convertvector(v,bf16x2_t);return __builtin_bit_cast(unsigned,b);}
#define WAIT_BAR(N) asm volatile("s_waitcnt vmcnt(" #N ") lgkmcnt(0)\n\ts_barrier":::"memory")
typedef __attribute__((address_space(3))) const char* lds_cptr;
typedef short v4i16_t __attribute__((ext_vector_type(4)));
__device__ __forceinline__ void kload8(bf16x8*kf,lds_cptr kp){
  kf[0]=*(const __attribute__((address_space(3))) bf16x8*)(kp);      kf[1]=*(const __attribute__((address_space(3))) bf16x8*)(kp+512);
  kf[2]=*(const __attribute__((address_space(3))) bf16x8*)(kp+2048); kf[3]=*(const __attribute__((address_space(3))) bf16x8*)(kp+2560);
  kf[4]=*(const __attribute__((address_space(3))) bf16x8*)(kp+4096); kf[5]=*(const __attribute__((address_space(3))) bf16x8*)(kp+4608);
  kf[6]=*(const __attribute__((address_space(3))) bf16x8*)(kp+6144); kf[7]=*(const __attribute__((address_space(3))) bf16x8*)(kp+6656);
}
__device__ __forceinline__ void kload2(bf16x8*kf,lds_cptr kp,int j){ kf[2*j]=*(const __attribute__((address_space(3))) bf16x8*)(kp+j*2048); kf[2*j+1]=*(const __attribute__((address_space(3))) bf16x8*)(kp+j*2048+512); }
__device__ __forceinline__ s16x4 vtr(lds_cptr p){ return __builtin_bit_cast(s16x4,__builtin_amdgcn_ds_read_tr16_b64_v4i16((__attribute__((address_space(3))) v4i16_t*)p)); }
template<bool FOX> __device__ __forceinline__ void cinit(f32x16&C,const __attribute__((address_space(3))) float*ckt,float bs){
  if constexpr(FOX){
    #pragma unroll
    for(int g=0;g<4;++g){ const f32x4 kb=*(const __attribute__((address_space(3))) f32x4*)(ckt+8*g); C[4*g]=bs-kb[0]; C[4*g+1]=bs-kb[1]; C[4*g+2]=bs-kb[2]; C[4*g+3]=bs-kb[3]; }
  } else {
    #pragma unroll
    for(int r=0;r<16;++r)C[r]=bs;
  }
  asm volatile("":"+v"(C));
}
__device__ __forceinline__ void pv(f32x16*o,int vb,bf16x8 pa0,bf16x8 pa1,bf16x8 pa2,bf16x8 pa3){
  #pragma unroll
  for(int d0=0;d0<2;++d0){s16x4 lo[4],hi[4];
    #pragma unroll
    for(int ks=0;ks<4;++ks){
      asm volatile("ds_read_b64_tr_b16 %0,%1 offset:%c2":"=&v"(lo[ks]):"v"(vb),"i"(d0*4096+ks*1024):"memory");
      asm volatile("ds_read_b64_tr_b16 %0,%1 offset:%c2":"=&v"(hi[ks]):"v"(vb),"i"(d0*4096+ks*1024+512):"memory");}
    asm volatile("s_waitcnt lgkmcnt(0)":::"memory");SBAR();
    #define PK(k) (bf16x8){lo[k][0],lo[k][1],lo[k][2],lo[k][3],hi[k][0],hi[k][1],hi[k][2],hi[k][3]}
    o[d0]=__builtin_amdgcn_mfma_f32_32x32x16_bf16(pa0,PK(0),o[d0],0,0,0);
    o[d0]=__builtin_amdgcn_mfma_f32_32x32x16_bf16(pa1,PK(1),o[d0],0,0,0);
    o[d0]=__builtin_amdgcn_mfma_f32_32x32x16_bf16(pa2,PK(2),o[d0],0,0,0);
    o[d0]=__builtin_amdgcn_mfma_f32_32x32x16_bf16(pa3,PK(3),o[d0],0,0,0);
    #undef PK
  }
}
#define ATTN_STORE16(p,v) (*(u32x4*)(p)=(v))
struct MobaIo { const unsigned short* QL; int qcnt, jblk; const unsigned* SEL3; bf16* PART0; bf16* PART1; bf16* PART2; float* LSE; };
template<bool FOX,int THRL,int VAR> __device__ __forceinline__ void attn_unit(int b,int h,int qb,int t0,const bf16*Q,const bf16*__restrict__ K,const bf16*__restrict__ V,bf16*O,const float*CK2,const MobaIo&mio,char*shm){
  const int tid=otid(),lane=tid&63,r32=lane&31,hi=lane>>5; const int wid=__builtin_amdgcn_readfirstlane(tid>>6);
  const long rowbase=(long)b*SEQ; const int q0=qb*QB;
  int qidx=q0+wid*QBLK+r32; bool qvalid=true;
  if constexpr(VAR==2){ const int li=wid*QBLK+r32; qvalid=li<mio.qcnt; qidx=(int)mio.QL[qvalid?li:mio.qcnt-1]; }
  const bf16*Qrow=Q+(rowbase+qidx)*DM+h*D;
  const bf16*Kh=K+(rowbase+(long)t0*KVBLK)*DM+h*D,*Vh=V+(rowbase+(long)t0*KVBLK)*DM+h*D;
  const unsigned lds0=(unsigned)(uintptr_t)shm;
  float*wsf=(float*)(shm+LDS_WS)+wid*64;
  const bf16*ksrc=Kh+(long)lane*DM+wid*8;
  const bf16*vsrc=Vh+(long)(16*(wid&3)+(lane>>2))*DM+(wid>>2)*32+(lane&3)*8;
  const unsigned kdst=lds0+LDS_K+wid*1024, vdst=lds0+LDS_V+wid*1024;
  #define DMA_K(t,slot) glds16(ksrc+(long)(t)*KVBLK*DM,(unsigned)__builtin_amdgcn_readfirstlane(kdst+(slot)))
  #define DMA_V(t,slot) glds16(vsrc+(long)(t)*KVBLK*DM,(unsigned)__builtin_amdgcn_readfirstlane(vdst+(slot)))
  const int vb0=(int)(lds0+LDS_V)+((lane>>4)&1)*32+(lane&3)*8+(4*hi+((lane&15)>>2))*64;
  bf16x8 kf[8];
  const lds_cptr shm3=(lds_cptr)shm; const lds_cptr kp0=shm3+LDS_K+hi*1024+r32*16; const lds_cptr vp0=shm3+LDS_V+((lane>>4)&1)*32+(lane&3)*8+(4*hi+((lane&15)>>2))*64;
  const __attribute__((address_space(3))) float*ckl=(const __attribute__((address_space(3))) float*)(shm3+LDS_CK)+4*hi;
  const int NT=(VAR==2)?4:(q0+QB)/KVBLK-t0;
  DMA_K(0,0);DMA_V(0,0);DMA_K(1,SLOTB);
  bf16x8 qr[4];
  #pragma unroll
  for(int d0=0;d0<4;++d0)qr[d0]=*reinterpret_cast<const bf16x8*>(&Qrow[d0*16+hi*8]);
  float cq2=0.f;
  if constexpr(FOX){ __attribute__((address_space(3))) f32x4*ck4=(__attribute__((address_space(3))) f32x4*)(shm3+LDS_CK); const f32x4*g4=(const f32x4*)CK2+t0*16;
    for(int i=tid;i<NT*16;i+=NW*64)ck4[i]=g4[i];
    cq2=CK2[q0+wid*QBLK+r32]; }
  float mhat=0.f,l_reg=0.f;f32x16 o[2];o[0]=f32x16{};o[1]=f32x16{};
  const int qrel=wid*QBLK+r32;
  #define CMASK(P0,P1,t) do{ if constexpr(VAR!=2){ int jb_=(t)-(NT-4); if(jb_>=0)cmask(P0,P1,jb_,qrel,hi); } }while(0)
  #define BASE(t) (FOX ? (cq2-mhat) : -mhat)
  bool resc=false,nmd=true; f32x16 negm=f32x16{}; asm volatile("":"+v"(negm));
  #define RESC() do{ if(resc){ asm volatile("s_waitcnt lgkmcnt(0)":::"memory"); \
      _Pragma("unroll") for(int d_=0;d_<2;++d_) _Pragma("unroll") for(int r=0;r<16;++r)o[d_][r]*=wsf[crow(r,hi)]; } }while(0)
  #define MX3(a,b,c) __builtin_fmaxf(__builtin_fmaxf((a),(b)),(c))
  #define DECIDE(C0,C1) do{ float a=MX3(C0[0],C0[1],C1[0]),b_=MX3(C0[2],C0[3],C1[1]); a=MX3(a,C1[2],C1[3]); \
      _Pragma("unroll") for(int r=4;r<16;r+=4){a=MX3(a,C0[r],C0[r+1]);b_=MX3(b_,C0[r+2],C0[r+3]);a=MX3(a,C1[r],C1[r+1]);b_=MX3(b_,C1[r+2],C1[r+3]);} \
      float rm=__builtin_fmaxf(a,b_); { auto rr=__builtin_amdgcn_permlane32_swap(__float_as_uint(rm),__float_as_uint(rm),false,false); rm=__builtin_fmaxf(__uint_as_float(rr[0]),__uint_as_float(rr[1])); } \
      resc=false; \
      if(__builtin_expect(__any(rm>(float)THRL),0)){ const float dl=(rm>(float)THRL)?rm:0.f; mhat+=dl;     \
        _Pragma("unroll") for(int r=0;r<16;++r){C0[r]-=dl;C1[r]-=dl;} \
        const float f=__builtin_amdgcn_exp2f(-dl); l_reg*=f; if(hi==0)wsf[r32]=f; resc=true; nmd=true; } }while(0)
  f32x16 pA0,pA1,pB0,pB1;
  int sl_prev=0,sl_cur=0,sl_next=SLOTB;
  #define ROT() do{sl_prev=sl_cur;sl_cur=sl_next;sl_next=(sl_next==(NSLOT-1)*SLOTB)?0:sl_next+SLOTB;}while(0)
  DMA_K(2,2*SLOTB);
  WAIT_BAR(3);
  { const float bs=BASE(0); cinit<FOX>(pA0,ckl,bs); cinit<FOX>(pA1,ckl+32,bs);
    const char*kb=shm+LDS_K+hi*1024+r32*16;
    #pragma unroll
    for(int d0=0;d0<4;++d0){
      const bf16x8 b0=*reinterpret_cast<const bf16x8*>(kb+d0*2048);
      const bf16x8 b1=*reinterpret_cast<const bf16x8*>(kb+d0*2048+512);
      pA0=__builtin_amdgcn_mfma_f32_32x32x16_bf16(b0,qr[d0],pA0,0,0,0);pA1=__builtin_amdgcn_mfma_f32_32x32x16_bf16(b1,qr[d0],pA1,0,0,0);}
    CMASK(pA0,pA1,0);
    DECIDE(pA0,pA1); resc=false;
    _Pragma("unroll") for(int r=0;r<16;++r){pA0[r]=__builtin_amdgcn_exp2f(pA0[r]);pA1[r]=__builtin_amdgcn_exp2f(pA1[r]);} }
  WAIT_BAR(0);
  DMA_K(3,0);DMA_V(1,SLOTB);
  ROT();
  kload8(kf,kp0+sl_cur);
  WAIT_BAR(2);
  s16x4 vlo[8],vhi[8]; u32x4 pw0,pw1,pw2,pw3;
  #define PKW(P,B) cvtpk_s(P[B],P[B+1])
  #define PAF(k) __builtin_bit_cast(bf16x8,pw##k)
  #define VFR(i) (bf16x8){vlo[i][0],vlo[i][1],vlo[i][2],vlo[i][3],vhi[i][0],vhi[i][1],vhi[i][2],vhi[i][3]}
  #define PIN(x) asm volatile("":"+v"(x))
  #define GAPA(MF,A0,A1,A2,A3,W0,W1,PW) do{ MF; sacc+=A0; sacc+=A1; sacc+=A2; sacc+=A3; PIN(sacc); W0; W1; PIN(PW); SBAR(); }while(0)
  #define EX(v) __builtin_amdgcn_exp2f(v)
  #define GAPB(MF,X,B) do{ MF; X[B]=EX(X[B]); X[B+1]=EX(X[B+1]); X[B+2]=EX(X[B+2]); X[B+3]=EX(X[B+3]); PIN(X); SBAR(); }while(0)
  #define VRD(i) do{ vlo[i]=vtr(vp_+(((i)>>2)*4096+((i)&3)*1024)); vhi[i]=vtr(vp_+(((i)>>2)*4096+((i)&3)*1024+512)); }while(0)
  #define KRD(G,j) do{ if(G){ kload2(kf,kp0+sl_next,j); SBAR(); } }while(0)
  #define STEP(C0,C1,P0,P1,t,GK,GV,GL) do{ SBAR(); \
    const lds_cptr vp_=vp0+sl_prev; const float bs_=BASE(t); \
    if constexpr(FOX){ cinit<FOX>(C0,ckl+(t)*64,bs_); SBAR(); } \
    else if(nmd){ _Pragma("unroll") for(int r=0;r<16;++r)negm[r]=bs_; asm volatile("":"+v"(negm)); nmd=false; SBAR(); }     \
    VRD(0); SBAR(); float sacc=(P0[0]+P0[1]); \
    GAPA(C0=__builtin_amdgcn_mfma_f32_32x32x16_bf16(kf[0],qr[0],FOX?C0:negm,0,0,0), P0[2],P0[3],P0[4],P0[5],     pw0[0]=PKW(P0,0), pw0[1]=PKW(P0,2), pw0); \
    if constexpr(FOX){ cinit<FOX>(C1,ckl+(t)*64+32,bs_); SBAR(); } \
    VRD(4); SBAR(); GAPA(C1=__builtin_amdgcn_mfma_f32_32x32x16_bf16(kf[1],qr[0],FOX?C1:negm,0,0,0), P0[6],P0[7],P0[8],P0[9],     pw0[2]=PKW(P0,4), pw0[3]=PKW(P0,6), pw0); \
    VRD(1); SBAR(); GAPA(C0=__builtin_amdgcn_mfma_f32_32x32x16_bf16(kf[2],qr[1],C0,0,0,0),   P0[10],P0[11],P0[12],P0[13], pw1[0]=PKW(P0,8), pw1[1]=PKW(P0,10), pw1); \
    VRD(5); SBAR(); GAPA(C1=__builtin_amdgcn_mfma_f32_32x32x16_bf16(kf[3],qr[1],C1,0,0,0),   P0[14],P0[15],P1[0],P1[1],   pw1[2]=PKW(P0,12),pw1[3]=PKW(P0,14), pw1); \
    VRD(2); SBAR(); GAPA(C0=__builtin_amdgcn_mfma_f32_32x32x16_bf16(kf[4],qr[2],C0,0,0,0),   P1[2],P1[3],P1[4],P1[5],     pw2[0]=PKW(P1,0), pw2[1]=PKW(P1,2), pw2); \
    VRD(6); SBAR(); GAPA(C1=__builtin_amdgcn_mfma_f32_32x32x16_bf16(kf[5],qr[2],C1,0,0,0),   P1[6],P1[7],P1[8],P1[9],     pw2[2]=PKW(P1,4), pw2[3]=PKW(P1,6), pw2); \
    VRD(3); SBAR(); GAPA(C0=__builtin_amdgcn_mfma_f32_32x32x16_bf16(kf[6],qr[3],C0,0,0,0),   P1[10],P1[11],P1[12],P1[13], pw3[0]=PKW(P1,8), pw3[1]=PKW(P1,10), pw3); \
    VRD(7); SBAR(); GAPA(C1=__builtin_amdgcn_mfma_f32_32x32x16_bf16(kf[7],qr[3],C1,0,0,0),   P1[14],P1[15],0.f,0.f,       pw3[2]=PKW(P1,12),pw3[3]=PKW(P1,14), pw3); \
    l_reg+=sacc; \
    if(GK){DMA_K((t)+3,sl_cur);} if(GV){DMA_V((t)+1,sl_next);} \
    CMASK(C0,C1,t); \
    DECIDE(C0,C1); \
    SBAR(); \
    GAPB(o[0]=__builtin_amdgcn_mfma_f32_32x32x16_bf16(PAF(0),VFR(0),o[0],0,0,0), C0,0); \
    GAPB(o[1]=__builtin_amdgcn_mfma_f32_32x32x16_bf16(PAF(0),VFR(4),o[1],0,0,0), C0,4); \
    KRD(GL,0); GAPB(o[0]=__builtin_amdgcn_mfma_f32_32x32x16_bf16(PAF(1),VFR(1),o[0],0,0,0), C0,8); \
    KRD(GL,1); GAPB(o[1]=__builtin_amdgcn_mfma_f32_32x32x16_bf16(PAF(1),VFR(5),o[1],0,0,0), C0,12); \
    KRD(GL,2); GAPB(o[0]=__builtin_amdgcn_mfma_f32_32x32x16_bf16(PAF(2),VFR(2),o[0],0,0,0), C1,0); \
    KRD(GL,3); GAPB(o[1]=__builtin_amdgcn_mfma_f32_32x32x16_bf16(PAF(2),VFR(6),o[1],0,0,0), C1,4); \
    GAPB(o[0]=__builtin_amdgcn_mfma_f32_32x32x16_bf16(PAF(3),VFR(3),o[0],0,0,0), C1,8); \
    GAPB(o[1]=__builtin_amdgcn_mfma_f32_32x32x16_bf16(PAF(3),VFR(7),o[1],0,0,0), C1,12); \
    }while(0)
  int t=1;
  #undef CMASK
  #define CMASK(P0,P1,t) do{}while(0)
  for(;t+5<NT;t+=2){
    STEP(pB0,pB1,pA0,pA1,t,true,true,true);     WAIT_BAR(2); RESC(); ROT();
    STEP(pA0,pA1,pB0,pB1,t+1,true,true,true);   WAIT_BAR(2); RESC(); ROT();
  }
  #undef CMASK
  #define CMASK(P0,P1,t) do{ if constexpr(VAR!=2){ int jb_=(t)-(NT-4); if(jb_>=0)cmask(P0,P1,jb_,qrel,hi); } }while(0)
  #define ENDW(tt) do{ if((tt)+3<NT){WAIT_BAR(2);} else if((tt)+2<NT){WAIT_BAR(1);} else {WAIT_BAR(0);} }while(0)
  for(;t+1<NT;t+=2){
    STEP(pB0,pB1,pA0,pA1,t,(t+3<NT),(t+1<NT),(t+1<NT));       ENDW(t);   RESC(); ROT();
    STEP(pA0,pA1,pB0,pB1,t+1,(t+4<NT),(t+2<NT),(t+2<NT));     ENDW(t+1); RESC(); ROT();
  }
  STEP(pB0,pB1,pA0,pA1,NT-1,false,false,false); RESC();
  { float sacc=pB0[0]+pB0[1]; _Pragma("unroll") for(int r=2;r<16;++r)sacc+=pB0[r]; _Pragma("unroll") for(int r=0;r<16;++r)sacc+=pB1[r]; l_reg+=sacc;
    pw0=(u32x4){PKW(pB0,0),PKW(pB0,2),PKW(pB0,4),PKW(pB0,6)};pw1=(u32x4){PKW(pB0,8),PKW(pB0,10),PKW(pB0,12),PKW(pB0,14)};pw2=(u32x4){PKW(pB1,0),PKW(pB1,2),PKW(pB1,4),PKW(pB1,6)};pw3=(u32x4){PKW(pB1,8),PKW(pB1,10),PKW(pB1,12),PKW(pB1,14)};
    SBAR(); pv(o,vb0+sl_cur,PAF(0),PAF(1),PAF(2),PAF(3)); }
  #undef PKW
  #undef PAF
  #undef VFR
  #undef PIN
  #undef MX3
  #undef GAPA
  #undef GAPB
  #undef EX
  #undef VRD
  #undef KRD
  #undef STEP
  #undef ENDW
  #undef DECIDE
  #undef BASE
  {auto rr=__builtin_amdgcn_permlane32_swap(__float_as_uint(l_reg),__float_as_uint(l_reg),false,false);l_reg=__uint_as_float(rr[0])+__uint_as_float(rr[1]);}
  int pslot=0;
  if constexpr(VAR==2){ const unsigned s3=mio.SEL3[qidx]; pslot=((int)(s3&31u)==mio.jblk)?0:(((int)((s3>>5)&31u)==mio.jblk)?1:2); }
  if(hi==0){ wsf[32+r32]=l_reg; if constexpr(VAR==2) wsf[r32]=__int_as_float(qvalid?(qidx*4+pslot):-1); }
  asm volatile("s_waitcnt lgkmcnt(0)":::"memory");
  if constexpr(VAR>=1){ if(hi==0&&qvalid) mio.LSE[(long)qidx*4+((VAR==1)?3:pslot)]=mhat+__builtin_amdgcn_logf(l_reg); }
  float rli[16];
  #pragma unroll
  for(int r=0;r<16;++r)rli[r]=__builtin_amdgcn_rcpf(wsf[32+crow(r,hi)]);
  { bf16*stg=(bf16*)(shm+LDS_OST)+wid*2048;
    #pragma unroll
    for(int r=0;r<16;++r){const int orow=crow(r,hi);
      #pragma unroll
      for(int d0=0;d0<2;++d0)stg[orow*64+d0*32+r32]=__float2bfloat16(o[d0][r]*rli[r]);}
    asm volatile("s_waitcnt lgkmcnt(0)":::"memory");
    if constexpr(VAR==2){
      #pragma unroll
      for(int i=0;i<4;++i){const int row=i*8+(lane>>3),ch=lane&7; const u32x4 v=*(const u32x4*)(stg+row*64+ch*8); const int inf=__float_as_int(wsf[row]);
        if(inf>=0){ bf16*pb=((inf&3)==0)?mio.PART0:(((inf&3)==1)?mio.PART1:mio.PART2); ATTN_STORE16(pb+(long)(inf>>2)*D+ch*8,v); } }
    } else if constexpr(VAR==1){
      bf16*Ow=mio.PART0+(long)(q0+wid*QBLK)*D;
      #pragma unroll
      for(int i=0;i<4;++i){const int row=i*8+(lane>>3),ch=lane&7; const u32x4 v=*(const u32x4*)(stg+row*64+ch*8); ATTN_STORE16(Ow+(long)row*D+ch*8,v);}
    } else {
      bf16*Ow=O+(rowbase+q0+wid*QBLK)*DM+h*D;
      #pragma unroll
      for(int i=0;i<4;++i){const int row=i*8+(lane>>3),ch=lane&7; const u32x4 v=*(const u32x4*)(stg+row*64+ch*8); ATTN_STORE16(Ow+(long)row*DM+ch*8,v);} } }
  asm volatile("s_waitcnt lgkmcnt(0)\n\ts_barrier":::"memory");
  #undef DMA_K
  #undef DMA_V
  #undef CMASK
  #undef RESC
  #undef ROT
}
template<bool OWN> __device__ __forceinline__ void moba4_unit(int b,int h,int qb,int jblk,int cnt,const bf16*Q,const bf16*__restrict__ K,const bf16*__restrict__ V,const MobaIo&mio,char*shm){
  constexpr bool FOX=false; constexpr int THRL=8, VAR=OWN?1:2; constexpr int LK=0,LV=4*SLOTB,LWS=8*SLOTB,LOST=LWS+NW*128*4;
  const int t0=4*jblk; bf16*O=nullptr; const float*CK2=nullptr; (void)O; (void)CK2;
  const int tid=otid(),lane=tid&63,r32=lane&31,hi=lane>>5; const int wid=__builtin_amdgcn_readfirstlane(tid>>6);
  const long rowbase=(long)b*SEQ; const int q0=qb*QB;
  const bf16*Kh=K+(rowbase+(long)t0*KVBLK)*DM+h*D,*Vh=V+(rowbase+(long)t0*KVBLK)*DM+h*D;
  const unsigned lds0=(unsigned)(uintptr_t)shm;
  float*wsf=(float*)(shm+LWS)+wid*128;
  const bf16*ksrc=Kh+(long)lane*DM+wid*8;
  const bf16*vsrc=Vh+(long)(16*(wid&3)+(lane>>2))*DM+(wid>>2)*32+(lane&3)*8;
  const unsigned kdst=lds0+LK+wid*1024, vdst=lds0+LV+wid*1024;
  #define DMA_K(t,slot) glds16(ksrc+(long)(t)*KVBLK*DM,(unsigned)__builtin_amdgcn_readfirstlane(kdst+(slot)))
  #define DMA_V(t,slot) glds16(vsrc+(long)(t)*KVBLK*DM,(unsigned)__builtin_amdgcn_readfirstlane(vdst+(slot)))
  const int vb0=(int)(lds0+LV)+((lane>>4)&1)*32+(lane&3)*8+(4*hi+((lane&15)>>2))*64;
  bf16x8 kf[8];
  const lds_cptr shm3=(lds_cptr)shm; const lds_cptr kp0=shm3+LK+hi*1024+r32*16; const lds_cptr vp0=shm3+LV+((lane>>4)&1)*32+(lane&3)*8+(4*hi+((lane&15)>>2))*64;
  const __attribute__((address_space(3))) float*ckl=(const __attribute__((address_space(3))) float*)(shm3+LWS)+4*hi;
  constexpr int NT=4; const float cq2=0.f; (void)cq2;
  DMA_K(0,0);DMA_V(0,0);DMA_K(1,SLOTB);DMA_V(1,SLOTB);DMA_K(2,2*SLOTB);DMA_V(2,2*SLOTB);DMA_K(3,3*SLOTB);DMA_V(3,3*SLOTB);
  const int nch=OWN?1:(cnt+QB-1)/QB;
  int qidx=q0+wid*QBLK+r32,qnext=0; unsigned s3=0u; bf16x8 qr[4];
  if constexpr(VAR==2){ qidx=(int)mio.QL[min(wid*QBLK+r32,cnt-1)]; s3=mio.SEL3[qidx]; qnext=(int)mio.QL[min(QB+wid*QBLK+r32,cnt-1)]; }
  { const bf16*Qrow=Q+(rowbase+qidx)*DM+h*D;
    #pragma unroll
    for(int d0=0;d0<4;++d0)qr[d0]=*reinterpret_cast<const bf16x8*>(&Qrow[d0*16+hi*8]); }
  for(int c_=0;c_<nch;++c_){
  bool qvalid=true; int pslot=0;
  if constexpr(VAR==2){ qvalid=(c_*QB+wid*QBLK+r32)<cnt; pslot=((int)(s3&31u)==jblk)?0:(((int)((s3>>5)&31u)==jblk)?1:2); }
  wsf[64+lane]=__int_as_float(qvalid?(qidx*4+(OWN?3:pslot)):-1);
  float mhat=0.f,l_reg=0.f;f32x16 o[2];o[0]=f32x16{};o[1]=f32x16{};
  const int qrel=wid*QBLK+r32;
  #define CMASK(P0,P1,t) do{ if constexpr(VAR!=2){ int jb_=(t)-(NT-4); if(jb_>=0)cmask(P0,P1,jb_,qrel,hi); } }while(0)
  #define BASE(t) (FOX ? (cq2-mhat) : -mhat)
  bool resc=false,nmd=true; f32x16 negm=f32x16{}; asm volatile("":"+v"(negm));
  #define RESC() do{ if(resc){ asm volatile("s_waitcnt lgkmcnt(0)":::"memory"); \
      _Pragma("unroll") for(int d_=0;d_<2;++d_) _Pragma("unroll") for(int r=0;r<16;++r)o[d_][r]*=wsf[crow(r,hi)]; } }while(0)
  #define MX3(a,b,c) __builtin_fmaxf(__builtin_fmaxf((a),(b)),(c))
  #define DECIDE(C0,C1) do{ float a=MX3(C0[0],C0[1],C1[0]),b_=MX3(C0[2],C0[3],C1[1]); a=MX3(a,C1[2],C1[3]); \
      _Pragma("unroll") for(int r=4;r<16;r+=4){a=MX3(a,C0[r],C0[r+1]);b_=MX3(b_,C0[r+2],C0[r+3]);a=MX3(a,C1[r],C1[r+1]);b_=MX3(b_,C1[r+2],C1[r+3]);} \
      float rm=__builtin_fmaxf(a,b_); { auto rr=__builtin_amdgcn_permlane32_swap(__float_as_uint(rm),__float_as_uint(rm),false,false); rm=__builtin_fmaxf(__uint_as_float(rr[0]),__uint_as_float(rr[1])); } \
      resc=false; \
      if(__builtin_expect(__any(rm>(float)THRL),0)){ const float dl=(rm>(float)THRL)?rm:0.f; mhat+=dl;     \
        _Pragma("unroll") for(int r=0;r<16;++r){C0[r]-=dl;C1[r]-=dl;} \
        const float f=__builtin_amdgcn_exp2f(-dl); l_reg*=f; if(hi==0)wsf[r32]=f; resc=true; nmd=true; } }while(0)
  f32x16 pA0,pA1,pB0,pB1;
  int sl_prev=0,sl_cur=0,sl_next=SLOTB;
  #define ROT() do{sl_prev=sl_cur;sl_cur=sl_next;sl_next=sl_next+SLOTB;}while(0)
  #define WAIT_NB() asm volatile("s_waitcnt lgkmcnt(0)":::"memory")
  if(c_==0){ WAIT_BAR(0); }
  { const float bs=BASE(0); cinit<FOX>(pA0,ckl,bs); cinit<FOX>(pA1,ckl+32,bs);
    const char*kb=shm+LK+hi*1024+r32*16;
    #pragma unroll
    for(int d0=0;d0<4;++d0){
      const bf16x8 b0=*reinterpret_cast<const bf16x8*>(kb+d0*2048);
      const bf16x8 b1=*reinterpret_cast<const bf16x8*>(kb+d0*2048+512);
      pA0=__builtin_amdgcn_mfma_f32_32x32x16_bf16(b0,qr[d0],pA0,0,0,0);pA1=__builtin_amdgcn_mfma_f32_32x32x16_bf16(b1,qr[d0],pA1,0,0,0);}
    CMASK(pA0,pA1,0);
    DECIDE(pA0,pA1); resc=false;
    _Pragma("unroll") for(int r=0;r<16;++r){pA0[r]=__builtin_amdgcn_exp2f(pA0[r]);pA1[r]=__builtin_amdgcn_exp2f(pA1[r]);} }
  WAIT_NB();
  ROT();
  kload8(kf,kp0+sl_cur);
  WAIT_NB();
  s16x4 vlo[8],vhi[8]; u32x4 pw0,pw1,pw2,pw3;
  #define PKW(P,B) cvtpk_s(P[B],P[B+1])
  #define PAF(k) __builtin_bit_cast(bf16x8,pw##k)
  #define VFR(i) (bf16x8){vlo[i][0],vlo[i][1],vlo[i][2],vlo[i][3],vhi[i][0],vhi[i][1],vhi[i][2],vhi[i][3]}
  #define PIN(x) asm volatile("":"+v"(x))
  #define GAPA(MF,A0,A1,A2,A3,W0,W1,PW) do{ MF; sacc+=A0; sacc+=A1; sacc+=A2; sacc+=A3; PIN(sacc); W0; W1; PIN(PW); SBAR(); }while(0)
  #define EX(v) __builtin_amdgcn_exp2f(v)
  #define GAPB(MF,X,B) do{ MF; X[B]=EX(X[B]); X[B+1]=EX(X[B+1]); X[B+2]=EX(X[B+2]); X[B+3]=EX(X[B+3]); PIN(X); SBAR(); }while(0)
  #define VRD(i) do{ vlo[i]=vtr(vp_+(((i)>>2)*4096+((i)&3)*1024)); vhi[i]=vtr(vp_+(((i)>>2)*4096+((i)&3)*1024+512)); }while(0)
  #define KRD(G,j) do{ if(G){ kload2(kf,kp0+sl_next,j); SBAR(); } }while(0)
  #define STEP(C0,C1,P0,P1,t,GK,GV,GL) do{ SBAR(); \
    const lds_cptr vp_=vp0+sl_prev; const float bs_=BASE(t); \
    if constexpr(FOX){ cinit<FOX>(C0,ckl+(t)*64,bs_); SBAR(); } \
    else if(nmd){ _Pragma("unroll") for(int r=0;r<16;++r)negm[r]=bs_; asm volatile("":"+v"(negm)); nmd=false; SBAR(); }     \
    VRD(0); SBAR(); float sacc=(P0[0]+P0[1]); \
    GAPA(C0=__builtin_amdgcn_mfma_f32_32x32x16_bf16(kf[0],qr[0],FOX?C0:negm,0,0,0), P0[2],P0[3],P0[4],P0[5],     pw0[0]=PKW(P0,0), pw0[1]=PKW(P0,2), pw0); \
    if constexpr(FOX){ cinit<FOX>(C1,ckl+(t)*64+32,bs_); SBAR(); } \
    VRD(4); SBAR(); GAPA(C1=__builtin_amdgcn_mfma_f32_32x32x16_bf16(kf[1],qr[0],FOX?C1:negm,0,0,0), P0[6],P0[7],P0[8],P0[9],     pw0[2]=PKW(P0,4), pw0[3]=PKW(P0,6), pw0); \
    VRD(1); SBAR(); GAPA(C0=__builtin_amdgcn_mfma_f32_32x32x16_bf16(kf[2],qr[1],C0,0,0,0),   P0[10],P0[11],P0[12],P0[13], pw1[0]=PKW(P0,8), pw1[1]=PKW(P0,10), pw1); \
    VRD(5); SBAR(); GAPA(C1=__builtin_amdgcn_mfma_f32_32x32x16_bf16(kf[3],qr[1],C1,0,0,0),   P0[14],P0[15],P1[0],P1[1],   pw1[2]=PKW(P0,12),pw1[3]=PKW(P0,14), pw1); \
    VRD(2); SBAR(); GAPA(C0=__builtin_amdgcn_mfma_f32_32x32x16_bf16(kf[4],qr[2],C0,0,0,0),   P1[2],P1[3],P1[4],P1[5],     pw2[0]=PKW(P1,0), pw2[1]=PKW(P1,2), pw2); \
    VRD(6); SBAR(); GAPA(C1=__builtin_amdgcn_mfma_f32_32x32x16_bf16(kf[5],qr[2],C1,0,0,0),   P1[6],P1[7],P1[8],P1[9],     pw2[2]=PKW(P1,4), pw2[3]=PKW(P1,6), pw2); \
    VRD(3); SBAR(); GAPA(C0=__builtin_amdgcn_mfma_f32_32x32x16_bf16(kf[6],qr[3],C0,0,0,0),   P1[10],P1[11],P1[12],P1[13], pw3[0]=PKW(P1,8), pw3[1]=PKW(P1,10), pw3); \
    VRD(7); SBAR(); GAPA(C1=__builtin_amdgcn_mfma_f32_32x32x16_bf16(kf[7],qr[3],C1,0,0,0),   P1[14],P1[15],0.f,0.f,       pw3[2]=PKW(P1,12),pw3[3]=PKW(P1,14), pw3); \
    l_reg+=sacc; \
    if(GK){DMA_K((t)+3,sl_cur);} if(GV){DMA_V((t)+1,sl_next);} \
    CMASK(C0,C1,t); \
    DECIDE(C0,C1); \
    SBAR(); \
    GAPB(o[0]=__builtin_amdgcn_mfma_f32_32x32x16_bf16(PAF(0),VFR(0),o[0],0,0,0), C0,0); \
    GAPB(o[1]=__builtin_amdgcn_mfma_f32_32x32x16_bf16(PAF(0),VFR(4),o[1],0,0,0), C0,4); \
    KRD(GL,0); GAPB(o[0]=__builtin_amdgcn_mfma_f32_32x32x16_bf16(PAF(1),VFR(1),o[0],0,0,0), C0,8); \
    KRD(GL,1); GAPB(o[1]=__builtin_amdgcn_mfma_f32_32x32x16_bf16(PAF(1),VFR(5),o[1],0,0,0), C0,12); \
    KRD(GL,2); GAPB(o[0]=__builtin_amdgcn_mfma_f32_32x32x16_bf16(PAF(2),VFR(2),o[0],0,0,0), C1,0); \
    KRD(GL,3); GAPB(o[1]=__builtin_amdgcn_mfma_f32_32x32x16_bf16(PAF(2),VFR(6),o[1],0,0,0), C1,4); \
    GAPB(o[0]=__builtin_amdgcn_mfma_f32_32x32x16_bf16(PAF(3),VFR(3),o[0],0,0,0), C1,8); \
    GAPB(o[1]=__builtin_amdgcn_mfma_f32_32x32x16_bf16(PAF(3),VFR(7),o[1],0,0,0), C1,12); \
    }while(0)
  int t=1;
  #undef CMASK
  #define CMASK(P0,P1,t) do{}while(0)
  for(;t+5<NT;t+=2){
    STEP(pB0,pB1,pA0,pA1,t,false,false,true);     WAIT_NB(); RESC(); ROT();
    STEP(pA0,pA1,pB0,pB1,t+1,false,false,true);   WAIT_NB(); RESC(); ROT();
  }
  #undef CMASK
  #define CMASK(P0,P1,t) do{ if constexpr(VAR!=2){ int jb_=(t)-(NT-4); if(jb_>=0)cmask(P0,P1,jb_,qrel,hi); } }while(0)
  #define ENDW(tt) WAIT_NB()
  for(;t+1<NT;t+=2){
    STEP(pB0,pB1,pA0,pA1,t,false,false,(t+1<NT));       ENDW(t);   RESC(); ROT();
    STEP(pA0,pA1,pB0,pB1,t+1,false,false,(t+2<NT));     ENDW(t+1); RESC(); ROT();
  }
  STEP(pB0,pB1,pA0,pA1,NT-1,false,false,false); RESC();
  if constexpr(VAR==2){ if(c_+1<nch){ qidx=qnext; const bf16*Qrow=Q+(rowbase+qidx)*DM+h*D;
      #pragma unroll
      for(int d0=0;d0<4;++d0)qr[d0]=*reinterpret_cast<const bf16x8*>(&Qrow[d0*16+hi*8]);
      s3=mio.SEL3[qidx]; qnext=(int)mio.QL[min((c_+2)*QB+wid*QBLK+r32,cnt-1)]; } }
  { float sacc=pB0[0]+pB0[1]; _Pragma("unroll") for(int r=2;r<16;++r)sacc+=pB0[r]; _Pragma("unroll") for(int r=0;r<16;++r)sacc+=pB1[r]; l_reg+=sacc;
    pw0=(u32x4){PKW(pB0,0),PKW(pB0,2),PKW(pB0,4),PKW(pB0,6)};pw1=(u32x4){PKW(pB0,8),PKW(pB0,10),PKW(pB0,12),PKW(pB0,14)};pw2=(u32x4){PKW(pB1,0),PKW(pB1,2),PKW(pB1,4),PKW(pB1,6)};pw3=(u32x4){PKW(pB1,8),PKW(pB1,10),PKW(pB1,12),PKW(pB1,14)};
    SBAR(); pv(o,vb0+sl_cur,PAF(0),PAF(1),PAF(2),PAF(3)); }
  #undef PKW
  #undef PAF
  #undef VFR
  #undef PIN
  #undef MX3
  #undef GAPA
  #undef GAPB
  #undef EX
  #undef VRD
  #undef KRD
  #undef STEP
  #undef ENDW
  #undef DECIDE
  #undef BASE
  {auto rr=__builtin_amdgcn_permlane32_swap(__float_as_uint(l_reg),__float_as_uint(l_reg),false,false);l_reg=__uint_as_float(rr[0])+__uint_as_float(rr[1]);}
  const int info=__float_as_int(wsf[64+lane]);
  if(hi==0){ wsf[32+r32]=l_reg; if constexpr(VAR==2) wsf[r32]=__int_as_float(info); }
  asm volatile("s_waitcnt lgkmcnt(0)":::"memory");
  if(hi==0&&info>=0) mio.LSE[info]=mhat+__builtin_amdgcn_logf(l_reg);
  float rli[16];
  #pragma unroll
  for(int r=0;r<16;++r)rli[r]=__builtin_amdgcn_rcpf(wsf[32+crow(r,hi)]);
  { bf16*stg=(bf16*)(shm+LOST)+wid*2048;
    #pragma unroll
    for(int r=0;r<16;++r){const int orow=crow(r,hi);
      #pragma unroll
      for(int d0=0;d0<2;++d0)stg[orow*64+d0*32+r32]=__float2bfloat16(o[d0][r]*rli[r]);}
    asm volatile("s_waitcnt lgkmcnt(0)":::"memory");
    if constexpr(VAR==2){
      #pragma unroll
      for(int i=0;i<4;++i){const int row=i*8+(lane>>3),ch=lane&7; const u32x4 v=*(const u32x4*)(stg+row*64+ch*8); const int inf=__float_as_int(wsf[row]);
        if(inf>=0){ bf16*pb=((inf&3)==0)?mio.PART0:(((inf&3)==1)?mio.PART1:mio.PART2); ATTN_STORE16(pb+(long)(inf>>2)*D+ch*8,v); } }
    } else if constexpr(VAR==1){
      bf16*Ow=mio.PART0+(long)(q0+wid*QBLK)*D;
      #pragma unroll
      for(int i=0;i<4;++i){const int row=i*8+(lane>>3),ch=lane&7; const u32x4 v=*(const u32x4*)(stg+row*64+ch*8); ATTN_STORE16(Ow+(long)row*D+ch*8,v);}
    } else {
      bf16*Ow=O+(rowbase+q0+wid*QBLK)*DM+h*D;
      #pragma unroll
      for(int i=0;i<4;++i){const int row=i*8+(lane>>3),ch=lane&7; const u32x4 v=*(const u32x4*)(stg+row*64+ch*8); ATTN_STORE16(Ow+(long)row*DM+ch*8,v);} } }
  asm volatile("s_waitcnt lgkmcnt(0)":::"memory");
  }
  #undef WAIT_NB
  #undef DMA_K
  #undef DMA_V
  #undef CMASK
  #undef RESC
  #undef ROT
}

__device__ __forceinline__ void moba_gate_item(int b,int h,int qb,const bf16*Q,const float*KSUM,unsigned*SEL3,unsigned*CNT,unsigned short*LIST){
  const int tid=otid(),lane=tid&63,r32=lane&31,hi=lane>>5; const int wid=__builtin_amdgcn_readfirstlane(tid>>6);
  const int q=qb*QB+wid*QBLK+r32;
  const bf16*Qrow=Q+((long)b*SEQ+q)*DM+h*D;
  bf16x8 qr[4];
  #pragma unroll
  for(int d0=0;d0<4;++d0)qr[d0]=*reinterpret_cast<const bf16x8*>(&Qrow[d0*16+hi*8]);
  f32x16 ga=f32x16{};
  const float*km=KSUM+r32*64+8*hi;
  #pragma unroll
  for(int ks=0;ks<4;++ks){
    const f32x4 a0=*(const f32x4*)(km+16*ks),a1=*(const f32x4*)(km+16*ks+4),c0=*(const f32x4*)(km+KSUM_P1+16*ks),c1=*(const f32x4*)(km+KSUM_P1+16*ks+4);
    float x[8]; u32x4 fh,fl;
    #pragma unroll
    for(int e=0;e<4;++e){x[e]=a0[e]+c0[e];x[4+e]=a1[e]+c1[e];}
    #pragma unroll
    for(int e=0;e<4;++e){ const unsigned hw=cvtpk_s(x[2*e],x[2*e+1]); fh[e]=hw; fl[e]=cvtpk_s(x[2*e]-__uint_as_float(hw<<16),x[2*e+1]-__uint_as_float(hw&0xffff0000u)); }
    ga=__builtin_amdgcn_mfma_f32_32x32x16_bf16(__builtin_bit_cast(bf16x8,fh),qr[ks],ga,0,0,0);
    ga=__builtin_amdgcn_mfma_f32_32x32x16_bf16(__builtin_bit_cast(bf16x8,fl),qr[ks],ga,0,0,0);
  }
  unsigned t0=0u,t1=0u,t2=0u;
  #define INS3(x) do{ unsigned x_=(x); unsigned m_=max(t0,x_); x_=min(t0,x_); t0=m_; m_=max(t1,x_); x_=min(t1,x_); t1=m_; t2=max(t2,x_); }while(0)
  #pragma unroll
  for(int r=0;r<16;++r){ const int n=(r&3)+8*(r>>2)+4*hi; const unsigned u_=__float_as_uint(ga[r]); const unsigned o_=u_^((unsigned)((int)u_>>31)|0x80000000u);
    const unsigned key=(n<qb)?((o_&~31u)|(unsigned)(31-n)):0u; INS3(key); }
  { const unsigned p0=(unsigned)__shfl_xor((int)t0,32),p1=(unsigned)__shfl_xor((int)t1,32),p2=(unsigned)__shfl_xor((int)t2,32); INS3(p0); INS3(p1); INS3(p2); }
  #undef INS3
  const int n0=t0?(int)(31u-(t0&31u)):-1,n1=t1?(int)(31u-(t1&31u)):-1,n2=t2?(int)(31u-(t2&31u)):-1;
  const unsigned cntv=(t0?1u:0u)+(t1?1u:0u)+(t2?1u:0u);
  if(hi==0)SEL3[q]=(unsigned)(n0&31)|((unsigned)(n1&31)<<5)|((unsigned)(n2&31)<<10)|(cntv<<15);
  unsigned mycnt=0u; int rk0=0,rk1=0,rk2=0; const unsigned long long below=(1ull<<r32)-1ull;
  for(int j=0;j<qb;++j){ const unsigned long long m=__ballot(hi==0&&(n0==j||n1==j||n2==j))&0xffffffffull; const int pc=__builtin_popcountll(m);
    if(lane==j)mycnt=(unsigned)pc; const int rk=__builtin_popcountll(m&below); if(n0==j)rk0=rk; if(n1==j)rk1=rk; if(n2==j)rk2=rk; }
  unsigned basev=0u;
  if(lane<qb&&mycnt)basev=__hip_atomic_fetch_add(CNT+lane,mycnt,__ATOMIC_RELAXED,__HIP_MEMORY_SCOPE_AGENT);
  const unsigned b0=(unsigned)__shfl((int)basev,n0<0?0:n0),b1=(unsigned)__shfl((int)basev,n1<0?0:n1),b2=(unsigned)__shfl((int)basev,n2<0?0:n2);
  if(hi==0){ if(n0>=0)LIST[(long)n0*SEQ+b0+rk0]=(unsigned short)q; if(n1>=0)LIST[(long)n1*SEQ+b1+rk1]=(unsigned short)q; if(n2>=0)LIST[(long)n2*SEQ+b2+rk2]=(unsigned short)q; }
}
#undef SBAR
#undef WAIT_BAR
}

constexpr float FOX_SKIP = 32.0f;
constexpr size_t WS_QCTR = 32 * KiB;
__device__ __forceinline__ void phase_attn(char* lds, volatile LAS unsigned* misc, const P& p) {
    attn::bf16* QKVb = (attn::bf16*)(p.ws + WS_QKV);
    unsigned* qctr = (unsigned*)(p.ws + WS_QCTR); unsigned* MCNT = (unsigned*)(p.ws + WS_MCNT); unsigned* MG1 = (unsigned*)(p.ws + WS_MG1);
    bool g1seen = false; const attn::MobaIo mio0{};
    volatile LAS unsigned* CNL = misc + 64;
    for (;;) {
        if (threadIdx.x == 0) misc[16] = __hip_atomic_fetch_add(qctr, 1u, __ATOMIC_RELAXED, __HIP_MEMORY_SCOPE_AGENT);
        __syncthreads();
        const int u = (int)__builtin_amdgcn_readfirstlane((int)misc[16]);
        __syncthreads();
        if (u >= 2032) break;
        if (u < 512) {
            const int bh = u & 15, qb = u >> 4;
            attn::moba_gate_item(bh >> 3, bh & 7, qb, QKVb, (const float*)(p.ws + WS_KMP) + (size_t)bh * 32 * 64, (unsigned*)(p.ws + WS_SEL3) + (size_t)bh * S, MCNT + bh * 32, (unsigned short*)(p.ws + WS_MLIST) + (size_t)bh * 32 * S);
            asm volatile("s_waitcnt vmcnt(0)" ::: "memory");
            __syncthreads();
            if (threadIdx.x == 0) { __builtin_amdgcn_fence(__ATOMIC_RELEASE, "agent"); asm volatile("s_waitcnt vmcnt(0)" ::: "memory");
                const unsigned old = __hip_atomic_fetch_add(MG1, 1u, __ATOMIC_RELAXED, __HIP_MEMORY_SCOPE_AGENT);
                if (old == 511u) { __builtin_amdgcn_fence(__ATOMIC_ACQ_REL, "agent"); asm volatile("s_waitcnt vmcnt(0)" ::: "memory"); __hip_atomic_store(MG1 + 64, 1u, __ATOMIC_RELAXED, __HIP_MEMORY_SCOPE_AGENT); } }
            continue;
        }
        if (u >= 1008 && u < 1520) {
            const int v = u - 1008, qb = 31 - (v >> 4), bh = v & 15;
            const float* c2 = (const float*)(p.ws + WS_C) + (size_t)bh * S; const int lane = threadIdx.x & 63, nt = 4 * qb + 4;
            const float cq = c2[qb * 256];
            const float* FK = (const float*)(p.ws + WS_FKN) + (size_t)bh * 256; const float* FQ = (const float*)(p.ws + WS_FQN) + ((size_t)bh * 32 + qb) * 4;
#define FOX_KN(t) sqrtf(FK[2 * (t)] + FK[2 * (t) + 1])
            const float qm = sqrtf(fmaxf(FQ[0] + FQ[1], FQ[2] + FQ[3])), ko = fmaxf(fmaxf(FOX_KN(4 * qb), FOX_KN(4 * qb + 1)), fmaxf(FOX_KN(4 * qb + 2), FOX_KN(4 * qb + 3)));
            const float th0 = (lane < nt) ? 1.01f * qm * (FOX_KN(lane) + ko) + FOX_SKIP : 0.f, th1 = (lane + 64 < nt) ? 1.01f * qm * (FOX_KN(lane + 64) + ko) + FOX_SKIP : 0.f;
#undef FOX_KN
            const bool keep0 = (lane < nt) ? (cq - c2[64 * lane + 63] >= -th0) : true, keep1 = (lane + 64 < nt) ? (cq - c2[64 * (lane + 64) + 63] >= -th1) : true;
            const unsigned long long m0 = __ballot(keep0), m1 = __ballot(keep1);
            int first = m0 ? __builtin_ctzll(m0) : 64 + __builtin_ctzll(m1);
            int t0 = first & ~1; if (t0 > nt - 4) t0 = nt - 4;
            t0 = __builtin_amdgcn_readfirstlane(t0);
            attn::attn_unit<true, 24, 0>(bh >> 3, bh & 7, qb, t0, QKVb + SLOT, QKVb + 4 * SLOT, QKVb + 5 * SLOT, QKVb + SLOT, c2, mio0, lds);
            continue;
        }
        if (!g1seen) {
            if (threadIdx.x == 0) { unsigned sp = 0u;
                while (__hip_atomic_load(MG1 + 64, __ATOMIC_RELAXED, __HIP_MEMORY_SCOPE_AGENT) == 0u) { __builtin_amdgcn_s_sleep(8); if (++sp > (1u << 22)) break; }
                __builtin_amdgcn_fence(__ATOMIC_ACQUIRE, "agent"); asm volatile("s_waitcnt vmcnt(0)" ::: "memory"); }
            __syncthreads();
            CNL[threadIdx.x] = __hip_atomic_load(MCNT + threadIdx.x, __ATOMIC_RELAXED, __HIP_MEMORY_SCOPE_AGENT);
            __syncthreads();
            g1seen = true;
        }
        attn::MobaIo mio{};
        if (u < 1008) {
            const int v = u - 512, j = v >> 4, bh = v & 15, cnt = (int)__builtin_amdgcn_readfirstlane((int)CNL[bh * 32 + j]);
            if (cnt == 0) continue;
            mio.QL = (const unsigned short*)(p.ws + WS_MLIST) + ((size_t)bh * 32 + j) * S; mio.SEL3 = (const unsigned*)(p.ws + WS_SEL3) + (size_t)bh * S; mio.LSE = (float*)(p.ws + WS_MLSE) + (size_t)bh * S * 4;
            mio.PART0 = (attn::bf16*)(p.ws + WS_MP0) + (size_t)bh * S * 64; mio.PART1 = (attn::bf16*)(p.ws + WS_MP1) + (size_t)bh * S * 64; mio.PART2 = (attn::bf16*)(p.ws + WS_MP2) + (size_t)bh * S * 64;
            attn::moba4_unit<false>(bh >> 3, bh & 7, 0, j, cnt, QKVb, QKVb + 2 * SLOT, QKVb + 3 * SLOT, mio, lds);
        } else {
            const int v = u - 1520, qb = v >> 4, bh = v & 15;
            mio.LSE = (float*)(p.ws + WS_MLSE) + (size_t)bh * S * 4; mio.PART0 = (attn::bf16*)(p.ws + WS_MP3) + (size_t)bh * S * 64;
            attn::moba4_unit<true>(bh >> 3, bh & 7, qb, qb, 256, QKVb, QKVb + 2 * SLOT, QKVb + 3 * SLOT, mio, lds);
        }
    }
}
__device__ __forceinline__ void phase_moba_combine(const P& p) {
    const int TID = otid();
    bf16_t* OA = (bf16_t*)(p.ws + WS_QKV); const unsigned* SEL3 = (const unsigned*)(p.ws + WS_SEL3); const float* LSE = (const float*)(p.ws + WS_MLSE);
    const bf16_t* P0 = (const bf16_t*)(p.ws + WS_MP0); const bf16_t* P1 = (const bf16_t*)(p.ws + WS_MP1); const bf16_t* P2 = (const bf16_t*)(p.ws + WS_MP2); const bf16_t* P3 = (const bf16_t*)(p.ws + WS_MP3);
    for (int it = blockIdx.x * 512 + TID; it < Bn * NH * S * 8; it += gridDim.x * 512) {
        const int ch = it & 7, bq = it >> 3, bh = bq >> 13, q = bq & (S - 1), b = bh >> 3, h = bh & 7;
        const unsigned n = SEL3[bq] >> 15;
        bf16_t* orow = OA + ((size_t)b * S + q) * 512 + h * 64 + ch * 8;
        const u32x4 own = *(const u32x4*)(P3 + (size_t)bq * 64 + ch * 8);
        if (n == 0u) { *(u32x4*)orow = own; continue; }
        const f32x4 ls = *(const f32x4*)(LSE + (size_t)bq * 4);
        float m = fmaxf(ls[3], ls[0]); if (n > 1u) m = fmaxf(m, ls[1]); if (n > 2u) m = fmaxf(m, ls[2]);
        const float w3 = __builtin_amdgcn_exp2f(ls[3] - m), w0 = __builtin_amdgcn_exp2f(ls[0] - m), w1 = (n > 1u) ? __builtin_amdgcn_exp2f(ls[1] - m) : 0.f, w2 = (n > 2u) ? __builtin_amdgcn_exp2f(ls[2] - m) : 0.f;
        const float rw = 1.f / (w3 + w0 + w1 + w2);
        f32x4 a0, a1, x0, x1; pg8::unpack8(own, a0, a1); a0 = a0 * w3; a1 = a1 * w3;
        pg8::unpack8(*(const u32x4*)(P0 + (size_t)bq * 64 + ch * 8), x0, x1); a0 += x0 * w0; a1 += x1 * w0;
        if (n > 1u) { pg8::unpack8(*(const u32x4*)(P1 + (size_t)bq * 64 + ch * 8), x0, x1); a0 += x0 * w1; a1 += x1 * w1; }
        if (n > 2u) { pg8::unpack8(*(const u32x4*)(P2 + (size_t)bq * 64 + ch * 8), x0, x1); a0 += x0 * w2; a1 += x1 * w2; }
        *(u32x4*)orow = pg8::pack8(a0 * rw, a1 * rw);
    }
}

typedef float f32x2v __attribute__((ext_vector_type(2)));
__device__ __forceinline__ unsigned q8_pack(const f32x4& a, float sc, int bias) {
    const int q0 = (int)rintf(a[0] * sc) + bias, q1 = (int)rintf(a[1] * sc) + bias, q2 = (int)rintf(a[2] * sc) + bias, q3 = (int)rintf(a[3] * sc) + bias;
    return (unsigned)(q0 & 0xff) | ((unsigned)(q1 & 0xff) << 8) | ((unsigned)(q2 & 0xff) << 16) | ((unsigned)(q3 & 0xff) << 24); }
__device__ __forceinline__ void q8_row(const float* src, const float* gain, unsigned char* dst, size_t sstride, float* scale_out, int lane, int bias) {
    f32x4 a[4]; float am = 0.f;
#pragma unroll
    for (int q = 0; q < 4; ++q) { a[q] = *(const f32x4*)(src + 16 * lane + 4 * q);
        if (gain) { const f32x4 g = *(const f32x4*)(gain + 16 * lane + 4 * q); a[q][0] *= g[0]; a[q][1] *= g[1]; a[q][2] *= g[2]; a[q][3] *= g[3]; }
        am = fmaxf(fmaxf(am, fmaxf(fabsf(a[q][0]), fabsf(a[q][1]))), fmaxf(fabsf(a[q][2]), fabsf(a[q][3]))); }
    am = wave_max_fast(am);
    const float sc = am > 0.f ? 127.0f / am : 1.0f;
    u32x4 o;
#pragma unroll
    for (int q = 0; q < 4; ++q) o[q] = q8_pack(a[q], sc, bias);
    *(u32x4*)(dst + (sstride ? (size_t)(lane >> 3) * sstride + 16 * (lane & 7) : (size_t)16 * lane)) = o;
    if (lane == 0) *scale_out = am > 0.f ? am * (1.0f / 127.0f) : 1.0f;
}
template <bool USGN> __device__ __forceinline__ void q4_row(const float* src, const float* gain, unsigned char* dst, float* scale_out, int lane) {
    f32x4 a[4]; float ss = 0.f;
#pragma unroll
    for (int q = 0; q < 4; ++q) { a[q] = *(const f32x4*)(src + 16 * lane + 4 * q);
        if (gain) { const f32x4 g = *(const f32x4*)(gain + 16 * lane + 4 * q); a[q][0] *= g[0]; a[q][1] *= g[1]; a[q][2] *= g[2]; a[q][3] *= g[3]; }
        ss += (a[q][0] * a[q][0] + a[q][1] * a[q][1]) + (a[q][2] * a[q][2] + a[q][3] * a[q][3]); }
    ss = wave_sum_fast(ss);
    const float step = sqrtf(ss * (1.f / D)) * 0.3352f, inv = step > 0.f ? 1.0f / step : 0.f;
    u32x2 o; o[0] = 0u; o[1] = 0u;
    int qs = 0;
#pragma unroll
    for (int i = 0; i < 16; ++i) { int q = (int)floorf(a[i >> 2][i & 3] * inv); q = min(max(q, -8), 7); qs += q;
        o[i >> 3] |= (unsigned)((USGN || (i & 1)) ? (q & 15) : (q + 8)) << (4 * (i & 7)); }
    *(u32x2*)(dst + (size_t)(lane >> 4) * ESLICE + 8 * (lane & 15)) = o;
    if (USGN) { const float rs = wave_sum_fast((float)qs); if (lane == 0) scale_out[2 * PNK * PNK] = rs; }
    if (lane == 0) *scale_out = step > 0.f ? step : 1.0f;
}
__device__ __forceinline__ void phase_expert_tables(const P& p) {
    const int TID = otid();
    const int lane = TID & 63, gw = (blockIdx.x * blockDim.x + TID) >> 6, nw = (gridDim.x * blockDim.x) >> 6;
    for (int r = gw; r < PNK * PNK; r += nw) {
        q4_row<true>(p.eu + (size_t)r * D, p.g_ffn, p.ws + WS_EU + (size_t)r * 128, (float*)(p.ws + WS_USC) + r, lane);
        q4_row<false>(p.ev + (size_t)r * D, nullptr, p.ws + WS_EV + (size_t)r * 128, (float*)(p.ws + WS_VSC) + r, lane);
    }
}

typedef short bf16x8_t __attribute__((ext_vector_type(8)));
typedef float f32x16_t __attribute__((ext_vector_type(16)));
__device__ __forceinline__ unsigned f2ord(float f) { const unsigned u = __float_as_uint(f); return u ^ ((unsigned)((int)u >> 31) | 0x80000000u); }
__device__ __forceinline__ float ord2f(unsigned k) { return __uint_as_float((k & 0x80000000u) ? (k ^ 0x80000000u) : ~k); }
#define TK_CAS(a, b, desc) do { const unsigned hi__ = max(a, b), lo__ = min(a, b); if (desc) { a = hi__; b = lo__; } else { a = lo__; b = hi__; } } while (0)
__device__ __forceinline__ void tk_sort16(unsigned (&v)[16]) {
#define C(i, j) TK_CAS(v[i], v[j], true);
    C(0,1) C(2,3) C(0,2) C(1,3) C(1,2) C(4,5) C(6,7) C(4,6) C(5,7) C(5,6) C(0,4) C(2,6) C(2,4) C(1,5) C(3,7) C(3,5) C(1,2) C(3,4) C(5,6) C(8,9) C(10,11) C(8,10) C(9,11) C(9,10) C(12,13) C(14,15) C(12,14) C(13,15) C(13,14) C(8,12) C(10,14) C(10,12) C(9,13) C(11,15) C(11,13) C(9,10) C(11,12) C(13,14) C(0,8) C(4,12) C(4,8) C(2,10) C(6,14) C(6,10) C(2,4) C(6,8) C(10,12) C(1,9) C(5,13) C(5,9) C(3,11) C(7,15) C(7,11) C(3,5) C(7,9) C(11,13) C(1,2) C(3,4) C(5,6) C(7,8) C(9,10) C(11,12) C(13,14)
#undef C
}
__device__ __forceinline__ void tk_merge16(unsigned (&a)[16], const unsigned (&b)[16]) {
#pragma unroll
    for (int i = 0; i < 16; ++i) a[i] = max(a[i], b[15 - i]);
#pragma unroll
    for (int st = 8; st >= 1; st >>= 1)
#pragma unroll
        for (int i = 0; i < 16; ++i) if ((i & st) == 0) TK_CAS(a[i], a[i + st], true);
}
__host__ __device__ constexpr int tk_pair_rank(int i, int j) { int c = 0; for (int a = 0; a < 16; ++a) for (int b = 0; b < 16; ++b) { if (a == i && b == j) return c; if ((a + 1) * (b + 1) <= 16) ++c; } return c; }
__device__ __forceinline__ unsigned tk_lookup(unsigned long long lo, unsigned long long hi, int i) {
    const unsigned long long w = (i & 8) ? hi : lo; return (unsigned)(w >> ((i & 7) * 8)) & 0xffu; }
__device__ __forceinline__ void phase_h8(const P& p) {
    const int TID = otid();
    const int lane = TID & 63, gw = (blockIdx.x * blockDim.x + TID) >> 6, nw = (gridDim.x * blockDim.x) >> 6;
    for (int t = gw; t < T; t += nw) {
        const bf16_t* hb = (const bf16_t*)(p.ws + WS_XN) + (size_t)t * D + 16 * lane; const u32x4 h0 = *(const u32x4*)hb, h1 = *(const u32x4*)(hb + 8);
        f32x4 a[4]; float am = 0.f;
#pragma unroll
        for (int w = 0; w < 4; ++w) { const unsigned d = (w < 2) ? h0[2 * w] : h1[2 * (w - 2)], e = (w < 2) ? h0[2 * w + 1] : h1[2 * (w - 2) + 1];
            a[w][0] = __uint_as_float(d << 16); a[w][1] = __uint_as_float(d & 0xffff0000u); a[w][2] = __uint_as_float(e << 16); a[w][3] = __uint_as_float(e & 0xffff0000u);
            am = fmaxf(fmaxf(am, fmaxf(fabsf(a[w][0]), fabsf(a[w][1]))), fmaxf(fabsf(a[w][2]), fabsf(a[w][3]))); }
        am = wave_max_fast(am);
        const float sc = am > 0.f ? 127.0f / am : 1.0f;
        int hs = 0; u32x2 hh, hl; hh[0] = 0u; hh[1] = 0u; hl[0] = 0u; hl[1] = 0u;
#pragma unroll
        for (int w = 0; w < 4; ++w)
#pragma unroll
            for (int k = 0; k < 4; ++k) { const int qv = (int)rintf(a[w][k] * sc); hs += qv; const int n = 4 * (w & 1) + k;
                hh[w >> 1] |= (unsigned)((qv >> 4) & 15) << (4 * n); hl[w >> 1] |= (unsigned)((qv & 15) ^ 8) << (4 * n); }
        unsigned char* hb8 = p.ws + WS_H8 + (size_t)t * D + 32 * (lane >> 1) + 8 * (lane & 1);
        *(u32x2*)hb8 = hh; *(u32x2*)(hb8 + 16) = hl;
        const float hc = wave_sum_fast(0.5f * (float)hs);
        if (lane == 0) { ((float*)(p.ws + WS_HSC))[t] = am > 0.f ? am * (1.0f / 127.0f) : 1.0f; ((float*)(p.ws + WS_HSC))[T + t] = hc; }
    }
}
__device__ __forceinline__ void phase_peer_topk(LAS unsigned char* ldsb, const P& p, const pg8::StaticOrder& So) {
    const int TID = otid();
    const int lane = TID & 63, r32 = lane & 31, hi = lane >> 5, wave = TID >> 6;
    const bf16_t* PQ = (const bf16_t*)(p.ws + WS_PQ); const bf16_t* SKb = (const bf16_t*)(p.ws + WS_SK); int* IDX = (int*)(p.ws + WS_IDX); float* GATE = (float*)(p.ws + WS_GATE);
    pg8::Unit un;
    for (int ui = 0; So.next(ui, un); ++ui) {
        const int tg = un.pm * 8 + wave, h = un.pn, t = tg * 32 + r32;
        __syncthreads();
#pragma unroll
        for (int j = 0; j < 8; ++j) { const int q = TID + 512 * j, pp_ = q >> 11, row = (q >> 4) & 127, ch = q & 15;
            *(LAS u32x4*)(ldsb + pp_ * 32768 + row * 256 + ((ch ^ (row & 15)) * 16)) = *(const u32x4*)(SKb + ((size_t)(h * 2 + pp_) * PNK + row) * PHALF + ch * 8); }
        u32x4 qfr[2][8];
#pragma unroll
        for (int pp = 0; pp < 2; ++pp)
#pragma unroll
            for (int ks = 0; ks < 8; ++ks) qfr[pp][ks] = *(const u32x4*)(PQ + (size_t)t * PQC + h * 256 + pp * 128 + 8 * hi + 16 * ks);
        __syncthreads();
        unsigned K0[16], K1[16];
#pragma unroll
        for (int pp = 0; pp < 2; ++pp) {
            f32x16_t acc[4];
#pragma unroll
            for (int mt = 0; mt < 4; ++mt) acc[mt] = f32x16_t{};
#pragma unroll
            for (int ks = 0; ks < 8; ++ks) {
                const bf16x8_t qf = __builtin_bit_cast(bf16x8_t, qfr[pp][ks]);
#pragma unroll
                for (int mt = 0; mt < 4; ++mt) { const int row = 32 * mt + r32;
                    const bf16x8_t kf = __builtin_bit_cast(bf16x8_t, *(const LAS u32x4*)(ldsb + pp * 32768 + row * 256 + (((2 * ks + hi) ^ (row & 15)) * 16)));
                    acc[mt] = __builtin_amdgcn_mfma_f32_32x32x16_bf16(kf, qf, acc[mt], 0, 0, 0); }
            }
            unsigned L[16], L1[16], L2[16], L3[16];
            const unsigned h4 = 4u * (unsigned)hi;
#pragma unroll
            for (int r = 0; r < 16; ++r) { const unsigned lowb = (unsigned)(127 - (r & 3) - 8 * (r >> 2)) - h4;
                L[r] = (f2ord(acc[0][r]) & ~127u) | lowb; L1[r] = (f2ord(acc[1][r]) & ~127u) | (lowb - 32u); L2[r] = (f2ord(acc[2][r]) & ~127u) | (lowb - 64u); L3[r] = (f2ord(acc[3][r]) & ~127u) | (lowb - 96u); }
            tk_sort16(L); tk_sort16(L1); tk_sort16(L2); tk_sort16(L3);
            tk_merge16(L, L1); tk_merge16(L2, L3); tk_merge16(L, L2);
            unsigned M[16];
#pragma unroll
            for (int i = 0; i < 16; ++i) { const auto r_ = __builtin_amdgcn_permlane32_swap(L[i], L[i], false, false); M[i] = hi ? r_[0] : r_[1]; }
            tk_merge16(L, M);
#pragma unroll
            for (int i = 0; i < 16; ++i) { if (pp == 0) K0[i] = L[i]; else K1[i] = L[i]; }
        }
        float v0[16], v1[16]; unsigned long long t0lo = 0ull, t0hi = 0ull, t1lo = 0ull, t1hi = 0ull;
#pragma unroll
        for (int i = 0; i < 16; ++i) { v0[i] = ord2f(K0[i] & ~127u); v1[i] = ord2f(K1[i] & ~127u);
            const unsigned long long e0 = (unsigned long long)(127u - (K0[i] & 127u)) << ((i & 7) * 8), e1 = (unsigned long long)(127u - (K1[i] & 127u)) << ((i & 7) * 8);
            if (i < 8) { t0lo |= e0; t1lo |= e1; } else { t0hi |= e0; t1hi |= e1; } }
        unsigned Bk[16], B1[16], B2[16], B3[16];
#pragma unroll
        for (int i = 0; i < 16; ++i) { Bk[i] = 0u; B1[i] = 0u; B2[i] = 0u; B3[i] = 0u; }
#pragma unroll
        for (int i = 0; i < 16; ++i)
#pragma unroll
            for (int j = 0; j < 16; ++j) if ((i + 1) * (j + 1) <= 16) {
                const unsigned key = (f2ord(v0[i] + v1[j]) & ~255u) | (unsigned)(255 - (i * 16 + j));
                const int rk = tk_pair_rank(i, j);
                if ((rk >> 4) == 0) Bk[rk & 15] = key; else if ((rk >> 4) == 1) B1[rk & 15] = key; else if ((rk >> 4) == 2) B2[rk & 15] = key; else B3[rk & 15] = key; }
#pragma unroll
        for (int i = 0; i < 16; ++i) { Bk[i] = hi ? B2[i] : Bk[i]; B1[i] = hi ? B3[i] : B1[i]; }
        tk_sort16(Bk); tk_sort16(B1); tk_merge16(Bk, B1);
#pragma unroll
        for (int i = 0; i < 16; ++i) { const auto r_ = __builtin_amdgcn_permlane32_swap(Bk[i], Bk[i], false, false); B2[i] = hi ? r_[0] : r_[1]; }
        tk_merge16(Bk, B2);
        float rstd;
        { const f32x4* rp = (const f32x4*)((const float*)(p.ws + WS_RSSP) + (size_t)t * 16); const f32x4 s4 = (rp[0] + rp[1]) + (rp[2] + rp[3]);
          rstd = rsqrtf(((s4[0] + s4[1]) + (s4[2] + s4[3])) * (1.f / D) + EPS); }
        float gt[16]; int ex[16]; float sum = 0.f; const float best0 = ord2f(Bk[0] & ~255u);
#pragma unroll
        for (int r = 0; r < 16; ++r) { const float bv = ord2f(Bk[r] & ~255u); gt[r] = __expf(rstd * (bv - best0)); sum += gt[r];
            const int flat = 255 - (int)(Bk[r] & 255u); ex[r] = (int)tk_lookup(t0lo, t0hi, flat >> 4) * PNK + (int)tk_lookup(t1lo, t1hi, flat & 15); }
        const float rs = 1.f / sum;
        if (hi == 0) {
#pragma unroll
            for (int q = 0; q < 4; ++q) {
                u32x4 iv; iv.x = (unsigned)ex[4 * q]; iv.y = (unsigned)ex[4 * q + 1]; iv.z = (unsigned)ex[4 * q + 2]; iv.w = (unsigned)ex[4 * q + 3];
                *(u32x4*)(IDX + ((size_t)t * PH + h) * PK + 4 * q) = iv;
                f32x4 gv; gv[0] = gt[4 * q] * rs; gv[1] = gt[4 * q + 1] * rs; gv[2] = gt[4 * q + 2] * rs; gv[3] = gt[4 * q + 3] * rs;
                *(f32x4*)(GATE + ((size_t)t * PH + h) * PK + 4 * q) = gv; }
        }
    }
}

__device__ __forceinline__ float gelu_exact(float v) {
    const float av = fabsf(v), t = __builtin_amdgcn_rcpf(av * 0.2316418882f + 1.0f);
    float q = t * 0.5307027145f + (-0.7265760135f); q = q * t + 0.7107068705f; q = q * t + (-0.142248368f); q = q * t + 0.127414796f; q = q * t;
    const float e = __builtin_amdgcn_exp2f((v * v) * (-0.72134752044f)), m = v * (q * e);
    return v < 0.f ? m : v - m;
}
#define EX_HALVE16(d, m2, m1, m0, u2, u1, u0, r0, r1) do { float h8_[8], h4_[4]; \
        _Pragma("unroll") for (int i_ = 0; i_ < 8; ++i_) { const float k_ = (u2) ? d[i_ + 8] : d[i_], s_ = (u2) ? d[i_] : d[i_ + 8]; h8_[i_] = k_ + __shfl_xor(s_, (m2)); } \
        _Pragma("unroll") for (int i_ = 0; i_ < 4; ++i_) { const float k_ = (u1) ? h8_[i_ + 4] : h8_[i_], s_ = (u1) ? h8_[i_] : h8_[i_ + 4]; h4_[i_] = k_ + __shfl_xor(s_, (m1)); } \
        { const float k0_ = (u0) ? h4_[2] : h4_[0], s0_ = (u0) ? h4_[0] : h4_[2], k1_ = (u0) ? h4_[3] : h4_[1], s1_ = (u0) ? h4_[1] : h4_[3]; r0 = k0_ + __shfl_xor(s0_, (m0)); r1 = k1_ + __shfl_xor(s1_, (m0)); } } while (0)
#define EX_HALVE16_SWAP(d, u0, r0, r1) do { float h8_[8], h4_[4]; \
        _Pragma("unroll") for (int i_ = 0; i_ < 8; ++i_) { const auto q_ = __builtin_amdgcn_permlane32_swap(__float_as_uint(d[i_]), __float_as_uint(d[i_ + 8]), false, false); h8_[i_] = __uint_as_float(q_[0]) + __uint_as_float(q_[1]); } \
        _Pragma("unroll") for (int i_ = 0; i_ < 4; ++i_) { const auto q_ = __builtin_amdgcn_permlane16_swap(__float_as_uint(h8_[i_]), __float_as_uint(h8_[i_ + 4]), false, false); h4_[i_] = __uint_as_float(q_[0]) + __uint_as_float(q_[1]); } \
        { const float k0_ = (u0) ? h4_[2] : h4_[0], s0_ = (u0) ? h4_[0] : h4_[2], k1_ = (u0) ? h4_[3] : h4_[1], s1_ = (u0) ? h4_[1] : h4_[3]; \
          r0 = k0_ + __builtin_bit_cast(float, __builtin_amdgcn_update_dpp(0, __builtin_bit_cast(int, s0_), 0x128, 0xf, 0xf, true)); r1 = k1_ + __builtin_bit_cast(float, __builtin_amdgcn_update_dpp(0, __builtin_bit_cast(int, s1_), 0x128, 0xf, 0xf, true)); } } while (0)
#define EX_HALVE16_SWAP_I(d, u0, r0, r1) do { int h8_[8], h4_[4]; \
        _Pragma("unroll") for (int i_ = 0; i_ < 8; ++i_) { const auto q_ = __builtin_amdgcn_permlane32_swap((unsigned)d[i_], (unsigned)d[i_ + 8], false, false); h8_[i_] = (int)(q_[0] + q_[1]); } \
        _Pragma("unroll") for (int i_ = 0; i_ < 4; ++i_) { const auto q_ = __builtin_amdgcn_permlane16_swap((unsigned)h8_[i_], (unsigned)h8_[i_ + 4], false, false); h4_[i_] = (int)(q_[0] + q_[1]); } \
        { const int k0_ = (u0) ? h4_[2] : h4_[0], s0_ = (u0) ? h4_[0] : h4_[2], k1_ = (u0) ? h4_[3] : h4_[1], s1_ = (u0) ? h4_[1] : h4_[3]; \
          r0 = k0_ + __builtin_amdgcn_update_dpp(0, s0_, 0x128, 0xf, 0xf, true); r1 = k1_ + __builtin_amdgcn_update_dpp(0, s1_, 0x128, 0xf, 0xf, true); } } while (0)
struct ExIds { u32x4 i0, i1, i2, i3; };
struct ExAux { u32x4 w0; f32x4 y; };
__device__ __forceinline__ void ex_ids(ExIds& I, const P& p, int t, int g) {
    const u32x4* ip = (const u32x4*)((const int*)(p.ws + WS_IDX) + (size_t)t * 128 + 16 * g); I.i0 = ip[0]; I.i1 = ip[1]; I.i2 = ip[2]; I.i3 = ip[3]; }
template <int PASS> __device__ __forceinline__ void ex_gather(u32x4 (&buf)[16], ExAux& X, const ExIds& I, const P& p, int t, int x, int g, int c) {
    const __amdgpu_buffer_rsrc_t TAB = __builtin_amdgcn_make_buffer_rsrc((void*)(p.ws + (PASS == 0 ? WS_EU : WS_EV) + (size_t)x * ESLICE), 0, (int)ESLICE, 0x00020000);
#pragma unroll
    for (int j = 0; j < 16; ++j) { const unsigned e = (j < 4) ? I.i0[j & 3] : (j < 8) ? I.i1[j & 3] : (j < 12) ? I.i2[j & 3] : I.i3[j & 3];
        buf[j] = __builtin_amdgcn_raw_buffer_load_b128(TAB, (int)(e * 128u) + 16 * c, 0, 0); }
    if constexpr (PASS == 0) { const u32x4* hp8 = (const u32x4*)(p.ws + WS_H8 + (size_t)t * D + x * 256 + 32 * c); X.w0 = hp8[0]; X.y = __builtin_bit_cast(f32x4, hp8[1]); }
    else { X.w0 = *(const u32x4*)(p.ws + WS_A + (size_t)t * 128 + 16 * g);
           const bf16_t* hp = (const bf16_t*)(p.ws + WS_XN) + (size_t)t * D + x * 256 + 32 * c + 2 * g; const unsigned hw = *(const unsigned*)hp, hw1 = *(const unsigned*)(hp + 16);
           X.y[0] = __uint_as_float(hw << 16); X.y[1] = __uint_as_float(hw & 0xffff0000u); X.y[2] = __uint_as_float(hw1 << 16); X.y[3] = __uint_as_float(hw1 & 0xffff0000u); }
}
template <int PASS> __device__ __forceinline__ void ex_compute(const u32x4 (&buf)[16], const ExAux& X, const P& p, int t, int x, int lane, int g, int c, float asc, float cs, float& o0, float& o1) {
    float d[16];
    if constexpr (PASS == 0) {
        const u32x4 w1 = __builtin_bit_cast(u32x4, X.y);
#pragma unroll
        for (int j = 0; j < 16; ++j) { int aH = 0, aL = 0;
#pragma unroll
            for (int q = 0; q < 4; ++q) { aH = __builtin_amdgcn_sdot8((int)buf[j][q], (int)X.w0[q], aH, false); aL = __builtin_amdgcn_sdot8((int)buf[j][q], (int)w1[q], aL, false); }
            d[j] = (float)((aH << 4) + aL); }
        float r0, r1;
        EX_HALVE16(d, 4, 2, 1, (lane & 4) != 0, (lane & 2) != 0, (lane & 1) != 0, r0, r1);
        o0 += r0; o1 += r1;
    } else {
        float osq = 0.f;
#pragma unroll
        for (int hf = 0; hf < 2; ++hf) {
            int ai[16];
#pragma unroll
            for (int i = 0; i < 16; ++i) ai[i] = 0;
#pragma unroll
            for (int j4 = 0; j4 < 4; ++j4) { const int a4 = (int)X.w0[j4];
#pragma unroll
                for (int q2 = 0; q2 < 2; ++q2) { const int q = 2 * hf + q2; const unsigned r0_ = buf[4 * j4][q], r1_ = buf[4 * j4 + 1][q], r2_ = buf[4 * j4 + 2][q], r3_ = buf[4 * j4 + 3][q];
                    const unsigned t0 = __builtin_amdgcn_perm(r1_, r0_, 0x05010400u), t1 = __builtin_amdgcn_perm(r1_, r0_, 0x07030602u), t2 = __builtin_amdgcn_perm(r3_, r2_, 0x05010400u), t3 = __builtin_amdgcn_perm(r3_, r2_, 0x07030602u);
                    const unsigned c0_ = __builtin_amdgcn_perm(t2, t0, 0x05040100u), c1_ = __builtin_amdgcn_perm(t2, t0, 0x07060302u), c2_ = __builtin_amdgcn_perm(t3, t1, 0x05040100u), c3_ = __builtin_amdgcn_perm(t3, t1, 0x07060302u);
                    ai[8 * q2 + 0] = __builtin_amdgcn_sdot4((int)(c0_ & 0x0f0f0f0fu), a4, ai[8 * q2 + 0], false); ai[8 * q2 + 1] = __builtin_amdgcn_sdot4((int)c0_, a4, ai[8 * q2 + 1], false);
                    ai[8 * q2 + 2] = __builtin_amdgcn_sdot4((int)(c1_ & 0x0f0f0f0fu), a4, ai[8 * q2 + 2], false); ai[8 * q2 + 3] = __builtin_amdgcn_sdot4((int)c1_, a4, ai[8 * q2 + 3], false);
                    ai[8 * q2 + 4] = __builtin_amdgcn_sdot4((int)(c2_ & 0x0f0f0f0fu), a4, ai[8 * q2 + 4], false); ai[8 * q2 + 5] = __builtin_amdgcn_sdot4((int)c2_, a4, ai[8 * q2 + 5], false);
                    ai[8 * q2 + 6] = __builtin_amdgcn_sdot4((int)(c3_ & 0x0f0f0f0fu), a4, ai[8 * q2 + 6], false); ai[8 * q2 + 7] = __builtin_amdgcn_sdot4((int)c3_, a4, ai[8 * q2 + 7], false); }
                asm volatile("" : "+v"(ai[0]), "+v"(ai[1]), "+v"(ai[2]), "+v"(ai[3]), "+v"(ai[4]), "+v"(ai[5]), "+v"(ai[6]), "+v"(ai[7]), "+v"(ai[8]), "+v"(ai[9]), "+v"(ai[10]), "+v"(ai[11]), "+v"(ai[12]), "+v"(ai[13]), "+v"(ai[14]), "+v"(ai[15]));
                __builtin_amdgcn_sched_barrier(0); }
            int i0, i1;
            EX_HALVE16_SWAP_I(ai, (lane & 8) != 0, i0, i1);
            const float r0 = (float)i0 * asc, r1 = (float)(i1 - i0) * (asc * 0.0625f);
            f32x2v y; y[0] = X.y[2 * hf] + (r0 - 7.5f * cs); y[1] = X.y[2 * hf + 1] + (r1 + 0.5f * cs);
            *(f32x2v*)(p.out + (size_t)t * D + x * 256 + 32 * c + 16 * hf + 2 * g) = y;
            osq += y[0] * y[0] + y[1] * y[1];
        }
        o0 += osq;
    }
}
typedef float f32x2l __attribute__((ext_vector_type(2)));
template <int PASS> __device__ __forceinline__ void ex_pass(const P& p, int tb, int lane, int g, int c, LAS f32x2l* acc, const LAS float* ascl) {
    u32x4 bA[16], bB[16]; ExAux xA, xB; ExIds I;
    ex_ids(I, p, tb, g);
    ex_gather<PASS>(bA, xA, I, p, tb, 0, g, c);
    ex_ids(I, p, tb + 1, g);
    constexpr int NS = 32;
#pragma unroll 1
    for (int s_ = 0; s_ < NS; s_ += 2) {
        const int x = s_ >> 3, i = s_ & 7, s2 = min(s_ + 2, NS - 1), x2 = s2 >> 3, i2 = s2 & 7;
        ex_gather<PASS>(bB, xB, I, p, tb + i + 1, x, g, c);
        ex_ids(I, p, tb + i2, g);
        { float o0 = 0.f, o1 = 0.f; ex_compute<PASS>(bA, xA, p, tb + i, x, lane, g, c, (PASS == 1) ? ascl[i] : 0.f, (PASS == 1) ? ascl[8 + i] : 0.f, o0, o1); f32x2l v = acc[i * 64 + lane]; v[0] += o0; v[1] += o1; acc[i * 64 + lane] = v; }
        ex_gather<PASS>(bA, xA, I, p, tb + i2, x2, g, c);
        ex_ids(I, p, tb + ((i2 + 1) & 7), g);
        { float o0 = 0.f, o1 = 0.f; ex_compute<PASS>(bB, xB, p, tb + i + 1, x, lane, g, c, (PASS == 1) ? ascl[i + 1] : 0.f, (PASS == 1) ? ascl[9 + i] : 0.f, o0, o1); f32x2l v = acc[(i + 1) * 64 + lane]; v[0] += o0; v[1] += o1; acc[(i + 1) * 64 + lane] = v; }
    }
}
__device__ __forceinline__ void phase_experts(LAS unsigned char* ldsb, const P& p) {
    const int TID = otid();
    const int lane = TID & 63, wave = TID >> 6, g = lane >> 3, c = lane & 7, tb = (blockIdx.x * 8 + wave) * 8;
    const float* USC = (const float*)(p.ws + WS_USC); const float* VSC = (const float*)(p.ws + WS_VSC);
    LAS f32x2l* acc = (LAS f32x2l*)(ldsb + wave * 8192); LAS float* ascl = (LAS float*)(ldsb + wave * 8192 + 4096);
#pragma unroll
    for (int i = 0; i < 8; ++i) { f32x2l z; z[0] = 0.f; z[1] = 0.f; acc[i * 64 + lane] = z; }
    ex_pass<0>(p, tb, lane, g, c, acc, ascl);
#pragma unroll 1
    for (int i = 0; i < 8; ++i) { const int t = tb + i, k0 = 16 * g + 2 * c;
        float rstd;
        { const f32x4* rp = (const f32x4*)((const float*)(p.ws + WS_RSSP) + (size_t)t * 16); const f32x4 s4 = (rp[0] + rp[1]) + (rp[2] + rp[3]);
          rstd = rsqrtf(((s4[0] + s4[1]) + (s4[2] + s4[3])) * (1.f / D) + EPS); }
        const u32x2 e = *(const u32x2*)((const int*)(p.ws + WS_IDX) + (size_t)t * 128 + k0);
        const f32x2v gt = *(const f32x2v*)((const float*)(p.ws + WS_GATE) + (size_t)t * 128 + k0);
        const float hs = rstd * ((const float*)(p.ws + WS_HSC))[t], hc = ((const float*)(p.ws + WS_HSC))[T + t];
        f32x2l hv = acc[i * 64 + lane]; hv[0] += hc; hv[1] += hc;
        const float a0 = gt[0] * gelu_exact(hs * USC[e.x] * (hv[0] + 8.f * USC[2 * PNK * PNK + e.x])) * VSC[e.x], a1 = gt[1] * gelu_exact(hs * USC[e.y] * (hv[1] + 8.f * USC[2 * PNK * PNK + e.y])) * VSC[e.y];
        const float am = wave_max_fast(fmaxf(fabsf(a0), fabsf(a1))), sc = am > 0.f ? 127.0f / am : 1.0f;
        const int q0 = (int)rintf(a0 * sc), q1 = (int)rintf(a1 * sc);
        *(unsigned short*)(p.ws + WS_A + (size_t)t * 128 + k0) = (unsigned short)((q0 & 0xff) | ((q1 & 0xff) << 8));
        const float asum = wave_sum_fast((float)(q0 + q1)), asc_ = am > 0.f ? am * (1.0f / 127.0f) : 1.0f;
        if (lane == 0) { ascl[i] = asc_; ascl[8 + i] = asc_ * asum; }
        f32x2l z; z[0] = 0.f; z[1] = 0.f; acc[i * 64 + lane] = z; }
    asm volatile("s_waitcnt vmcnt(0) lgkmcnt(0)" ::: "memory");
    ex_pass<1>(p, tb, lane, g, c, acc, ascl);
    asm volatile("s_waitcnt vmcnt(0) lgkmcnt(0)" ::: "memory");
#pragma unroll 1
    for (int i = 0; i < 8; ++i) { const f32x2l q = acc[i * 64 + lane]; const float r2 = rsqrtf(wave_sum_fast(q[0]) * (1.f / D) + EPS);
        f32x4* orow = (f32x4*)(p.out + (size_t)(tb + i) * D);
#pragma unroll
        for (int j = 0; j < 4; ++j) { const f32x4 gf = ((const f32x4*)p.g_fin)[lane + 64 * j]; f32x4 y = orow[lane + 64 * j] * r2; y[0] *= gf[0]; y[1] *= gf[1]; y[2] *= gf[2]; y[3] *= gf[3]; orow[lane + 64 * j] = y; } }
}
#undef EX_HALVE16
#undef EX_HALVE16_SWAP
#undef EX_HALVE16_SWAP_I

#define LAS __attribute__((address_space(3)))
#define XB_TMO      128
#define XB_XCNT(j)  (256  + 64 * (j))
#define XB_XSUB(j)  (1280 + 64 * (j))
#define XB_XGEN(j)  (2304 + 64 * (j))
#define XB_TOP      3328
#define XB_TOPGEN   3392
#define XCD_BAR_WORDS 3456
#define XB_SPIN_CAP (1u << 22)
__device__ __forceinline__ unsigned xb_ld(unsigned* p)              { return __hip_atomic_load(p, __ATOMIC_RELAXED, __HIP_MEMORY_SCOPE_AGENT); }
__device__ __forceinline__ unsigned xb_add(unsigned* p, unsigned v) { return __hip_atomic_fetch_add(p, v, __ATOMIC_RELAXED, __HIP_MEMORY_SCOPE_AGENT); }
__device__ __forceinline__ unsigned xb_xcc_id() { return (unsigned)__builtin_amdgcn_s_getreg((3 << 11) | 20) & 0xFu; }
#define XB_SPIN(cond, bar) do { unsigned _sp = 0; while (cond) { __builtin_amdgcn_s_sleep(1); \
    if ((++_sp & 255u) == 0u) { if (xb_ld(&(bar)[XB_TMO])) break; if (_sp > XB_SPIN_CAP) { atomicAdd(&(bar)[XB_TMO], 1u); break; } } } } while (0)
struct XcdBarrier { unsigned* bar; unsigned x; volatile LAS unsigned* st; };
__device__ __forceinline__ XcdBarrier xcd_barrier_post(unsigned* bar, volatile LAS unsigned* st) {
    XcdBarrier b; b.bar = bar; b.x = xb_xcc_id(); b.st = st;
    if (threadIdx.x == 0) (void)xb_add(&bar[XB_XCNT(b.x)], 1u);
    return b;
}
__device__ __forceinline__ void xcd_barrier_complete(unsigned* bar, unsigned x, unsigned& nloc, unsigned& nx) {
    const unsigned G = gridDim.x * gridDim.y * gridDim.z;
    unsigned sum, cnt, mine, sp = 0u;
    for (;;) {
        sum = 0u; cnt = 0u; mine = 0u;
#pragma unroll
        for (unsigned j = 0; j < 16; ++j) { const unsigned c = xb_ld(&bar[XB_XCNT(j)]); sum += c; cnt += (c > 0u) ? 1u : 0u; mine = (j == x) ? c : mine; }
        if (sum == G) break;
        __builtin_amdgcn_s_sleep(1);
        if ((++sp & 255u) == 0u) { if (xb_ld(&bar[XB_TMO])) break; if (sp > XB_SPIN_CAP) { atomicAdd(&bar[XB_TMO], 1u); break; } }
    }
    nloc = mine > 0u ? mine : 1u; nx = cnt > 0u ? cnt : 1u;
}
__device__ __forceinline__ void xcd_barrier(const XcdBarrier& b) {
    asm volatile("s_waitcnt vmcnt(0)" ::: "memory");
    __syncthreads();
    if (threadIdx.x == 0) {
        unsigned* bar = b.bar;
        __builtin_amdgcn_s_waitcnt(0);
        unsigned nloc = b.st[0], nx = b.st[1];
        if (nloc == 0u) { xcd_barrier_complete(bar, b.x, nloc, nx); b.st[0] = nloc; b.st[1] = nx; }
        const unsigned old = xb_add(&bar[XB_XSUB(b.x)], 1u);
        const unsigned gen = old / nloc;
        if (old + 1u == (gen + 1u) * nloc) {
            __builtin_amdgcn_fence(__ATOMIC_RELEASE, "agent");
            asm volatile("s_waitcnt vmcnt(0)" ::: "memory");
            const unsigned og = xb_add(&bar[XB_TOP], 1u);
            const unsigned tg = og / nx;
            if (og + 1u == (tg + 1u) * nx) xb_add(&bar[XB_TOPGEN], 1u);
            else XB_SPIN(xb_ld(&bar[XB_TOPGEN]) == tg, bar);
            __builtin_amdgcn_fence(__ATOMIC_ACQUIRE, "agent");
            xb_add(&bar[XB_XGEN(b.x)], 1u);
            asm volatile("s_waitcnt vmcnt(0)" ::: "memory");
        } else {
            XB_SPIN(xb_ld(&bar[XB_XGEN(b.x)]) == gen, bar);
            __builtin_amdgcn_fence(__ATOMIC_ACQUIRE, "agent");
            asm volatile("s_waitcnt vmcnt(0)" ::: "memory");
        }
    }
    __syncthreads();
}

constexpr int NT = 512;
constexpr int LDS_BYTES = 147456;
constexpr int MISC_OFF = 131072;

__global__ void __launch_bounds__(NT, 2) mega(P p) {
    extern __shared__ __attribute__((aligned(16))) unsigned char lds_raw[];
    float* lds = (float*)lds_raw;
    LAS unsigned char* ldsb = (LAS unsigned char*)lds_raw;
    volatile LAS unsigned* MISC = (volatile LAS unsigned*)(ldsb + MISC_OFF);
    if (threadIdx.x < 32) MISC[threadIdx.x] = 0u;
    __syncthreads();
    XcdBarrier bar = xcd_barrier_post((unsigned*)p.ws, MISC + 8);
#define GRID_BAR() xcd_barrier(bar)
    const int G = gridDim.x;
    bf16_t* QKV = (bf16_t*)(p.ws + WS_QKV);
    phase_prologue(ldsb, p);
    GRID_BAR();
    phase_cumsum(p);
    { pg8::Gemm g{(const bf16_t*)(p.ws + WS_XN), (const bf16_t*)(p.ws + WS_WIN), T, 5120, D / 2}; pg8::StaticOrder So; So.init(T, 5120, G, (int)blockIdx.x);
      pg8::EpiProj E{QKV, (bf16_t*)(p.ws + WS_G), (const float*)(p.ws + WS_ROPE), (float*)(p.ws + WS_KMP), (float*)(p.ws + WS_FKN), (float*)(p.ws + WS_FQN)};
      pg8::gemm_phase<pg8::EpiProj, pg8::StaticOrder, true, true, true>(ldsb, g, So, E); }
    GRID_BAR();
    phase_attn((char*)lds_raw, MISC, p);
    GRID_BAR();
    phase_moba_combine(p);
    phase_expert_tables(p);
    GRID_BAR();
    { pg8::Gemm g{QKV, (const bf16_t*)(p.ws + WS_WA), T, D, 512}; pg8::StaticOrder So; So.init(T, D, G, (int)blockIdx.x);
      pg8::EpiMerge E{(bf16_t*)(p.ws + WS_MERGED), (const bf16_t*)(p.ws + WS_G), true};
      pg8::gemm_phase<pg8::EpiMerge, pg8::StaticOrder, true, true>(ldsb, g, So, E); }
    { pg8::Gemm g{QKV + SLOT, (const bf16_t*)(p.ws + WS_WB), T, D, 512}; pg8::StaticOrder So; So.init(T, D, G, (int)blockIdx.x);
      pg8::EpiMerge E{(bf16_t*)(p.ws + WS_MERGED), (const bf16_t*)(p.ws + WS_G) + (size_t)T * D, false};
      pg8::gemm_phase<pg8::EpiMerge, pg8::StaticOrder, true, true>(ldsb, g, So, E); }
    GRID_BAR();
    { pg8::Gemm g{(const bf16_t*)(p.ws + WS_MERGED), (const bf16_t*)(p.ws + WS_WOUT), T, D, D}; pg8::StaticOrder So; So.init(T, D, G, (int)blockIdx.x);
      pg8::EpiOut E{p.x, p.out, (bf16_t*)(p.ws + WS_XN), (float*)(p.ws + WS_RSSP)};
      pg8::gemm_phase<pg8::EpiOut, pg8::StaticOrder, true, true>(ldsb, g, So, E); }
    GRID_BAR();
    { pg8::Gemm g{(const bf16_t*)(p.ws + WS_XN), (const bf16_t*)(p.ws + WS_WPQ), T, PQC, D}; pg8::StaticOrder So; So.init(T, PQC, G, (int)blockIdx.x);
      pg8::EpiStore E{(bf16_t*)(p.ws + WS_PQ), PQC};
      pg8::gemm_phase<pg8::EpiStore, pg8::StaticOrder, true, true>(ldsb, g, So, E);
      phase_peer_topk(ldsb, p, So); }
    phase_h8(p);
    GRID_BAR();
    phase_experts(ldsb, p);
}

extern "C" void kernel_launch(void* const* d_in, const int* in_sizes, int n_in, void* d_out, int out_size, void* d_ws, size_t ws_size, hipStream_t stream) {
    static int grid = 0;
    if (grid == 0) {
        int dev = 0, cus = 0, per_cu = 0;
        if (hipGetDevice(&dev) != hipSuccess || hipDeviceGetAttribute(&cus, hipDeviceAttributeMultiprocessorCount, dev) != hipSuccess) { fprintf(stderr, "kernel_launch: device query failed\n"); grid = -1; return; }
        if (hipFuncSetAttribute((const void*)mega, hipFuncAttributeMaxDynamicSharedMemorySize, LDS_BYTES) != hipSuccess) { fprintf(stderr, "kernel_launch: hipFuncSetAttribute failed\n"); grid = -1; return; }
        if (hipOccupancyMaxActiveBlocksPerMultiprocessor(&per_cu, (const void*)mega, NT, LDS_BYTES) != hipSuccess || per_cu < 1) { fprintf(stderr, "kernel_launch: occupancy query says %d blocks per CU\n", per_cu); (void)hipGetLastError(); grid = -1; return; }
        if (cus < 256) { fprintf(stderr, "kernel_launch: built for a 256-CU device, found %d CUs\n", cus); grid = -1; return; }
        grid = 256;
    }
    if (grid < 0) return;
    (void)hipMemsetAsync(d_ws, 0, CTL_ZERO_BYTES, stream);
    P p{};
    p.x = (const float*)d_in[0]; p.g_mix = (const float*)d_in[1]; p.w_in = (const float*)d_in[2]; p.b_f = (const float*)d_in[3];
    p.w_a = (const float*)d_in[4]; p.w_b = (const float*)d_in[5]; p.w_out = (const float*)d_in[6]; p.g_ffn = (const float*)d_in[7];
    p.w_pq = (const float*)d_in[8]; p.sk = (const float*)d_in[9]; p.eu = (const float*)d_in[10]; p.ev = (const float*)d_in[11]; p.g_fin = (const float*)d_in[12];
    p.out = (float*)d_out; p.ws = (unsigned char*)d_ws;
    hipLaunchKernelGGL(mega, dim3(grid), dim3(NT), LDS_BYTES, stream, p);
}
```

```cpp
#include <hip/hip_runtime.h>
#include <cstdio>
#include <cstdint>
#include <cmath>

constexpr int Bn = 2, S = 8192, D = 1024, T = Bn * S;
constexpr int HD = 64, NH = 8;
constexpr int INC = 5128;
constexpr int LBLK = 256, NBLK = S / LBLK;
constexpr int PH = 8, PNK = 128, PHALF = 128, PK = 16, PQC = PH * 2 * PHALF;
constexpr float EPS = 1e-6f;
constexpr float LOG2E = 1.4426950408889634f;
constexpr float C2 = 0.125f * LOG2E;

typedef unsigned short bf16_t;
typedef float f32x4 __attribute__((ext_vector_type(4)));
typedef unsigned u32x2 __attribute__((ext_vector_type(2)));
typedef unsigned u32x4 __attribute__((ext_vector_type(4)));
#define LAS __attribute__((address_space(3)))

__device__ __forceinline__ float bf2f(bf16_t v) { return __uint_as_float((unsigned)v << 16); }
__device__ __forceinline__ unsigned f2bf(float f) { unsigned u = __float_as_uint(f); return (u + 0x7fffu + ((u >> 16) & 1u)) >> 16; }
__device__ __forceinline__ unsigned pk2(float lo, float hi) { return f2bf(lo) | (f2bf(hi) << 16); }
#define WS_DPP(v, ctrl) ((v) + __builtin_bit_cast(float, __builtin_amdgcn_update_dpp(0, __builtin_bit_cast(int, (v)), (ctrl), 0xf, 0xf, true)))
#define WM_DPP(v, ctrl) fmaxf((v), __builtin_bit_cast(float, __builtin_amdgcn_update_dpp(0, __builtin_bit_cast(int, (v)), (ctrl), 0xf, 0xf, true)))
__device__ __forceinline__ float wave_sum_fast(float v) {
    v = WS_DPP(v, 0xB1); v = WS_DPP(v, 0x4E); v = WS_DPP(v, 0x141); v = WS_DPP(v, 0x140);
    const int iv = __builtin_bit_cast(int, v);
    return (__builtin_bit_cast(float, __builtin_amdgcn_readlane(iv, 0)) + __builtin_bit_cast(float, __builtin_amdgcn_readlane(iv, 16))) + (__builtin_bit_cast(float, __builtin_amdgcn_readlane(iv, 32)) + __builtin_bit_cast(float, __builtin_amdgcn_readlane(iv, 48)));
}
__device__ __forceinline__ float wave_max_fast(float v) {
    v = WM_DPP(v, 0xB1); v = WM_DPP(v, 0x4E); v = WM_DPP(v, 0x141); v = WM_DPP(v, 0x140);
    const int iv = __builtin_bit_cast(int, v);
    return fmaxf(fmaxf(__builtin_bit_cast(float, __builtin_amdgcn_readlane(iv, 0)), __builtin_bit_cast(float, __builtin_amdgcn_readlane(iv, 16))), fmaxf(__builtin_bit_cast(float, __builtin_amdgcn_readlane(iv, 32)), __builtin_bit_cast(float, __builtin_amdgcn_readlane(iv, 48))));
}
__device__ __forceinline__ int otid() { int t = threadIdx.x; asm volatile("" : "+v"(t)); return t; }

constexpr size_t MiB = 1u << 20, KiB = 1u << 10;
constexpr size_t CTL_ZERO_BYTES = 65536;
constexpr size_t WS_ROPE = 1 * MiB;
constexpr size_t WS_C = 1 * MiB + 512 * KiB;
constexpr size_t WS_LOGF = 2 * MiB;
constexpr size_t WS_KMP = 2 * MiB + 512 * KiB;
constexpr size_t WS_MCNT = 40 * KiB;
constexpr size_t WS_FKN = 2 * MiB + 768 * KiB;
constexpr size_t WS_FQN = WS_FKN + 32 * KiB;
constexpr size_t WS_MG1 = 44 * KiB;
constexpr size_t WS_SEL3 = 4 * MiB + 512 * KiB;
constexpr size_t WS_MLIST = 5 * MiB;
constexpr size_t WS_MLSE = 13 * MiB;
constexpr size_t WS_MP2 = 23 * MiB, WS_MP3 = 39 * MiB;
constexpr size_t WS_MP0 = 215 * MiB, WS_MP1 = 231 * MiB;
constexpr size_t WS_WSUM = 3 * MiB;
constexpr size_t WS_WIN = 5 * MiB;
constexpr size_t WS_WA = 15 * MiB, WS_WB = 16 * MiB;
constexpr size_t WS_WOUT = 17 * MiB;
constexpr size_t WS_WPQ = 19 * MiB;
constexpr size_t WS_XN = 23 * MiB;
constexpr size_t WS_QKV = 55 * MiB;
constexpr size_t SLOT = (size_t)T * 512;
constexpr size_t WS_G = 151 * MiB;
constexpr size_t WS_MERGED = 215 * MiB;
constexpr size_t WS_PQ = 151 * MiB;
constexpr size_t WS_IDX = 215 * MiB;
constexpr size_t WS_GATE = 223 * MiB;
constexpr size_t WS_SK = 247 * MiB;
constexpr size_t WS_RSSP = 3 * MiB + 512 * KiB;
constexpr size_t WS_EU = 87 * MiB;
constexpr size_t WS_EV = 103 * MiB;
constexpr size_t ESLICE = (size_t)16384 * 128;
constexpr size_t WS_A = 231 * MiB;
constexpr size_t WS_H8 = 55 * MiB;
constexpr size_t WS_HSC = 71 * MiB;
constexpr size_t WS_USC = 119 * MiB;
constexpr size_t WS_VSC = 119 * MiB + 64 * KiB;

struct P {
    const float *x, *g_mix, *w_in, *b_f, *w_a, *w_b, *w_out, *g_ffn, *w_pq, *sk, *eu, *ev, *g_fin;
    float* out; unsigned char* ws;
};

namespace pg8 {
#define PG8_LAS __attribute__((address_space(3)))
typedef unsigned short bf16_t;
typedef short bf16x8 __attribute__((ext_vector_type(8)));
typedef int i32x4 __attribute__((ext_vector_type(4))); typedef int i32x8 __attribute__((ext_vector_type(8)));
typedef float f32x4 __attribute__((ext_vector_type(4)));
typedef unsigned u32x4 __attribute__((ext_vector_type(4)));
constexpr int BM = 256, BK = 64, HALF = 128, HTB = HALF * BK * 2  , STAGE_BYTES = 8 * HTB, NXCD = 8, WGM = 8;

__host__ __device__ __forceinline__ int lds_byte(int r, int c) { const int st = (r >> 4) * 2 + (c >> 5), rr = r & 15, cc = c & 31, ob = rr * 64 + cc * 2; return st * 1024 + (ob ^ (((ob >> 9) & 1) << 5)); }
__host__ __device__ __forceinline__ void stage_rc(int b, int& R, int& C) { const int st = b / 1024, sb = b % 1024, swz = sb ^ (((sb >> 9) & 1) << 5); R = (st >> 1) * 16 + swz / 64; C = (st & 1) * 32 + (swz % 64) / 2; }
__host__ __device__ __forceinline__ int perm32(int rho) { const int n = rho >> 4, i = rho & 15; return 8 * (i >> 2) + 4 * n + (i & 3); }

struct Unit { int pm, pn; };
struct Gemm { const bf16_t* A; const bf16_t* Bt; int M, N, K; };

struct StaticOrder {
    int nM, nN, nwg, G, c;
    __host__ __device__ void init(int M, int N, int G_, int c_) { nM = M / BM; nN = N / BM; nwg = nM * nN; G = G_; c = c_; }
    __host__ __device__ bool next(int i, Unit& u) const {
        const long L = (long)i * G + c; if (L >= nwg) return false;
        int wgid = (int)L; { const int q = nwg / NXCD, r = nwg % NXCD, xcd = wgid % NXCD, off = wgid / NXCD; wgid = (xcd < r ? xcd * (q + 1) : r * (q + 1) + (xcd - r) * q) + off; }
        const int nig = WGM * nN, gid = wgid / nig, fm = gid * WGM, gsz = (nM - fm) < WGM ? (nM - fm) : WGM;
        u.pm = fm + ((wgid % nig) % gsz); u.pn = (wgid % nig) / gsz; return true;
    }
    __device__ __forceinline__ void a_ready(const Unit&) const {}
    __device__ __forceinline__ void done(const Unit&) const {}
};

__device__ __forceinline__ unsigned cvt_pk_bf16(float lo, float hi) { unsigned r; asm volatile("v_cvt_pk_bf16_f32 %0, %1, %2" : "=v"(r) : "v"(lo), "v"(hi)); return r; }

typedef float f32x2_t __attribute__((ext_vector_type(2))); typedef __bf16 bf16x2_t __attribute__((ext_vector_type(2)));
__device__ __forceinline__ unsigned cvtpk_c(float lo, float hi) { f32x2_t v = {lo, hi}; bf16x2_t b = __builtin_convertvector(v, bf16x2_t); return __builtin_bit_cast(unsigned, b); }
__device__ __forceinline__ u32x4 pack8(const f32x4& v0, const f32x4& v1) { u32x4 w; w.x = cvtpk_c(v0[0], v0[1]); w.y = cvtpk_c(v0[2], v0[3]); w.z = cvtpk_c(v1[0], v1[1]); w.w = cvtpk_c(v1[2], v1[3]); return w; }
__device__ __forceinline__ void unpack8(const u32x4& w, f32x4& v0, f32x4& v1) {
    v0[0] = __uint_as_float(w.x << 16); v0[1] = __uint_as_float(w.x & 0xffff0000u); v0[2] = __uint_as_float(w.y << 16); v0[3] = __uint_as_float(w.y & 0xffff0000u);
    v1[0] = __uint_as_float(w.z << 16); v1[1] = __uint_as_float(w.z & 0xffff0000u); v1[2] = __uint_as_float(w.w << 16); v1[3] = __uint_as_float(w.w & 0xffff0000u); }

struct EpiProj {
    static constexpr bool PERM = true, AFTER_DRAIN = false;
    bf16_t* QKV; bf16_t* G; const float* ROPE; float* KMP; float* FKN; float* FQN;
    __device__ __forceinline__ void operator()(const f32x4 (&acc)[2][2][4][2], const Unit& u, int wr, int wc, int fr, int fq) const {
        const int pn = u.pn, row0 = u.pm * BM + wr * 64 + fr;
        if (pn < 12) {
            const int typ = pn >> 1;
            const int slot = (typ == 0) ? 0 : (typ == 3) ? 1 : (typ < 3) ? typ + 1 : typ;
            bf16_t* base = QKV + (size_t)slot * ((size_t)16384 * 512);
            const int colt = (pn & 1) * 256, col0 = colt + wc * 32 + 8 * fq;
            const float sc = (typ == 0 || typ == 3) ? 0.18033688011112042f : 1.0f;
            const bool rope = (typ < 2) && ((wc & 1) == 0);
            const float sgn = (fq == 0) ? -1.f : 1.f; const bool rl = fq < 2;
            f32x4 ks[2][2];
#pragma unroll
            for (int bj = 0; bj < 2; ++bj) { ks[bj][0] = (f32x4){0.f, 0.f, 0.f, 0.f}; ks[bj][1] = (f32x4){0.f, 0.f, 0.f, 0.f}; }
            const bool nrm = (typ == 3 || typ == 4);
            float nmx[2][2] = {{0.f, 0.f}, {0.f, 0.f}};
#pragma unroll
            for (int ai = 0; ai < 2; ++ai)
#pragma unroll
                for (int m = 0; m < 4; ++m) {
                    const int row = row0 + ai * HALF + m * 16;
                    f32x4 c0 = (f32x4){1.f, 1.f, 1.f, 1.f}, c1 = c0, s0 = (f32x4){0.f, 0.f, 0.f, 0.f}, s1 = s0;
                    if (rope) { const f32x4* rp = (const f32x4*)(ROPE + (size_t)(row & 8191) * 16); c0 = rp[0]; c1 = rp[1]; s0 = rp[2]; s1 = rp[3]; }
#pragma unroll
                    for (int bj = 0; bj < 2; ++bj) {
                        f32x4 v0 = acc[ai][bj][m][0], v1 = acc[ai][bj][m][1];
                        if (rope) {
                            f32x4 p0, p1;
#pragma unroll
                            for (int e = 0; e < 4; ++e) { p0[e] = __shfl_xor(v0[e], 16); p1[e] = __shfl_xor(v1[e], 16); }
                            if (rl) { v0 = v0 * c0 + sgn * (p0 * s0); v1 = v1 * c1 + sgn * (p1 * s1); }
                        }
                        if (typ == 1) { ks[bj][0] += v0; ks[bj][1] += v1; }
                        v0 = v0 * sc; v1 = v1 * sc;
                        *(u32x4*)(base + (size_t)row * 512 + col0 + bj * HALF) = pack8(v0, v1);
                        if (nrm) { float ss = ((v0[0] * v0[0] + v0[1] * v0[1]) + (v0[2] * v0[2] + v0[3] * v0[3])) + ((v1[0] * v1[0] + v1[1] * v1[1]) + (v1[2] * v1[2] + v1[3] * v1[3]));
                            { const auto r_ = __builtin_amdgcn_permlane16_swap(__float_as_uint(ss), __float_as_uint(ss), false, false); ss = __uint_as_float(r_[0]) + __uint_as_float(r_[1]); }
                            { const auto r_ = __builtin_amdgcn_permlane32_swap(__float_as_uint(ss), __float_as_uint(ss), false, false); ss = __uint_as_float(r_[0]) + __uint_as_float(r_[1]); }
                            nmx[ai][bj] = fmaxf(nmx[ai][bj], ss); }
                    }
                }
            if (nrm) {
                const int b = u.pm >> 5, nb = u.pm & 31;
#pragma unroll
                for (int bj = 0; bj < 2; ++bj) { const int head = (colt + 128 * bj + 32 * wc) >> 6;
                    float a0 = nmx[0][bj], a1 = nmx[1][bj];
                    a0 = WM_DPP(a0, 0xB1); a0 = WM_DPP(a0, 0x4E); a0 = WM_DPP(a0, 0x141); a0 = WM_DPP(a0, 0x140); a1 = WM_DPP(a1, 0xB1); a1 = WM_DPP(a1, 0x4E); a1 = WM_DPP(a1, 0x141); a1 = WM_DPP(a1, 0x140);
                    if (fr == 0 && fq == 0) {
                        if (typ == 4) { float* d = FKN + ((size_t)(b * 8 + head) * 128 + 4 * nb + wr) * 2 + (wc & 1); d[0] = a0; d[4] = a1; }
                        else FQN[(((size_t)(b * 8 + head) * 32 + nb) * 2 + wr) * 2 + (wc & 1)] = fmaxf(a0, a1); } }
            }
            if (typ == 1) {
#pragma unroll
                for (int bj = 0; bj < 2; ++bj)
#pragma unroll
                    for (int n = 0; n < 2; ++n)
#pragma unroll
                        for (int e = 0; e < 4; ++e) { float v = ks[bj][n][e]; v = WS_DPP(v, 0xB1); v = WS_DPP(v, 0x4E); v = WS_DPP(v, 0x141); v = WS_DPP(v, 0x140); ks[bj][n][e] = v; }
                if (fr == 0) {
                    const int b = u.pm >> 5, nb = u.pm & 31;
#pragma unroll
                    for (int bj = 0; bj < 2; ++bj) { const int head = (colt + 128 * bj + 32 * wc) >> 6, d = 32 * (wc & 1) + 8 * fq;
                        float* dst = KMP + ((((size_t)wr * 16 + b * 8 + head) * 32 + nb) * 64 + d); *(f32x4*)dst = ks[bj][0]; *(f32x4*)(dst + 4) = ks[bj][1]; }
                }
            }
        } else {
            const int gi = pn - 12; bf16_t* base = G + (size_t)(gi >> 2) * ((size_t)16384 * 1024);
            const int col0 = (gi & 3) * 256 + wc * 32 + 8 * fq;
#pragma unroll
            for (int ai = 0; ai < 2; ++ai)
#pragma unroll
                for (int m = 0; m < 4; ++m) { const int row = row0 + ai * HALF + m * 16;
#pragma unroll
                    for (int bj = 0; bj < 2; ++bj) { f32x4 v0 = acc[ai][bj][m][0], v1 = acc[ai][bj][m][1];
#pragma unroll
                        for (int e = 0; e < 4; ++e) { v0[e] = __builtin_amdgcn_rcpf(1.f + __builtin_amdgcn_exp2f(-1.4426950408889634f * v0[e])); v1[e] = __builtin_amdgcn_rcpf(1.f + __builtin_amdgcn_exp2f(-1.4426950408889634f * v1[e])); }
                        *(u32x4*)(base + (size_t)row * 1024 + col0 + bj * HALF) = pack8(v0, v1); } }
        }
    }
};
struct EpiMerge {
    static constexpr bool PERM = true, AFTER_DRAIN = false;
    bf16_t* Mg; const bf16_t* Gt; bool first;
    __device__ __forceinline__ void operator()(const f32x4 (&acc)[2][2][4][2], const Unit& u, int wr, int wc, int fr, int fq) const {
        const int row0 = u.pm * BM + wr * 64 + fr, col0 = u.pn * BM + wc * 32 + 8 * fq;
#pragma unroll
        for (int ai = 0; ai < 2; ++ai)
#pragma unroll
            for (int m = 0; m < 4; ++m) { const size_t off = (size_t)(row0 + ai * HALF + m * 16) * 1024 + col0;
#pragma unroll
                for (int bj = 0; bj < 2; ++bj) { f32x4 g0, g1; unpack8(*(const u32x4*)(Gt + off + bj * HALF), g0, g1);
                    f32x4 v0 = g0 * acc[ai][bj][m][0], v1 = g1 * acc[ai][bj][m][1];
                    if (!first) { f32x4 o0, o1; unpack8(*(const u32x4*)(Mg + off + bj * HALF), o0, o1); v0 += o0; v1 += o1; }
                    *(u32x4*)(Mg + off + bj * HALF) = pack8(v0, v1); } }
    }
};
struct EpiOut {
    static constexpr bool PERM = true, AFTER_DRAIN = false;
    const float* X; float* O; bf16_t* Hb; float* RSSP;
    __device__ __forceinline__ void operator()(const f32x4 (&acc)[2][2][4][2], const Unit& u, int wr, int wc, int fr, int fq) const {
        const int row0 = u.pm * BM + wr * 64 + fr, col0 = u.pn * BM + wc * 32 + 8 * fq;
#pragma unroll
        for (int ai = 0; ai < 2; ++ai)
#pragma unroll
            for (int m = 0; m < 4; ++m) { const int row = row0 + ai * HALF + m * 16; const size_t off = (size_t)row * 1024 + col0; float ss = 0.f;
#pragma unroll
                for (int bj = 0; bj < 2; ++bj) { const f32x4 x0 = *(const f32x4*)(X + off + bj * HALF), x1 = *(const f32x4*)(X + off + bj * HALF + 4);
                    const f32x4 h0 = x0 + acc[ai][bj][m][0], h1 = x1 + acc[ai][bj][m][1];
                    *(u32x4*)(Hb + off + bj * HALF) = pack8(h0, h1);
                    ss += (h0[0] * h0[0] + h0[1] * h0[1]) + (h0[2] * h0[2] + h0[3] * h0[3]) + (h1[0] * h1[0] + h1[1] * h1[1]) + (h1[2] * h1[2] + h1[3] * h1[3]); }
                ss += __shfl_xor(ss, 16); ss += __shfl_xor(ss, 32);
                if (fq == 0) RSSP[(size_t)row * 16 + u.pn * 4 + wc] = ss; }
    }
};
struct EpiStore {
    static constexpr bool PERM = true, AFTER_DRAIN = false;
    bf16_t* O; int ldc;
    __device__ __forceinline__ void operator()(const f32x4 (&acc)[2][2][4][2], const Unit& u, int wr, int wc, int fr, int fq) const {
        const int row0 = u.pm * BM + wr * 64 + fr, col0 = u.pn * BM + wc * 32 + 8 * fq;
#pragma unroll
        for (int ai = 0; ai < 2; ++ai)
#pragma unroll
            for (int m = 0; m < 4; ++m)
#pragma unroll
                for (int bj = 0; bj < 2; ++bj) *(u32x4*)(O + (size_t)(row0 + ai * HALF + m * 16) * ldc + col0 + bj * HALF) = pack8(acc[ai][bj][m][0], acc[ai][bj][m][1]);
    }
};

template <class Epi, class Sched, bool ALIGN_EPI = false, bool SP2 = false, bool F8 = false>
__device__ __forceinline__ void gemm_phase(PG8_LAS unsigned char* lds, const Gemm g, const Sched& S, const Epi& E) {
    const int tid = otid(), wid = __builtin_amdgcn_readfirstlane(tid >> 6), lane = tid & 63, wr = wid >> 2, wc = wid & 3, fr = lane & 15, fq = lane >> 4;
    int K_ = g.K; if constexpr (F8) asm volatile("" : "+s"(K_));
    const int K = K_, nt = K / BK;
    unsigned voffA[2], voffB[2];
#pragma unroll
    for (int i = 0; i < 2; ++i) { int R, C; stage_rc(tid * 16 + i * 8192, R, C); const int Rb = Epi::PERM ? ((R & ~31) + perm32(R & 31)) : R;
        voffA[i] = (unsigned)(R * K + C) * 2u; voffB[i] = (unsigned)(Rb * K + C) * 2u; }
    const size_t kstep = (size_t)(BK * 2);
    const size_t hstep = (size_t)HALF * K * 2;
    const size_t tstep = 2 * hstep;
    const unsigned ldsw = (unsigned)wid * 1024u;
    const int aoff = lds_byte(wr * 64 + fr, fq * 8), boff = lds_byte(wc * 32 + fr, fq * 8);
#define PG8_SA(b, h) (((b) * 2 + (h)) * HTB)
#define PG8_SB(b, h) ((4 + (b) * 2 + (h)) * HTB)
#define PG8_STAGE(bufoff, gbase, voff) do { _Pragma("unroll") for (int _i = 0; _i < 2; ++_i) \
        __builtin_amdgcn_global_load_lds((const unsigned*)((const char*)(gbase) + (voff)[_i]), (PG8_LAS unsigned*)(lds + (bufoff) + ldsw + _i * 8192), 16, 0, 0); } while (0)
#define PG8_LDA(dst, b, h) do { _Pragma("unroll") for (int m = 0; m < 4; ++m) { \
        if constexpr (F8) dst##8[m] = __builtin_shufflevector(*(const PG8_LAS i32x4*)(lds + PG8_SA(b, h) + aoff + m * 2048), *(const PG8_LAS i32x4*)(lds + PG8_SA(b, h) + aoff + m * 2048 + 1024), 0, 1, 2, 3, 4, 5, 6, 7); \
        else { _Pragma("unroll") for (int k = 0; k < 2; ++k) dst[m][k] = *(const PG8_LAS bf16x8*)(lds + PG8_SA(b, h) + aoff + m * 2048 + k * 1024); } } } while (0)
#define PG8_LDB(dst, b, h) do { _Pragma("unroll") for (int n = 0; n < 2; ++n) { \
        if constexpr (F8) dst##8[n] = __builtin_shufflevector(*(const PG8_LAS i32x4*)(lds + PG8_SB(b, h) + boff + n * 2048), *(const PG8_LAS i32x4*)(lds + PG8_SB(b, h) + boff + n * 2048 + 1024), 0, 1, 2, 3, 4, 5, 6, 7); \
        else { _Pragma("unroll") for (int k = 0; k < 2; ++k) dst[n][k] = *(const PG8_LAS bf16x8*)(lds + PG8_SB(b, h) + boff + n * 2048 + k * 1024); } } } while (0)
#define PG8_MMA(ai, bj, At, Bt) do { __builtin_amdgcn_s_setprio(1); _Pragma("unroll") for (int m = 0; m < 4; ++m) _Pragma("unroll") for (int n = 0; n < 2; ++n) { \
        if constexpr (F8) asm volatile("v_mfma_scale_f32_16x16x128_f8f6f4 %0, %1, %2, %0, %3, %4 op_sel_hi:[0,0,0]" : "+v"(acc[ai][bj][m][n]) : "v"(Bt##8[n]), "v"(At##8[m]), "v"(f8sb), "v"(f8sa)); \
        else { _Pragma("unroll") for (int k = 0; k < 2; ++k) acc[ai][bj][m][n] = __builtin_amdgcn_mfma_f32_16x16x32_bf16(Bt[n][k], At[m][k], acc[ai][bj][m][n], 0, 0, 0); } } \
        __builtin_amdgcn_s_setprio(0); } while (0)
#define PG8_WAIT_V(n) asm volatile("s_waitcnt vmcnt(" #n ")" ::: "memory")
#define PG8_WAIT_L(n) asm volatile("s_waitcnt lgkmcnt(" #n ")" ::: "memory")
#define PG8_BAR __builtin_amdgcn_s_barrier()
#define PG8_SCHED __builtin_amdgcn_sched_barrier(0)
    Unit cur, nxt; int ui = 0;
    if (!S.next(0, cur)) return;
    f32x4 acc[2][2][4][2];
#pragma unroll
    for (int a = 0; a < 2; ++a)
#pragma unroll
        for (int b = 0; b < 2; ++b)
#pragma unroll
            for (int m = 0; m < 4; ++m)
#pragma unroll
                for (int n = 0; n < 2; ++n) acc[a][b][m][n] = (f32x4){0.f, 0.f, 0.f, 0.f};
    bf16x8 At[4][2], B0[2][2], B1[2][2]; i32x8 At8[4], B08[2], B18[2];
    const int f8sb = 0x79797979, f8sa = 0x7d7d7d7d;
    const char* cA = (const char*)g.A + (size_t)cur.pm * tstep; const char* cB = (const char*)g.Bt + (size_t)cur.pn * tstep;
    S.a_ready(cur);
    if constexpr (SP2) {
        PG8_STAGE(PG8_SB(0, 0), cB, voffB); PG8_STAGE(PG8_SB(0, 1), cB + hstep, voffB); PG8_STAGE(PG8_SA(0, 0), cA, voffA); PG8_STAGE(PG8_SA(0, 1), cA + hstep, voffA);
        if (wr == 1) PG8_BAR;
        PG8_WAIT_V(2); PG8_BAR;
        PG8_STAGE(PG8_SB(1, 0), cB + kstep, voffB); PG8_STAGE(PG8_SA(1, 0), cA + kstep, voffA); PG8_STAGE(PG8_SB(1, 1), cB + hstep + kstep, voffB);
        PG8_WAIT_V(6); PG8_BAR;
    } else {
        PG8_STAGE(PG8_SB(0, 0), cB, voffB); PG8_STAGE(PG8_SA(0, 0), cA, voffA); PG8_STAGE(PG8_SB(0, 1), cB + hstep, voffB); PG8_STAGE(PG8_SA(0, 1), cA + hstep, voffA);
        if (wr == 1) PG8_BAR;
        PG8_WAIT_V(4); PG8_BAR;
        PG8_STAGE(PG8_SB(1, 0), cB + kstep, voffB); PG8_STAGE(PG8_SA(1, 0), cA + kstep, voffA); PG8_STAGE(PG8_SB(1, 1), cB + hstep + kstep, voffB);
        PG8_WAIT_V(6); PG8_BAR;
    }
    for (;;) {
        const bool has_next = S.next(ui + 1, nxt);
        const char* nA = has_next ? (const char*)g.A + (size_t)nxt.pm * tstep : cA; const char* nB = has_next ? (const char*)g.Bt + (size_t)nxt.pn * tstep : cB;
        for (int t = 0; t < nt; t += 2) {
            const bool last = (t == nt - 2);
            const char* a1 = cA + (size_t)(t + 1) * kstep;
            const char* a2 = last ? nA : cA + (size_t)(t + 2) * kstep; const char* b2 = last ? nB : cB + (size_t)(t + 2) * kstep;
            const char* a3 = a2 + kstep; const char* b3 = b2 + kstep;
            if (last && has_next) S.a_ready(nxt);
            if constexpr (SP2) {
            PG8_LDB(B0, 0, 0); PG8_LDB(B1, 0, 1); PG8_SCHED; PG8_LDA(At, 0, 0); PG8_STAGE(PG8_SA(1, 1), a1 + hstep, voffA);
            PG8_WAIT_V(8); PG8_WAIT_L(0); PG8_BAR; PG8_MMA(0, 0, At, B0); PG8_MMA(0, 1, At, B1); PG8_BAR; PG8_SCHED;
            PG8_LDA(At, 0, 1); PG8_STAGE(PG8_SB(0, 0), b2, voffB); PG8_STAGE(PG8_SB(0, 1), b2 + hstep, voffB); PG8_STAGE(PG8_SA(0, 0), a2, voffA);
            PG8_WAIT_V(8); PG8_WAIT_L(0); PG8_BAR; PG8_MMA(1, 0, At, B0); PG8_MMA(1, 1, At, B1); PG8_BAR; PG8_SCHED;
            PG8_LDB(B0, 1, 0); PG8_LDB(B1, 1, 1); PG8_SCHED; PG8_LDA(At, 1, 0); PG8_STAGE(PG8_SA(0, 1), a2 + hstep, voffA);
            PG8_WAIT_V(8); PG8_WAIT_L(0); PG8_BAR; PG8_MMA(0, 0, At, B0); PG8_MMA(0, 1, At, B1); PG8_BAR; PG8_SCHED;
            PG8_LDA(At, 1, 1); PG8_STAGE(PG8_SB(1, 0), b3, voffB); PG8_STAGE(PG8_SB(1, 1), b3 + hstep, voffB); PG8_STAGE(PG8_SA(1, 0), a3, voffA);
            PG8_WAIT_V(8); PG8_WAIT_L(0); PG8_BAR; PG8_MMA(1, 0, At, B0); PG8_MMA(1, 1, At, B1); PG8_BAR; PG8_SCHED;
            } else {
            PG8_LDB(B0, 0, 0); PG8_SCHED; PG8_LDA(At, 0, 0); PG8_STAGE(PG8_SA(1, 1), a1 + hstep, voffA);
            PG8_WAIT_L(8); PG8_BAR; PG8_WAIT_L(0); PG8_MMA(0, 0, At, B0); PG8_BAR; PG8_SCHED;
            PG8_LDB(B1, 0, 1); PG8_STAGE(PG8_SB(0, 0), b2, voffB);
            PG8_BAR; PG8_WAIT_L(0); PG8_MMA(0, 1, At, B1); PG8_BAR;
            PG8_LDA(At, 0, 1); PG8_STAGE(PG8_SA(0, 0), a2, voffA);
            PG8_BAR; PG8_WAIT_L(0); PG8_MMA(1, 0, At, B0); PG8_BAR; PG8_SCHED;
            PG8_STAGE(PG8_SB(0, 1), b2 + hstep, voffB);
            PG8_WAIT_V(6); PG8_BAR; PG8_MMA(1, 1, At, B1); PG8_BAR;
            PG8_LDB(B0, 1, 0); PG8_SCHED; PG8_LDA(At, 1, 0); PG8_STAGE(PG8_SA(0, 1), a2 + hstep, voffA);
            PG8_WAIT_L(8); PG8_BAR; PG8_WAIT_L(0); PG8_MMA(0, 0, At, B0); PG8_BAR; PG8_SCHED;
            PG8_LDB(B1, 1, 1); PG8_STAGE(PG8_SB(1, 0), b3, voffB);
            PG8_BAR; PG8_WAIT_L(0); PG8_MMA(0, 1, At, B1); PG8_BAR;
            PG8_LDA(At, 1, 1); PG8_STAGE(PG8_SA(1, 0), a3, voffA);
            PG8_BAR; PG8_WAIT_L(0); PG8_MMA(1, 0, At, B0); PG8_BAR; PG8_SCHED;
            PG8_STAGE(PG8_SB(1, 1), b3 + hstep, voffB);
            PG8_WAIT_V(6); PG8_BAR; PG8_MMA(1, 1, At, B1); PG8_BAR;
            }
        }
        if constexpr (ALIGN_EPI) { if (wr == 0) PG8_BAR; }
        if constexpr (F8) {
            asm volatile("s_nop 15\n\ts_nop 15" ::: "memory");
#pragma unroll
            for (int a_ = 0; a_ < 2; ++a_)
#pragma unroll
                for (int b_ = 0; b_ < 2; ++b_)
                    asm volatile("" : "+v"(acc[a_][b_][0][0]), "+v"(acc[a_][b_][0][1]), "+v"(acc[a_][b_][1][0]), "+v"(acc[a_][b_][1][1]), "+v"(acc[a_][b_][2][0]), "+v"(acc[a_][b_][2][1]), "+v"(acc[a_][b_][3][0]), "+v"(acc[a_][b_][3][1])); }
        if constexpr (!Epi::AFTER_DRAIN) { E(acc, cur, wr, wc, fr, fq); S.done(cur); }
        if (!has_next) break;
#pragma unroll
        for (int a = 0; a < 2; ++a)
#pragma unroll
            for (int b = 0; b < 2; ++b)
#pragma unroll
                for (int m = 0; m < 4; ++m)
#pragma unroll
                    for (int n = 0; n < 2; ++n) acc[a][b][m][n] = (f32x4){0.f, 0.f, 0.f, 0.f};
        cur = nxt; cA = nA; cB = nB; ++ui;
        if constexpr (ALIGN_EPI) { if (wr == 1) PG8_BAR; }
    }
    PG8_WAIT_V(0);
    if constexpr (!ALIGN_EPI) { if (wr == 0) PG8_BAR; }
    PG8_BAR;
    if constexpr (Epi::AFTER_DRAIN) { E.fused(acc, cur, wr, wc, fr, fq, lds, wid, lane); S.done(cur); }
#undef PG8_SA
#undef PG8_SB
#undef PG8_STAGE
#undef PG8_LDA
#undef PG8_LDB
#undef PG8_MMA
#undef PG8_WAIT_V
#undef PG8_WAIT_L
#undef PG8_BAR
#undef PG8_SCHED
}
}


__device__ __forceinline__ float log_sigmoid(float z) { return z >= 0.f ? -log1pf(expf(-z)) : z - log1pf(expf(z)); }
constexpr float XN8_SCALE = 4.0f, WIN8_SCALE = 64.0f;
__device__ __forceinline__ unsigned pk4_fp8(float a, float b, float c, float d) { int w = __builtin_amdgcn_cvt_pk_fp8_f32(a, b, 0, false); w = __builtin_amdgcn_cvt_pk_fp8_f32(c, d, w, true); return (unsigned)w; }
__device__ __forceinline__ void p0_transpose_item8(const float* W, int ldw, int K, int ncols, unsigned char* WT, int row_off, LAS float* scr, int item, int lane, float scale) {
    const int nblk = ncols / 32, kb = item / nblk, nb = item % nblk, k0 = 64 * kb, n0 = 32 * nb;
#pragma unroll 8
    for (int i = 0; i < 32; ++i) { const int kk = 2 * i + (lane >> 5); scr[kk * 33 + (lane & 31)] = W[(size_t)(k0 + kk) * ldw + n0 + (lane & 31)] * scale; }
    asm volatile("s_waitcnt lgkmcnt(0)" ::: "memory");
    const int c = lane & 7;
#pragma unroll
    for (int j = 0; j < 4; ++j) { const int n = (lane >> 3) + 8 * j; const LAS float* s = scr + (8 * c) * 33 + n;
        u32x2 o; o.x = pk4_fp8(s[0 * 33], s[1 * 33], s[2 * 33], s[3 * 33]); o.y = pk4_fp8(s[4 * 33], s[5 * 33], s[6 * 33], s[7 * 33]);
        *(u32x2*)(WT + (size_t)(row_off + n0 + n) * K + k0 + 8 * c) = o; }
    asm volatile("s_waitcnt lgkmcnt(0)" ::: "memory");
}
__device__ __forceinline__ void p0_transpose_item(const float* W, int ldw, int K, int ncols, bf16_t* WT, int row_off, LAS float* scr, int item, int lane, const float* ksc = nullptr) {
    const int nblk = ncols / 32, kb = item / nblk, nb = item % nblk, k0 = 64 * kb, n0 = 32 * nb;
#pragma unroll 8
    for (int i = 0; i < 32; ++i) { const int kk = 2 * i + (lane >> 5); scr[kk * 33 + (lane & 31)] = W[(size_t)(k0 + kk) * ldw + n0 + (lane & 31)] * (ksc ? ksc[k0 + kk] : 1.0f); }
    asm volatile("s_waitcnt lgkmcnt(0)" ::: "memory");
    const int c = lane & 7;
#pragma unroll
    for (int j = 0; j < 4; ++j) { const int n = (lane >> 3) + 8 * j; const LAS float* s = scr + (8 * c) * 33 + n;
        u32x4 o; o.x = pk2(s[0 * 33], s[1 * 33]); o.y = pk2(s[2 * 33], s[3 * 33]); o.z = pk2(s[4 * 33], s[5 * 33]); o.w = pk2(s[6 * 33], s[7 * 33]);
        *(u32x4*)(WT + (size_t)(row_off + n0 + n) * K + k0 + 8 * c) = o; }
    asm volatile("s_waitcnt lgkmcnt(0)" ::: "memory");
}
__device__ __forceinline__ void phase_prologue(LAS unsigned char* ldsb, const P& p) {
    const int TID = otid();
    const int lane = TID & 63, wave = TID >> 6, gw = blockIdx.x * 8 + wave, nw = gridDim.x * 8;
    LAS float* scr = (LAS float*)(ldsb + wave * 16384);
    constexpr int I1 = 16 * 96, I2 = 16 * 64, IA = 8 * 32, IO = 16 * 32, IQ = 16 * 64;
    for (int it = gw; it < I1 + I2 + 2 * IA + IO + IQ; it += nw) {
        int r = it;
        if (r < I1) { p0_transpose_item8(p.w_in, INC, D, 3072, p.ws + WS_WIN, 0, scr, r, lane, WIN8_SCALE); continue; } r -= I1;
        if (r < I2) { p0_transpose_item8(p.w_in + 3080, INC, D, 2048, p.ws + WS_WIN, 3072, scr, r, lane, WIN8_SCALE); continue; } r -= I2;
        if (r < IA) { p0_transpose_item(p.w_a, D, 512, 1024, (bf16_t*)(p.ws + WS_WA), 0, scr, r, lane); continue; } r -= IA;
        if (r < IA) { p0_transpose_item(p.w_b, D, 512, 1024, (bf16_t*)(p.ws + WS_WB), 0, scr, r, lane); continue; } r -= IA;
        if (r < IO) { p0_transpose_item(p.w_out, D, D, 1024, (bf16_t*)(p.ws + WS_WOUT), 0, scr, r, lane); continue; } r -= IO;
        p0_transpose_item(p.w_pq, PQC, D, 2048, (bf16_t*)(p.ws + WS_WPQ), 0, scr, r, lane, p.g_ffn);
    }
    { u32x4* SKo = (u32x4*)(p.ws + WS_SK);
      for (int c = blockIdx.x * 512 + TID; c < PH * 2 * PNK * PHALF / 8; c += gridDim.x * 512) { const f32x4 a0 = *(const f32x4*)(p.sk + (size_t)c * 8), a1 = *(const f32x4*)(p.sk + (size_t)c * 8 + 4);
          u32x4 o; o.x = pk2(a0.x, a0.y); o.y = pk2(a0.z, a0.w); o.z = pk2(a1.x, a1.y); o.w = pk2(a1.z, a1.w); SKo[c] = o; } }
    { float* ROPE = (float*)(p.ws + WS_ROPE);
      for (int it = blockIdx.x * 512 + TID; it < S * 8; it += gridDim.x * 512) { const int i = it & 7, pos = it >> 3;
          const float inv_freq = powf(500000.0f, -(float)i / 8.0f); const float ang = (float)pos * inv_freq;
          ROPE[pos * 16 + i] = cosf(ang); ROPE[pos * 16 + 8 + i] = sinf(ang); } }
    __syncthreads();
    { LAS float* WFt = (LAS float*)ldsb;
      for (int i = TID; i < 2 * D; i += 512) { const int col = i >> 1, half = i & 1; const f32x4 w = *(const f32x4*)(p.w_in + (size_t)col * INC + 3072 + 4 * half);
          WFt[(4 * half + 0) * D + col] = w.x; WFt[(4 * half + 1) * D + col] = w.y; WFt[(4 * half + 2) * D + col] = w.z; WFt[(4 * half + 3) * D + col] = w.w; } }
    __syncthreads();
    bf16_t* XN = (bf16_t*)(p.ws + WS_XN); float* LOGF = (float*)(p.ws + WS_LOGF); const LAS float* WFt = (const LAS float*)ldsb;
    float wsum = 0.f;
    for (int r8 = 0; r8 < 8; ++r8) {
        const int row = gw * 8 + r8;
        const f32x4* xr = (const f32x4*)(p.x + (size_t)row * D);
        f32x4 v[4]; float ss = 0.f;
#pragma unroll
        for (int j = 0; j < 4; ++j) { v[j] = xr[lane + 64 * j]; ss += v[j].x * v[j].x + v[j].y * v[j].y + v[j].z * v[j].z + v[j].w * v[j].w; }
        ss = wave_sum_fast(ss);
        const float rstd = rsqrtf(ss * (1.f / D) + EPS);
        float fs[8];
#pragma unroll
        for (int f = 0; f < 8; ++f) fs[f] = 0.f;
#pragma unroll
        for (int j = 0; j < 4; ++j) {
            const f32x4 g = ((const f32x4*)p.g_mix)[lane + 64 * j];
            v[j].x *= rstd * g.x; v[j].y *= rstd * g.y; v[j].z *= rstd * g.z; v[j].w *= rstd * g.w;
            *(unsigned*)((unsigned char*)XN + (size_t)row * D + 4 * (lane + 64 * j)) = pk4_fp8(v[j].x * XN8_SCALE, v[j].y * XN8_SCALE, v[j].z * XN8_SCALE, v[j].w * XN8_SCALE);
#pragma unroll
            for (int f = 0; f < 8; ++f) { const f32x4 w = *(const LAS f32x4*)(WFt + f * D + 4 * (lane + 64 * j)); fs[f] += (v[j].x * w.x + v[j].y * w.y) + (v[j].z * w.z + v[j].w * w.w); }
        }
#pragma unroll
        for (int f = 0; f < 8; ++f) fs[f] = wave_sum_fast(fs[f]);
        float z = fs[0];
#pragma unroll
        for (int f = 1; f < 8; ++f) z = (lane == f) ? fs[f] : z;
        if (lane < 8) { const float lf = log_sigmoid(z + p.b_f[lane]); LOGF[(size_t)row * 8 + lane] = lf; wsum += lf; }
    }
    if (lane < 8) ((float*)(p.ws + WS_WSUM))[gw * 8 + lane] = wsum;
}

__device__ __forceinline__ void phase_cumsum(const P& p) {
    const int TID = otid();
    const int lane = TID & 63, gw = blockIdx.x * 8 + (TID >> 6), b = gw >> 10, w0 = b << 10, h = lane & 7, j = lane >> 3;
    const float* WSUM = (const float*)(p.ws + WS_WSUM); const float* LOGF = (const float*)(p.ws + WS_LOGF); float* C = (float*)(p.ws + WS_C);
    float part = 0.f;
    { float p1 = 0.f, p2 = 0.f, p3 = 0.f; int w = w0 + j;
      for (; w + 24 < gw; w += 32) { part += WSUM[w * 8 + h]; p1 += WSUM[(w + 8) * 8 + h]; p2 += WSUM[(w + 16) * 8 + h]; p3 += WSUM[(w + 24) * 8 + h]; }
      for (; w < gw; w += 8) part += WSUM[w * 8 + h];
      part = (part + p1) + (p2 + p3); }
    part += __shfl_xor(part, 8); part += __shfl_xor(part, 16); part += __shfl_xor(part, 32);
    if (lane < 8) { float run = part;
#pragma unroll
        for (int r = 0; r < 8; ++r) { const int row = gw * 8 + r; run += LOGF[(size_t)row * 8 + h]; C[(size_t)(b * 8 + h) * S + (row & (S - 1))] = run * LOG2E; } }
}

#include <hip/hip_bf16.h>
namespace attn {
using bf16=__hip_bfloat16;
using bf16x8=__attribute__((ext_vector_type(8)))short;
using s16x4=__attribute__((ext_vector_type(4)))short;
using f32x16=__attribute__((ext_vector_type(16)))float;
using f32x4=__attribute__((ext_vector_type(4)))float;
using u32x4=__attribute__((ext_vector_type(4)))unsigned;
constexpr int SEQ=8192,D=64,DM=512;
constexpr int NW=8,QBLK=32,QB=QBLK*NW,KVBLK=64;
__device__ __forceinline__ int crow(int r,int hi){return (r&3)+8*(r>>2)+4*hi;}
#define SBAR() __builtin_amdgcn_sched_barrier(0)
__device__ __forceinline__ void cmask(f32x16&p0,f32x16&p1,int jb,int qrel,int hi){
  const float NEG=-INFINITY; int kb=64*jb+4*hi;
  #pragma unroll
  for(int r=0;r<16;++r){int kv=kb+(r&3)+8*(r>>2); if(kv>qrel)p0[r]=NEG; if(kv+32>qrel)p1[r]=NEG;}
}
constexpr int KSUM_P1=16*32*64;
constexpr int NSLOT=3, SLOTB=8192;
constexpr int LDS_K=0, LDS_V=NSLOT*SLOTB, LDS_WS=2*NSLOT*SLOTB, LDS_OST=LDS_WS+NW*64*4, LDS_CK=LDS_OST+NW*4096, LDS_BYTES=LDS_CK+SEQ*4;
__device__ __forceinline__ void glds16(const void*gsrc,unsigned lds_dst){unsigned keep;
  asm volatile("s_mov_b32 %0, m0\n\ts_mov_b32 m0, %2\n\ts_nop 0\n\tglobal_load_lds_dwordx4 %1, off\n\ts_mov_b32 m0, %0":"=&s"(keep):"v"(gsrc),"s"(lds_dst):"memory");}
typedef float f32x2_t __attribute__((ext_vector_type(2))); typedef __bf16 bf16x2_t __attribute__((ext_vector_type(2)));
__device__ __forceinline__ unsigned cvtpk_s(float lo,float hi){f32x2_t v={lo,hi};bf16x2_t b=__builtin_convertvector(v,bf16x2_t);return __builtin_bit_cast(unsigned,b);}
#define WAIT_BAR(N) asm volatile("s_waitcnt vmcnt(" #N ") lgkmcnt(0)\n\ts_barrier":::"memory")
typedef __attribute__((address_space(3))) const char* lds_cptr;
typedef short v4i16_t __attribute__((ext_vector_type(4)));
__device__ __forceinline__ void kload8(bf16x8*kf,lds_cptr kp){
  kf[0]=*(const __attribute__((address_space(3))) bf16x8*)(kp);      kf[1]=*(const __attribute__((address_space(3))) bf16x8*)(kp+512);
  kf[2]=*(const __attribute__((address_space(3))) bf16x8*)(kp+2048); kf[3]=*(const __attribute__((address_space(3))) bf16x8*)(kp+2560);
  kf[4]=*(const __attribute__((address_space(3))) bf16x8*)(kp+4096); kf[5]=*(const __attribute__((address_space(3))) bf16x8*)(kp+4608);
  kf[6]=*(const __attribute__((address_space(3))) bf16x8*)(kp+6144); kf[7]=*(const __attribute__((address_space(3))) bf16x8*)(kp+6656);
}
__device__ __forceinline__ void kload2(bf16x8*kf,lds_cptr kp,int j){ kf[2*j]=*(const __attribute__((address_space(3))) bf16x8*)(kp+j*2048); kf[2*j+1]=*(const __attribute__((address_space(3))) bf16x8*)(kp+j*2048+512); }
__device__ __forceinline__ s16x4 vtr(lds_cptr p){ return __builtin_bit_cast(s16x4,__builtin_amdgcn_ds_read_tr16_b64_v4i16((__attribute__((address_space(3))) v4i16_t*)p)); }
template<bool FOX> __device__ __forceinline__ void cinit(f32x16&C,const __attribute__((address_space(3))) float*ckt,float bs){
  if constexpr(FOX){
    #pragma unroll
    for(int g=0;g<4;++g){ const f32x4 kb=*(const __attribute__((address_space(3))) f32x4*)(ckt+8*g); C[4*g]=bs-kb[0]; C[4*g+1]=bs-kb[1]; C[4*g+2]=bs-kb[2]; C[4*g+3]=bs-kb[3]; }
  } else {
    #pragma unroll
    for(int r=0;r<16;++r)C[r]=bs;
  }
  asm volatile("":"+v"(C));
}
__device__ __forceinline__ void pv(f32x16*o,int vb,bf16x8 pa0,bf16x8 pa1,bf16x8 pa2,bf16x8 pa3){
  #pragma unroll
  for(int d0=0;d0<2;++d0){s16x4 lo[4],hi[4];
    #pragma unroll
    for(int ks=0;ks<4;++ks){
      asm volatile("ds_read_b64_tr_b16 %0,%1 offset:%c2":"=&v"(lo[ks]):"v"(vb),"i"(d0*4096+ks*1024):"memory");
      asm volatile("ds_read_b64_tr_b16 %0,%1 offset:%c2":"=&v"(hi[ks]):"v"(vb),"i"(d0*4096+ks*1024+512):"memory");}
    asm volatile("s_waitcnt lgkmcnt(0)":::"memory");SBAR();
    #define PK(k) (bf16x8){lo[k][0],lo[k][1],lo[k][2],lo[k][3],hi[k][0],hi[k][1],hi[k][2],hi[k][3]}
    o[d0]=__builtin_amdgcn_mfma_f32_32x32x16_bf16(pa0,PK(0),o[d0],0,0,0);
    o[d0]=__builtin_amdgcn_mfma_f32_32x32x16_bf16(pa1,PK(1),o[d0],0,0,0);
    o[d0]=__builtin_amdgcn_mfma_f32_32x32x16_bf16(pa2,PK(2),o[d0],0,0,0);
    o[d0]=__builtin_amdgcn_mfma_f32_32x32x16_bf16(pa3,PK(3),o[d0],0,0,0);
    #undef PK
  }
}
#define ATTN_STORE16(p,v) (*(u32x4*)(p)=(v))
struct MobaIo { const unsigned short* QL; int qcnt, jblk; const unsigned* SEL3; bf16* PART0; bf16* PART1; bf16* PART2; float* LSE; };
template<bool FOX,int THRL,int VAR> __device__ __forceinline__ void attn_unit(int b,int h,int qb,int t0,const bf16*Q,const bf16*__restrict__ K,const bf16*__restrict__ V,bf16*O,const float*CK2,const MobaIo&mio,char*shm){
  const int tid=otid(),lane=tid&63,r32=lane&31,hi=lane>>5; const int wid=__builtin_amdgcn_readfirstlane(tid>>6);
  const long rowbase=(long)b*SEQ; const int q0=qb*QB;
  int qidx=q0+wid*QBLK+r32; bool qvalid=true;
  if constexpr(VAR==2){ const int li=wid*QBLK+r32; qvalid=li<mio.qcnt; qidx=(int)mio.QL[qvalid?li:mio.qcnt-1]; }
  const bf16*Qrow=Q+(rowbase+qidx)*DM+h*D;
  const bf16*Kh=K+(rowbase+(long)t0*KVBLK)*DM+h*D,*Vh=V+(rowbase+(long)t0*KVBLK)*DM+h*D;
  const unsigned lds0=(unsigned)(uintptr_t)shm;
  float*wsf=(float*)(shm+LDS_WS)+wid*64;
  const bf16*ksrc=Kh+(long)lane*DM+wid*8;
  const bf16*vsrc=Vh+(long)(16*(wid&3)+(lane>>2))*DM+(wid>>2)*32+(lane&3)*8;
  const unsigned kdst=lds0+LDS_K+wid*1024, vdst=lds0+LDS_V+wid*1024;
  #define DMA_K(t,slot) glds16(ksrc+(long)(t)*KVBLK*DM,(unsigned)__builtin_amdgcn_readfirstlane(kdst+(slot)))
  #define DMA_V(t,slot) glds16(vsrc+(long)(t)*KVBLK*DM,(unsigned)__builtin_amdgcn_readfirstlane(vdst+(slot)))
  const int vb0=(int)(lds0+LDS_V)+((lane>>4)&1)*32+(lane&3)*8+(4*hi+((lane&15)>>2))*64;
  bf16x8 kf[8];
  const lds_cptr shm3=(lds_cptr)shm; const lds_cptr kp0=shm3+LDS_K+hi*1024+r32*16; const lds_cptr vp0=shm3+LDS_V+((lane>>4)&1)*32+(lane&3)*8+(4*hi+((lane&15)>>2))*64;
  const __attribute__((address_space(3))) float*ckl=(const __attribute__((address_space(3))) float*)(shm3+LDS_CK)+4*hi;
  const int NT=(VAR==2)?4:(q0+QB)/KVBLK-t0;
  DMA_K(0,0);DMA_V(0,0);DMA_K(1,SLOTB);
  bf16x8 qr[4];
  #pragma unroll
  for(int d0=0;d0<4;++d0)qr[d0]=*reinterpret_cast<const bf16x8*>(&Qrow[d0*16+hi*8]);
  float cq2=0.f;
  if constexpr(FOX){ __attribute__((address_space(3))) f32x4*ck4=(__attribute__((address_space(3))) f32x4*)(shm3+LDS_CK); const f32x4*g4=(const f32x4*)CK2+t0*16;
    for(int i=tid;i<NT*16;i+=NW*64)ck4[i]=g4[i];
    cq2=CK2[q0+wid*QBLK+r32]; }
  float mhat=0.f,l_reg=0.f;f32x16 o[2];o[0]=f32x16{};o[1]=f32x16{};
  const int qrel=wid*QBLK+r32;
  #define CMASK(P0,P1,t) do{ if constexpr(VAR!=2){ int jb_=(t)-(NT-4); if(jb_>=0)cmask(P0,P1,jb_,qrel,hi); } }while(0)
  #define BASE(t) (FOX ? (cq2-mhat) : -mhat)
  bool resc=false,nmd=true; f32x16 negm=f32x16{}; asm volatile("":"+v"(negm));
  #define RESC() do{ if(resc){ asm volatile("s_waitcnt lgkmcnt(0)":::"memory"); \
      _Pragma("unroll") for(int d_=0;d_<2;++d_) _Pragma("unroll") for(int r=0;r<16;++r)o[d_][r]*=wsf[crow(r,hi)]; } }while(0)
  #define MX3(a,b,c) __builtin_fmaxf(__builtin_fmaxf((a),(b)),(c))
  #define DECIDE(C0,C1) do{ float a=MX3(C0[0],C0[1],C1[0]),b_=MX3(C0[2],C0[3],C1[1]); a=MX3(a,C1[2],C1[3]); \
      _Pragma("unroll") for(int r=4;r<16;r+=4){a=MX3(a,C0[r],C0[r+1]);b_=MX3(b_,C0[r+2],C0[r+3]);a=MX3(a,C1[r],C1[r+1]);b_=MX3(b_,C1[r+2],C1[r+3]);} \
      float rm=__builtin_fmaxf(a,b_); { auto rr=__builtin_amdgcn_permlane32_swap(__float_as_uint(rm),__float_as_uint(rm),false,false); rm=__builtin_fmaxf(__uint_as_float(rr[0]),__uint_as_float(rr[1])); } \
      resc=false; \
      if(__builtin_expect(__any(rm>(float)THRL),0)){ const float dl=(rm>(float)THRL)?rm:0.f; mhat+=dl;     \
        _Pragma("unroll") for(int r=0;r<16;++r){C0[r]-=dl;C1[r]-=dl;} \
        const float f=__builtin_amdgcn_exp2f(-dl); l_reg*=f; if(hi==0)wsf[r32]=f; resc=true; nmd=true; } }while(0)
  f32x16 pA0,pA1,pB0,pB1;
  int sl_prev=0,sl_cur=0,sl_next=SLOTB;
  #define ROT() do{sl_prev=sl_cur;sl_cur=sl_next;sl_next=(sl_next==(NSLOT-1)*SLOTB)?0:sl_next+SLOTB;}while(0)
  DMA_K(2,2*SLOTB);
  WAIT_BAR(3);
  { const float bs=BASE(0); cinit<FOX>(pA0,ckl,bs); cinit<FOX>(pA1,ckl+32,bs);
    const char*kb=shm+LDS_K+hi*1024+r32*16;
    #pragma unroll
    for(int d0=0;d0<4;++d0){
      const bf16x8 b0=*reinterpret_cast<const bf16x8*>(kb+d0*2048);
      const bf16x8 b1=*reinterpret_cast<const bf16x8*>(kb+d0*2048+512);
      pA0=__builtin_amdgcn_mfma_f32_32x32x16_bf16(b0,qr[d0],pA0,0,0,0);pA1=__builtin_amdgcn_mfma_f32_32x32x16_bf16(b1,qr[d0],pA1,0,0,0);}
    CMASK(pA0,pA1,0);
    DECIDE(pA0,pA1); resc=false;
    _Pragma("unroll") for(int r=0;r<16;++r){pA0[r]=__builtin_amdgcn_exp2f(pA0[r]);pA1[r]=__builtin_amdgcn_exp2f(pA1[r]);} }
  WAIT_BAR(0);
  DMA_K(3,0);DMA_V(1,SLOTB);
  ROT();
  kload8(kf,kp0+sl_cur);
  WAIT_BAR(2);
  s16x4 vlo[8],vhi[8]; u32x4 pw0,pw1,pw2,pw3;
  #define PKW(P,B) cvtpk_s(P[B],P[B+1])
  #define PAF(k) __builtin_bit_cast(bf16x8,pw##k)
  #define VFR(i) (bf16x8){vlo[i][0],vlo[i][1],vlo[i][2],vlo[i][3],vhi[i][0],vhi[i][1],vhi[i][2],vhi[i][3]}
  #define PIN(x) asm volatile("":"+v"(x))
  #define GAPA(MF,A0,A1,A2,A3,W0,W1,PW) do{ MF; sacc+=A0; sacc+=A1; sacc+=A2; sacc+=A3; PIN(sacc); W0; W1; PIN(PW); SBAR(); }while(0)
  #define EX(v) __builtin_amdgcn_exp2f(v)
  #define GAPB(MF,X,B) do{ MF; X[B]=EX(X[B]); X[B+1]=EX(X[B+1]); X[B+2]=EX(X[B+2]); X[B+3]=EX(X[B+3]); PIN(X); SBAR(); }while(0)
  #define VRD(i) do{ vlo[i]=vtr(vp_+(((i)>>2)*4096+((i)&3)*1024)); vhi[i]=vtr(vp_+(((i)>>2)*4096+((i)&3)*1024+512)); }while(0)
  #define KRD(G,j) do{ if(G){ kload2(kf,kp0+sl_next,j); SBAR(); } }while(0)
  #define STEP(C0,C1,P0,P1,t,GK,GV,GL) do{ SBAR(); \
    const lds_cptr vp_=vp0+sl_prev; const float bs_=BASE(t); \
    if constexpr(FOX){ cinit<FOX>(C0,ckl+(t)*64,bs_); SBAR(); } \
    else if(nmd){ _Pragma("unroll") for(int r=0;r<16;++r)negm[r]=bs_; asm volatile("":"+v"(negm)); nmd=false; SBAR(); }     \
    VRD(0); SBAR(); float sacc=(P0[0]+P0[1]); \
    GAPA(C0=__builtin_amdgcn_mfma_f32_32x32x16_bf16(kf[0],qr[0],FOX?C0:negm,0,0,0), P0[2],P0[3],P0[4],P0[5],     pw0[0]=PKW(P0,0), pw0[1]=PKW(P0,2), pw0); \
    if constexpr(FOX){ cinit<FOX>(C1,ckl+(t)*64+32,bs_); SBAR(); } \
    VRD(4); SBAR(); GAPA(C1=__builtin_amdgcn_mfma_f32_32x32x16_bf16(kf[1],qr[0],FOX?C1:negm,0,0,0), P0[6],P0[7],P0[8],P0[9],     pw0[2]=PKW(P0,4), pw0[3]=PKW(P0,6), pw0); \
    VRD(1); SBAR(); GAPA(C0=__builtin_amdgcn_mfma_f32_32x32x16_bf16(kf[2],qr[1],C0,0,0,0),   P0[10],P0[11],P0[12],P0[13], pw1[0]=PKW(P0,8), pw1[1]=PKW(P0,10), pw1); \
    VRD(5); SBAR(); GAPA(C1=__builtin_amdgcn_mfma_f32_32x32x16_bf16(kf[3],qr[1],C1,0,0,0),   P0[14],P0[15],P1[0],P1[1],   pw1[2]=PKW(P0,12),pw1[3]=PKW(P0,14), pw1); \
    VRD(2); SBAR(); GAPA(C0=__builtin_amdgcn_mfma_f32_32x32x16_bf16(kf[4],qr[2],C0,0,0,0),   P1[2],P1[3],P1[4],P1[5],     pw2[0]=PKW(P1,0), pw2[1]=PKW(P1,2), pw2); \
    VRD(6); SBAR(); GAPA(C1=__builtin_amdgcn_mfma_f32_32x32x16_bf16(kf[5],qr[2],C1,0,0,0),   P1[6],P1[7],P1[8],P1[9],     pw2[2]=PKW(P1,4), pw2[3]=PKW(P1,6), pw2); \
    VRD(3); SBAR(); GAPA(C0=__builtin_amdgcn_mfma_f32_32x32x16_bf16(kf[6],qr[3],C0,0,0,0),   P1[10],P1[11],P1[12],P1[13], pw3[0]=PKW(P1,8), pw3[1]=PKW(P1,10), pw3); \
    VRD(7); SBAR(); GAPA(C1=__builtin_amdgcn_mfma_f32_32x32x16_bf16(kf[7],qr[3],C1,0,0,0),   P1[14],P1[15],0.f,0.f,       pw3[2]=PKW(P1,12),pw3[3]=PKW(P1,14), pw3); \
    l_reg+=sacc; \
    if(GK){DMA_K((t)+3,sl_cur);} if(GV){DMA_V((t)+1,sl_next);} \
    CMASK(C0,C1,t); \
    DECIDE(C0,C1); \
    SBAR(); \
    GAPB(o[0]=__builtin_amdgcn_mfma_f32_32x32x16_bf16(PAF(0),VFR(0),o[0],0,0,0), C0,0); \
    GAPB(o[1]=__builtin_amdgcn_mfma_f32_32x32x16_bf16(PAF(0),VFR(4),o[1],0,0,0), C0,4); \
    KRD(GL,0); GAPB(o[0]=__builtin_amdgcn_mfma_f32_32x32x16_bf16(PAF(1),VFR(1),o[0],0,0,0), C0,8); \
    KRD(GL,1); GAPB(o[1]=__builtin_amdgcn_mfma_f32_32x32x16_bf16(PAF(1),VFR(5),o[1],0,0,0), C0,12); \
    KRD(GL,2); GAPB(o[0]=__builtin_amdgcn_mfma_f32_32x32x16_bf16(PAF(2),VFR(2),o[0],0,0,0), C1,0); \
    KRD(GL,3); GAPB(o[1]=__builtin_amdgcn_mfma_f32_32x32x16_bf16(PAF(2),VFR(6),o[1],0,0,0), C1,4); \
    GAPB(o[0]=__builtin_amdgcn_mfma_f32_32x32x16_bf16(PAF(3),VFR(3),o[0],0,0,0), C1,8); \
    GAPB(o[1]=__builtin_amdgcn_mfma_f32_32x32x16_bf16(PAF(3),VFR(7),o[1],0,0,0), C1,12); \
    }while(0)
  int t=1;
  #undef CMASK
  #define CMASK(P0,P1,t) do{}while(0)
  for(;t+5<NT;t+=2){
    STEP(pB0,pB1,pA0,pA1,t,true,true,true);     WAIT_BAR(2); RESC(); ROT();
    STEP(pA0,pA1,pB0,pB1,t+1,true,true,true);   WAIT_BAR(2); RESC(); ROT();
  }
  #undef CMASK
  #define CMASK(P0,P1,t) do{ if constexpr(VAR!=2){ int jb_=(t)-(NT-4); if(jb_>=0)cmask(P0,P1,jb_,qrel,hi); } }while(0)
  #define ENDW(tt) do{ if((tt)+3<NT){WAIT_BAR(2);} else if((tt)+2<NT){WAIT_BAR(1);} else {WAIT_BAR(0);} }while(0)
  for(;t+1<NT;t+=2){
    STEP(pB0,pB1,pA0,pA1,t,(t+3<NT),(t+1<NT),(t+1<NT));       ENDW(t);   RESC(); ROT();
    STEP(pA0,pA1,pB0,pB1,t+1,(t+4<NT),(t+2<NT),(t+2<NT));     ENDW(t+1); RESC(); ROT();
  }
  STEP(pB0,pB1,pA0,pA1,NT-1,false,false,false); RESC();
  { float sacc=pB0[0]+pB0[1]; _Pragma("unroll") for(int r=2;r<16;++r)sacc+=pB0[r]; _Pragma("unroll") for(int r=0;r<16;++r)sacc+=pB1[r]; l_reg+=sacc;
    pw0=(u32x4){PKW(pB0,0),PKW(pB0,2),PKW(pB0,4),PKW(pB0,6)};pw1=(u32x4){PKW(pB0,8),PKW(pB0,10),PKW(pB0,12),PKW(pB0,14)};pw2=(u32x4){PKW(pB1,0),PKW(pB1,2),PKW(pB1,4),PKW(pB1,6)};pw3=(u32x4){PKW(pB1,8),PKW(pB1,10),PKW(pB1,12),PKW(pB1,14)};
    SBAR(); pv(o,vb0+sl_cur,PAF(0),PAF(1),PAF(2),PAF(3)); }
  #undef PKW
  #undef PAF
  #undef VFR
  #undef PIN
  #undef MX3
  #undef GAPA
  #undef GAPB
  #undef EX
  #undef VRD
  #undef KRD
  #undef STEP
  #undef ENDW
  #undef DECIDE
  #undef BASE
  {auto rr=__builtin_amdgcn_permlane32_swap(__float_as_uint(l_reg),__float_as_uint(l_reg),false,false);l_reg=__uint_as_float(rr[0])+__uint_as_float(rr[1]);}
  int pslot=0;
  if constexpr(VAR==2){ const unsigned s3=mio.SEL3[qidx]; pslot=((int)(s3&31u)==mio.jblk)?0:(((int)((s3>>5)&31u)==mio.jblk)?1:2); }
  if(hi==0){ wsf[32+r32]=l_reg; if constexpr(VAR==2) wsf[r32]=__int_as_float(qvalid?(qidx*4+pslot):-1); }
  asm volatile("s_waitcnt lgkmcnt(0)":::"memory");
  if constexpr(VAR>=1){ if(hi==0&&qvalid) mio.LSE[(long)qidx*4+((VAR==1)?3:pslot)]=mhat+__builtin_amdgcn_logf(l_reg); }
  float rli[16];
  #pragma unroll
  for(int r=0;r<16;++r)rli[r]=__builtin_amdgcn_rcpf(wsf[32+crow(r,hi)]);
  { bf16*stg=(bf16*)(shm+LDS_OST)+wid*2048;
    #pragma unroll
    for(int r=0;r<16;++r){const int orow=crow(r,hi);
      #pragma unroll
      for(int d0=0;d0<2;++d0)stg[orow*64+d0*32+r32]=__float2bfloat16(o[d0][r]*rli[r]);}
    asm volatile("s_waitcnt lgkmcnt(0)":::"memory");
    if constexpr(VAR==2){
      #pragma unroll
      for(int i=0;i<4;++i){const int row=i*8+(lane>>3),ch=lane&7; const u32x4 v=*(const u32x4*)(stg+row*64+ch*8); const int inf=__float_as_int(wsf[row]);
        if(inf>=0){ bf16*pb=((inf&3)==0)?mio.PART0:(((inf&3)==1)?mio.PART1:mio.PART2); ATTN_STORE16(pb+(long)(inf>>2)*D+ch*8,v); } }
    } else if constexpr(VAR==1){
      bf16*Ow=mio.PART0+(long)(q0+wid*QBLK)*D;
      #pragma unroll
      for(int i=0;i<4;++i){const int row=i*8+(lane>>3),ch=lane&7; const u32x4 v=*(const u32x4*)(stg+row*64+ch*8); ATTN_STORE16(Ow+(long)row*D+ch*8,v);}
    } else {
      bf16*Ow=O+(rowbase+q0+wid*QBLK)*DM+h*D;
      #pragma unroll
      for(int i=0;i<4;++i){const int row=i*8+(lane>>3),ch=lane&7; const u32x4 v=*(const u32x4*)(stg+row*64+ch*8); ATTN_STORE16(Ow+(long)row*DM+ch*8,v);} } }
  asm volatile("s_waitcnt lgkmcnt(0)\n\ts_barrier":::"memory");
  #undef DMA_K
  #undef DMA_V
  #undef CMASK
  #undef RESC
  #undef ROT
}
template<bool OWN> __device__ __forceinline__ void moba4_unit(int b,int h,int qb,int jblk,int cnt,const bf16*Q,const bf16*__restrict__ K,const bf16*__restrict__ V,const MobaIo&mio,char*shm){
  constexpr bool FOX=false; constexpr int THRL=8, VAR=OWN?1:2; constexpr int LK=0,LV=4*SLOTB,LWS=8*SLOTB,LOST=LWS+NW*128*4;
  const int t0=4*jblk; bf16*O=nullptr; const float*CK2=nullptr; (void)O; (void)CK2;
  const int tid=otid(),lane=tid&63,r32=lane&31,hi=lane>>5; const int wid=__builtin_amdgcn_readfirstlane(tid>>6);
  const long rowbase=(long)b*SEQ; const int q0=qb*QB;
  const bf16*Kh=K+(rowbase+(long)t0*KVBLK)*DM+h*D,*Vh=V+(rowbase+(long)t0*KVBLK)*DM+h*D;
  const unsigned lds0=(unsigned)(uintptr_t)shm;
  float*wsf=(float*)(shm+LWS)+wid*128;
  const bf16*ksrc=Kh+(long)lane*DM+wid*8;
  const bf16*vsrc=Vh+(long)(16*(wid&3)+(lane>>2))*DM+(wid>>2)*32+(lane&3)*8;
  const unsigned kdst=lds0+LK+wid*1024, vdst=lds0+LV+wid*1024;
  #define DMA_K(t,slot) glds16(ksrc+(long)(t)*KVBLK*DM,(unsigned)__builtin_amdgcn_readfirstlane(kdst+(slot)))
  #define DMA_V(t,slot) glds16(vsrc+(long)(t)*KVBLK*DM,(unsigned)__builtin_amdgcn_readfirstlane(vdst+(slot)))
  const int vb0=(int)(lds0+LV)+((lane>>4)&1)*32+(lane&3)*8+(4*hi+((lane&15)>>2))*64;
  bf16x8 kf[8];
  const lds_cptr shm3=(lds_cptr)shm; const lds_cptr kp0=shm3+LK+hi*1024+r32*16; const lds_cptr vp0=shm3+LV+((lane>>4)&1)*32+(lane&3)*8+(4*hi+((lane&15)>>2))*64;
  const __attribute__((address_space(3))) float*ckl=(const __attribute__((address_space(3))) float*)(shm3+LWS)+4*hi;
  constexpr int NT=4; const float cq2=0.f; (void)cq2;
  DMA_K(0,0);DMA_V(0,0);DMA_K(1,SLOTB);DMA_V(1,SLOTB);DMA_K(2,2*SLOTB);DMA_V(2,2*SLOTB);DMA_K(3,3*SLOTB);DMA_V(3,3*SLOTB);
  const int nch=OWN?1:(cnt+QB-1)/QB;
  int qidx=q0+wid*QBLK+r32,qnext=0; unsigned s3=0u; bf16x8 qr[4];
  if constexpr(VAR==2){ qidx=(int)mio.QL[min(wid*QBLK+r32,cnt-1)]; s3=mio.SEL3[qidx]; qnext=(int)mio.QL[min(QB+wid*QBLK+r32,cnt-1)]; }
  { const bf16*Qrow=Q+(rowbase+qidx)*DM+h*D;
    #pragma unroll
    for(int d0=0;d0<4;++d0)qr[d0]=*reinterpret_cast<const bf16x8*>(&Qrow[d0*16+hi*8]); }
  for(int c_=0;c_<nch;++c_){
  bool qvalid=true; int pslot=0;
  if constexpr(VAR==2){ qvalid=(c_*QB+wid*QBLK+r32)<cnt; pslot=((int)(s3&31u)==jblk)?0:(((int)((s3>>5)&31u)==jblk)?1:2); }
  wsf[64+lane]=__int_as_float(qvalid?(qidx*4+(OWN?3:pslot)):-1);
  float mhat=0.f,l_reg=0.f;f32x16 o[2];o[0]=f32x16{};o[1]=f32x16{};
  const int qrel=wid*QBLK+r32;
  #define CMASK(P0,P1,t) do{ if constexpr(VAR!=2){ int jb_=(t)-(NT-4); if(jb_>=0)cmask(P0,P1,jb_,qrel,hi); } }while(0)
  #define BASE(t) (FOX ? (cq2-mhat) : -mhat)
  bool resc=false,nmd=true; f32x16 negm=f32x16{}; asm volatile("":"+v"(negm));
  #define RESC() do{ if(resc){ asm volatile("s_waitcnt lgkmcnt(0)":::"memory"); \
      _Pragma("unroll") for(int d_=0;d_<2;++d_) _Pragma("unroll") for(int r=0;r<16;++r)o[d_][r]*=wsf[crow(r,hi)]; } }while(0)
  #define MX3(a,b,c) __builtin_fmaxf(__builtin_fmaxf((a),(b)),(c))
  #define DECIDE(C0,C1) do{ float a=MX3(C0[0],C0[1],C1[0]),b_=MX3(C0[2],C0[3],C1[1]); a=MX3(a,C1[2],C1[3]); \
      _Pragma("unroll") for(int r=4;r<16;r+=4){a=MX3(a,C0[r],C0[r+1]);b_=MX3(b_,C0[r+2],C0[r+3]);a=MX3(a,C1[r],C1[r+1]);b_=MX3(b_,C1[r+2],C1[r+3]);} \
      float rm=__builtin_fmaxf(a,b_); { auto rr=__builtin_amdgcn_permlane32_swap(__float_as_uint(rm),__float_as_uint(rm),false,false); rm=__builtin_fmaxf(__uint_as_float(rr[0]),__uint_as_float(rr[1])); } \
      resc=false; \
      if(__builtin_expect(__any(rm>(float)THRL),0)){ const float dl=(rm>(float)THRL)?rm:0.f; mhat+=dl;     \
        _Pragma("unroll") for(int r=0;r<16;++r){C0[r]-=dl;C1[r]-=dl;} \
        const float f=__builtin_amdgcn_exp2f(-dl); l_reg*=f; if(hi==0)wsf[r32]=f; resc=true; nmd=true; } }while(0)
  f32x16 pA0,pA1,pB0,pB1;
  int sl_prev=0,sl_cur=0,sl_next=SLOTB;
  #define ROT() do{sl_prev=sl_cur;sl_cur=sl_next;sl_next=sl_next+SLOTB;}while(0)
  #define WAIT_NB() asm volatile("s_waitcnt lgkmcnt(0)":::"memory")
  if(c_==0){ WAIT_BAR(0); if(wid>=4) __builtin_amdgcn_s_sleep(10); }
  { const float bs=BASE(0); cinit<FOX>(pA0,ckl,bs); cinit<FOX>(pA1,ckl+32,bs);
    const char*kb=shm+LK+hi*1024+r32*16;
    #pragma unroll
    for(int d0=0;d0<4;++d0){
      const bf16x8 b0=*reinterpret_cast<const bf16x8*>(kb+d0*2048);
      const bf16x8 b1=*reinterpret_cast<const bf16x8*>(kb+d0*2048+512);
      pA0=__builtin_amdgcn_mfma_f32_32x32x16_bf16(b0,qr[d0],pA0,0,0,0);pA1=__builtin_amdgcn_mfma_f32_32x32x16_bf16(b1,qr[d0],pA1,0,0,0);}
    CMASK(pA0,pA1,0);
    DECIDE(pA0,pA1); resc=false;
    _Pragma("unroll") for(int r=0;r<16;++r){pA0[r]=__builtin_amdgcn_exp2f(pA0[r]);pA1[r]=__builtin_amdgcn_exp2f(pA1[r]);} }
  WAIT_NB();
  ROT();
  kload8(kf,kp0+sl_cur);
  WAIT_NB();
  s16x4 vlo[8],vhi[8]; u32x4 pw0,pw1,pw2,pw3;
  #define PKW(P,B) cvtpk_s(P[B],P[B+1])
  #define PAF(k) __builtin_bit_cast(bf16x8,pw##k)
  #define VFR(i) (bf16x8){vlo[i][0],vlo[i][1],vlo[i][2],vlo[i][3],vhi[i][0],vhi[i][1],vhi[i][2],vhi[i][3]}
  #define PIN(x) asm volatile("":"+v"(x))
  #define GAPA(MF,A0,A1,A2,A3,W0,W1,PW) do{ MF; sacc+=A0; sacc+=A1; sacc+=A2; sacc+=A3; PIN(sacc); W0; W1; PIN(PW); SBAR(); }while(0)
  #define EX(v) __builtin_amdgcn_exp2f(v)
  #define GAPB(MF,X,B) do{ MF; X[B]=EX(X[B]); X[B+1]=EX(X[B+1]); X[B+2]=EX(X[B+2]); X[B+3]=EX(X[B+3]); PIN(X); SBAR(); }while(0)
  #define VRD(i) do{ vlo[i]=vtr(vp_+(((i)>>2)*4096+((i)&3)*1024)); vhi[i]=vtr(vp_+(((i)>>2)*4096+((i)&3)*1024+512)); }while(0)
  #define KRD(G,j) do{ if(G){ kload2(kf,kp0+sl_next,j); SBAR(); } }while(0)
  #define STEP(C0,C1,P0,P1,t,GK,GV,GL) do{ SBAR(); \
    const lds_cptr vp_=vp0+sl_prev; const float bs_=BASE(t); \
    if constexpr(FOX){ cinit<FOX>(C0,ckl+(t)*64,bs_); SBAR(); } \
    else if(nmd){ _Pragma("unroll") for(int r=0;r<16;++r)negm[r]=bs_; asm volatile("":"+v"(negm)); nmd=false; SBAR(); }     \
    VRD(0); SBAR(); float sacc=(P0[0]+P0[1]); \
    GAPA(C0=__builtin_amdgcn_mfma_f32_32x32x16_bf16(kf[0],qr[0],FOX?C0:negm,0,0,0), P0[2],P0[3],P0[4],P0[5],     pw0[0]=PKW(P0,0), pw0[1]=PKW(P0,2), pw0); \
    if constexpr(FOX){ cinit<FOX>(C1,ckl+(t)*64+32,bs_); SBAR(); } \
    VRD(4); SBAR(); GAPA(C1=__builtin_amdgcn_mfma_f32_32x32x16_bf16(kf[1],qr[0],FOX?C1:negm,0,0,0), P0[6],P0[7],P0[8],P0[9],     pw0[2]=PKW(P0,4), pw0[3]=PKW(P0,6), pw0); \
    VRD(1); SBAR(); GAPA(C0=__builtin_amdgcn_mfma_f32_32x32x16_bf16(kf[2],qr[1],C0,0,0,0),   P0[10],P0[11],P0[12],P0[13], pw1[0]=PKW(P0,8), pw1[1]=PKW(P0,10), pw1); \
    VRD(5); SBAR(); GAPA(C1=__builtin_amdgcn_mfma_f32_32x32x16_bf16(kf[3],qr[1],C1,0,0,0),   P0[14],P0[15],P1[0],P1[1],   pw1[2]=PKW(P0,12),pw1[3]=PKW(P0,14), pw1); \
    VRD(2); SBAR(); GAPA(C0=__builtin_amdgcn_mfma_f32_32x32x16_bf16(kf[4],qr[2],C0,0,0,0),   P1[2],P1[3],P1[4],P1[5],     pw2[0]=PKW(P1,0), pw2[1]=PKW(P1,2), pw2); \
    VRD(6); SBAR(); GAPA(C1=__builtin_amdgcn_mfma_f32_32x32x16_bf16(kf[5],qr[2],C1,0,0,0),   P1[6],P1[7],P1[8],P1[9],     pw2[2]=PKW(P1,4), pw2[3]=PKW(P1,6), pw2); \
    VRD(3); SBAR(); GAPA(C0=__builtin_amdgcn_mfma_f32_32x32x16_bf16(kf[6],qr[3],C0,0,0,0),   P1[10],P1[11],P1[12],P1[13], pw3[0]=PKW(P1,8), pw3[1]=PKW(P1,10), pw3); \
    VRD(7); SBAR(); GAPA(C1=__builtin_amdgcn_mfma_f32_32x32x16_bf16(kf[7],qr[3],C1,0,0,0),   P1[14],P1[15],0.f,0.f,       pw3[2]=PKW(P1,12),pw3[3]=PKW(P1,14), pw3); \
    l_reg+=sacc; \
    if(GK){DMA_K((t)+3,sl_cur);} if(GV){DMA_V((t)+1,sl_next);} \
    CMASK(C0,C1,t); \
    DECIDE(C0,C1); \
    SBAR(); \
    GAPB(o[0]=__builtin_amdgcn_mfma_f32_32x32x16_bf16(PAF(0),VFR(0),o[0],0,0,0), C0,0); \
    GAPB(o[1]=__builtin_amdgcn_mfma_f32_32x32x16_bf16(PAF(0),VFR(4),o[1],0,0,0), C0,4); \
    KRD(GL,0); GAPB(o[0]=__builtin_amdgcn_mfma_f32_32x32x16_bf16(PAF(1),VFR(1),o[0],0,0,0), C0,8); \
    KRD(GL,1); GAPB(o[1]=__builtin_amdgcn_mfma_f32_32x32x16_bf16(PAF(1),VFR(5),o[1],0,0,0), C0,12); \
    KRD(GL,2); GAPB(o[0]=__builtin_amdgcn_mfma_f32_32x32x16_bf16(PAF(2),VFR(2),o[0],0,0,0), C1,0); \
    KRD(GL,3); GAPB(o[1]=__builtin_amdgcn_mfma_f32_32x32x16_bf16(PAF(2),VFR(6),o[1],0,0,0), C1,4); \
    GAPB(o[0]=__builtin_amdgcn_mfma_f32_32x32x16_bf16(PAF(3),VFR(3),o[0],0,0,0), C1,8); \
    GAPB(o[1]=__builtin_amdgcn_mfma_f32_32x32x16_bf16(PAF(3),VFR(7),o[1],0,0,0), C1,12); \
    }while(0)
  int t=1;
  #undef CMASK
  #define CMASK(P0,P1,t) do{}while(0)
  for(;t+5<NT;t+=2){
    STEP(pB0,pB1,pA0,pA1,t,false,false,true);     WAIT_NB(); RESC(); ROT();
    STEP(pA0,pA1,pB0,pB1,t+1,false,false,true);   WAIT_NB(); RESC(); ROT();
  }
  #undef CMASK
  #define CMASK(P0,P1,t) do{ if constexpr(VAR!=2){ int jb_=(t)-(NT-4); if(jb_>=0)cmask(P0,P1,jb_,qrel,hi); } }while(0)
  #define ENDW(tt) WAIT_NB()
  for(;t+1<NT;t+=2){
    STEP(pB0,pB1,pA0,pA1,t,false,false,(t+1<NT));       ENDW(t);   RESC(); ROT();
    STEP(pA0,pA1,pB0,pB1,t+1,false,false,(t+2<NT));     ENDW(t+1); RESC(); ROT();
  }
  STEP(pB0,pB1,pA0,pA1,NT-1,false,false,false); RESC();
  if constexpr(VAR==2){ if(c_+1<nch){ qidx=qnext; const bf16*Qrow=Q+(rowbase+qidx)*DM+h*D;
      #pragma unroll
      for(int d0=0;d0<4;++d0)qr[d0]=*reinterpret_cast<const bf16x8*>(&Qrow[d0*16+hi*8]);
      s3=mio.SEL3[qidx]; qnext=(int)mio.QL[min((c_+2)*QB+wid*QBLK+r32,cnt-1)]; } }
  { float sacc=pB0[0]+pB0[1]; _Pragma("unroll") for(int r=2;r<16;++r)sacc+=pB0[r]; _Pragma("unroll") for(int r=0;r<16;++r)sacc+=pB1[r]; l_reg+=sacc;
    pw0=(u32x4){PKW(pB0,0),PKW(pB0,2),PKW(pB0,4),PKW(pB0,6)};pw1=(u32x4){PKW(pB0,8),PKW(pB0,10),PKW(pB0,12),PKW(pB0,14)};pw2=(u32x4){PKW(pB1,0),PKW(pB1,2),PKW(pB1,4),PKW(pB1,6)};pw3=(u32x4){PKW(pB1,8),PKW(pB1,10),PKW(pB1,12),PKW(pB1,14)};
    SBAR(); pv(o,vb0+sl_cur,PAF(0),PAF(1),PAF(2),PAF(3)); }
  #undef PKW
  #undef PAF
  #undef VFR
  #undef PIN
  #undef MX3
  #undef GAPA
  #undef GAPB
  #undef EX
  #undef VRD
  #undef KRD
  #undef STEP
  #undef ENDW
  #undef DECIDE
  #undef BASE
  {auto rr=__builtin_amdgcn_permlane32_swap(__float_as_uint(l_reg),__float_as_uint(l_reg),false,false);l_reg=__uint_as_float(rr[0])+__uint_as_float(rr[1]);}
  const int info=__float_as_int(wsf[64+lane]);
  if(hi==0){ wsf[32+r32]=l_reg; if constexpr(VAR==2) wsf[r32]=__int_as_float(info); }
  asm volatile("s_waitcnt lgkmcnt(0)":::"memory");
  if(hi==0&&info>=0) mio.LSE[info]=mhat+__builtin_amdgcn_logf(l_reg);
  float rli[16];
  #pragma unroll
  for(int r=0;r<16;++r)rli[r]=__builtin_amdgcn_rcpf(wsf[32+crow(r,hi)]);
  { bf16*stg=(bf16*)(shm+LOST)+wid*2048;
    #pragma unroll
    for(int r=0;r<16;++r){const int orow=crow(r,hi);
      #pragma unroll
      for(int d0=0;d0<2;++d0)stg[orow*64+d0*32+r32]=__float2bfloat16(o[d0][r]*rli[r]);}
    asm volatile("s_waitcnt lgkmcnt(0)":::"memory");
    if constexpr(VAR==2){
      #pragma unroll
      for(int i=0;i<4;++i){const int row=i*8+(lane>>3),ch=lane&7; const u32x4 v=*(const u32x4*)(stg+row*64+ch*8); const int inf=__float_as_int(wsf[row]);
        if(inf>=0){ bf16*pb=((inf&3)==0)?mio.PART0:(((inf&3)==1)?mio.PART1:mio.PART2); ATTN_STORE16(pb+(long)(inf>>2)*D+ch*8,v); } }
    } else if constexpr(VAR==1){
      bf16*Ow=mio.PART0+(long)(q0+wid*QBLK)*D;
      #pragma unroll
      for(int i=0;i<4;++i){const int row=i*8+(lane>>3),ch=lane&7; const u32x4 v=*(const u32x4*)(stg+row*64+ch*8); ATTN_STORE16(Ow+(long)row*D+ch*8,v);}
    } else {
      bf16*Ow=O+(rowbase+q0+wid*QBLK)*DM+h*D;
      #pragma unroll
      for(int i=0;i<4;++i){const int row=i*8+(lane>>3),ch=lane&7; const u32x4 v=*(const u32x4*)(stg+row*64+ch*8); ATTN_STORE16(Ow+(long)row*DM+ch*8,v);} } }
  asm volatile("s_waitcnt lgkmcnt(0)":::"memory");
  }
  #undef WAIT_NB
  #undef DMA_K
  #undef DMA_V
  #undef CMASK
  #undef RESC
  #undef ROT
}

__device__ __forceinline__ void moba_gate_item(int b,int h,int qb,const bf16*Q,const float*KSUM,unsigned*SEL3,unsigned*CNT,unsigned short*LIST){
  const int tid=otid(),lane=tid&63,r32=lane&31,hi=lane>>5; const int wid=__builtin_amdgcn_readfirstlane(tid>>6);
  const int q=qb*QB+wid*QBLK+r32;
  const bf16*Qrow=Q+((long)b*SEQ+q)*DM+h*D;
  bf16x8 qr[4];
  #pragma unroll
  for(int d0=0;d0<4;++d0)qr[d0]=*reinterpret_cast<const bf16x8*>(&Qrow[d0*16+hi*8]);
  f32x16 ga=f32x16{};
  const float*km=KSUM+r32*64+8*hi;
  #pragma unroll
  for(int ks=0;ks<4;++ks){
    const f32x4 a0=*(const f32x4*)(km+16*ks),a1=*(const f32x4*)(km+16*ks+4),c0=*(const f32x4*)(km+KSUM_P1+16*ks),c1=*(const f32x4*)(km+KSUM_P1+16*ks+4);
    float x[8]; u32x4 fh,fl;
    #pragma unroll
    for(int e=0;e<4;++e){x[e]=a0[e]+c0[e];x[4+e]=a1[e]+c1[e];}
    #pragma unroll
    for(int e=0;e<4;++e){ const unsigned hw=cvtpk_s(x[2*e],x[2*e+1]); fh[e]=hw; fl[e]=cvtpk_s(x[2*e]-__uint_as_float(hw<<16),x[2*e+1]-__uint_as_float(hw&0xffff0000u)); }
    ga=__builtin_amdgcn_mfma_f32_32x32x16_bf16(__builtin_bit_cast(bf16x8,fh),qr[ks],ga,0,0,0);
    ga=__builtin_amdgcn_mfma_f32_32x32x16_bf16(__builtin_bit_cast(bf16x8,fl),qr[ks],ga,0,0,0);
  }
  unsigned t0=0u,t1=0u,t2=0u;
  #define INS3(x) do{ unsigned x_=(x); unsigned m_=max(t0,x_); x_=min(t0,x_); t0=m_; m_=max(t1,x_); x_=min(t1,x_); t1=m_; t2=max(t2,x_); }while(0)
  #pragma unroll
  for(int r=0;r<16;++r){ const int n=(r&3)+8*(r>>2)+4*hi; const unsigned u_=__float_as_uint(ga[r]); const unsigned o_=u_^((unsigned)((int)u_>>31)|0x80000000u);
    const unsigned key=(n<qb)?((o_&~31u)|(unsigned)(31-n)):0u; INS3(key); }
  { const unsigned p0=(unsigned)__shfl_xor((int)t0,32),p1=(unsigned)__shfl_xor((int)t1,32),p2=(unsigned)__shfl_xor((int)t2,32); INS3(p0); INS3(p1); INS3(p2); }
  #undef INS3
  const int n0=t0?(int)(31u-(t0&31u)):-1,n1=t1?(int)(31u-(t1&31u)):-1,n2=t2?(int)(31u-(t2&31u)):-1;
  const unsigned cntv=(t0?1u:0u)+(t1?1u:0u)+(t2?1u:0u);
  if(hi==0)SEL3[q]=(unsigned)(n0&31)|((unsigned)(n1&31)<<5)|((unsigned)(n2&31)<<10)|(cntv<<15);
  unsigned mycnt=0u; int rk0=0,rk1=0,rk2=0; const unsigned long long below=(1ull<<r32)-1ull;
  for(int j=0;j<qb;++j){ const unsigned long long m=__ballot(hi==0&&(n0==j||n1==j||n2==j))&0xffffffffull; const int pc=__builtin_popcountll(m);
    if(lane==j)mycnt=(unsigned)pc; const int rk=__builtin_popcountll(m&below); if(n0==j)rk0=rk; if(n1==j)rk1=rk; if(n2==j)rk2=rk; }
  unsigned basev=0u;
  if(lane<qb&&mycnt)basev=__hip_atomic_fetch_add(CNT+lane,mycnt,__ATOMIC_RELAXED,__HIP_MEMORY_SCOPE_AGENT);
  const unsigned b0=(unsigned)__shfl((int)basev,n0<0?0:n0),b1=(unsigned)__shfl((int)basev,n1<0?0:n1),b2=(unsigned)__shfl((int)basev,n2<0?0:n2);
  if(hi==0){ if(n0>=0)LIST[(long)n0*SEQ+b0+rk0]=(unsigned short)q; if(n1>=0)LIST[(long)n1*SEQ+b1+rk1]=(unsigned short)q; if(n2>=0)LIST[(long)n2*SEQ+b2+rk2]=(unsigned short)q; }
}
#undef SBAR
#undef WAIT_BAR
}

constexpr float FOX_SKIP = 32.0f;
constexpr size_t WS_QCTR = 32 * KiB;
__device__ __forceinline__ void phase_attn(char* lds, volatile LAS unsigned* misc, const P& p) {
    attn::bf16* QKVb = (attn::bf16*)(p.ws + WS_QKV);
    unsigned* qctr = (unsigned*)(p.ws + WS_QCTR); unsigned* MCNT = (unsigned*)(p.ws + WS_MCNT); unsigned* MG1 = (unsigned*)(p.ws + WS_MG1);
    bool g1seen = false; const attn::MobaIo mio0{};
    volatile LAS unsigned* CNL = misc + 64;
    for (;;) {
        if (threadIdx.x == 0) misc[16] = __hip_atomic_fetch_add(qctr, 1u, __ATOMIC_RELAXED, __HIP_MEMORY_SCOPE_AGENT);
        __syncthreads();
        const int u = (int)__builtin_amdgcn_readfirstlane((int)misc[16]);
        __syncthreads();
        if (u >= 2032) break;
        if (u < 512) {
            const int bh = u & 15, qb = u >> 4;
            attn::moba_gate_item(bh >> 3, bh & 7, qb, QKVb, (const float*)(p.ws + WS_KMP) + (size_t)bh * 32 * 64, (unsigned*)(p.ws + WS_SEL3) + (size_t)bh * S, MCNT + bh * 32, (unsigned short*)(p.ws + WS_MLIST) + (size_t)bh * 32 * S);
            asm volatile("s_waitcnt vmcnt(0)" ::: "memory");
            __syncthreads();
            if (threadIdx.x == 0) { __builtin_amdgcn_fence(__ATOMIC_RELEASE, "agent"); asm volatile("s_waitcnt vmcnt(0)" ::: "memory");
                const unsigned old = __hip_atomic_fetch_add(MG1, 1u, __ATOMIC_RELAXED, __HIP_MEMORY_SCOPE_AGENT);
                if (old == 511u) { __builtin_amdgcn_fence(__ATOMIC_ACQ_REL, "agent"); asm volatile("s_waitcnt vmcnt(0)" ::: "memory"); __hip_atomic_store(MG1 + 64, 1u, __ATOMIC_RELAXED, __HIP_MEMORY_SCOPE_AGENT); } }
            continue;
        }
        if (u >= 1008 && u < 1520) {
            const int v = u - 1008, qb = 31 - (v >> 4), bh = v & 15;
            const float* c2 = (const float*)(p.ws + WS_C) + (size_t)bh * S; const int lane = threadIdx.x & 63, nt = 4 * qb + 4;
            const float cq = c2[qb * 256];
            const float* FK = (const float*)(p.ws + WS_FKN) + (size_t)bh * 256; const float* FQ = (const float*)(p.ws + WS_FQN) + ((size_t)bh * 32 + qb) * 4;
#define FOX_KN(t) sqrtf(FK[2 * (t)] + FK[2 * (t) + 1])
            const float qm = sqrtf(fmaxf(FQ[0] + FQ[1], FQ[2] + FQ[3])), ko = fmaxf(fmaxf(FOX_KN(4 * qb), FOX_KN(4 * qb + 1)), fmaxf(FOX_KN(4 * qb + 2), FOX_KN(4 * qb + 3)));
            const float th0 = (lane < nt) ? 1.01f * qm * (FOX_KN(lane) + ko) + FOX_SKIP : 0.f, th1 = (lane + 64 < nt) ? 1.01f * qm * (FOX_KN(lane + 64) + ko) + FOX_SKIP : 0.f;
#undef FOX_KN
            const bool keep0 = (lane < nt) ? (cq - c2[64 * lane + 63] >= -th0) : true, keep1 = (lane + 64 < nt) ? (cq - c2[64 * (lane + 64) + 63] >= -th1) : true;
            const unsigned long long m0 = __ballot(keep0), m1 = __ballot(keep1);
            int first = m0 ? __builtin_ctzll(m0) : 64 + __builtin_ctzll(m1);
            int t0 = first & ~1; if (t0 > nt - 4) t0 = nt - 4;
            t0 = __builtin_amdgcn_readfirstlane(t0);
            attn::attn_unit<true, 24, 0>(bh >> 3, bh & 7, qb, t0, QKVb + SLOT, QKVb + 4 * SLOT, QKVb + 5 * SLOT, QKVb + SLOT, c2, mio0, lds);
            continue;
        }
        if (!g1seen) {
            if (threadIdx.x == 0) { unsigned sp = 0u;
                while (__hip_atomic_load(MG1 + 64, __ATOMIC_RELAXED, __HIP_MEMORY_SCOPE_AGENT) == 0u) { __builtin_amdgcn_s_sleep(8); if (++sp > (1u << 22)) break; }
                __builtin_amdgcn_fence(__ATOMIC_ACQUIRE, "agent"); asm volatile("s_waitcnt vmcnt(0)" ::: "memory"); }
            __syncthreads();
            CNL[threadIdx.x] = __hip_atomic_load(MCNT + threadIdx.x, __ATOMIC_RELAXED, __HIP_MEMORY_SCOPE_AGENT);
            __syncthreads();
            g1seen = true;
        }
        attn::MobaIo mio{};
        if (u < 1008) {
            const int v = u - 512, j = v >> 4, bh = v & 15, cnt = (int)__builtin_amdgcn_readfirstlane((int)CNL[bh * 32 + j]);
            if (cnt == 0) continue;
            mio.QL = (const unsigned short*)(p.ws + WS_MLIST) + ((size_t)bh * 32 + j) * S; mio.SEL3 = (const unsigned*)(p.ws + WS_SEL3) + (size_t)bh * S; mio.LSE = (float*)(p.ws + WS_MLSE) + (size_t)bh * S * 4;
            mio.PART0 = (attn::bf16*)(p.ws + WS_MP0) + (size_t)bh * S * 64; mio.PART1 = (attn::bf16*)(p.ws + WS_MP1) + (size_t)bh * S * 64; mio.PART2 = (attn::bf16*)(p.ws + WS_MP2) + (size_t)bh * S * 64;
            attn::moba4_unit<false>(bh >> 3, bh & 7, 0, j, cnt, QKVb, QKVb + 2 * SLOT, QKVb + 3 * SLOT, mio, lds);
        } else {
            const int v = u - 1520, qb = v >> 4, bh = v & 15;
            mio.LSE = (float*)(p.ws + WS_MLSE) + (size_t)bh * S * 4; mio.PART0 = (attn::bf16*)(p.ws + WS_MP3) + (size_t)bh * S * 64;
            attn::moba4_unit<true>(bh >> 3, bh & 7, qb, qb, 256, QKVb, QKVb + 2 * SLOT, QKVb + 3 * SLOT, mio, lds);
        }
    }
}
__device__ __forceinline__ void phase_moba_combine(const P& p) {
    const int TID = otid();
    bf16_t* OA = (bf16_t*)(p.ws + WS_QKV); const unsigned* SEL3 = (const unsigned*)(p.ws + WS_SEL3); const float* LSE = (const float*)(p.ws + WS_MLSE);
    const bf16_t* P0 = (const bf16_t*)(p.ws + WS_MP0); const bf16_t* P1 = (const bf16_t*)(p.ws + WS_MP1); const bf16_t* P2 = (const bf16_t*)(p.ws + WS_MP2); const bf16_t* P3 = (const bf16_t*)(p.ws + WS_MP3);
    for (int it = blockIdx.x * 512 + TID; it < Bn * NH * S * 8; it += gridDim.x * 512) {
        const int ch = it & 7, bq = it >> 3, bh = bq >> 13, q = bq & (S - 1), b = bh >> 3, h = bh & 7;
        const unsigned n = SEL3[bq] >> 15;
        bf16_t* orow = OA + ((size_t)b * S + q) * 512 + h * 64 + ch * 8;
        const u32x4 own = *(const u32x4*)(P3 + (size_t)bq * 64 + ch * 8);
        if (n == 0u) { *(u32x4*)orow = own; continue; }
        const f32x4 ls = *(const f32x4*)(LSE + (size_t)bq * 4);
        float m = fmaxf(ls[3], ls[0]); if (n > 1u) m = fmaxf(m, ls[1]); if (n > 2u) m = fmaxf(m, ls[2]);
        const float w3 = __builtin_amdgcn_exp2f(ls[3] - m), w0 = __builtin_amdgcn_exp2f(ls[0] - m), w1 = (n > 1u) ? __builtin_amdgcn_exp2f(ls[1] - m) : 0.f, w2 = (n > 2u) ? __builtin_amdgcn_exp2f(ls[2] - m) : 0.f;
        const float rw = 1.f / (w3 + w0 + w1 + w2);
        f32x4 a0, a1, x0, x1; pg8::unpack8(own, a0, a1); a0 = a0 * w3; a1 = a1 * w3;
        pg8::unpack8(*(const u32x4*)(P0 + (size_t)bq * 64 + ch * 8), x0, x1); a0 += x0 * w0; a1 += x1 * w0;
        if (n > 1u) { pg8::unpack8(*(const u32x4*)(P1 + (size_t)bq * 64 + ch * 8), x0, x1); a0 += x0 * w1; a1 += x1 * w1; }
        if (n > 2u) { pg8::unpack8(*(const u32x4*)(P2 + (size_t)bq * 64 + ch * 8), x0, x1); a0 += x0 * w2; a1 += x1 * w2; }
        *(u32x4*)orow = pg8::pack8(a0 * rw, a1 * rw);
    }
}

typedef float f32x2v __attribute__((ext_vector_type(2)));
__device__ __forceinline__ unsigned q8_pack(const f32x4& a, float sc, int bias) {
    const int q0 = (int)rintf(a[0] * sc) + bias, q1 = (int)rintf(a[1] * sc) + bias, q2 = (int)rintf(a[2] * sc) + bias, q3 = (int)rintf(a[3] * sc) + bias;
    return (unsigned)(q0 & 0xff) | ((unsigned)(q1 & 0xff) << 8) | ((unsigned)(q2 & 0xff) << 16) | ((unsigned)(q3 & 0xff) << 24); }
__device__ __forceinline__ void q8_row(const float* src, const float* gain, unsigned char* dst, size_t sstride, float* scale_out, int lane, int bias) {
    f32x4 a[4]; float am = 0.f;
#pragma unroll
    for (int q = 0; q < 4; ++q) { a[q] = *(const f32x4*)(src + 16 * lane + 4 * q);
        if (gain) { const f32x4 g = *(const f32x4*)(gain + 16 * lane + 4 * q); a[q][0] *= g[0]; a[q][1] *= g[1]; a[q][2] *= g[2]; a[q][3] *= g[3]; }
        am = fmaxf(fmaxf(am, fmaxf(fabsf(a[q][0]), fabsf(a[q][1]))), fmaxf(fabsf(a[q][2]), fabsf(a[q][3]))); }
    am = wave_max_fast(am);
    const float sc = am > 0.f ? 127.0f / am : 1.0f;
    u32x4 o;
#pragma unroll
    for (int q = 0; q < 4; ++q) o[q] = q8_pack(a[q], sc, bias);
    *(u32x4*)(dst + (sstride ? (size_t)(lane >> 3) * sstride + 16 * (lane & 7) : (size_t)16 * lane)) = o;
    if (lane == 0) *scale_out = am > 0.f ? am * (1.0f / 127.0f) : 1.0f;
}
template <bool USGN> __device__ __forceinline__ void q4_row(const float* src, const float* gain, unsigned char* dst, float* scale_out, int lane) {
    f32x4 a[4]; float ss = 0.f;
#pragma unroll
    for (int q = 0; q < 4; ++q) { a[q] = *(const f32x4*)(src + 16 * lane + 4 * q);
        if (gain) { const f32x4 g = *(const f32x4*)(gain + 16 * lane + 4 * q); a[q][0] *= g[0]; a[q][1] *= g[1]; a[q][2] *= g[2]; a[q][3] *= g[3]; }
        ss += (a[q][0] * a[q][0] + a[q][1] * a[q][1]) + (a[q][2] * a[q][2] + a[q][3] * a[q][3]); }
    ss = wave_sum_fast(ss);
    const float step = sqrtf(ss * (1.f / D)) * 0.3352f, inv = step > 0.f ? 1.0f / step : 0.f;
    u32x2 o; o[0] = 0u; o[1] = 0u;
    int qs = 0;
#pragma unroll
    for (int i = 0; i < 16; ++i) { int q = (int)floorf(a[i >> 2][i & 3] * inv); q = min(max(q, -8), 7); qs += q;
        o[i >> 3] |= (unsigned)((USGN || (i & 1)) ? (q & 15) : (q + 8)) << (4 * (i & 7)); }
    *(u32x2*)(dst + (size_t)(lane >> 4) * ESLICE + 8 * (lane & 15)) = o;
    if (USGN) { const float rs = wave_sum_fast((float)qs); if (lane == 0) scale_out[2 * PNK * PNK] = rs; }
    if (lane == 0) *scale_out = step > 0.f ? step : 1.0f;
}
__device__ __forceinline__ void phase_expert_tables(const P& p) {
    const int TID = otid();
    const int lane = TID & 63, gw = (blockIdx.x * blockDim.x + TID) >> 6, nw = (gridDim.x * blockDim.x) >> 6;
    for (int r = gw; r < PNK * PNK; r += nw) {
        q4_row<true>(p.eu + (size_t)r * D, p.g_ffn, p.ws + WS_EU + (size_t)r * 128, (float*)(p.ws + WS_USC) + r, lane);
        q4_row<false>(p.ev + (size_t)r * D, nullptr, p.ws + WS_EV + (size_t)r * 128, (float*)(p.ws + WS_VSC) + r, lane);
    }
}

typedef short bf16x8_t __attribute__((ext_vector_type(8)));
typedef float f32x16_t __attribute__((ext_vector_type(16)));
__device__ __forceinline__ unsigned f2ord(float f) { const unsigned u = __float_as_uint(f); return u ^ ((unsigned)((int)u >> 31) | 0x80000000u); }
__device__ __forceinline__ float ord2f(unsigned k) { return __uint_as_float((k & 0x80000000u) ? (k ^ 0x80000000u) : ~k); }
#define TK_CAS(a, b, desc) do { const unsigned hi__ = max(a, b), lo__ = min(a, b); if (desc) { a = hi__; b = lo__; } else { a = lo__; b = hi__; } } while (0)
__device__ __forceinline__ void tk_sort16(unsigned (&v)[16]) {
#define C(i, j) TK_CAS(v[i], v[j], true);
    C(0,1) C(2,3) C(0,2) C(1,3) C(1,2) C(4,5) C(6,7) C(4,6) C(5,7) C(5,6) C(0,4) C(2,6) C(2,4) C(1,5) C(3,7) C(3,5) C(1,2) C(3,4) C(5,6) C(8,9) C(10,11) C(8,10) C(9,11) C(9,10) C(12,13) C(14,15) C(12,14) C(13,15) C(13,14) C(8,12) C(10,14) C(10,12) C(9,13) C(11,15) C(11,13) C(9,10) C(11,12) C(13,14) C(0,8) C(4,12) C(4,8) C(2,10) C(6,14) C(6,10) C(2,4) C(6,8) C(10,12) C(1,9) C(5,13) C(5,9) C(3,11) C(7,15) C(7,11) C(3,5) C(7,9) C(11,13) C(1,2) C(3,4) C(5,6) C(7,8) C(9,10) C(11,12) C(13,14)
#undef C
}
__device__ __forceinline__ void tk_merge16(unsigned (&a)[16], const unsigned (&b)[16]) {
#pragma unroll
    for (int i = 0; i < 16; ++i) a[i] = max(a[i], b[15 - i]);
#pragma unroll
    for (int st = 8; st >= 1; st >>= 1)
#pragma unroll
        for (int i = 0; i < 16; ++i) if ((i & st) == 0) TK_CAS(a[i], a[i + st], true);
}
__host__ __device__ constexpr int tk_pair_rank(int i, int j) { int c = 0; for (int a = 0; a < 16; ++a) for (int b = 0; b < 16; ++b) { if (a == i && b == j) return c; if ((a + 1) * (b + 1) <= 16) ++c; } return c; }
__device__ __forceinline__ unsigned tk_lookup(unsigned long long lo, unsigned long long hi, int i) {
    const unsigned long long w = (i & 8) ? hi : lo; return (unsigned)(w >> ((i & 7) * 8)) & 0xffu; }
__device__ __forceinline__ void phase_h8(const P& p) {
    const int TID = otid();
    const int lane = TID & 63, gw = (blockIdx.x * blockDim.x + TID) >> 6, nw = (gridDim.x * blockDim.x) >> 6;
    for (int t = gw; t < T; t += nw) {
        const bf16_t* hb = (const bf16_t*)(p.ws + WS_XN) + (size_t)t * D + 16 * lane; const u32x4 h0 = *(const u32x4*)hb, h1 = *(const u32x4*)(hb + 8);
        f32x4 a[4]; float am = 0.f;
#pragma unroll
        for (int w = 0; w < 4; ++w) { const unsigned d = (w < 2) ? h0[2 * w] : h1[2 * (w - 2)], e = (w < 2) ? h0[2 * w + 1] : h1[2 * (w - 2) + 1];
            a[w][0] = __uint_as_float(d << 16); a[w][1] = __uint_as_float(d & 0xffff0000u); a[w][2] = __uint_as_float(e << 16); a[w][3] = __uint_as_float(e & 0xffff0000u);
            am = fmaxf(fmaxf(am, fmaxf(fabsf(a[w][0]), fabsf(a[w][1]))), fmaxf(fabsf(a[w][2]), fabsf(a[w][3]))); }
        am = wave_max_fast(am);
        const float sc = am > 0.f ? 127.0f / am : 1.0f;
        int hs = 0; u32x2 hh, hl; hh[0] = 0u; hh[1] = 0u; hl[0] = 0u; hl[1] = 0u;
#pragma unroll
        for (int w = 0; w < 4; ++w)
#pragma unroll
            for (int k = 0; k < 4; ++k) { const int qv = (int)rintf(a[w][k] * sc); hs += qv; const int n = 4 * (w & 1) + k;
                hh[w >> 1] |= (unsigned)((qv >> 4) & 15) << (4 * n); hl[w >> 1] |= (unsigned)((qv & 15) ^ 8) << (4 * n); }
        unsigned char* hb8 = p.ws + WS_H8 + (size_t)t * D + 32 * (lane >> 1) + 8 * (lane & 1);
        *(u32x2*)hb8 = hh; *(u32x2*)(hb8 + 16) = hl;
        const float hc = wave_sum_fast(0.5f * (float)hs);
        if (lane == 0) { ((float*)(p.ws + WS_HSC))[t] = am > 0.f ? am * (1.0f / 127.0f) : 1.0f; ((float*)(p.ws + WS_HSC))[T + t] = hc; }
    }
}
__device__ __forceinline__ void phase_peer_topk(LAS unsigned char* ldsb, const P& p, const pg8::StaticOrder& So) {
    const int TID = otid();
    const int lane = TID & 63, r32 = lane & 31, hi = lane >> 5, wave = TID >> 6;
    const bf16_t* PQ = (const bf16_t*)(p.ws + WS_PQ); const bf16_t* SKb = (const bf16_t*)(p.ws + WS_SK); int* IDX = (int*)(p.ws + WS_IDX); float* GATE = (float*)(p.ws + WS_GATE);
    pg8::Unit un;
    for (int ui = 0; So.next(ui, un); ++ui) {
        const int tg = un.pm * 8 + wave, h = un.pn, t = tg * 32 + r32;
        __syncthreads();
#pragma unroll
        for (int j = 0; j < 8; ++j) { const int q = TID + 512 * j, pp_ = q >> 11, row = (q >> 4) & 127, ch = q & 15;
            *(LAS u32x4*)(ldsb + pp_ * 32768 + row * 256 + ((ch ^ (row & 15)) * 16)) = *(const u32x4*)(SKb + ((size_t)(h * 2 + pp_) * PNK + row) * PHALF + ch * 8); }
        u32x4 qfr[2][8];
#pragma unroll
        for (int pp = 0; pp < 2; ++pp)
#pragma unroll
            for (int ks = 0; ks < 8; ++ks) qfr[pp][ks] = *(const u32x4*)(PQ + (size_t)t * PQC + h * 256 + pp * 128 + 8 * hi + 16 * ks);
        __syncthreads();
        unsigned K0[16], K1[16];
#pragma unroll
        for (int pp = 0; pp < 2; ++pp) {
            f32x16_t acc[4];
#pragma unroll
            for (int mt = 0; mt < 4; ++mt) acc[mt] = f32x16_t{};
#pragma unroll
            for (int ks = 0; ks < 8; ++ks) {
                const bf16x8_t qf = __builtin_bit_cast(bf16x8_t, qfr[pp][ks]);
#pragma unroll
                for (int mt = 0; mt < 4; ++mt) { const int row = 32 * mt + r32;
                    const bf16x8_t kf = __builtin_bit_cast(bf16x8_t, *(const LAS u32x4*)(ldsb + pp * 32768 + row * 256 + (((2 * ks + hi) ^ (row & 15)) * 16)));
                    acc[mt] = __builtin_amdgcn_mfma_f32_32x32x16_bf16(kf, qf, acc[mt], 0, 0, 0); }
            }
            unsigned L[16], L1[16], L2[16], L3[16];
            const unsigned h4 = 4u * (unsigned)hi;
#pragma unroll
            for (int r = 0; r < 16; ++r) { const unsigned lowb = (unsigned)(127 - (r & 3) - 8 * (r >> 2)) - h4;
                L[r] = (f2ord(acc[0][r]) & ~127u) | lowb; L1[r] = (f2ord(acc[1][r]) & ~127u) | (lowb - 32u); L2[r] = (f2ord(acc[2][r]) & ~127u) | (lowb - 64u); L3[r] = (f2ord(acc[3][r]) & ~127u) | (lowb - 96u); }
            tk_sort16(L); tk_sort16(L1); tk_sort16(L2); tk_sort16(L3);
            tk_merge16(L, L1); tk_merge16(L2, L3); tk_merge16(L, L2);
            unsigned M[16];
#pragma unroll
            for (int i = 0; i < 16; ++i) { const auto r_ = __builtin_amdgcn_permlane32_swap(L[i], L[i], false, false); M[i] = hi ? r_[0] : r_[1]; }
            tk_merge16(L, M);
#pragma unroll
            for (int i = 0; i < 16; ++i) { if (pp == 0) K0[i] = L[i]; else K1[i] = L[i]; }
        }
        float v0[16], v1[16]; unsigned long long t0lo = 0ull, t0hi = 0ull, t1lo = 0ull, t1hi = 0ull;
#pragma unroll
        for (int i = 0; i < 16; ++i) { v0[i] = ord2f(K0[i] & ~127u); v1[i] = ord2f(K1[i] & ~127u);
            const unsigned long long e0 = (unsigned long long)(127u - (K0[i] & 127u)) << ((i & 7) * 8), e1 = (unsigned long long)(127u - (K1[i] & 127u)) << ((i & 7) * 8);
            if (i < 8) { t0lo |= e0; t1lo |= e1; } else { t0hi |= e0; t1hi |= e1; } }
        unsigned Bk[16], B1[16], B2[16], B3[16];
#pragma unroll
        for (int i = 0; i < 16; ++i) { Bk[i] = 0u; B1[i] = 0u; B2[i] = 0u; B3[i] = 0u; }
#pragma unroll
        for (int i = 0; i < 16; ++i)
#pragma unroll
            for (int j = 0; j < 16; ++j) if ((i + 1) * (j + 1) <= 16) {
                const unsigned key = (f2ord(v0[i] + v1[j]) & ~255u) | (unsigned)(255 - (i * 16 + j));
                const int rk = tk_pair_rank(i, j);
                if ((rk >> 4) == 0) Bk[rk & 15] = key; else if ((rk >> 4) == 1) B1[rk & 15] = key; else if ((rk >> 4) == 2) B2[rk & 15] = key; else B3[rk & 15] = key; }
#pragma unroll
        for (int i = 0; i < 16; ++i) { Bk[i] = hi ? B2[i] : Bk[i]; B1[i] = hi ? B3[i] : B1[i]; }
        tk_sort16(Bk); tk_sort16(B1); tk_merge16(Bk, B1);
#pragma unroll
        for (int i = 0; i < 16; ++i) { const auto r_ = __builtin_amdgcn_permlane32_swap(Bk[i], Bk[i], false, false); B2[i] = hi ? r_[0] : r_[1]; }
        tk_merge16(Bk, B2);
        float rstd;
        { const f32x4* rp = (const f32x4*)((const float*)(p.ws + WS_RSSP) + (size_t)t * 16); const f32x4 s4 = (rp[0] + rp[1]) + (rp[2] + rp[3]);
          rstd = rsqrtf(((s4[0] + s4[1]) + (s4[2] + s4[3])) * (1.f / D) + EPS); }
        float gt[16]; int ex[16]; float sum = 0.f; const float best0 = ord2f(Bk[0] & ~255u);
#pragma unroll
        for (int r = 0; r < 16; ++r) { const float bv = ord2f(Bk[r] & ~255u); gt[r] = __expf(rstd * (bv - best0)); sum += gt[r];
            const int flat = 255 - (int)(Bk[r] & 255u); ex[r] = (int)tk_lookup(t0lo, t0hi, flat >> 4) * PNK + (int)tk_lookup(t1lo, t1hi, flat & 15); }
        const float rs = 1.f / sum;
        if (hi == 0) {
#pragma unroll
            for (int q = 0; q < 4; ++q) {
                u32x4 iv; iv.x = (unsigned)ex[4 * q]; iv.y = (unsigned)ex[4 * q + 1]; iv.z = (unsigned)ex[4 * q + 2]; iv.w = (unsigned)ex[4 * q + 3];
                *(u32x4*)(IDX + ((size_t)t * PH + h) * PK + 4 * q) = iv;
                f32x4 gv; gv[0] = gt[4 * q] * rs; gv[1] = gt[4 * q + 1] * rs; gv[2] = gt[4 * q + 2] * rs; gv[3] = gt[4 * q + 3] * rs;
                *(f32x4*)(GATE + ((size_t)t * PH + h) * PK + 4 * q) = gv; }
        }
    }
}

__device__ __forceinline__ float gelu_exact(float v) {
    const float av = fabsf(v), t = __builtin_amdgcn_rcpf(av * 0.2316418882f + 1.0f);
    float q = t * 0.5307027145f + (-0.7265760135f); q = q * t + 0.7107068705f; q = q * t + (-0.142248368f); q = q * t + 0.127414796f; q = q * t;
    const float e = __builtin_amdgcn_exp2f((v * v) * (-0.72134752044f)), m = v * (q * e);
    return v < 0.f ? m : v - m;
}
#define EX_HALVE16(d, m2, m1, m0, u2, u1, u0, r0, r1) do { float h8_[8], h4_[4]; \
        _Pragma("unroll") for (int i_ = 0; i_ < 8; ++i_) { const float k_ = (u2) ? d[i_ + 8] : d[i_], s_ = (u2) ? d[i_] : d[i_ + 8]; h8_[i_] = k_ + __shfl_xor(s_, (m2)); } \
        _Pragma("unroll") for (int i_ = 0; i_ < 4; ++i_) { const float k_ = (u1) ? h8_[i_ + 4] : h8_[i_], s_ = (u1) ? h8_[i_] : h8_[i_ + 4]; h4_[i_] = k_ + __shfl_xor(s_, (m1)); } \
        { const float k0_ = (u0) ? h4_[2] : h4_[0], s0_ = (u0) ? h4_[0] : h4_[2], k1_ = (u0) ? h4_[3] : h4_[1], s1_ = (u0) ? h4_[1] : h4_[3]; r0 = k0_ + __shfl_xor(s0_, (m0)); r1 = k1_ + __shfl_xor(s1_, (m0)); } } while (0)
#define EX_HALVE16_SWAP(d, u0, r0, r1) do { float h8_[8], h4_[4]; \
        _Pragma("unroll") for (int i_ = 0; i_ < 8; ++i_) { const auto q_ = __builtin_amdgcn_permlane32_swap(__float_as_uint(d[i_]), __float_as_uint(d[i_ + 8]), false, false); h8_[i_] = __uint_as_float(q_[0]) + __uint_as_float(q_[1]); } \
        _Pragma("unroll") for (int i_ = 0; i_ < 4; ++i_) { const auto q_ = __builtin_amdgcn_permlane16_swap(__float_as_uint(h8_[i_]), __float_as_uint(h8_[i_ + 4]), false, false); h4_[i_] = __uint_as_float(q_[0]) + __uint_as_float(q_[1]); } \
        { const float k0_ = (u0) ? h4_[2] : h4_[0], s0_ = (u0) ? h4_[0] : h4_[2], k1_ = (u0) ? h4_[3] : h4_[1], s1_ = (u0) ? h4_[1] : h4_[3]; \
          r0 = k0_ + __builtin_bit_cast(float, __builtin_amdgcn_update_dpp(0, __builtin_bit_cast(int, s0_), 0x128, 0xf, 0xf, true)); r1 = k1_ + __builtin_bit_cast(float, __builtin_amdgcn_update_dpp(0, __builtin_bit_cast(int, s1_), 0x128, 0xf, 0xf, true)); } } while (0)
#define EX_HALVE16_SWAP_I(d, u0, r0, r1) do { int h8_[8], h4_[4]; \
        _Pragma("unroll") for (int i_ = 0; i_ < 8; ++i_) { const auto q_ = __builtin_amdgcn_permlane32_swap((unsigned)d[i_], (unsigned)d[i_ + 8], false, false); h8_[i_] = (int)(q_[0] + q_[1]); } \
        _Pragma("unroll") for (int i_ = 0; i_ < 4; ++i_) { const auto q_ = __builtin_amdgcn_permlane16_swap((unsigned)h8_[i_], (unsigned)h8_[i_ + 4], false, false); h4_[i_] = (int)(q_[0] + q_[1]); } \
        { const int k0_ = (u0) ? h4_[2] : h4_[0], s0_ = (u0) ? h4_[0] : h4_[2], k1_ = (u0) ? h4_[3] : h4_[1], s1_ = (u0) ? h4_[1] : h4_[3]; \
          r0 = k0_ + __builtin_amdgcn_update_dpp(0, s0_, 0x128, 0xf, 0xf, true); r1 = k1_ + __builtin_amdgcn_update_dpp(0, s1_, 0x128, 0xf, 0xf, true); } } while (0)
struct ExIds { u32x4 i0, i1, i2, i3; };
struct ExAux { u32x4 w0; f32x4 y; };
__device__ __forceinline__ void ex_ids(ExIds& I, const P& p, int t, int g) {
    const u32x4* ip = (const u32x4*)((const int*)(p.ws + WS_IDX) + (size_t)t * 128 + 16 * g); I.i0 = ip[0]; I.i1 = ip[1]; I.i2 = ip[2]; I.i3 = ip[3]; }
template <int PASS> __device__ __forceinline__ void ex_gather(u32x4 (&buf)[16], ExAux& X, const ExIds& I, const P& p, int t, int x, int g, int c) {
    const __amdgpu_buffer_rsrc_t TAB = __builtin_amdgcn_make_buffer_rsrc((void*)(p.ws + (PASS == 0 ? WS_EU : WS_EV) + (size_t)x * ESLICE), 0, (int)ESLICE, 0x00020000);
#pragma unroll
    for (int j = 0; j < 16; ++j) { const unsigned e = (j < 4) ? I.i0[j & 3] : (j < 8) ? I.i1[j & 3] : (j < 12) ? I.i2[j & 3] : I.i3[j & 3];
        buf[j] = __builtin_amdgcn_raw_buffer_load_b128(TAB, (int)(e * 128u) + 16 * c, 0, 0); }
    if constexpr (PASS == 0) { const u32x4* hp8 = (const u32x4*)(p.ws + WS_H8 + (size_t)t * D + x * 256 + 32 * c); X.w0 = hp8[0]; X.y = __builtin_bit_cast(f32x4, hp8[1]); }
    else { X.w0 = *(const u32x4*)(p.ws + WS_A + (size_t)t * 128 + 16 * g);
           const bf16_t* hp = (const bf16_t*)(p.ws + WS_XN) + (size_t)t * D + x * 256 + 32 * c + 2 * g; const unsigned hw = *(const unsigned*)hp, hw1 = *(const unsigned*)(hp + 16);
           X.y[0] = __uint_as_float(hw << 16); X.y[1] = __uint_as_float(hw & 0xffff0000u); X.y[2] = __uint_as_float(hw1 << 16); X.y[3] = __uint_as_float(hw1 & 0xffff0000u); }
}
template <int PASS> __device__ __forceinline__ void ex_compute(const u32x4 (&buf)[16], const ExAux& X, const P& p, int t, int x, int lane, int g, int c, float asc, float cs, float& o0, float& o1) {
    float d[16];
    if constexpr (PASS == 0) {
        const u32x4 w1 = __builtin_bit_cast(u32x4, X.y);
#pragma unroll
        for (int j = 0; j < 16; ++j) { int aH = 0, aL = 0;
#pragma unroll
            for (int q = 0; q < 4; ++q) { aH = __builtin_amdgcn_sdot8((int)buf[j][q], (int)X.w0[q], aH, false); aL = __builtin_amdgcn_sdot8((int)buf[j][q], (int)w1[q], aL, false); }
            d[j] = (float)((aH << 4) + aL); }
        float r0, r1;
        EX_HALVE16(d, 4, 2, 1, (lane & 4) != 0, (lane & 2) != 0, (lane & 1) != 0, r0, r1);
        o0 += r0; o1 += r1;
    } else {
        float osq = 0.f;
#pragma unroll
        for (int hf = 0; hf < 2; ++hf) {
            int ai[16];
#pragma unroll
            for (int i = 0; i < 16; ++i) ai[i] = 0;
#pragma unroll
            for (int j4 = 0; j4 < 4; ++j4) { const int a4 = (int)X.w0[j4];
#pragma unroll
                for (int q2 = 0; q2 < 2; ++q2) { const int q = 2 * hf + q2; const unsigned r0_ = buf[4 * j4][q], r1_ = buf[4 * j4 + 1][q], r2_ = buf[4 * j4 + 2][q], r3_ = buf[4 * j4 + 3][q];
                    const unsigned t0 = __builtin_amdgcn_perm(r1_, r0_, 0x05010400u), t1 = __builtin_amdgcn_perm(r1_, r0_, 0x07030602u), t2 = __builtin_amdgcn_perm(r3_, r2_, 0x05010400u), t3 = __builtin_amdgcn_perm(r3_, r2_, 0x07030602u);
                    const unsigned c0_ = __builtin_amdgcn_perm(t2, t0, 0x05040100u), c1_ = __builtin_amdgcn_perm(t2, t0, 0x07060302u), c2_ = __builtin_amdgcn_perm(t3, t1, 0x05040100u), c3_ = __builtin_amdgcn_perm(t3, t1, 0x07060302u);
                    ai[8 * q2 + 0] = __builtin_amdgcn_sdot4((int)(c0_ & 0x0f0f0f0fu), a4, ai[8 * q2 + 0], false); ai[8 * q2 + 1] = __builtin_amdgcn_sdot4((int)c0_, a4, ai[8 * q2 + 1], false);
                    ai[8 * q2 + 2] = __builtin_amdgcn_sdot4((int)(c1_ & 0x0f0f0f0fu), a4, ai[8 * q2 + 2], false); ai[8 * q2 + 3] = __builtin_amdgcn_sdot4((int)c1_, a4, ai[8 * q2 + 3], false);
                    ai[8 * q2 + 4] = __builtin_amdgcn_sdot4((int)(c2_ & 0x0f0f0f0fu), a4, ai[8 * q2 + 4], false); ai[8 * q2 + 5] = __builtin_amdgcn_sdot4((int)c2_, a4, ai[8 * q2 + 5], false);
                    ai[8 * q2 + 6] = __builtin_amdgcn_sdot4((int)(c3_ & 0x0f0f0f0fu), a4, ai[8 * q2 + 6], false); ai[8 * q2 + 7] = __builtin_amdgcn_sdot4((int)c3_, a4, ai[8 * q2 + 7], false); }
                asm volatile("" : "+v"(ai[0]), "+v"(ai[1]), "+v"(ai[2]), "+v"(ai[3]), "+v"(ai[4]), "+v"(ai[5]), "+v"(ai[6]), "+v"(ai[7]), "+v"(ai[8]), "+v"(ai[9]), "+v"(ai[10]), "+v"(ai[11]), "+v"(ai[12]), "+v"(ai[13]), "+v"(ai[14]), "+v"(ai[15]));
                __builtin_amdgcn_sched_barrier(0); }
            int i0, i1;
            EX_HALVE16_SWAP_I(ai, (lane & 8) != 0, i0, i1);
            const float r0 = (float)i0 * asc, r1 = (float)(i1 - i0) * (asc * 0.0625f);
            f32x2v y; y[0] = X.y[2 * hf] + (r0 - 7.5f * cs); y[1] = X.y[2 * hf + 1] + (r1 + 0.5f * cs);
            *(f32x2v*)(p.out + (size_t)t * D + x * 256 + 32 * c + 16 * hf + 2 * g) = y;
            osq += y[0] * y[0] + y[1] * y[1];
        }
        o0 += osq;
    }
}
typedef float f32x2l __attribute__((ext_vector_type(2)));
template <int PASS> __device__ __forceinline__ void ex_pass(const P& p, int tb, int lane, int g, int c, LAS f32x2l* acc, const LAS float* ascl) {
    u32x4 bA[16], bB[16]; ExAux xA, xB; ExIds I;
    ex_ids(I, p, tb, g);
    ex_gather<PASS>(bA, xA, I, p, tb, 0, g, c);
    ex_ids(I, p, tb + 1, g);
    constexpr int NS = 32;
#pragma unroll 1
    for (int s_ = 0; s_ < NS; s_ += 2) {
        const int x = s_ >> 3, i = s_ & 7, s2 = min(s_ + 2, NS - 1), x2 = s2 >> 3, i2 = s2 & 7;
        ex_gather<PASS>(bB, xB, I, p, tb + i + 1, x, g, c);
        ex_ids(I, p, tb + i2, g);
        { float o0 = 0.f, o1 = 0.f; ex_compute<PASS>(bA, xA, p, tb + i, x, lane, g, c, (PASS == 1) ? ascl[i] : 0.f, (PASS == 1) ? ascl[8 + i] : 0.f, o0, o1); f32x2l v = acc[i * 64 + lane]; v[0] += o0; v[1] += o1; acc[i * 64 + lane] = v; }
        ex_gather<PASS>(bA, xA, I, p, tb + i2, x2, g, c);
        ex_ids(I, p, tb + ((i2 + 1) & 7), g);
        { float o0 = 0.f, o1 = 0.f; ex_compute<PASS>(bB, xB, p, tb + i + 1, x, lane, g, c, (PASS == 1) ? ascl[i + 1] : 0.f, (PASS == 1) ? ascl[9 + i] : 0.f, o0, o1); f32x2l v = acc[(i + 1) * 64 + lane]; v[0] += o0; v[1] += o1; acc[(i + 1) * 64 + lane] = v; }
    }
}
__device__ __forceinline__ void phase_experts(LAS unsigned char* ldsb, const P& p) {
    const int TID = otid();
    const int lane = TID & 63, wave = TID >> 6, g = lane >> 3, c = lane & 7, tb = (blockIdx.x * 8 + wave) * 8;
    const float* USC = (const float*)(p.ws + WS_USC); const float* VSC = (const float*)(p.ws + WS_VSC);
    LAS f32x2l* acc = (LAS f32x2l*)(ldsb + wave * 8192); LAS float* ascl = (LAS float*)(ldsb + wave * 8192 + 4096);
#pragma unroll
    for (int i = 0; i < 8; ++i) { f32x2l z; z[0] = 0.f; z[1] = 0.f; acc[i * 64 + lane] = z; }
    ex_pass<0>(p, tb, lane, g, c, acc, ascl);
#pragma unroll 1
    for (int i = 0; i < 8; ++i) { const int t = tb + i, k0 = 16 * g + 2 * c;
        float rstd;
        { const f32x4* rp = (const f32x4*)((const float*)(p.ws + WS_RSSP) + (size_t)t * 16); const f32x4 s4 = (rp[0] + rp[1]) + (rp[2] + rp[3]);
          rstd = rsqrtf(((s4[0] + s4[1]) + (s4[2] + s4[3])) * (1.f / D) + EPS); }
        const u32x2 e = *(const u32x2*)((const int*)(p.ws + WS_IDX) + (size_t)t * 128 + k0);
        const f32x2v gt = *(const f32x2v*)((const float*)(p.ws + WS_GATE) + (size_t)t * 128 + k0);
        const float hs = rstd * ((const float*)(p.ws + WS_HSC))[t], hc = ((const float*)(p.ws + WS_HSC))[T + t];
        f32x2l hv = acc[i * 64 + lane]; hv[0] += hc; hv[1] += hc;
        const float a0 = gt[0] * gelu_exact(hs * USC[e.x] * (hv[0] + 8.f * USC[2 * PNK * PNK + e.x])) * VSC[e.x], a1 = gt[1] * gelu_exact(hs * USC[e.y] * (hv[1] + 8.f * USC[2 * PNK * PNK + e.y])) * VSC[e.y];
        const float am = wave_max_fast(fmaxf(fabsf(a0), fabsf(a1))), sc = am > 0.f ? 127.0f / am : 1.0f;
        const int q0 = (int)rintf(a0 * sc), q1 = (int)rintf(a1 * sc);
        *(unsigned short*)(p.ws + WS_A + (size_t)t * 128 + k0) = (unsigned short)((q0 & 0xff) | ((q1 & 0xff) << 8));
        const float asum = wave_sum_fast((float)(q0 + q1)), asc_ = am > 0.f ? am * (1.0f / 127.0f) : 1.0f;
        if (lane == 0) { ascl[i] = asc_; ascl[8 + i] = asc_ * asum; }
        f32x2l z; z[0] = 0.f; z[1] = 0.f; acc[i * 64 + lane] = z; }
    asm volatile("s_waitcnt vmcnt(0) lgkmcnt(0)" ::: "memory");
    ex_pass<1>(p, tb, lane, g, c, acc, ascl);
    asm volatile("s_waitcnt vmcnt(0) lgkmcnt(0)" ::: "memory");
#pragma unroll 1
    for (int i = 0; i < 8; ++i) { const f32x2l q = acc[i * 64 + lane]; const float r2 = rsqrtf(wave_sum_fast(q[0]) * (1.f / D) + EPS);
        f32x4* orow = (f32x4*)(p.out + (size_t)(tb + i) * D);
#pragma unroll
        for (int j = 0; j < 4; ++j) { const f32x4 gf = ((const f32x4*)p.g_fin)[lane + 64 * j]; f32x4 y = orow[lane + 64 * j] * r2; y[0] *= gf[0]; y[1] *= gf[1]; y[2] *= gf[2]; y[3] *= gf[3]; orow[lane + 64 * j] = y; } }
}
#undef EX_HALVE16
#undef EX_HALVE16_SWAP
#undef EX_HALVE16_SWAP_I

#define LAS __attribute__((address_space(3)))
#define XB_TMO      128
#define XB_XCNT(j)  (256  + 64 * (j))
#define XB_XSUB(j)  (1280 + 64 * (j))
#define XB_XGEN(j)  (2304 + 64 * (j))
#define XB_TOP      3328
#define XB_TOPGEN   3392
#define XCD_BAR_WORDS 3456
#define XB_SPIN_CAP (1u << 22)
__device__ __forceinline__ unsigned xb_ld(unsigned* p)              { return __hip_atomic_load(p, __ATOMIC_RELAXED, __HIP_MEMORY_SCOPE_AGENT); }
__device__ __forceinline__ unsigned xb_add(unsigned* p, unsigned v) { return __hip_atomic_fetch_add(p, v, __ATOMIC_RELAXED, __HIP_MEMORY_SCOPE_AGENT); }
__device__ __forceinline__ unsigned xb_xcc_id() { return (unsigned)__builtin_amdgcn_s_getreg((3 << 11) | 20) & 0xFu; }
#define XB_SPIN(cond, bar) do { unsigned _sp = 0; while (cond) { __builtin_amdgcn_s_sleep(1); \
    if ((++_sp & 255u) == 0u) { if (xb_ld(&(bar)[XB_TMO])) break; if (_sp > XB_SPIN_CAP) { atomicAdd(&(bar)[XB_TMO], 1u); break; } } } } while (0)
struct XcdBarrier { unsigned* bar; unsigned x; volatile LAS unsigned* st; };
__device__ __forceinline__ XcdBarrier xcd_barrier_post(unsigned* bar, volatile LAS unsigned* st) {
    XcdBarrier b; b.bar = bar; b.x = xb_xcc_id(); b.st = st;
    if (threadIdx.x == 0) (void)xb_add(&bar[XB_XCNT(b.x)], 1u);
    return b;
}
__device__ __forceinline__ void xcd_barrier_complete(unsigned* bar, unsigned x, unsigned& nloc, unsigned& nx) {
    const unsigned G = gridDim.x * gridDim.y * gridDim.z;
    unsigned sum, cnt, mine, sp = 0u;
    for (;;) {
        sum = 0u; cnt = 0u; mine = 0u;
#pragma unroll
        for (unsigned j = 0; j < 16; ++j) { const unsigned c = xb_ld(&bar[XB_XCNT(j)]); sum += c; cnt += (c > 0u) ? 1u : 0u; mine = (j == x) ? c : mine; }
        if (sum == G) break;
        __builtin_amdgcn_s_sleep(1);
        if ((++sp & 255u) == 0u) { if (xb_ld(&bar[XB_TMO])) break; if (sp > XB_SPIN_CAP) { atomicAdd(&bar[XB_TMO], 1u); break; } }
    }
    nloc = mine > 0u ? mine : 1u; nx = cnt > 0u ? cnt : 1u;
}
__device__ __forceinline__ void xcd_barrier(const XcdBarrier& b) {
    asm volatile("s_waitcnt vmcnt(0)" ::: "memory");
    __syncthreads();
    if (threadIdx.x == 0) {
        unsigned* bar = b.bar;
        __builtin_amdgcn_s_waitcnt(0);
        unsigned nloc = b.st[0], nx = b.st[1];
        if (nloc == 0u) { xcd_barrier_complete(bar, b.x, nloc, nx); b.st[0] = nloc; b.st[1] = nx; }
        const unsigned old = xb_add(&bar[XB_XSUB(b.x)], 1u);
        const unsigned gen = old / nloc;
        if (old + 1u == (gen + 1u) * nloc) {
            __builtin_amdgcn_fence(__ATOMIC_RELEASE, "agent");
            asm volatile("s_waitcnt vmcnt(0)" ::: "memory");
            const unsigned og = xb_add(&bar[XB_TOP], 1u);
            const unsigned tg = og / nx;
            if (og + 1u == (tg + 1u) * nx) xb_add(&bar[XB_TOPGEN], 1u);
            else XB_SPIN(xb_ld(&bar[XB_TOPGEN]) == tg, bar);
            __builtin_amdgcn_fence(__ATOMIC_ACQUIRE, "agent");
            xb_add(&bar[XB_XGEN(b.x)], 1u);
            asm volatile("s_waitcnt vmcnt(0)" ::: "memory");
        } else {
            XB_SPIN(xb_ld(&bar[XB_XGEN(b.x)]) == gen, bar);
            __builtin_amdgcn_fence(__ATOMIC_ACQUIRE, "agent");
            asm volatile("s_waitcnt vmcnt(0)" ::: "memory");
        }
    }
    __syncthreads();
}

constexpr int NT = 512;
constexpr int LDS_BYTES = 147456;
constexpr int MISC_OFF = 131072;

__global__ void __launch_bounds__(NT, 2) mega(P p) {
    extern __shared__ __attribute__((aligned(16))) unsigned char lds_raw[];
    float* lds = (float*)lds_raw;
    LAS unsigned char* ldsb = (LAS unsigned char*)lds_raw;
    volatile LAS unsigned* MISC = (volatile LAS unsigned*)(ldsb + MISC_OFF);
    if (threadIdx.x < 32) MISC[threadIdx.x] = 0u;
    __syncthreads();
    XcdBarrier bar = xcd_barrier_post((unsigned*)p.ws, MISC + 8);
#define GRID_BAR() xcd_barrier(bar)
    const int G = gridDim.x;
    bf16_t* QKV = (bf16_t*)(p.ws + WS_QKV);
    phase_prologue(ldsb, p);
    GRID_BAR();
    phase_cumsum(p);
    { pg8::Gemm g{(const bf16_t*)(p.ws + WS_XN), (const bf16_t*)(p.ws + WS_WIN), T, 5120, D / 2}; pg8::StaticOrder So; So.init(T, 5120, G, (int)blockIdx.x);
      pg8::EpiProj E{QKV, (bf16_t*)(p.ws + WS_G), (const float*)(p.ws + WS_ROPE), (float*)(p.ws + WS_KMP), (float*)(p.ws + WS_FKN), (float*)(p.ws + WS_FQN)};
      pg8::gemm_phase<pg8::EpiProj, pg8::StaticOrder, true, true, true>(ldsb, g, So, E); }
    GRID_BAR();
    phase_attn((char*)lds_raw, MISC, p);
    GRID_BAR();
    phase_moba_combine(p);
    phase_expert_tables(p);
    GRID_BAR();
    { pg8::Gemm g{QKV, (const bf16_t*)(p.ws + WS_WA), T, D, 512}; pg8::StaticOrder So; So.init(T, D, G, (int)blockIdx.x);
      pg8::EpiMerge E{(bf16_t*)(p.ws + WS_MERGED), (const bf16_t*)(p.ws + WS_G), true};
      pg8::gemm_phase<pg8::EpiMerge, pg8::StaticOrder, true, true>(ldsb, g, So, E); }
    { pg8::Gemm g{QKV + SLOT, (const bf16_t*)(p.ws + WS_WB), T, D, 512}; pg8::StaticOrder So; So.init(T, D, G, (int)blockIdx.x);
      pg8::EpiMerge E{(bf16_t*)(p.ws + WS_MERGED), (const bf16_t*)(p.ws + WS_G) + (size_t)T * D, false};
      pg8::gemm_phase<pg8::EpiMerge, pg8::StaticOrder, true, true>(ldsb, g, So, E); }
    GRID_BAR();
    { pg8::Gemm g{(const bf16_t*)(p.ws + WS_MERGED), (const bf16_t*)(p.ws + WS_WOUT), T, D, D}; pg8::StaticOrder So; So.init(T, D, G, (int)blockIdx.x);
      pg8::EpiOut E{p.x, p.out, (bf16_t*)(p.ws + WS_XN), (float*)(p.ws + WS_RSSP)};
      pg8::gemm_phase<pg8::EpiOut, pg8::StaticOrder, true, true>(ldsb, g, So, E); }
    GRID_BAR();
    { pg8::Gemm g{(const bf16_t*)(p.ws + WS_XN), (const bf16_t*)(p.ws + WS_WPQ), T, PQC, D}; pg8::StaticOrder So; So.init(T, PQC, G, (int)blockIdx.x);
      pg8::EpiStore E{(bf16_t*)(p.ws + WS_PQ), PQC};
      pg8::gemm_phase<pg8::EpiStore, pg8::StaticOrder, true, true>(ldsb, g, So, E);
      phase_peer_topk(ldsb, p, So); }
    phase_h8(p);
    GRID_BAR();
    phase_experts(ldsb, p);
}

extern "C" void kernel_launch(void* const* d_in, const int* in_sizes, int n_in, void* d_out, int out_size, void* d_ws, size_t ws_size, hipStream_t stream) {
    static int grid = 0;
    if (grid == 0) {
        int dev = 0, cus = 0, per_cu = 0;
        if (hipGetDevice(&dev) != hipSuccess || hipDeviceGetAttribute(&cus, hipDeviceAttributeMultiprocessorCount, dev) != hipSuccess) { fprintf(stderr, "kernel_launch: device query failed\n"); grid = -1; return; }
        if (hipFuncSetAttribute((const void*)mega, hipFuncAttributeMaxDynamicSharedMemorySize, LDS_BYTES) != hipSuccess) { fprintf(stderr, "kernel_launch: hipFuncSetAttribute failed\n"); grid = -1; return; }
        if (hipOccupancyMaxActiveBlocksPerMultiprocessor(&per_cu, (const void*)mega, NT, LDS_BYTES) != hipSuccess || per_cu < 1) { fprintf(stderr, "kernel_launch: occupancy query says %d blocks per CU\n", per_cu); (void)hipGetLastError(); grid = -1; return; }
        if (cus < 256) { fprintf(stderr, "kernel_launch: built for a 256-CU device, found %d CUs\n", cus); grid = -1; return; }
        grid = 256;
    }
    if (grid < 0) return;
    (void)hipMemsetAsync(d_ws, 0, CTL_ZERO_BYTES, stream);
    P p{};
    p.x = (const float*)d_in[0]; p.g_mix = (const float*)d_in[1]; p.w_in = (const float*)d_in[2]; p.b_f = (const float*)d_in[3];
    p.w_a = (const float*)d_in[4]; p.w_b = (const float*)d_in[5]; p.w_out = (const float*)d_in[6]; p.g_ffn = (const float*)d_in[7];
    p.w_pq = (const float*)d_in[8]; p.sk = (const float*)d_in[9]; p.eu = (const float*)d_in[10]; p.ev = (const float*)d_in[11]; p.g_fin = (const float*)d_in[12];
    p.out = (float*)d_out; p.ws = (unsigned char*)d_ws;
    hipLaunchKernelGGL(mega, dim3(grid), dim3(NT), LDS_BYTES, stream, p);
}
```

```cpp
#include <hip/hip_runtime.h>
#include <cstdio>
#include <cstdint>
#include <cmath>

constexpr int Bn = 2, S = 8192, D = 1024, T = Bn * S;
constexpr int HD = 64, NH = 8;
constexpr int INC = 5128;
constexpr int LBLK = 256, NBLK = S / LBLK;
constexpr int PH = 8, PNK = 128, PHALF = 128, PK = 16, PQC = PH * 2 * PHALF;
constexpr float EPS = 1e-6f;
constexpr float LOG2E = 1.4426950408889634f;
constexpr float C2 = 0.125f * LOG2E;

typedef unsigned short bf16_t;
typedef float f32x4 __attribute__((ext_vector_type(4)));
typedef unsigned u32x2 __attribute__((ext_vector_type(2)));
typedef unsigned u32x4 __attribute__((ext_vector_type(4)));
#define LAS __attribute__((address_space(3)))

__device__ __forceinline__ float bf2f(bf16_t v) { return __uint_as_float((unsigned)v << 16); }
__device__ __forceinline__ unsigned f2bf(float f) { unsigned u = __float_as_uint(f); return (u + 0x7fffu + ((u >> 16) & 1u)) >> 16; }
__device__ __forceinline__ unsigned pk2(float lo, float hi) { return f2bf(lo) | (f2bf(hi) << 16); }
#define WS_DPP(v, ctrl) ((v) + __builtin_bit_cast(float, __builtin_amdgcn_update_dpp(0, __builtin_bit_cast(int, (v)), (ctrl), 0xf, 0xf, true)))
#define WM_DPP(v, ctrl) fmaxf((v), __builtin_bit_cast(float, __builtin_amdgcn_update_dpp(0, __builtin_bit_cast(int, (v)), (ctrl), 0xf, 0xf, true)))
__device__ __forceinline__ float sum_x16(float v) { const auto r = __builtin_amdgcn_permlane16_swap(__float_as_uint(v), __float_as_uint(v), false, false); return __uint_as_float(r[0]) + __uint_as_float(r[1]); }
__device__ __forceinline__ float sum_x32(float v) { const auto r = __builtin_amdgcn_permlane32_swap(__float_as_uint(v), __float_as_uint(v), false, false); return __uint_as_float(r[0]) + __uint_as_float(r[1]); }
__device__ __forceinline__ float sum_x8(float v) { return v + __builtin_bit_cast(float, __builtin_amdgcn_update_dpp(0, __builtin_bit_cast(int, v), 0x128, 0xf, 0xf, true)); }
__device__ __forceinline__ float wave_sum_fast(float v) {
    v = WS_DPP(v, 0xB1); v = WS_DPP(v, 0x4E); v = WS_DPP(v, 0x141); v = WS_DPP(v, 0x140);
    const int iv = __builtin_bit_cast(int, v);
    return (__builtin_bit_cast(float, __builtin_amdgcn_readlane(iv, 0)) + __builtin_bit_cast(float, __builtin_amdgcn_readlane(iv, 16))) + (__builtin_bit_cast(float, __builtin_amdgcn_readlane(iv, 32)) + __builtin_bit_cast(float, __builtin_amdgcn_readlane(iv, 48)));
}
__device__ __forceinline__ float wave_max_fast(float v) {
    v = WM_DPP(v, 0xB1); v = WM_DPP(v, 0x4E); v = WM_DPP(v, 0x141); v = WM_DPP(v, 0x140);
    const int iv = __builtin_bit_cast(int, v);
    return fmaxf(fmaxf(__builtin_bit_cast(float, __builtin_amdgcn_readlane(iv, 0)), __builtin_bit_cast(float, __builtin_amdgcn_readlane(iv, 16))), fmaxf(__builtin_bit_cast(float, __builtin_amdgcn_readlane(iv, 32)), __builtin_bit_cast(float, __builtin_amdgcn_readlane(iv, 48))));
}
__device__ __forceinline__ int otid() { int t = threadIdx.x; asm volatile("" : "+v"(t)); return t; }

constexpr size_t MiB = 1u << 20, KiB = 1u << 10;
constexpr size_t CTL_ZERO_BYTES = 65536;
constexpr size_t WS_ROPE = 1 * MiB;
constexpr size_t WS_C = 1 * MiB + 512 * KiB;
constexpr size_t WS_LOGF = 2 * MiB;
constexpr size_t WS_KMP = 2 * MiB + 512 * KiB;
constexpr size_t WS_MCNT = 40 * KiB;
constexpr size_t WS_FKN = 2 * MiB + 768 * KiB;
constexpr size_t WS_FQN = WS_FKN + 32 * KiB;
constexpr size_t WS_MG1 = 44 * KiB;
constexpr size_t WS_SEL3 = 4 * MiB + 512 * KiB;
constexpr size_t WS_MLIST = 5 * MiB;
constexpr size_t WS_MLSE = 13 * MiB;
constexpr size_t WS_MP2 = 23 * MiB, WS_MP3 = 39 * MiB;
constexpr size_t WS_MP0 = 215 * MiB, WS_MP1 = 231 * MiB;
constexpr size_t WS_WSUM = 3 * MiB;
constexpr size_t WS_WIN = 5 * MiB;
constexpr size_t WS_WA = 15 * MiB, WS_WB = 16 * MiB;
constexpr size_t WS_WOUT = 17 * MiB;
constexpr size_t WS_WPQ = 19 * MiB;
constexpr size_t WS_XN = 23 * MiB;
constexpr size_t WS_QKV = 55 * MiB;
constexpr size_t SLOT = (size_t)T * 512;
constexpr size_t WS_G = 151 * MiB;
constexpr size_t WS_MERGED = 215 * MiB;
constexpr size_t WS_PQ = 151 * MiB;
constexpr size_t WS_IDX = 215 * MiB;
constexpr size_t WS_GATE = 223 * MiB;
constexpr size_t WS_SK = 247 * MiB;
constexpr size_t WS_RSSP = 3 * MiB + 512 * KiB;
constexpr size_t WS_EU = 87 * MiB;
constexpr size_t WS_EV = 103 * MiB;
constexpr size_t ESLICE = (size_t)16384 * 128;
constexpr size_t WS_A = 231 * MiB;
constexpr size_t WS_H8 = 55 * MiB;
constexpr size_t WS_HSC = 71 * MiB;
constexpr size_t WS_USC = 119 * MiB;
constexpr size_t WS_VSC = 119 * MiB + 64 * KiB;

struct P {
    const float *x, *g_mix, *w_in, *b_f, *w_a, *w_b, *w_out, *g_ffn, *w_pq, *sk, *eu, *ev, *g_fin;
    float* out; unsigned char* ws;
};

namespace pg8 {
#define PG8_LAS __attribute__((address_space(3)))
typedef unsigned short bf16_t;
typedef short bf16x8 __attribute__((ext_vector_type(8)));
typedef int i32x4 __attribute__((ext_vector_type(4))); typedef int i32x8 __attribute__((ext_vector_type(8)));
typedef float f32x4 __attribute__((ext_vector_type(4)));
typedef unsigned u32x4 __attribute__((ext_vector_type(4)));
constexpr int BM = 256, BK = 64, HALF = 128, HTB = HALF * BK * 2  , STAGE_BYTES = 8 * HTB, NXCD = 8, WGM = 8;

__host__ __device__ __forceinline__ int lds_byte(int r, int c) { const int st = (r >> 4) * 2 + (c >> 5), rr = r & 15, cc = c & 31, ob = rr * 64 + cc * 2; return st * 1024 + (ob ^ (((ob >> 9) & 1) << 5)); }
__host__ __device__ __forceinline__ void stage_rc(int b, int& R, int& C) { const int st = b / 1024, sb = b % 1024, swz = sb ^ (((sb >> 9) & 1) << 5); R = (st >> 1) * 16 + swz / 64; C = (st & 1) * 32 + (swz % 64) / 2; }
__host__ __device__ __forceinline__ int perm32(int rho) { const int n = rho >> 4, i = rho & 15; return 8 * (i >> 2) + 4 * n + (i & 3); }

struct Unit { int pm, pn; };
struct Gemm { const bf16_t* A; const bf16_t* Bt; int M, N, K; };

struct StaticOrder {
    int nM, nN, nwg, G, c;
    __host__ __device__ void init(int M, int N, int G_, int c_) { nM = M / BM; nN = N / BM; nwg = nM * nN; G = G_; c = c_; }
    __host__ __device__ bool next(int i, Unit& u) const {
        const long L = (long)i * G + c; if (L >= nwg) return false;
        int wgid = (int)L; { const int q = nwg / NXCD, r = nwg % NXCD, xcd = wgid % NXCD, off = wgid / NXCD; wgid = (xcd < r ? xcd * (q + 1) : r * (q + 1) + (xcd - r) * q) + off; }
        const int nig = WGM * nN, gid = wgid / nig, fm = gid * WGM, gsz = (nM - fm) < WGM ? (nM - fm) : WGM;
        u.pm = fm + ((wgid % nig) % gsz); u.pn = (wgid % nig) / gsz; return true;
    }
    __device__ __forceinline__ void a_ready(const Unit&) const {}
    __device__ __forceinline__ void done(const Unit&) const {}
};

__device__ __forceinline__ unsigned cvt_pk_bf16(float lo, float hi) { unsigned r; asm volatile("v_cvt_pk_bf16_f32 %0, %1, %2" : "=v"(r) : "v"(lo), "v"(hi)); return r; }

typedef float f32x2_t __attribute__((ext_vector_type(2))); typedef __bf16 bf16x2_t __attribute__((ext_vector_type(2)));
__device__ __forceinline__ unsigned cvtpk_c(float lo, float hi) { f32x2_t v = {lo, hi}; bf16x2_t b = __builtin_convertvector(v, bf16x2_t); return __builtin_bit_cast(unsigned, b); }
__device__ __forceinline__ u32x4 pack8(const f32x4& v0, const f32x4& v1) { u32x4 w; w.x = cvtpk_c(v0[0], v0[1]); w.y = cvtpk_c(v0[2], v0[3]); w.z = cvtpk_c(v1[0], v1[1]); w.w = cvtpk_c(v1[2], v1[3]); return w; }
__device__ __forceinline__ void unpack8(const u32x4& w, f32x4& v0, f32x4& v1) {
    v0[0] = __uint_as_float(w.x << 16); v0[1] = __uint_as_float(w.x & 0xffff0000u); v0[2] = __uint_as_float(w.y << 16); v0[3] = __uint_as_float(w.y & 0xffff0000u);
    v1[0] = __uint_as_float(w.z << 16); v1[1] = __uint_as_float(w.z & 0xffff0000u); v1[2] = __uint_as_float(w.w << 16); v1[3] = __uint_as_float(w.w & 0xffff0000u); }

struct EpiProj {
    static constexpr bool PERM = true, AFTER_DRAIN = false;
    bf16_t* QKV; bf16_t* G; const float* ROPE; float* KMP; float* FKN; float* FQN;
    __device__ __forceinline__ void operator()(const f32x4 (&acc)[2][2][4][2], const Unit& u, int wr, int wc, int fr, int fq) const {
        const int pn = u.pn, row0 = u.pm * BM + wr * 64 + fr;
        if (pn < 12) {
            const int typ = pn >> 1;
            const int slot = (typ == 0) ? 0 : (typ == 3) ? 1 : (typ < 3) ? typ + 1 : typ;
            bf16_t* base = QKV + (size_t)slot * ((size_t)16384 * 512);
            const int colt = (pn & 1) * 256, col0 = colt + wc * 32 + 8 * fq;
            const float sc = (typ == 0 || typ == 3) ? 0.18033688011112042f : 1.0f;
            const bool rope = (typ < 2) && ((wc & 1) == 0);
            const float sgn = (fq == 0) ? -1.f : 1.f; const bool rl = fq < 2;
            f32x4 ks[2][2];
#pragma unroll
            for (int bj = 0; bj < 2; ++bj) { ks[bj][0] = (f32x4){0.f, 0.f, 0.f, 0.f}; ks[bj][1] = (f32x4){0.f, 0.f, 0.f, 0.f}; }
            const bool nrm = (typ == 3 || typ == 4);
            float nmx[2][2] = {{0.f, 0.f}, {0.f, 0.f}};
#pragma unroll
            for (int ai = 0; ai < 2; ++ai)
#pragma unroll
                for (int m = 0; m < 4; ++m) {
                    const int row = row0 + ai * HALF + m * 16;
                    f32x4 c0 = (f32x4){1.f, 1.f, 1.f, 1.f}, c1 = c0, s0 = (f32x4){0.f, 0.f, 0.f, 0.f}, s1 = s0;
                    if (rope) { const f32x4* rp = (const f32x4*)(ROPE + (size_t)(row & 8191) * 16); c0 = rp[0]; c1 = rp[1]; s0 = rp[2]; s1 = rp[3]; }
#pragma unroll
                    for (int bj = 0; bj < 2; ++bj) {
                        f32x4 v0 = acc[ai][bj][m][0], v1 = acc[ai][bj][m][1];
                        if (rope) {
                            f32x4 p0, p1;
#pragma unroll
                            for (int e = 0; e < 4; ++e) { p0[e] = __shfl_xor(v0[e], 16); p1[e] = __shfl_xor(v1[e], 16); }
                            if (rl) { v0 = v0 * c0 + sgn * (p0 * s0); v1 = v1 * c1 + sgn * (p1 * s1); }
                        }
                        if (typ == 1) { ks[bj][0] += v0; ks[bj][1] += v1; }
                        v0 = v0 * sc; v1 = v1 * sc;
                        *(u32x4*)(base + (size_t)row * 512 + col0 + bj * HALF) = pack8(v0, v1);
                        if (nrm) { float ss = ((v0[0] * v0[0] + v0[1] * v0[1]) + (v0[2] * v0[2] + v0[3] * v0[3])) + ((v1[0] * v1[0] + v1[1] * v1[1]) + (v1[2] * v1[2] + v1[3] * v1[3]));
                            { const auto r_ = __builtin_amdgcn_permlane16_swap(__float_as_uint(ss), __float_as_uint(ss), false, false); ss = __uint_as_float(r_[0]) + __uint_as_float(r_[1]); }
                            { const auto r_ = __builtin_amdgcn_permlane32_swap(__float_as_uint(ss), __float_as_uint(ss), false, false); ss = __uint_as_float(r_[0]) + __uint_as_float(r_[1]); }
                            nmx[ai][bj] = fmaxf(nmx[ai][bj], ss); }
                    }
                }
            if (nrm) {
                const int b = u.pm >> 5, nb = u.pm & 31;
#pragma unroll
                for (int bj = 0; bj < 2; ++bj) { const int head = (colt + 128 * bj + 32 * wc) >> 6;
                    float a0 = nmx[0][bj], a1 = nmx[1][bj];
                    a0 = WM_DPP(a0, 0xB1); a0 = WM_DPP(a0, 0x4E); a0 = WM_DPP(a0, 0x141); a0 = WM_DPP(a0, 0x140); a1 = WM_DPP(a1, 0xB1); a1 = WM_DPP(a1, 0x4E); a1 = WM_DPP(a1, 0x141); a1 = WM_DPP(a1, 0x140);
                    if (fr == 0 && fq == 0) {
                        if (typ == 4) { float* d = FKN + ((size_t)(b * 8 + head) * 128 + 4 * nb + wr) * 2 + (wc & 1); d[0] = a0; d[4] = a1; }
                        else FQN[(((size_t)(b * 8 + head) * 32 + nb) * 2 + wr) * 2 + (wc & 1)] = fmaxf(a0, a1); } }
            }
            if (typ == 1) {
#pragma unroll
                for (int bj = 0; bj < 2; ++bj)
#pragma unroll
                    for (int n = 0; n < 2; ++n)
#pragma unroll
                        for (int e = 0; e < 4; ++e) { float v = ks[bj][n][e]; v = WS_DPP(v, 0xB1); v = WS_DPP(v, 0x4E); v = WS_DPP(v, 0x141); v = WS_DPP(v, 0x140); ks[bj][n][e] = v; }
                if (fr == 0) {
                    const int b = u.pm >> 5, nb = u.pm & 31;
#pragma unroll
                    for (int bj = 0; bj < 2; ++bj) { const int head = (colt + 128 * bj + 32 * wc) >> 6, d = 32 * (wc & 1) + 8 * fq;
                        float* dst = KMP + ((((size_t)wr * 16 + b * 8 + head) * 32 + nb) * 64 + d); *(f32x4*)dst = ks[bj][0]; *(f32x4*)(dst + 4) = ks[bj][1]; }
                }
            }
        } else {
            const int gi = pn - 12; bf16_t* base = G + (size_t)(gi >> 2) * ((size_t)16384 * 1024);
            const int col0 = (gi & 3) * 256 + wc * 32 + 8 * fq;
#pragma unroll
            for (int ai = 0; ai < 2; ++ai)
#pragma unroll
                for (int m = 0; m < 4; ++m) { const int row = row0 + ai * HALF + m * 16;
#pragma unroll
                    for (int bj = 0; bj < 2; ++bj) { f32x4 v0 = acc[ai][bj][m][0], v1 = acc[ai][bj][m][1];
#pragma unroll
                        for (int e = 0; e < 4; ++e) { v0[e] = __builtin_amdgcn_rcpf(1.f + __builtin_amdgcn_exp2f(-1.4426950408889634f * v0[e])); v1[e] = __builtin_amdgcn_rcpf(1.f + __builtin_amdgcn_exp2f(-1.4426950408889634f * v1[e])); }
                        *(u32x4*)(base + (size_t)row * 1024 + col0 + bj * HALF) = pack8(v0, v1); } }
        }
    }
};
struct EpiMerge {
    static constexpr bool PERM = true, AFTER_DRAIN = false;
    bf16_t* Mg; const bf16_t* Gt; bool first;
    __device__ __forceinline__ void operator()(const f32x4 (&acc)[2][2][4][2], const Unit& u, int wr, int wc, int fr, int fq) const {
        const int row0 = u.pm * BM + wr * 64 + fr, col0 = u.pn * BM + wc * 32 + 8 * fq;
#pragma unroll
        for (int ai = 0; ai < 2; ++ai)
#pragma unroll
            for (int m = 0; m < 4; ++m) { const size_t off = (size_t)(row0 + ai * HALF + m * 16) * 1024 + col0;
#pragma unroll
                for (int bj = 0; bj < 2; ++bj) { f32x4 g0, g1; unpack8(*(const u32x4*)(Gt + off + bj * HALF), g0, g1);
                    f32x4 v0 = g0 * acc[ai][bj][m][0], v1 = g1 * acc[ai][bj][m][1];
                    if (!first) { f32x4 o0, o1; unpack8(*(const u32x4*)(Mg + off + bj * HALF), o0, o1); v0 += o0; v1 += o1; }
                    *(u32x4*)(Mg + off + bj * HALF) = pack8(v0, v1); } }
    }
};
struct EpiOut {
    static constexpr bool PERM = true, AFTER_DRAIN = false;
    const float* X; float* O; bf16_t* Hb; float* RSSP;
    __device__ __forceinline__ void operator()(const f32x4 (&acc)[2][2][4][2], const Unit& u, int wr, int wc, int fr, int fq) const {
        const int row0 = u.pm * BM + wr * 64 + fr, col0 = u.pn * BM + wc * 32 + 8 * fq;
#pragma unroll
        for (int ai = 0; ai < 2; ++ai)
#pragma unroll
            for (int m = 0; m < 4; ++m) { const int row = row0 + ai * HALF + m * 16; const size_t off = (size_t)row * 1024 + col0; float ss = 0.f;
#pragma unroll
                for (int bj = 0; bj < 2; ++bj) { const f32x4 x0 = *(const f32x4*)(X + off + bj * HALF), x1 = *(const f32x4*)(X + off + bj * HALF + 4);
                    const f32x4 h0 = x0 + acc[ai][bj][m][0], h1 = x1 + acc[ai][bj][m][1];
                    *(u32x4*)(Hb + off + bj * HALF) = pack8(h0, h1);
                    ss += (h0[0] * h0[0] + h0[1] * h0[1]) + (h0[2] * h0[2] + h0[3] * h0[3]) + (h1[0] * h1[0] + h1[1] * h1[1]) + (h1[2] * h1[2] + h1[3] * h1[3]); }
                ss += __shfl_xor(ss, 16); ss += __shfl_xor(ss, 32);
                if (fq == 0) RSSP[(size_t)row * 16 + u.pn * 4 + wc] = ss; }
    }
};
struct EpiStore {
    static constexpr bool PERM = true, AFTER_DRAIN = false;
    bf16_t* O; int ldc;
    __device__ __forceinline__ void operator()(const f32x4 (&acc)[2][2][4][2], const Unit& u, int wr, int wc, int fr, int fq) const {
        const int row0 = u.pm * BM + wr * 64 + fr, col0 = u.pn * BM + wc * 32 + 8 * fq;
#pragma unroll
        for (int ai = 0; ai < 2; ++ai)
#pragma unroll
            for (int m = 0; m < 4; ++m)
#pragma unroll
                for (int bj = 0; bj < 2; ++bj) *(u32x4*)(O + (size_t)(row0 + ai * HALF + m * 16) * ldc + col0 + bj * HALF) = pack8(acc[ai][bj][m][0], acc[ai][bj][m][1]);
    }
};

template <class Epi, class Sched, bool ALIGN_EPI = false, bool SP2 = false, bool F8 = false>
__device__ __forceinline__ void gemm_phase(PG8_LAS unsigned char* lds, const Gemm g, const Sched& S, const Epi& E) {
    const int tid = otid(), wid = __builtin_amdgcn_readfirstlane(tid >> 6), lane = tid & 63, wr = wid >> 2, wc = wid & 3, fr = lane & 15, fq = lane >> 4;
    int K_ = g.K; if constexpr (F8) asm volatile("" : "+s"(K_));
    const int K = K_, nt = K / BK;
    unsigned voffA[2], voffB[2];
#pragma unroll
    for (int i = 0; i < 2; ++i) { int R, C; stage_rc(tid * 16 + i * 8192, R, C); const int Rb = Epi::PERM ? ((R & ~31) + perm32(R & 31)) : R;
        voffA[i] = (unsigned)(R * K + C) * 2u; voffB[i] = (unsigned)(Rb * K + C) * 2u; }
    const size_t kstep = (size_t)(BK * 2);
    const size_t hstep = (size_t)HALF * K * 2;
    const size_t tstep = 2 * hstep;
    const unsigned ldsw = (unsigned)wid * 1024u;
    const int aoff = lds_byte(wr * 64 + fr, fq * 8), boff = lds_byte(wc * 32 + fr, fq * 8);
#define PG8_SA(b, h) (((b) * 2 + (h)) * HTB)
#define PG8_SB(b, h) ((4 + (b) * 2 + (h)) * HTB)
#define PG8_STAGE(bufoff, gbase, voff) do { _Pragma("unroll") for (int _i = 0; _i < 2; ++_i) \
        __builtin_amdgcn_global_load_lds((const unsigned*)((const char*)(gbase) + (voff)[_i]), (PG8_LAS unsigned*)(lds + (bufoff) + ldsw + _i * 8192), 16, 0, 0); } while (0)
#define PG8_LDA(dst, b, h) do { _Pragma("unroll") for (int m = 0; m < 4; ++m) { \
        if constexpr (F8) dst##8[m] = __builtin_shufflevector(*(const PG8_LAS i32x4*)(lds + PG8_SA(b, h) + aoff + m * 2048), *(const PG8_LAS i32x4*)(lds + PG8_SA(b, h) + aoff + m * 2048 + 1024), 0, 1, 2, 3, 4, 5, 6, 7); \
        else { _Pragma("unroll") for (int k = 0; k < 2; ++k) dst[m][k] = *(const PG8_LAS bf16x8*)(lds + PG8_SA(b, h) + aoff + m * 2048 + k * 1024); } } } while (0)
#define PG8_LDB(dst, b, h) do { _Pragma("unroll") for (int n = 0; n < 2; ++n) { \
        if constexpr (F8) dst##8[n] = __builtin_shufflevector(*(const PG8_LAS i32x4*)(lds + PG8_SB(b, h) + boff + n * 2048), *(const PG8_LAS i32x4*)(lds + PG8_SB(b, h) + boff + n * 2048 + 1024), 0, 1, 2, 3, 4, 5, 6, 7); \
        else { _Pragma("unroll") for (int k = 0; k < 2; ++k) dst[n][k] = *(const PG8_LAS bf16x8*)(lds + PG8_SB(b, h) + boff + n * 2048 + k * 1024); } } } while (0)
#define PG8_MMA(ai, bj, At, Bt) do { __builtin_amdgcn_s_setprio(1); _Pragma("unroll") for (int m = 0; m < 4; ++m) _Pragma("unroll") for (int n = 0; n < 2; ++n) { \
        if constexpr (F8) asm volatile("v_mfma_scale_f32_16x16x128_f8f6f4 %0, %1, %2, %0, %3, %4 op_sel_hi:[0,0,0]" : "+v"(acc[ai][bj][m][n]) : "v"(Bt##8[n]), "v"(At##8[m]), "v"(f8sb), "v"(f8sa)); \
        else { _Pragma("unroll") for (int k = 0; k < 2; ++k) acc[ai][bj][m][n] = __builtin_amdgcn_mfma_f32_16x16x32_bf16(Bt[n][k], At[m][k], acc[ai][bj][m][n], 0, 0, 0); } } \
        __builtin_amdgcn_s_setprio(0); } while (0)
#define PG8_WAIT_V(n) asm volatile("s_waitcnt vmcnt(" #n ")" ::: "memory")
#define PG8_WAIT_L(n) asm volatile("s_waitcnt lgkmcnt(" #n ")" ::: "memory")
#define PG8_BAR __builtin_amdgcn_s_barrier()
#define PG8_SCHED __builtin_amdgcn_sched_barrier(0)
    Unit cur, nxt; int ui = 0;
    if (!S.next(0, cur)) return;
    f32x4 acc[2][2][4][2];
#pragma unroll
    for (int a = 0; a < 2; ++a)
#pragma unroll
        for (int b = 0; b < 2; ++b)
#pragma unroll
            for (int m = 0; m < 4; ++m)
#pragma unroll
                for (int n = 0; n < 2; ++n) acc[a][b][m][n] = (f32x4){0.f, 0.f, 0.f, 0.f};
    bf16x8 At[4][2], B0[2][2], B1[2][2]; i32x8 At8[4], B08[2], B18[2];
    const int f8sb = 0x79797979, f8sa = 0x7d7d7d7d;
    const char* cA = (const char*)g.A + (size_t)cur.pm * tstep; const char* cB = (const char*)g.Bt + (size_t)cur.pn * tstep;
    S.a_ready(cur);
    if constexpr (SP2) {
        PG8_STAGE(PG8_SB(0, 0), cB, voffB); PG8_STAGE(PG8_SB(0, 1), cB + hstep, voffB); PG8_STAGE(PG8_SA(0, 0), cA, voffA); PG8_STAGE(PG8_SA(0, 1), cA + hstep, voffA);
        if (wr == 1) PG8_BAR;
        PG8_WAIT_V(2); PG8_BAR;
        PG8_STAGE(PG8_SB(1, 0), cB + kstep, voffB); PG8_STAGE(PG8_SA(1, 0), cA + kstep, voffA); PG8_STAGE(PG8_SB(1, 1), cB + hstep + kstep, voffB);
        PG8_WAIT_V(6); PG8_BAR;
    } else {
        PG8_STAGE(PG8_SB(0, 0), cB, voffB); PG8_STAGE(PG8_SA(0, 0), cA, voffA); PG8_STAGE(PG8_SB(0, 1), cB + hstep, voffB); PG8_STAGE(PG8_SA(0, 1), cA + hstep, voffA);
        if (wr == 1) PG8_BAR;
        PG8_WAIT_V(4); PG8_BAR;
        PG8_STAGE(PG8_SB(1, 0), cB + kstep, voffB); PG8_STAGE(PG8_SA(1, 0), cA + kstep, voffA); PG8_STAGE(PG8_SB(1, 1), cB + hstep + kstep, voffB);
        PG8_WAIT_V(6); PG8_BAR;
    }
    for (;;) {
        const bool has_next = S.next(ui + 1, nxt);
        const char* nA = has_next ? (const char*)g.A + (size_t)nxt.pm * tstep : cA; const char* nB = has_next ? (const char*)g.Bt + (size_t)nxt.pn * tstep : cB;
        for (int t = 0; t < nt; t += 2) {
            const bool last = (t == nt - 2);
            const char* a1 = cA + (size_t)(t + 1) * kstep;
            const char* a2 = last ? nA : cA + (size_t)(t + 2) * kstep; const char* b2 = last ? nB : cB + (size_t)(t + 2) * kstep;
            const char* a3 = a2 + kstep; const char* b3 = b2 + kstep;
            if (last && has_next) S.a_ready(nxt);
            if constexpr (SP2) {
            PG8_LDB(B0, 0, 0); PG8_LDB(B1, 0, 1); PG8_SCHED; PG8_LDA(At, 0, 0); PG8_STAGE(PG8_SA(1, 1), a1 + hstep, voffA);
            PG8_WAIT_V(8); PG8_WAIT_L(0); PG8_BAR; PG8_MMA(0, 0, At, B0); PG8_MMA(0, 1, At, B1); PG8_BAR; PG8_SCHED;
            PG8_LDA(At, 0, 1); PG8_STAGE(PG8_SB(0, 0), b2, voffB); PG8_STAGE(PG8_SB(0, 1), b2 + hstep, voffB); PG8_STAGE(PG8_SA(0, 0), a2, voffA);
            PG8_WAIT_V(8); PG8_WAIT_L(0); PG8_BAR; PG8_MMA(1, 0, At, B0); PG8_MMA(1, 1, At, B1); PG8_BAR; PG8_SCHED;
            PG8_LDB(B0, 1, 0); PG8_LDB(B1, 1, 1); PG8_SCHED; PG8_LDA(At, 1, 0); PG8_STAGE(PG8_SA(0, 1), a2 + hstep, voffA);
            PG8_WAIT_V(8); PG8_WAIT_L(0); PG8_BAR; PG8_MMA(0, 0, At, B0); PG8_MMA(0, 1, At, B1); PG8_BAR; PG8_SCHED;
            PG8_LDA(At, 1, 1); PG8_STAGE(PG8_SB(1, 0), b3, voffB); PG8_STAGE(PG8_SB(1, 1), b3 + hstep, voffB); PG8_STAGE(PG8_SA(1, 0), a3, voffA);
            PG8_WAIT_V(8); PG8_WAIT_L(0); PG8_BAR; PG8_MMA(1, 0, At, B0); PG8_MMA(1, 1, At, B1); PG8_BAR; PG8_SCHED;
            } else {
            PG8_LDB(B0, 0, 0); PG8_SCHED; PG8_LDA(At, 0, 0); PG8_STAGE(PG8_SA(1, 1), a1 + hstep, voffA);
            PG8_WAIT_L(8); PG8_BAR; PG8_WAIT_L(0); PG8_MMA(0, 0, At, B0); PG8_BAR; PG8_SCHED;
            PG8_LDB(B1, 0, 1); PG8_STAGE(PG8_SB(0, 0), b2, voffB);
            PG8_BAR; PG8_WAIT_L(0); PG8_MMA(0, 1, At, B1); PG8_BAR;
            PG8_LDA(At, 0, 1); PG8_STAGE(PG8_SA(0, 0), a2, voffA);
            PG8_BAR; PG8_WAIT_L(0); PG8_MMA(1, 0, At, B0); PG8_BAR; PG8_SCHED;
            PG8_STAGE(PG8_SB(0, 1), b2 + hstep, voffB);
            PG8_WAIT_V(6); PG8_BAR; PG8_MMA(1, 1, At, B1); PG8_BAR;
            PG8_LDB(B0, 1, 0); PG8_SCHED; PG8_LDA(At, 1, 0); PG8_STAGE(PG8_SA(0, 1), a2 + hstep, voffA);
            PG8_WAIT_L(8); PG8_BAR; PG8_WAIT_L(0); PG8_MMA(0, 0, At, B0); PG8_BAR; PG8_SCHED;
            PG8_LDB(B1, 1, 1); PG8_STAGE(PG8_SB(1, 0), b3, voffB);
            PG8_BAR; PG8_WAIT_L(0); PG8_MMA(0, 1, At, B1); PG8_BAR;
            PG8_LDA(At, 1, 1); PG8_STAGE(PG8_SA(1, 0), a3, voffA);
            PG8_BAR; PG8_WAIT_L(0); PG8_MMA(1, 0, At, B0); PG8_BAR; PG8_SCHED;
            PG8_STAGE(PG8_SB(1, 1), b3 + hstep, voffB);
            PG8_WAIT_V(6); PG8_BAR; PG8_MMA(1, 1, At, B1); PG8_BAR;
            }
        }
        if constexpr (ALIGN_EPI) { if (wr == 0) PG8_BAR; }
        if constexpr (F8) {
            asm volatile("s_nop 15\n\ts_nop 15" ::: "memory");
#pragma unroll
            for (int a_ = 0; a_ < 2; ++a_)
#pragma unroll
                for (int b_ = 0; b_ < 2; ++b_)
                    asm volatile("" : "+v"(acc[a_][b_][0][0]), "+v"(acc[a_][b_][0][1]), "+v"(acc[a_][b_][1][0]), "+v"(acc[a_][b_][1][1]), "+v"(acc[a_][b_][2][0]), "+v"(acc[a_][b_][2][1]), "+v"(acc[a_][b_][3][0]), "+v"(acc[a_][b_][3][1])); }
        if constexpr (!Epi::AFTER_DRAIN) { E(acc, cur, wr, wc, fr, fq); S.done(cur); }
        if (!has_next) break;
#pragma unroll
        for (int a = 0; a < 2; ++a)
#pragma unroll
            for (int b = 0; b < 2; ++b)
#pragma unroll
                for (int m = 0; m < 4; ++m)
#pragma unroll
                    for (int n = 0; n < 2; ++n) acc[a][b][m][n] = (f32x4){0.f, 0.f, 0.f, 0.f};
        cur = nxt; cA = nA; cB = nB; ++ui;
        if constexpr (ALIGN_EPI) { if (wr == 1) PG8_BAR; }
    }
    PG8_WAIT_V(0);
    if constexpr (!ALIGN_EPI) { if (wr == 0) PG8_BAR; }
    PG8_BAR;
    if constexpr (Epi::AFTER_DRAIN) { E.fused(acc, cur, wr, wc, fr, fq, lds, wid, lane); S.done(cur); }
#undef PG8_SA
#undef PG8_SB
#undef PG8_STAGE
#undef PG8_LDA
#undef PG8_LDB
#undef PG8_MMA
#undef PG8_WAIT_V
#undef PG8_WAIT_L
#undef PG8_BAR
#undef PG8_SCHED
}
}


__device__ __forceinline__ float log_sigmoid(float z) { return z >= 0.f ? -log1pf(expf(-z)) : z - log1pf(expf(z)); }
constexpr float XN8_SCALE = 4.0f, WIN8_SCALE = 64.0f;
__device__ __forceinline__ unsigned pk4_fp8(float a, float b, float c, float d) { int w = __builtin_amdgcn_cvt_pk_fp8_f32(a, b, 0, false); w = __builtin_amdgcn_cvt_pk_fp8_f32(c, d, w, true); return (unsigned)w; }
__device__ __forceinline__ void p0_transpose_item8(const float* W, int ldw, int K, int ncols, unsigned char* WT, int row_off, LAS float* scr, int item, int lane, float scale) {
    const int nblk = ncols / 32, kb = item / nblk, nb = item % nblk, k0 = 64 * kb, n0 = 32 * nb;
#pragma unroll 8
    for (int i = 0; i < 32; ++i) { const int kk = 2 * i + (lane >> 5); scr[kk * 33 + (lane & 31)] = W[(size_t)(k0 + kk) * ldw + n0 + (lane & 31)] * scale; }
    asm volatile("s_waitcnt lgkmcnt(0)" ::: "memory");
    const int c = lane & 7;
#pragma unroll
    for (int j = 0; j < 4; ++j) { const int n = (lane >> 3) + 8 * j; const LAS float* s = scr + (8 * c) * 33 + n;
        u32x2 o; o.x = pk4_fp8(s[0 * 33], s[1 * 33], s[2 * 33], s[3 * 33]); o.y = pk4_fp8(s[4 * 33], s[5 * 33], s[6 * 33], s[7 * 33]);
        *(u32x2*)(WT + (size_t)(row_off + n0 + n) * K + k0 + 8 * c) = o; }
    asm volatile("s_waitcnt lgkmcnt(0)" ::: "memory");
}
__device__ __forceinline__ void p0_transpose_item(const float* W, int ldw, int K, int ncols, bf16_t* WT, int row_off, LAS float* scr, int item, int lane, const float* ksc = nullptr) {
    const int nblk = ncols / 32, kb = item / nblk, nb = item % nblk, k0 = 64 * kb, n0 = 32 * nb;
#pragma unroll 8
    for (int i = 0; i < 32; ++i) { const int kk = 2 * i + (lane >> 5); scr[kk * 33 + (lane & 31)] = W[(size_t)(k0 + kk) * ldw + n0 + (lane & 31)] * (ksc ? ksc[k0 + kk] : 1.0f); }
    asm volatile("s_waitcnt lgkmcnt(0)" ::: "memory");
    const int c = lane & 7;
#pragma unroll
    for (int j = 0; j < 4; ++j) { const int n = (lane >> 3) + 8 * j; const LAS float* s = scr + (8 * c) * 33 + n;
        u32x4 o; o.x = pk2(s[0 * 33], s[1 * 33]); o.y = pk2(s[2 * 33], s[3 * 33]); o.z = pk2(s[4 * 33], s[5 * 33]); o.w = pk2(s[6 * 33], s[7 * 33]);
        *(u32x4*)(WT + (size_t)(row_off + n0 + n) * K + k0 + 8 * c) = o; }
    asm volatile("s_waitcnt lgkmcnt(0)" ::: "memory");
}
__device__ __forceinline__ void phase_prologue(LAS unsigned char* ldsb, const P& p) {
    const int TID = otid();
    const int lane = TID & 63, wave = TID >> 6, gw = blockIdx.x * 8 + wave, nw = gridDim.x * 8;
    LAS float* scr = (LAS float*)(ldsb + wave * 16384);
    constexpr int I1 = 16 * 96, I2 = 16 * 64, IA = 8 * 32, IO = 16 * 32, IQ = 16 * 64;
    for (int it = gw; it < I1 + I2 + 2 * IA + IO + IQ; it += nw) {
        int r = it;
        if (r < I1) { p0_transpose_item8(p.w_in, INC, D, 3072, p.ws + WS_WIN, 0, scr, r, lane, WIN8_SCALE); continue; } r -= I1;
        if (r < I2) { p0_transpose_item8(p.w_in + 3080, INC, D, 2048, p.ws + WS_WIN, 3072, scr, r, lane, WIN8_SCALE); continue; } r -= I2;
        if (r < IA) { p0_transpose_item(p.w_a, D, 512, 1024, (bf16_t*)(p.ws + WS_WA), 0, scr, r, lane); continue; } r -= IA;
        if (r < IA) { p0_transpose_item(p.w_b, D, 512, 1024, (bf16_t*)(p.ws + WS_WB), 0, scr, r, lane); continue; } r -= IA;
        if (r < IO) { p0_transpose_item(p.w_out, D, D, 1024, (bf16_t*)(p.ws + WS_WOUT), 0, scr, r, lane); continue; } r -= IO;
        p0_transpose_item(p.w_pq, PQC, D, 2048, (bf16_t*)(p.ws + WS_WPQ), 0, scr, r, lane, p.g_ffn);
    }
    { u32x4* SKo = (u32x4*)(p.ws + WS_SK);
      for (int c = blockIdx.x * 512 + TID; c < PH * 2 * PNK * PHALF / 8; c += gridDim.x * 512) { const f32x4 a0 = *(const f32x4*)(p.sk + (size_t)c * 8), a1 = *(const f32x4*)(p.sk + (size_t)c * 8 + 4);
          u32x4 o; o.x = pk2(a0.x, a0.y); o.y = pk2(a0.z, a0.w); o.z = pk2(a1.x, a1.y); o.w = pk2(a1.z, a1.w); SKo[c] = o; } }
    { float* ROPE = (float*)(p.ws + WS_ROPE);
      for (int it = blockIdx.x * 512 + TID; it < S * 8; it += gridDim.x * 512) { const int i = it & 7, pos = it >> 3;
          const float inv_freq = powf(500000.0f, -(float)i / 8.0f); const float ang = (float)pos * inv_freq;
          ROPE[pos * 16 + i] = cosf(ang); ROPE[pos * 16 + 8 + i] = sinf(ang); } }
    __syncthreads();
    { LAS float* WFt = (LAS float*)ldsb;
      for (int i = TID; i < 2 * D; i += 512) { const int col = i >> 1, half = i & 1; const f32x4 w = *(const f32x4*)(p.w_in + (size_t)col * INC + 3072 + 4 * half);
          WFt[(4 * half + 0) * D + col] = w.x; WFt[(4 * half + 1) * D + col] = w.y; WFt[(4 * half + 2) * D + col] = w.z; WFt[(4 * half + 3) * D + col] = w.w; } }
    __syncthreads();
    bf16_t* XN = (bf16_t*)(p.ws + WS_XN); float* LOGF = (float*)(p.ws + WS_LOGF); const LAS float* WFt = (const LAS float*)ldsb;
    float wsum = 0.f;
    const int fo = 4 * (lane & 1) + 2 * ((lane >> 1) & 1) + ((lane >> 2) & 1);
    const float bfo = p.b_f[fo];
#define PRO_X(x, ctrl) __builtin_bit_cast(float, __builtin_amdgcn_update_dpp(0, __builtin_bit_cast(int, (x)), (ctrl), 0xf, 0xf, true))
#pragma unroll 1
    for (int rh = 0; rh < 8; rh += 4) {
    f32x4 xv[4][4];
#pragma unroll
    for (int r8 = 0; r8 < 4; ++r8)
#pragma unroll
        for (int j = 0; j < 4; ++j) xv[r8][j] = ((const f32x4*)(p.x + (size_t)(gw * 8 + rh + r8) * D))[lane + 64 * j];
#pragma unroll
    for (int r8 = 0; r8 < 4; ++r8) {
        const int row = gw * 8 + rh + r8;
        f32x4 v[4]; float ss = 0.f;
#pragma unroll
        for (int j = 0; j < 4; ++j) { v[j] = xv[r8][j]; ss += v[j].x * v[j].x + v[j].y * v[j].y + v[j].z * v[j].z + v[j].w * v[j].w; }
        ss = wave_sum_fast(ss);
        const float rstd = rsqrtf(ss * (1.f / D) + EPS);
        float fs[8];
#pragma unroll
        for (int f = 0; f < 8; ++f) fs[f] = 0.f;
#pragma unroll
        for (int j = 0; j < 4; ++j) {
            const f32x4 g = ((const f32x4*)p.g_mix)[lane + 64 * j];
            v[j].x *= rstd * g.x; v[j].y *= rstd * g.y; v[j].z *= rstd * g.z; v[j].w *= rstd * g.w;
            *(unsigned*)((unsigned char*)XN + (size_t)row * D + 4 * (lane + 64 * j)) = pk4_fp8(v[j].x * XN8_SCALE, v[j].y * XN8_SCALE, v[j].z * XN8_SCALE, v[j].w * XN8_SCALE);
#pragma unroll
            for (int f = 0; f < 8; ++f) { const f32x4 w = *(const LAS f32x4*)(WFt + f * D + 4 * (lane + 64 * j)); fs[f] += (v[j].x * w.x + v[j].y * w.y) + (v[j].z * w.z + v[j].w * w.w); }
        }
        float h4[4], g2[2];
#pragma unroll
        for (int i = 0; i < 4; ++i) { const float a = fs[i] + PRO_X(fs[i], 0xB1), b = fs[i + 4] + PRO_X(fs[i + 4], 0xB1); h4[i] = (lane & 1) ? b : a; }
#pragma unroll
        for (int i = 0; i < 2; ++i) { const float a = h4[i] + PRO_X(h4[i], 0x4E), b = h4[i + 2] + PRO_X(h4[i + 2], 0x4E); g2[i] = (lane & 2) ? b : a; }
        float z;
        { const float a = g2[0] + __builtin_bit_cast(float, __builtin_amdgcn_ds_bpermute((lane ^ 4) << 2, __builtin_bit_cast(int, g2[0]))), b = g2[1] + __builtin_bit_cast(float, __builtin_amdgcn_ds_bpermute((lane ^ 4) << 2, __builtin_bit_cast(int, g2[1]))); z = (lane & 4) ? b : a; }
        z = sum_x8(z); z = sum_x16(z); z = sum_x32(z);
        if (lane < 8) { const float lf = log_sigmoid(z + bfo); LOGF[(size_t)row * 8 + fo] = lf; wsum += lf; }
    }
    }
#undef PRO_X
    if (lane < 8) ((float*)(p.ws + WS_WSUM))[gw * 8 + fo] = wsum;
}

__device__ __forceinline__ void phase_cumsum(const P& p) {
    const int TID = otid();
    const int lane = TID & 63, gw = blockIdx.x * 8 + (TID >> 6), b = gw >> 10, w0 = b << 10, h = lane & 7, j = lane >> 3;
    const float* WSUM = (const float*)(p.ws + WS_WSUM); const float* LOGF = (const float*)(p.ws + WS_LOGF); float* C = (float*)(p.ws + WS_C);
    float part = 0.f;
    { float p1 = 0.f, p2 = 0.f, p3 = 0.f; int w = w0 + j;
      for (; w + 24 < gw; w += 32) { part += WSUM[w * 8 + h]; p1 += WSUM[(w + 8) * 8 + h]; p2 += WSUM[(w + 16) * 8 + h]; p3 += WSUM[(w + 24) * 8 + h]; }
      for (; w < gw; w += 8) part += WSUM[w * 8 + h];
      part = (part + p1) + (p2 + p3); }
    part += __shfl_xor(part, 8); part += __shfl_xor(part, 16); part += __shfl_xor(part, 32);
    if (lane < 8) { float run = part;
#pragma unroll
        for (int r = 0; r < 8; ++r) { const int row = gw * 8 + r; run += LOGF[(size_t)row * 8 + h]; C[(size_t)(b * 8 + h) * S + (row & (S - 1))] = run * LOG2E; } }
}

#include <hip/hip_bf16.h>
namespace attn {
using bf16=__hip_bfloat16;
using bf16x8=__attribute__((ext_vector_type(8)))short;
using s16x4=__attribute__((ext_vector_type(4)))short;
using f32x16=__attribute__((ext_vector_type(16)))float;
using f32x4=__attribute__((ext_vector_type(4)))float;
using u32x4=__attribute__((ext_vector_type(4)))unsigned;
constexpr int SEQ=8192,D=64,DM=512;
constexpr int NW=8,QBLK=32,QB=QBLK*NW,KVBLK=64;
__device__ __forceinline__ int crow(int r,int hi){return (r&3)+8*(r>>2)+4*hi;}
#define SBAR() __builtin_amdgcn_sched_barrier(0)
__device__ __forceinline__ void cmask(f32x16&p0,f32x16&p1,int jb,int qrel,int hi){
  const float NEG=-INFINITY; int kb=64*jb+4*hi;
  #pragma unroll
  for(int r=0;r<16;++r){int kv=kb+(r&3)+8*(r>>2); if(kv>qrel)p0[r]=NEG; if(kv+32>qrel)p1[r]=NEG;}
}
constexpr int KSUM_P1=16*32*64;
constexpr int NSLOT=3, SLOTB=8192;
constexpr int LDS_K=0, LDS_V=NSLOT*SLOTB, LDS_WS=2*NSLOT*SLOTB, LDS_OST=LDS_WS+NW*64*4, LDS_CK=LDS_OST+NW*4096, LDS_BYTES=LDS_CK+SEQ*4;
__device__ __forceinline__ void glds16(const void*gsrc,unsigned lds_dst){unsigned keep;
  asm volatile("s_mov_b32 %0, m0\n\ts_mov_b32 m0, %2\n\ts_nop 0\n\tglobal_load_lds_dwordx4 %1, off\n\ts_mov_b32 m0, %0":"=&s"(keep):"v"(gsrc),"s"(lds_dst):"memory");}
typedef float f32x2_t __attribute__((ext_vector_type(2))); typedef __bf16 bf16x2_t __attribute__((ext_vector_type(2)));
__device__ __forceinline__ unsigned cvtpk_s(float lo,float hi){f32x2_t v={lo,hi};bf16x2_t b=__builtin_convertvector(v,bf16x2_t);return __builtin_bit_cast(unsigned,b);}
#define WAIT_BAR(N) asm volatile("s_waitcnt vmcnt(" #N ") lgkmcnt(0)\n\ts_barrier":::"memory")
typedef __attribute__((address_space(3))) const char* lds_cptr;
typedef short v4i16_t __attribute__((ext_vector_type(4)));
__device__ __forceinline__ void kload8(bf16x8*kf,lds_cptr kp){
  kf[0]=*(const __attribute__((address_space(3))) bf16x8*)(kp);      kf[1]=*(const __attribute__((address_space(3))) bf16x8*)(kp+512);
  kf[2]=*(const __attribute__((address_space(3))) bf16x8*)(kp+2048); kf[3]=*(const __attribute__((address_space(3))) bf16x8*)(kp+2560);
  kf[4]=*(const __attribute__((address_space(3))) bf16x8*)(kp+4096); kf[5]=*(const __attribute__((address_space(3))) bf16x8*)(kp+4608);
  kf[6]=*(const __attribute__((address_space(3))) bf16x8*)(kp+6144); kf[7]=*(const __attribute__((address_space(3))) bf16x8*)(kp+6656);
}
__device__ __forceinline__ void kload2(bf16x8*kf,lds_cptr kp,int j){ kf[2*j]=*(const __attribute__((address_space(3))) bf16x8*)(kp+j*2048); kf[2*j+1]=*(const __attribute__((address_space(3))) bf16x8*)(kp+j*2048+512); }
__device__ __forceinline__ s16x4 vtr(lds_cptr p){ return __builtin_bit_cast(s16x4,__builtin_amdgcn_ds_read_tr16_b64_v4i16((__attribute__((address_space(3))) v4i16_t*)p)); }
template<bool FOX> __device__ __forceinline__ void cinit(f32x16&C,const __attribute__((address_space(3))) float*ckt,float bs){
  if constexpr(FOX){
    #pragma unroll
    for(int g=0;g<4;++g){ const f32x4 kb=*(const __attribute__((address_space(3))) f32x4*)(ckt+8*g); C[4*g]=bs-kb[0]; C[4*g+1]=bs-kb[1]; C[4*g+2]=bs-kb[2]; C[4*g+3]=bs-kb[3]; }
  } else {
    #pragma unroll
    for(int r=0;r<16;++r)C[r]=bs;
  }
  asm volatile("":"+v"(C));
}
__device__ __forceinline__ void pv(f32x16*o,int vb,bf16x8 pa0,bf16x8 pa1,bf16x8 pa2,bf16x8 pa3){
  #pragma unroll
  for(int d0=0;d0<2;++d0){s16x4 lo[4],hi[4];
    #pragma unroll
    for(int ks=0;ks<4;++ks){
      asm volatile("ds_read_b64_tr_b16 %0,%1 offset:%c2":"=&v"(lo[ks]):"v"(vb),"i"(d0*4096+ks*1024):"memory");
      asm volatile("ds_read_b64_tr_b16 %0,%1 offset:%c2":"=&v"(hi[ks]):"v"(vb),"i"(d0*4096+ks*1024+512):"memory");}
    asm volatile("s_waitcnt lgkmcnt(0)":::"memory");SBAR();
    #define PK(k) (bf16x8){lo[k][0],lo[k][1],lo[k][2],lo[k][3],hi[k][0],hi[k][1],hi[k][2],hi[k][3]}
    o[d0]=__builtin_amdgcn_mfma_f32_32x32x16_bf16(pa0,PK(0),o[d0],0,0,0);
    o[d0]=__builtin_amdgcn_mfma_f32_32x32x16_bf16(pa1,PK(1),o[d0],0,0,0);
    o[d0]=__builtin_amdgcn_mfma_f32_32x32x16_bf16(pa2,PK(2),o[d0],0,0,0);
    o[d0]=__builtin_amdgcn_mfma_f32_32x32x16_bf16(pa3,PK(3),o[d0],0,0,0);
    #undef PK
  }
}
#define ATTN_STORE16(p,v) (*(u32x4*)(p)=(v))
struct MobaIo { const unsigned short* QL; int qcnt, jblk; const unsigned* SEL3; bf16* PART0; bf16* PART1; bf16* PART2; float* LSE; };
template<bool FOX,int THRL,int VAR> __device__ __forceinline__ void attn_unit(int b,int h,int qb,int t0,const bf16*Q,const bf16*__restrict__ K,const bf16*__restrict__ V,bf16*O,const float*CK2,const MobaIo&mio,char*shm){
  const int tid=otid(),lane=tid&63,r32=lane&31,hi=lane>>5; const int wid=__builtin_amdgcn_readfirstlane(tid>>6);
  const long rowbase=(long)b*SEQ; const int q0=qb*QB;
  int qidx=q0+wid*QBLK+r32; bool qvalid=true;
  if constexpr(VAR==2){ const int li=wid*QBLK+r32; qvalid=li<mio.qcnt; qidx=(int)mio.QL[qvalid?li:mio.qcnt-1]; }
  const bf16*Qrow=Q+(rowbase+qidx)*DM+h*D;
  const bf16*Kh=K+(rowbase+(long)t0*KVBLK)*DM+h*D,*Vh=V+(rowbase+(long)t0*KVBLK)*DM+h*D;
  const unsigned lds0=(unsigned)(uintptr_t)shm;
  float*wsf=(float*)(shm+LDS_WS)+wid*64;
  const bf16*ksrc=Kh+(long)lane*DM+wid*8;
  const bf16*vsrc=Vh+(long)(16*(wid&3)+(lane>>2))*DM+(wid>>2)*32+(lane&3)*8;
  const unsigned kdst=lds0+LDS_K+wid*1024, vdst=lds0+LDS_V+wid*1024;
  #define DMA_K(t,slot) glds16(ksrc+(long)(t)*KVBLK*DM,(unsigned)__builtin_amdgcn_readfirstlane(kdst+(slot)))
  #define DMA_V(t,slot) glds16(vsrc+(long)(t)*KVBLK*DM,(unsigned)__builtin_amdgcn_readfirstlane(vdst+(slot)))
  const int vb0=(int)(lds0+LDS_V)+((lane>>4)&1)*32+(lane&3)*8+(4*hi+((lane&15)>>2))*64;
  bf16x8 kf[8];
  const lds_cptr shm3=(lds_cptr)shm; const lds_cptr kp0=shm3+LDS_K+hi*1024+r32*16; const lds_cptr vp0=shm3+LDS_V+((lane>>4)&1)*32+(lane&3)*8+(4*hi+((lane&15)>>2))*64;
  const __attribute__((address_space(3))) float*ckl=(const __attribute__((address_space(3))) float*)(shm3+LDS_CK)+4*hi;
  const int NT=(VAR==2)?4:(q0+QB)/KVBLK-t0;
  DMA_K(0,0);DMA_V(0,0);DMA_K(1,SLOTB);
  bf16x8 qr[4];
  #pragma unroll
  for(int d0=0;d0<4;++d0)qr[d0]=*reinterpret_cast<const bf16x8*>(&Qrow[d0*16+hi*8]);
  float cq2=0.f;
  if constexpr(FOX){ __attribute__((address_space(3))) f32x4*ck4=(__attribute__((address_space(3))) f32x4*)(shm3+LDS_CK); const f32x4*g4=(const f32x4*)CK2+t0*16;
    for(int i=tid;i<NT*16;i+=NW*64)ck4[i]=g4[i];
    cq2=CK2[q0+wid*QBLK+r32]; }
  float mhat=0.f,l_reg=0.f;f32x16 o[2];o[0]=f32x16{};o[1]=f32x16{};
  const int qrel=wid*QBLK+r32;
  #define CMASK(P0,P1,t) do{ if constexpr(VAR!=2){ int jb_=(t)-(NT-4); if(jb_>=0)cmask(P0,P1,jb_,qrel,hi); } }while(0)
  #define BASE(t) (FOX ? (cq2-mhat) : -mhat)
  bool resc=false,nmd=true; f32x16 negm=f32x16{}; asm volatile("":"+v"(negm));
  #define RESC() do{ if(resc){ asm volatile("s_waitcnt lgkmcnt(0)":::"memory"); \
      _Pragma("unroll") for(int d_=0;d_<2;++d_) _Pragma("unroll") for(int r=0;r<16;++r)o[d_][r]*=wsf[crow(r,hi)]; } }while(0)
  #define MX3(a,b,c) __builtin_fmaxf(__builtin_fmaxf((a),(b)),(c))
  #define DECIDE(C0,C1) do{ float a=MX3(C0[0],C0[1],C1[0]),b_=MX3(C0[2],C0[3],C1[1]); a=MX3(a,C1[2],C1[3]); \
      _Pragma("unroll") for(int r=4;r<16;r+=4){a=MX3(a,C0[r],C0[r+1]);b_=MX3(b_,C0[r+2],C0[r+3]);a=MX3(a,C1[r],C1[r+1]);b_=MX3(b_,C1[r+2],C1[r+3]);} \
      float rm=__builtin_fmaxf(a,b_); { auto rr=__builtin_amdgcn_permlane32_swap(__float_as_uint(rm),__float_as_uint(rm),false,false); rm=__builtin_fmaxf(__uint_as_float(rr[0]),__uint_as_float(rr[1])); } \
      resc=false; \
      if(__builtin_expect(__any(rm>(float)THRL),0)){ const float dl=(rm>(float)THRL)?rm:0.f; mhat+=dl;     \
        _Pragma("unroll") for(int r=0;r<16;++r){C0[r]-=dl;C1[r]-=dl;} \
        const float f=__builtin_amdgcn_exp2f(-dl); l_reg*=f; if(hi==0)wsf[r32]=f; resc=true; nmd=true; } }while(0)
  f32x16 pA0,pA1,pB0,pB1;
  int sl_prev=0,sl_cur=0,sl_next=SLOTB;
  #define ROT() do{sl_prev=sl_cur;sl_cur=sl_next;sl_next=(sl_next==(NSLOT-1)*SLOTB)?0:sl_next+SLOTB;}while(0)
  DMA_K(2,2*SLOTB);
  WAIT_BAR(3);
  { const float bs=BASE(0); cinit<FOX>(pA0,ckl,bs); cinit<FOX>(pA1,ckl+32,bs);
    const char*kb=shm+LDS_K+hi*1024+r32*16;
    #pragma unroll
    for(int d0=0;d0<4;++d0){
      const bf16x8 b0=*reinterpret_cast<const bf16x8*>(kb+d0*2048);
      const bf16x8 b1=*reinterpret_cast<const bf16x8*>(kb+d0*2048+512);
      pA0=__builtin_amdgcn_mfma_f32_32x32x16_bf16(b0,qr[d0],pA0,0,0,0);pA1=__builtin_amdgcn_mfma_f32_32x32x16_bf16(b1,qr[d0],pA1,0,0,0);}
    CMASK(pA0,pA1,0);
    DECIDE(pA0,pA1); resc=false;
    _Pragma("unroll") for(int r=0;r<16;++r){pA0[r]=__builtin_amdgcn_exp2f(pA0[r]);pA1[r]=__builtin_amdgcn_exp2f(pA1[r]);} }
  WAIT_BAR(0);
  DMA_K(3,0);DMA_V(1,SLOTB);
  ROT();
  kload8(kf,kp0+sl_cur);
  WAIT_BAR(2);
  s16x4 vlo[8],vhi[8]; u32x4 pw0,pw1,pw2,pw3;
  #define PKW(P,B) cvtpk_s(P[B],P[B+1])
  #define PAF(k) __builtin_bit_cast(bf16x8,pw##k)
  #define VFR(i) (bf16x8){vlo[i][0],vlo[i][1],vlo[i][2],vlo[i][3],vhi[i][0],vhi[i][1],vhi[i][2],vhi[i][3]}
  #define PIN(x) asm volatile("":"+v"(x))
  #define GAPA(MF,A0,A1,A2,A3,W0,W1,PW) do{ MF; sacc+=A0; sacc+=A1; sacc+=A2; sacc+=A3; PIN(sacc); W0; W1; PIN(PW); SBAR(); }while(0)
  #define EX(v) __builtin_amdgcn_exp2f(v)
  #define GAPB(MF,X,B) do{ MF; X[B]=EX(X[B]); X[B+1]=EX(X[B+1]); X[B+2]=EX(X[B+2]); X[B+3]=EX(X[B+3]); PIN(X); SBAR(); }while(0)
  #define VRD(i) do{ vlo[i]=vtr(vp_+(((i)>>2)*4096+((i)&3)*1024)); vhi[i]=vtr(vp_+(((i)>>2)*4096+((i)&3)*1024+512)); }while(0)
  #define KRD(G,j) do{ if(G){ kload2(kf,kp0+sl_next,j); SBAR(); } }while(0)
  #define STEP(C0,C1,P0,P1,t,GK,GV,GL) do{ SBAR(); \
    const lds_cptr vp_=vp0+sl_prev; const float bs_=BASE(t); \
    if constexpr(FOX){ cinit<FOX>(C0,ckl+(t)*64,bs_); SBAR(); } \
    else if(nmd){ _Pragma("unroll") for(int r=0;r<16;++r)negm[r]=bs_; asm volatile("":"+v"(negm)); nmd=false; SBAR(); }     \
    VRD(0); SBAR(); float sacc=(P0[0]+P0[1]); \
    GAPA(C0=__builtin_amdgcn_mfma_f32_32x32x16_bf16(kf[0],qr[0],FOX?C0:negm,0,0,0), P0[2],P0[3],P0[4],P0[5],     pw0[0]=PKW(P0,0), pw0[1]=PKW(P0,2), pw0); \
    if constexpr(FOX){ cinit<FOX>(C1,ckl+(t)*64+32,bs_); SBAR(); } \
    VRD(4); SBAR(); GAPA(C1=__builtin_amdgcn_mfma_f32_32x32x16_bf16(kf[1],qr[0],FOX?C1:negm,0,0,0), P0[6],P0[7],P0[8],P0[9],     pw0[2]=PKW(P0,4), pw0[3]=PKW(P0,6), pw0); \
    VRD(1); SBAR(); GAPA(C0=__builtin_amdgcn_mfma_f32_32x32x16_bf16(kf[2],qr[1],C0,0,0,0),   P0[10],P0[11],P0[12],P0[13], pw1[0]=PKW(P0,8), pw1[1]=PKW(P0,10), pw1); \
    VRD(5); SBAR(); GAPA(C1=__builtin_amdgcn_mfma_f32_32x32x16_bf16(kf[3],qr[1],C1,0,0,0),   P0[14],P0[15],P1[0],P1[1],   pw1[2]=PKW(P0,12),pw1[3]=PKW(P0,14), pw1); \
    VRD(2); SBAR(); GAPA(C0=__builtin_amdgcn_mfma_f32_32x32x16_bf16(kf[4],qr[2],C0,0,0,0),   P1[2],P1[3],P1[4],P1[5],     pw2[0]=PKW(P1,0), pw2[1]=PKW(P1,2), pw2); \
    VRD(6); SBAR(); GAPA(C1=__builtin_amdgcn_mfma_f32_32x32x16_bf16(kf[5],qr[2],C1,0,0,0),   P1[6],P1[7],P1[8],P1[9],     pw2[2]=PKW(P1,4), pw2[3]=PKW(P1,6), pw2); \
    VRD(3); SBAR(); GAPA(C0=__builtin_amdgcn_mfma_f32_32x32x16_bf16(kf[6],qr[3],C0,0,0,0),   P1[10],P1[11],P1[12],P1[13], pw3[0]=PKW(P1,8), pw3[1]=PKW(P1,10), pw3); \
    VRD(7); SBAR(); GAPA(C1=__builtin_amdgcn_mfma_f32_32x32x16_bf16(kf[7],qr[3],C1,0,0,0),   P1[14],P1[15],0.f,0.f,       pw3[2]=PKW(P1,12),pw3[3]=PKW(P1,14), pw3); \
    l_reg+=sacc; \
    if(GK){DMA_K((t)+3,sl_cur);} if(GV){DMA_V((t)+1,sl_next);} \
    CMASK(C0,C1,t); \
    DECIDE(C0,C1); \
    SBAR(); \
    GAPB(o[0]=__builtin_amdgcn_mfma_f32_32x32x16_bf16(PAF(0),VFR(0),o[0],0,0,0), C0,0); \
    GAPB(o[1]=__builtin_amdgcn_mfma_f32_32x32x16_bf16(PAF(0),VFR(4),o[1],0,0,0), C0,4); \
    KRD(GL,0); GAPB(o[0]=__builtin_amdgcn_mfma_f32_32x32x16_bf16(PAF(1),VFR(1),o[0],0,0,0), C0,8); \
    KRD(GL,1); GAPB(o[1]=__builtin_amdgcn_mfma_f32_32x32x16_bf16(PAF(1),VFR(5),o[1],0,0,0), C0,12); \
    KRD(GL,2); GAPB(o[0]=__builtin_amdgcn_mfma_f32_32x32x16_bf16(PAF(2),VFR(2),o[0],0,0,0), C1,0); \
    KRD(GL,3); GAPB(o[1]=__builtin_amdgcn_mfma_f32_32x32x16_bf16(PAF(2),VFR(6),o[1],0,0,0), C1,4); \
    GAPB(o[0]=__builtin_amdgcn_mfma_f32_32x32x16_bf16(PAF(3),VFR(3),o[0],0,0,0), C1,8); \
    GAPB(o[1]=__builtin_amdgcn_mfma_f32_32x32x16_bf16(PAF(3),VFR(7),o[1],0,0,0), C1,12); \
    }while(0)
  int t=1;
  #undef CMASK
  #define CMASK(P0,P1,t) do{}while(0)
  for(;t+5<NT;t+=2){
    STEP(pB0,pB1,pA0,pA1,t,true,true,true);     WAIT_BAR(2); RESC(); ROT();
    STEP(pA0,pA1,pB0,pB1,t+1,true,true,true);   WAIT_BAR(2); RESC(); ROT();
  }
  #undef CMASK
  #define CMASK(P0,P1,t) do{ if constexpr(VAR!=2){ int jb_=(t)-(NT-4); if(jb_>=0)cmask(P0,P1,jb_,qrel,hi); } }while(0)
  #define ENDW(tt) do{ if((tt)+3<NT){WAIT_BAR(2);} else if((tt)+2<NT){WAIT_BAR(1);} else {WAIT_BAR(0);} }while(0)
  for(;t+1<NT;t+=2){
    STEP(pB0,pB1,pA0,pA1,t,(t+3<NT),(t+1<NT),(t+1<NT));       ENDW(t);   RESC(); ROT();
    STEP(pA0,pA1,pB0,pB1,t+1,(t+4<NT),(t+2<NT),(t+2<NT));     ENDW(t+1); RESC(); ROT();
  }
  STEP(pB0,pB1,pA0,pA1,NT-1,false,false,false); RESC();
  { float sacc=pB0[0]+pB0[1]; _Pragma("unroll") for(int r=2;r<16;++r)sacc+=pB0[r]; _Pragma("unroll") for(int r=0;r<16;++r)sacc+=pB1[r]; l_reg+=sacc;
    pw0=(u32x4){PKW(pB0,0),PKW(pB0,2),PKW(pB0,4),PKW(pB0,6)};pw1=(u32x4){PKW(pB0,8),PKW(pB0,10),PKW(pB0,12),PKW(pB0,14)};pw2=(u32x4){PKW(pB1,0),PKW(pB1,2),PKW(pB1,4),PKW(pB1,6)};pw3=(u32x4){PKW(pB1,8),PKW(pB1,10),PKW(pB1,12),PKW(pB1,14)};
    SBAR(); pv(o,vb0+sl_cur,PAF(0),PAF(1),PAF(2),PAF(3)); }
  #undef PKW
  #undef PAF
  #undef VFR
  #undef PIN
  #undef MX3
  #undef GAPA
  #undef GAPB
  #undef EX
  #undef VRD
  #undef KRD
  #undef STEP
  #undef ENDW
  #undef DECIDE
  #undef BASE
  {auto rr=__builtin_amdgcn_permlane32_swap(__float_as_uint(l_reg),__float_as_uint(l_reg),false,false);l_reg=__uint_as_float(rr[0])+__uint_as_float(rr[1]);}
  int pslot=0;
  if constexpr(VAR==2){ const unsigned s3=mio.SEL3[qidx]; pslot=((int)(s3&31u)==mio.jblk)?0:(((int)((s3>>5)&31u)==mio.jblk)?1:2); }
  if(hi==0){ wsf[32+r32]=l_reg; if constexpr(VAR==2) wsf[r32]=__int_as_float(qvalid?(qidx*4+pslot):-1); }
  asm volatile("s_waitcnt lgkmcnt(0)":::"memory");
  if constexpr(VAR>=1){ if(hi==0&&qvalid) mio.LSE[(long)qidx*4+((VAR==1)?3:pslot)]=mhat+__builtin_amdgcn_logf(l_reg); }
  float rli[16];
  #pragma unroll
  for(int r=0;r<16;++r)rli[r]=__builtin_amdgcn_rcpf(wsf[32+crow(r,hi)]);
  { bf16*stg=(bf16*)(shm+LDS_OST)+wid*2048;
    #pragma unroll
    for(int r=0;r<16;++r){const int orow=crow(r,hi);
      #pragma unroll
      for(int d0=0;d0<2;++d0)stg[orow*64+d0*32+r32]=__float2bfloat16(o[d0][r]*rli[r]);}
    asm volatile("s_waitcnt lgkmcnt(0)":::"memory");
    if constexpr(VAR==2){
      #pragma unroll
      for(int i=0;i<4;++i){const int row=i*8+(lane>>3),ch=lane&7; const u32x4 v=*(const u32x4*)(stg+row*64+ch*8); const int inf=__float_as_int(wsf[row]);
        if(inf>=0){ bf16*pb=((inf&3)==0)?mio.PART0:(((inf&3)==1)?mio.PART1:mio.PART2); ATTN_STORE16(pb+(long)(inf>>2)*D+ch*8,v); } }
    } else if constexpr(VAR==1){
      bf16*Ow=mio.PART0+(long)(q0+wid*QBLK)*D;
      #pragma unroll
      for(int i=0;i<4;++i){const int row=i*8+(lane>>3),ch=lane&7; const u32x4 v=*(const u32x4*)(stg+row*64+ch*8); ATTN_STORE16(Ow+(long)row*D+ch*8,v);}
    } else {
      bf16*Ow=O+(rowbase+q0+wid*QBLK)*DM+h*D;
      #pragma unroll
      for(int i=0;i<4;++i){const int row=i*8+(lane>>3),ch=lane&7; const u32x4 v=*(const u32x4*)(stg+row*64+ch*8); ATTN_STORE16(Ow+(long)row*DM+ch*8,v);} } }
  asm volatile("s_waitcnt lgkmcnt(0)\n\ts_barrier":::"memory");
  #undef DMA_K
  #undef DMA_V
  #undef CMASK
  #undef RESC
  #undef ROT
}
template<bool OWN> __device__ __forceinline__ void moba4_unit(int b,int h,int qb,int jblk,int cnt,const bf16*Q,const bf16*__restrict__ K,const bf16*__restrict__ V,const MobaIo&mio,char*shm){
  constexpr bool FOX=false; constexpr int THRL=8, VAR=OWN?1:2; constexpr int LK=0,LV=4*SLOTB,LWS=8*SLOTB,LOST=LWS+NW*128*4;
  const int t0=4*jblk; bf16*O=nullptr; const float*CK2=nullptr; (void)O; (void)CK2;
  const int tid=otid(),lane=tid&63,r32=lane&31,hi=lane>>5; const int wid=__builtin_amdgcn_readfirstlane(tid>>6);
  const long rowbase=(long)b*SEQ; const int q0=qb*QB;
  const bf16*Kh=K+(rowbase+(long)t0*KVBLK)*DM+h*D,*Vh=V+(rowbase+(long)t0*KVBLK)*DM+h*D;
  const unsigned lds0=(unsigned)(uintptr_t)shm;
  float*wsf=(float*)(shm+LWS)+wid*128;
  const bf16*ksrc=Kh+(long)lane*DM+wid*8;
  const bf16*vsrc=Vh+(long)(16*(wid&3)+(lane>>2))*DM+(wid>>2)*32+(lane&3)*8;
  const unsigned kdst=lds0+LK+wid*1024, vdst=lds0+LV+wid*1024;
  #define DMA_K(t,slot) glds16(ksrc+(long)(t)*KVBLK*DM,(unsigned)__builtin_amdgcn_readfirstlane(kdst+(slot)))
  #define DMA_V(t,slot) glds16(vsrc+(long)(t)*KVBLK*DM,(unsigned)__builtin_amdgcn_readfirstlane(vdst+(slot)))
  const int vb0=(int)(lds0+LV)+((lane>>4)&1)*32+(lane&3)*8+(4*hi+((lane&15)>>2))*64;
  bf16x8 kf[8];
  const lds_cptr shm3=(lds_cptr)shm; const lds_cptr kp0=shm3+LK+hi*1024+r32*16; const lds_cptr vp0=shm3+LV+((lane>>4)&1)*32+(lane&3)*8+(4*hi+((lane&15)>>2))*64;
  const __attribute__((address_space(3))) float*ckl=(const __attribute__((address_space(3))) float*)(shm3+LWS)+4*hi;
  constexpr int NT=4; const float cq2=0.f; (void)cq2;
  DMA_K(0,0);DMA_V(0,0);DMA_K(1,SLOTB);DMA_V(1,SLOTB);DMA_K(2,2*SLOTB);DMA_V(2,2*SLOTB);DMA_K(3,3*SLOTB);DMA_V(3,3*SLOTB);
  const int nch=OWN?1:(cnt+QB-1)/QB;
  int qidx=q0+wid*QBLK+r32,qnext=0; unsigned s3=0u; bf16x8 qr[4];
  if constexpr(VAR==2){ qidx=(int)mio.QL[min(wid*QBLK+r32,cnt-1)]; s3=mio.SEL3[qidx]; qnext=(int)mio.QL[min(QB+wid*QBLK+r32,cnt-1)]; }
  { const bf16*Qrow=Q+(rowbase+qidx)*DM+h*D;
    #pragma unroll
    for(int d0=0;d0<4;++d0)qr[d0]=*reinterpret_cast<const bf16x8*>(&Qrow[d0*16+hi*8]); }
  for(int c_=0;c_<nch;++c_){
  bool qvalid=true; int pslot=0;
  if constexpr(VAR==2){ qvalid=(c_*QB+wid*QBLK+r32)<cnt; pslot=((int)(s3&31u)==jblk)?0:(((int)((s3>>5)&31u)==jblk)?1:2); }
  wsf[64+lane]=__int_as_float(qvalid?(qidx*4+(OWN?3:pslot)):-1);
  float mhat=0.f,l_reg=0.f;f32x16 o[2];o[0]=f32x16{};o[1]=f32x16{};
  const int qrel=wid*QBLK+r32;
  #define CMASK(P0,P1,t) do{ if constexpr(VAR!=2){ int jb_=(t)-(NT-4); if(jb_>=0)cmask(P0,P1,jb_,qrel,hi); } }while(0)
  #define BASE(t) (FOX ? (cq2-mhat) : -mhat)
  bool resc=false,nmd=true; f32x16 negm=f32x16{}; asm volatile("":"+v"(negm));
  #define RESC() do{ if(resc){ asm volatile("s_waitcnt lgkmcnt(0)":::"memory"); \
      _Pragma("unroll") for(int d_=0;d_<2;++d_) _Pragma("unroll") for(int r=0;r<16;++r)o[d_][r]*=wsf[crow(r,hi)]; } }while(0)
  #define MX3(a,b,c) __builtin_fmaxf(__builtin_fmaxf((a),(b)),(c))
  #define DECIDE(C0,C1) do{ float a=MX3(C0[0],C0[1],C1[0]),b_=MX3(C0[2],C0[3],C1[1]); a=MX3(a,C1[2],C1[3]); \
      _Pragma("unroll") for(int r=4;r<16;r+=4){a=MX3(a,C0[r],C0[r+1]);b_=MX3(b_,C0[r+2],C0[r+3]);a=MX3(a,C1[r],C1[r+1]);b_=MX3(b_,C1[r+2],C1[r+3]);} \
      float rm=__builtin_fmaxf(a,b_); { auto rr=__builtin_amdgcn_permlane32_swap(__float_as_uint(rm),__float_as_uint(rm),false,false); rm=__builtin_fmaxf(__uint_as_float(rr[0]),__uint_as_float(rr[1])); } \
      resc=false; \
      if(__builtin_expect(__any(rm>(float)THRL),0)){ const float dl=(rm>(float)THRL)?rm:0.f; mhat+=dl;     \
        _Pragma("unroll") for(int r=0;r<16;++r){C0[r]-=dl;C1[r]-=dl;} \
        const float f=__builtin_amdgcn_exp2f(-dl); l_reg*=f; if(hi==0)wsf[r32]=f; resc=true; nmd=true; } }while(0)
  f32x16 pA0,pA1,pB0,pB1;
  int sl_prev=0,sl_cur=0,sl_next=SLOTB;
  #define ROT() do{sl_prev=sl_cur;sl_cur=sl_next;sl_next=sl_next+SLOTB;}while(0)
  #define WAIT_NB() asm volatile("s_waitcnt lgkmcnt(0)":::"memory")
  if(c_==0){ WAIT_BAR(0); }
  { const float bs=BASE(0); cinit<FOX>(pA0,ckl,bs); cinit<FOX>(pA1,ckl+32,bs);
    const char*kb=shm+LK+hi*1024+r32*16;
    #pragma unroll
    for(int d0=0;d0<4;++d0){
      const bf16x8 b0=*reinterpret_cast<const bf16x8*>(kb+d0*2048);
      const bf16x8 b1=*reinterpret_cast<const bf16x8*>(kb+d0*2048+512);
      pA0=__builtin_amdgcn_mfma_f32_32x32x16_bf16(b0,qr[d0],pA0,0,0,0);pA1=__builtin_amdgcn_mfma_f32_32x32x16_bf16(b1,qr[d0],pA1,0,0,0);}
    CMASK(pA0,pA1,0);
    DECIDE(pA0,pA1); resc=false;
    _Pragma("unroll") for(int r=0;r<16;++r){pA0[r]=__builtin_amdgcn_exp2f(pA0[r]);pA1[r]=__builtin_amdgcn_exp2f(pA1[r]);} }
  WAIT_NB();
  ROT();
  kload8(kf,kp0+sl_cur);
  WAIT_NB();
  s16x4 vlo[8],vhi[8]; u32x4 pw0,pw1,pw2,pw3;
  #define PKW(P,B) cvtpk_s(P[B],P[B+1])
  #define PAF(k) __builtin_bit_cast(bf16x8,pw##k)
  #define VFR(i) (bf16x8){vlo[i][0],vlo[i][1],vlo[i][2],vlo[i][3],vhi[i][0],vhi[i][1],vhi[i][2],vhi[i][3]}
  #define PIN(x) asm volatile("":"+v"(x))
  #define GAPA(MF,A0,A1,A2,A3,W0,W1,PW) do{ MF; sacc+=A0; sacc+=A1; sacc+=A2; sacc+=A3; PIN(sacc); W0; W1; PIN(PW); SBAR(); }while(0)
  #define EX(v) __builtin_amdgcn_exp2f(v)
  #define GAPB(MF,X,B) do{ MF; X[B]=EX(X[B]); X[B+1]=EX(X[B+1]); X[B+2]=EX(X[B+2]); X[B+3]=EX(X[B+3]); PIN(X); SBAR(); }while(0)
  #define VRD(i) do{ vlo[i]=vtr(vp_+(((i)>>2)*4096+((i)&3)*1024)); vhi[i]=vtr(vp_+(((i)>>2)*4096+((i)&3)*1024+512)); }while(0)
  #define KRD(G,j) do{ if(G){ kload2(kf,kp0+sl_next,j); SBAR(); } }while(0)
  #define STEP(C0,C1,P0,P1,t,GK,GV,GL) do{ SBAR(); \
    const lds_cptr vp_=vp0+sl_prev; const float bs_=BASE(t); \
    if constexpr(FOX){ cinit<FOX>(C0,ckl+(t)*64,bs_); SBAR(); } \
    else if(nmd){ _Pragma("unroll") for(int r=0;r<16;++r)negm[r]=bs_; asm volatile("":"+v"(negm)); nmd=false; SBAR(); }     \
    VRD(0); SBAR(); float sacc=(P0[0]+P0[1]); \
    GAPA(C0=__builtin_amdgcn_mfma_f32_32x32x16_bf16(kf[0],qr[0],FOX?C0:negm,0,0,0), P0[2],P0[3],P0[4],P0[5],     pw0[0]=PKW(P0,0), pw0[1]=PKW(P0,2), pw0); \
    if constexpr(FOX){ cinit<FOX>(C1,ckl+(t)*64+32,bs_); SBAR(); } \
    VRD(4); SBAR(); GAPA(C1=__builtin_amdgcn_mfma_f32_32x32x16_bf16(kf[1],qr[0],FOX?C1:negm,0,0,0), P0[6],P0[7],P0[8],P0[9],     pw0[2]=PKW(P0,4), pw0[3]=PKW(P0,6), pw0); \
    VRD(1); SBAR(); GAPA(C0=__builtin_amdgcn_mfma_f32_32x32x16_bf16(kf[2],qr[1],C0,0,0,0),   P0[10],P0[11],P0[12],P0[13], pw1[0]=PKW(P0,8), pw1[1]=PKW(P0,10), pw1); \
    VRD(5); SBAR(); GAPA(C1=__builtin_amdgcn_mfma_f32_32x32x16_bf16(kf[3],qr[1],C1,0,0,0),   P0[14],P0[15],P1[0],P1[1],   pw1[2]=PKW(P0,12),pw1[3]=PKW(P0,14), pw1); \
    VRD(2); SBAR(); GAPA(C0=__builtin_amdgcn_mfma_f32_32x32x16_bf16(kf[4],qr[2],C0,0,0,0),   P1[2],P1[3],P1[4],P1[5],     pw2[0]=PKW(P1,0), pw2[1]=PKW(P1,2), pw2); \
    VRD(6); SBAR(); GAPA(C1=__builtin_amdgcn_mfma_f32_32x32x16_bf16(kf[5],qr[2],C1,0,0,0),   P1[6],P1[7],P1[8],P1[9],     pw2[2]=PKW(P1,4), pw2[3]=PKW(P1,6), pw2); \
    VRD(3); SBAR(); GAPA(C0=__builtin_amdgcn_mfma_f32_32x32x16_bf16(kf[6],qr[3],C0,0,0,0),   P1[10],P1[11],P1[12],P1[13], pw3[0]=PKW(P1,8), pw3[1]=PKW(P1,10), pw3); \
    VRD(7); SBAR(); GAPA(C1=__builtin_amdgcn_mfma_f32_32x32x16_bf16(kf[7],qr[3],C1,0,0,0),   P1[14],P1[15],0.f,0.f,       pw3[2]=PKW(P1,12),pw3[3]=PKW(P1,14), pw3); \
    l_reg+=sacc; \
    if(GK){DMA_K((t)+3,sl_cur);} if(GV){DMA_V((t)+1,sl_next);} \
    CMASK(C0,C1,t); \
    DECIDE(C0,C1); \
    SBAR(); \
    GAPB(o[0]=__builtin_amdgcn_mfma_f32_32x32x16_bf16(PAF(0),VFR(0),o[0],0,0,0), C0,0); \
    GAPB(o[1]=__builtin_amdgcn_mfma_f32_32x32x16_bf16(PAF(0),VFR(4),o[1],0,0,0), C0,4); \
    KRD(GL,0); GAPB(o[0]=__builtin_amdgcn_mfma_f32_32x32x16_bf16(PAF(1),VFR(1),o[0],0,0,0), C0,8); \
    KRD(GL,1); GAPB(o[1]=__builtin_amdgcn_mfma_f32_32x32x16_bf16(PAF(1),VFR(5),o[1],0,0,0), C0,12); \
    KRD(GL,2); GAPB(o[0]=__builtin_amdgcn_mfma_f32_32x32x16_bf16(PAF(2),VFR(2),o[0],0,0,0), C1,0); \
    KRD(GL,3); GAPB(o[1]=__builtin_amdgcn_mfma_f32_32x32x16_bf16(PAF(2),VFR(6),o[1],0,0,0), C1,4); \
    GAPB(o[0]=__builtin_amdgcn_mfma_f32_32x32x16_bf16(PAF(3),VFR(3),o[0],0,0,0), C1,8); \
    GAPB(o[1]=__builtin_amdgcn_mfma_f32_32x32x16_bf16(PAF(3),VFR(7),o[1],0,0,0), C1,12); \
    }while(0)
  int t=1;
  #undef CMASK
  #define CMASK(P0,P1,t) do{}while(0)
  for(;t+5<NT;t+=2){
    STEP(pB0,pB1,pA0,pA1,t,false,false,true);     WAIT_NB(); RESC(); ROT();
    STEP(pA0,pA1,pB0,pB1,t+1,false,false,true);   WAIT_NB(); RESC(); ROT();
  }
  #undef CMASK
  #define CMASK(P0,P1,t) do{ if constexpr(VAR!=2){ int jb_=(t)-(NT-4); if(jb_>=0)cmask(P0,P1,jb_,qrel,hi); } }while(0)
  #define ENDW(tt) WAIT_NB()
  for(;t+1<NT;t+=2){
    STEP(pB0,pB1,pA0,pA1,t,false,false,(t+1<NT));       ENDW(t);   RESC(); ROT();
    STEP(pA0,pA1,pB0,pB1,t+1,false,false,(t+2<NT));     ENDW(t+1); RESC(); ROT();
  }
  STEP(pB0,pB1,pA0,pA1,NT-1,false,false,false); RESC();
  if constexpr(VAR==2){ if(c_+1<nch){ qidx=qnext; const bf16*Qrow=Q+(rowbase+qidx)*DM+h*D;
      #pragma unroll
      for(int d0=0;d0<4;++d0)qr[d0]=*reinterpret_cast<const bf16x8*>(&Qrow[d0*16+hi*8]);
      s3=mio.SEL3[qidx]; qnext=(int)mio.QL[min((c_+2)*QB+wid*QBLK+r32,cnt-1)]; } }
  { float sacc=pB0[0]+pB0[1]; _Pragma("unroll") for(int r=2;r<16;++r)sacc+=pB0[r]; _Pragma("unroll") for(int r=0;r<16;++r)sacc+=pB1[r]; l_reg+=sacc;
    pw0=(u32x4){PKW(pB0,0),PKW(pB0,2),PKW(pB0,4),PKW(pB0,6)};pw1=(u32x4){PKW(pB0,8),PKW(pB0,10),PKW(pB0,12),PKW(pB0,14)};pw2=(u32x4){PKW(pB1,0),PKW(pB1,2),PKW(pB1,4),PKW(pB1,6)};pw3=(u32x4){PKW(pB1,8),PKW(pB1,10),PKW(pB1,12),PKW(pB1,14)};
    SBAR(); pv(o,vb0+sl_cur,PAF(0),PAF(1),PAF(2),PAF(3)); }
  #undef PKW
  #undef PAF
  #undef VFR
  #undef PIN
  #undef MX3
  #undef GAPA
  #undef GAPB
  #undef EX
  #undef VRD
  #undef KRD
  #undef STEP
  #undef ENDW
  #undef DECIDE
  #undef BASE
  {auto rr=__builtin_amdgcn_permlane32_swap(__float_as_uint(l_reg),__float_as_uint(l_reg),false,false);l_reg=__uint_as_float(rr[0])+__uint_as_float(rr[1]);}
  const int info=__float_as_int(wsf[64+lane]);
  if(hi==0){ wsf[32+r32]=l_reg; if constexpr(VAR==2) wsf[r32]=__int_as_float(info); }
  asm volatile("s_waitcnt lgkmcnt(0)":::"memory");
  if(hi==0&&info>=0) mio.LSE[info]=mhat+__builtin_amdgcn_logf(l_reg);
  float rli[16];
  #pragma unroll
  for(int r=0;r<16;++r)rli[r]=__builtin_amdgcn_rcpf(wsf[32+crow(r,hi)]);
  { bf16*stg=(bf16*)(shm+LOST)+wid*2048;
    #pragma unroll
    for(int r=0;r<16;++r){const int orow=crow(r,hi);
      #pragma unroll
      for(int d0=0;d0<2;++d0)stg[orow*64+d0*32+r32]=__float2bfloat16(o[d0][r]*rli[r]);}
    asm volatile("s_waitcnt lgkmcnt(0)":::"memory");
    if constexpr(VAR==2){
      #pragma unroll
      for(int i=0;i<4;++i){const int row=i*8+(lane>>3),ch=lane&7; const u32x4 v=*(const u32x4*)(stg+row*64+ch*8); const int inf=__float_as_int(wsf[row]);
        if(inf>=0){ bf16*pb=((inf&3)==0)?mio.PART0:(((inf&3)==1)?mio.PART1:mio.PART2); ATTN_STORE16(pb+(long)(inf>>2)*D+ch*8,v); } }
    } else if constexpr(VAR==1){
      bf16*Ow=mio.PART0+(long)(q0+wid*QBLK)*D;
      #pragma unroll
      for(int i=0;i<4;++i){const int row=i*8+(lane>>3),ch=lane&7; const u32x4 v=*(const u32x4*)(stg+row*64+ch*8); ATTN_STORE16(Ow+(long)row*D+ch*8,v);}
    } else {
      bf16*Ow=O+(rowbase+q0+wid*QBLK)*DM+h*D;
      #pragma unroll
      for(int i=0;i<4;++i){const int row=i*8+(lane>>3),ch=lane&7; const u32x4 v=*(const u32x4*)(stg+row*64+ch*8); ATTN_STORE16(Ow+(long)row*DM+ch*8,v);} } }
  asm volatile("s_waitcnt lgkmcnt(0)":::"memory");
  }
  #undef WAIT_NB
  #undef DMA_K
  #undef DMA_V
  #undef CMASK
  #undef RESC
  #undef ROT
}

__device__ __forceinline__ void moba_gate_item(int b,int h,int qb,const bf16*Q,const float*KSUM,unsigned*SEL3,unsigned*CNT,unsigned short*LIST){
  const int tid=otid(),lane=tid&63,r32=lane&31,hi=lane>>5; const int wid=__builtin_amdgcn_readfirstlane(tid>>6);
  const int q=qb*QB+wid*QBLK+r32;
  const bf16*Qrow=Q+((long)b*SEQ+q)*DM+h*D;
  bf16x8 qr[4];
  #pragma unroll
  for(int d0=0;d0<4;++d0)qr[d0]=*reinterpret_cast<const bf16x8*>(&Qrow[d0*16+hi*8]);
  f32x16 ga=f32x16{};
  const float*km=KSUM+r32*64+8*hi;
  #pragma unroll
  for(int ks=0;ks<4;++ks){
    const f32x4 a0=*(const f32x4*)(km+16*ks),a1=*(const f32x4*)(km+16*ks+4),c0=*(const f32x4*)(km+KSUM_P1+16*ks),c1=*(const f32x4*)(km+KSUM_P1+16*ks+4);
    float x[8]; u32x4 fh,fl;
    #pragma unroll
    for(int e=0;e<4;++e){x[e]=a0[e]+c0[e];x[4+e]=a1[e]+c1[e];}
    #pragma unroll
    for(int e=0;e<4;++e){ const unsigned hw=cvtpk_s(x[2*e],x[2*e+1]); fh[e]=hw; fl[e]=cvtpk_s(x[2*e]-__uint_as_float(hw<<16),x[2*e+1]-__uint_as_float(hw&0xffff0000u)); }
    ga=__builtin_amdgcn_mfma_f32_32x32x16_bf16(__builtin_bit_cast(bf16x8,fh),qr[ks],ga,0,0,0);
    ga=__builtin_amdgcn_mfma_f32_32x32x16_bf16(__builtin_bit_cast(bf16x8,fl),qr[ks],ga,0,0,0);
  }
  unsigned t0=0u,t1=0u,t2=0u;
  #define INS3(x) do{ unsigned x_=(x); unsigned m_=max(t0,x_); x_=min(t0,x_); t0=m_; m_=max(t1,x_); x_=min(t1,x_); t1=m_; t2=max(t2,x_); }while(0)
  #pragma unroll
  for(int r=0;r<16;++r){ const int n=(r&3)+8*(r>>2)+4*hi; const unsigned u_=__float_as_uint(ga[r]); const unsigned o_=u_^((unsigned)((int)u_>>31)|0x80000000u);
    const unsigned key=(n<qb)?((o_&~31u)|(unsigned)(31-n)):0u; INS3(key); }
  { const unsigned p0=(unsigned)__shfl_xor((int)t0,32),p1=(unsigned)__shfl_xor((int)t1,32),p2=(unsigned)__shfl_xor((int)t2,32); INS3(p0); INS3(p1); INS3(p2); }
  #undef INS3
  const int n0=t0?(int)(31u-(t0&31u)):-1,n1=t1?(int)(31u-(t1&31u)):-1,n2=t2?(int)(31u-(t2&31u)):-1;
  const unsigned cntv=(t0?1u:0u)+(t1?1u:0u)+(t2?1u:0u);
  if(hi==0)SEL3[q]=(unsigned)(n0&31)|((unsigned)(n1&31)<<5)|((unsigned)(n2&31)<<10)|(cntv<<15);
  unsigned mycnt=0u; int rk0=0,rk1=0,rk2=0; const unsigned long long below=(1ull<<r32)-1ull;
  for(int j=0;j<qb;++j){ const unsigned long long m=__ballot(hi==0&&(n0==j||n1==j||n2==j))&0xffffffffull; const int pc=__builtin_popcountll(m);
    if(lane==j)mycnt=(unsigned)pc; const int rk=__builtin_popcountll(m&below); if(n0==j)rk0=rk; if(n1==j)rk1=rk; if(n2==j)rk2=rk; }
  unsigned basev=0u;
  if(lane<qb&&mycnt)basev=__hip_atomic_fetch_add(CNT+lane,mycnt,__ATOMIC_RELAXED,__HIP_MEMORY_SCOPE_AGENT);
  const unsigned b0=(unsigned)__shfl((int)basev,n0<0?0:n0),b1=(unsigned)__shfl((int)basev,n1<0?0:n1),b2=(unsigned)__shfl((int)basev,n2<0?0:n2);
  if(hi==0){ if(n0>=0)LIST[(long)n0*SEQ+b0+rk0]=(unsigned short)q; if(n1>=0)LIST[(long)n1*SEQ+b1+rk1]=(unsigned short)q; if(n2>=0)LIST[(long)n2*SEQ+b2+rk2]=(unsigned short)q; }
}
#undef SBAR
#undef WAIT_BAR
}

constexpr float FOX_SKIP = 32.0f;
constexpr size_t WS_QCTR = 32 * KiB;
__device__ __forceinline__ void phase_attn(char* lds, volatile LAS unsigned* misc, const P& p) {
    attn::bf16* QKVb = (attn::bf16*)(p.ws + WS_QKV);
    unsigned* qctr = (unsigned*)(p.ws + WS_QCTR); unsigned* MCNT = (unsigned*)(p.ws + WS_MCNT); unsigned* MG1 = (unsigned*)(p.ws + WS_MG1);
    bool g1seen = false; const attn::MobaIo mio0{};
    volatile LAS unsigned* CNL = misc + 64;
    for (;;) {
        if (threadIdx.x == 0) misc[16] = __hip_atomic_fetch_add(qctr, 1u, __ATOMIC_RELAXED, __HIP_MEMORY_SCOPE_AGENT);
        __syncthreads();
        const int u = (int)__builtin_amdgcn_readfirstlane((int)misc[16]);
        __syncthreads();
        if (u >= 2032) break;
        if (u < 512) {
            const int bh = u & 15, qb = u >> 4;
            attn::moba_gate_item(bh >> 3, bh & 7, qb, QKVb, (const float*)(p.ws + WS_KMP) + (size_t)bh * 32 * 64, (unsigned*)(p.ws + WS_SEL3) + (size_t)bh * S, MCNT + bh * 32, (unsigned short*)(p.ws + WS_MLIST) + (size_t)bh * 32 * S);
            asm volatile("s_waitcnt vmcnt(0)" ::: "memory");
            __syncthreads();
            if (threadIdx.x == 0) { __builtin_amdgcn_fence(__ATOMIC_RELEASE, "agent"); asm volatile("s_waitcnt vmcnt(0)" ::: "memory");
                const unsigned old = __hip_atomic_fetch_add(MG1, 1u, __ATOMIC_RELAXED, __HIP_MEMORY_SCOPE_AGENT);
                if (old == 511u) { __builtin_amdgcn_fence(__ATOMIC_ACQ_REL, "agent"); asm volatile("s_waitcnt vmcnt(0)" ::: "memory"); __hip_atomic_store(MG1 + 64, 1u, __ATOMIC_RELAXED, __HIP_MEMORY_SCOPE_AGENT); } }
            continue;
        }
        if (u >= 1008 && u < 1520) {
            const int v = u - 1008, qb = 31 - (v >> 4), bh = v & 15;
            const float* c2 = (const float*)(p.ws + WS_C) + (size_t)bh * S; const int lane = threadIdx.x & 63, nt = 4 * qb + 4;
            const float cq = c2[qb * 256];
            const float* FK = (const float*)(p.ws + WS_FKN) + (size_t)bh * 256; const float* FQ = (const float*)(p.ws + WS_FQN) + ((size_t)bh * 32 + qb) * 4;
#define FOX_KN(t) sqrtf(FK[2 * (t)] + FK[2 * (t) + 1])
            const float qm = sqrtf(fmaxf(FQ[0] + FQ[1], FQ[2] + FQ[3])), ko = fmaxf(fmaxf(FOX_KN(4 * qb), FOX_KN(4 * qb + 1)), fmaxf(FOX_KN(4 * qb + 2), FOX_KN(4 * qb + 3)));
            const float th0 = (lane < nt) ? 1.01f * qm * (FOX_KN(lane) + ko) + FOX_SKIP : 0.f, th1 = (lane + 64 < nt) ? 1.01f * qm * (FOX_KN(lane + 64) + ko) + FOX_SKIP : 0.f;
#undef FOX_KN
            const bool keep0 = (lane < nt) ? (cq - c2[64 * lane + 63] >= -th0) : true, keep1 = (lane + 64 < nt) ? (cq - c2[64 * (lane + 64) + 63] >= -th1) : true;
            const unsigned long long m0 = __ballot(keep0), m1 = __ballot(keep1);
            int first = m0 ? __builtin_ctzll(m0) : 64 + __builtin_ctzll(m1);
            int t0 = first & ~1; if (t0 > nt - 4) t0 = nt - 4;
            t0 = __builtin_amdgcn_readfirstlane(t0);
            attn::attn_unit<true, 24, 0>(bh >> 3, bh & 7, qb, t0, QKVb + SLOT, QKVb + 4 * SLOT, QKVb + 5 * SLOT, QKVb + SLOT, c2, mio0, lds);
            continue;
        }
        if (!g1seen) {
            if (threadIdx.x == 0) { unsigned sp = 0u;
                while (__hip_atomic_load(MG1 + 64, __ATOMIC_RELAXED, __HIP_MEMORY_SCOPE_AGENT) == 0u) { __builtin_amdgcn_s_sleep(8); if (++sp > (1u << 22)) break; }
                __builtin_amdgcn_fence(__ATOMIC_ACQUIRE, "agent"); asm volatile("s_waitcnt vmcnt(0)" ::: "memory"); }
            __syncthreads();
            CNL[threadIdx.x] = __hip_atomic_load(MCNT + threadIdx.x, __ATOMIC_RELAXED, __HIP_MEMORY_SCOPE_AGENT);
            __syncthreads();
            g1seen = true;
        }
        attn::MobaIo mio{};
        if (u < 1008) {
            const int v = u - 512, j = v >> 4, bh = v & 15, cnt = (int)__builtin_amdgcn_readfirstlane((int)CNL[bh * 32 + j]);
            if (cnt == 0) continue;
            mio.QL = (const unsigned short*)(p.ws + WS_MLIST) + ((size_t)bh * 32 + j) * S; mio.SEL3 = (const unsigned*)(p.ws + WS_SEL3) + (size_t)bh * S; mio.LSE = (float*)(p.ws + WS_MLSE) + (size_t)bh * S * 4;
            mio.PART0 = (attn::bf16*)(p.ws + WS_MP0) + (size_t)bh * S * 64; mio.PART1 = (attn::bf16*)(p.ws + WS_MP1) + (size_t)bh * S * 64; mio.PART2 = (attn::bf16*)(p.ws + WS_MP2) + (size_t)bh * S * 64;
            attn::moba4_unit<false>(bh >> 3, bh & 7, 0, j, cnt, QKVb, QKVb + 2 * SLOT, QKVb + 3 * SLOT, mio, lds);
        } else {
            const int v = u - 1520, qb = v >> 4, bh = v & 15;
            mio.LSE = (float*)(p.ws + WS_MLSE) + (size_t)bh * S * 4; mio.PART0 = (attn::bf16*)(p.ws + WS_MP3) + (size_t)bh * S * 64;
            attn::moba4_unit<true>(bh >> 3, bh & 7, qb, qb, 256, QKVb, QKVb + 2 * SLOT, QKVb + 3 * SLOT, mio, lds);
        }
    }
}
__device__ __forceinline__ void phase_moba_combine(const P& p) {
    const int TID = otid();
    bf16_t* OA = (bf16_t*)(p.ws + WS_QKV); const unsigned* SEL3 = (const unsigned*)(p.ws + WS_SEL3); const float* LSE = (const float*)(p.ws + WS_MLSE);
    const bf16_t* P0 = (const bf16_t*)(p.ws + WS_MP0); const bf16_t* P1 = (const bf16_t*)(p.ws + WS_MP1); const bf16_t* P2 = (const bf16_t*)(p.ws + WS_MP2); const bf16_t* P3 = (const bf16_t*)(p.ws + WS_MP3);
    for (int it = blockIdx.x * 512 + TID; it < Bn * NH * S * 8; it += gridDim.x * 512) {
        const int ch = it & 7, bq = it >> 3, bh = bq >> 13, q = bq & (S - 1), b = bh >> 3, h = bh & 7;
        const unsigned n = SEL3[bq] >> 15;
        bf16_t* orow = OA + ((size_t)b * S + q) * 512 + h * 64 + ch * 8;
        const u32x4 own = *(const u32x4*)(P3 + (size_t)bq * 64 + ch * 8);
        if (n == 0u) { *(u32x4*)orow = own; continue; }
        const f32x4 ls = *(const f32x4*)(LSE + (size_t)bq * 4);
        float m = fmaxf(ls[3], ls[0]); if (n > 1u) m = fmaxf(m, ls[1]); if (n > 2u) m = fmaxf(m, ls[2]);
        const float w3 = __builtin_amdgcn_exp2f(ls[3] - m), w0 = __builtin_amdgcn_exp2f(ls[0] - m), w1 = (n > 1u) ? __builtin_amdgcn_exp2f(ls[1] - m) : 0.f, w2 = (n > 2u) ? __builtin_amdgcn_exp2f(ls[2] - m) : 0.f;
        const float rw = 1.f / (w3 + w0 + w1 + w2);
        f32x4 a0, a1, x0, x1; pg8::unpack8(own, a0, a1); a0 = a0 * w3; a1 = a1 * w3;
        pg8::unpack8(*(const u32x4*)(P0 + (size_t)bq * 64 + ch * 8), x0, x1); a0 += x0 * w0; a1 += x1 * w0;
        if (n > 1u) { pg8::unpack8(*(const u32x4*)(P1 + (size_t)bq * 64 + ch * 8), x0, x1); a0 += x0 * w1; a1 += x1 * w1; }
        if (n > 2u) { pg8::unpack8(*(const u32x4*)(P2 + (size_t)bq * 64 + ch * 8), x0, x1); a0 += x0 * w2; a1 += x1 * w2; }
        *(u32x4*)orow = pg8::pack8(a0 * rw, a1 * rw);
    }
}

typedef float f32x2v __attribute__((ext_vector_type(2)));
__device__ __forceinline__ unsigned q8_pack(const f32x4& a, float sc, int bias) {
    const int q0 = (int)rintf(a[0] * sc) + bias, q1 = (int)rintf(a[1] * sc) + bias, q2 = (int)rintf(a[2] * sc) + bias, q3 = (int)rintf(a[3] * sc) + bias;
    return (unsigned)(q0 & 0xff) | ((unsigned)(q1 & 0xff) << 8) | ((unsigned)(q2 & 0xff) << 16) | ((unsigned)(q3 & 0xff) << 24); }
__device__ __forceinline__ void q8_row(const float* src, const float* gain, unsigned char* dst, size_t sstride, float* scale_out, int lane, int bias) {
    f32x4 a[4]; float am = 0.f;
#pragma unroll
    for (int q = 0; q < 4; ++q) { a[q] = *(const f32x4*)(src + 16 * lane + 4 * q);
        if (gain) { const f32x4 g = *(const f32x4*)(gain + 16 * lane + 4 * q); a[q][0] *= g[0]; a[q][1] *= g[1]; a[q][2] *= g[2]; a[q][3] *= g[3]; }
        am = fmaxf(fmaxf(am, fmaxf(fabsf(a[q][0]), fabsf(a[q][1]))), fmaxf(fabsf(a[q][2]), fabsf(a[q][3]))); }
    am = wave_max_fast(am);
    const float sc = am > 0.f ? 127.0f / am : 1.0f;
    u32x4 o;
#pragma unroll
    for (int q = 0; q < 4; ++q) o[q] = q8_pack(a[q], sc, bias);
    *(u32x4*)(dst + (sstride ? (size_t)(lane >> 3) * sstride + 16 * (lane & 7) : (size_t)16 * lane)) = o;
    if (lane == 0) *scale_out = am > 0.f ? am * (1.0f / 127.0f) : 1.0f;
}
template <bool USGN> __device__ __forceinline__ void q4_row(const float* src, const float* gain, unsigned char* dst, float* scale_out, int lane) {
    f32x4 a[4]; float ss = 0.f;
#pragma unroll
    for (int q = 0; q < 4; ++q) { a[q] = *(const f32x4*)(src + 16 * lane + 4 * q);
        if (gain) { const f32x4 g = *(const f32x4*)(gain + 16 * lane + 4 * q); a[q][0] *= g[0]; a[q][1] *= g[1]; a[q][2] *= g[2]; a[q][3] *= g[3]; }
        ss += (a[q][0] * a[q][0] + a[q][1] * a[q][1]) + (a[q][2] * a[q][2] + a[q][3] * a[q][3]); }
    ss = wave_sum_fast(ss);
    const float step = sqrtf(ss * (1.f / D)) * 0.3352f, inv = step > 0.f ? 1.0f / step : 0.f;
    u32x2 o; o[0] = 0u; o[1] = 0u;
    int qs = 0;
#pragma unroll
    for (int i = 0; i < 16; ++i) { int q = (int)floorf(a[i >> 2][i & 3] * inv); q = min(max(q, -8), 7); qs += q;
        o[i >> 3] |= (unsigned)((USGN || (i & 1)) ? (q & 15) : (q + 8)) << (4 * (i & 7)); }
    *(u32x2*)(dst + (size_t)(lane >> 4) * ESLICE + 8 * (lane & 15)) = o;
    if (USGN) { const float rs = wave_sum_fast((float)qs); if (lane == 0) scale_out[2 * PNK * PNK] = rs; }
    if (lane == 0) *scale_out = step > 0.f ? step : 1.0f;
}
__device__ __forceinline__ void phase_expert_tables(const P& p) {
    const int TID = otid();
    const int lane = TID & 63, gw = (blockIdx.x * blockDim.x + TID) >> 6, nw = (gridDim.x * blockDim.x) >> 6;
    for (int r = gw; r < PNK * PNK; r += nw) {
        q4_row<true>(p.eu + (size_t)r * D, p.g_ffn, p.ws + WS_EU + (size_t)r * 128, (float*)(p.ws + WS_USC) + r, lane);
        q4_row<false>(p.ev + (size_t)r * D, nullptr, p.ws + WS_EV + (size_t)r * 128, (float*)(p.ws + WS_VSC) + r, lane);
    }
}

typedef short bf16x8_t __attribute__((ext_vector_type(8)));
typedef float f32x16_t __attribute__((ext_vector_type(16)));
__device__ __forceinline__ unsigned f2ord(float f) { const unsigned u = __float_as_uint(f); return u ^ ((unsigned)((int)u >> 31) | 0x80000000u); }
__device__ __forceinline__ float ord2f(unsigned k) { return __uint_as_float((k & 0x80000000u) ? (k ^ 0x80000000u) : ~k); }
#define TK_CAS(a, b, desc) do { const unsigned hi__ = max(a, b), lo__ = min(a, b); if (desc) { a = hi__; b = lo__; } else { a = lo__; b = hi__; } } while (0)
__device__ __forceinline__ void tk_sort16(unsigned (&v)[16]) {
#define C(i, j) TK_CAS(v[i], v[j], true);
    C(0,1) C(2,3) C(0,2) C(1,3) C(1,2) C(4,5) C(6,7) C(4,6) C(5,7) C(5,6) C(0,4) C(2,6) C(2,4) C(1,5) C(3,7) C(3,5) C(1,2) C(3,4) C(5,6) C(8,9) C(10,11) C(8,10) C(9,11) C(9,10) C(12,13) C(14,15) C(12,14) C(13,15) C(13,14) C(8,12) C(10,14) C(10,12) C(9,13) C(11,15) C(11,13) C(9,10) C(11,12) C(13,14) C(0,8) C(4,12) C(4,8) C(2,10) C(6,14) C(6,10) C(2,4) C(6,8) C(10,12) C(1,9) C(5,13) C(5,9) C(3,11) C(7,15) C(7,11) C(3,5) C(7,9) C(11,13) C(1,2) C(3,4) C(5,6) C(7,8) C(9,10) C(11,12) C(13,14)
#undef C
}
__device__ __forceinline__ void tk_merge16(unsigned (&a)[16], const unsigned (&b)[16]) {
#pragma unroll
    for (int i = 0; i < 16; ++i) a[i] = max(a[i], b[15 - i]);
#pragma unroll
    for (int st = 8; st >= 1; st >>= 1)
#pragma unroll
        for (int i = 0; i < 16; ++i) if ((i & st) == 0) TK_CAS(a[i], a[i + st], true);
}
__host__ __device__ constexpr int tk_pair_rank(int i, int j) { int c = 0; for (int a = 0; a < 16; ++a) for (int b = 0; b < 16; ++b) { if (a == i && b == j) return c; if ((a + 1) * (b + 1) <= 16) ++c; } return c; }
__device__ __forceinline__ unsigned tk_lookup(unsigned long long lo, unsigned long long hi, int i) {
    const unsigned long long w = (i & 8) ? hi : lo; return (unsigned)(w >> ((i & 7) * 8)) & 0xffu; }
__device__ __forceinline__ void phase_h8(const P& p) {
    const int TID = otid();
    const int lane = TID & 63, gw = (blockIdx.x * blockDim.x + TID) >> 6, nw = (gridDim.x * blockDim.x) >> 6;
    for (int t = gw; t < T; t += nw) {
        const bf16_t* hb = (const bf16_t*)(p.ws + WS_XN) + (size_t)t * D + 16 * lane; const u32x4 h0 = *(const u32x4*)hb, h1 = *(const u32x4*)(hb + 8);
        f32x4 a[4]; float am = 0.f;
#pragma unroll
        for (int w = 0; w < 4; ++w) { const unsigned d = (w < 2) ? h0[2 * w] : h1[2 * (w - 2)], e = (w < 2) ? h0[2 * w + 1] : h1[2 * (w - 2) + 1];
            a[w][0] = __uint_as_float(d << 16); a[w][1] = __uint_as_float(d & 0xffff0000u); a[w][2] = __uint_as_float(e << 16); a[w][3] = __uint_as_float(e & 0xffff0000u);
            am = fmaxf(fmaxf(am, fmaxf(fabsf(a[w][0]), fabsf(a[w][1]))), fmaxf(fabsf(a[w][2]), fabsf(a[w][3]))); }
        am = wave_max_fast(am);
        const float sc = am > 0.f ? 127.0f / am : 1.0f;
        int hs = 0; u32x2 hh, hl; hh[0] = 0u; hh[1] = 0u; hl[0] = 0u; hl[1] = 0u;
#pragma unroll
        for (int w = 0; w < 4; ++w)
#pragma unroll
            for (int k = 0; k < 4; ++k) { const int qv = (int)rintf(a[w][k] * sc); hs += qv; const int n = 4 * (w & 1) + k;
                hh[w >> 1] |= (unsigned)((qv >> 4) & 15) << (4 * n); hl[w >> 1] |= (unsigned)((qv & 15) ^ 8) << (4 * n); }
        unsigned char* hb8 = p.ws + WS_H8 + (size_t)t * D + 32 * (lane >> 1) + 8 * (lane & 1);
        *(u32x2*)hb8 = hh; *(u32x2*)(hb8 + 16) = hl;
        const float hc = wave_sum_fast(0.5f * (float)hs);
        if (lane == 0) { ((float*)(p.ws + WS_HSC))[t] = am > 0.f ? am * (1.0f / 127.0f) : 1.0f; ((float*)(p.ws + WS_HSC))[T + t] = hc; }
    }
}
__device__ __forceinline__ void phase_peer_topk(LAS unsigned char* ldsb, const P& p, const pg8::StaticOrder& So) {
    const int TID = otid();
    const int lane = TID & 63, r32 = lane & 31, hi = lane >> 5, wave = TID >> 6;
    const bf16_t* PQ = (const bf16_t*)(p.ws + WS_PQ); const bf16_t* SKb = (const bf16_t*)(p.ws + WS_SK); int* IDX = (int*)(p.ws + WS_IDX); float* GATE = (float*)(p.ws + WS_GATE);
    pg8::Unit un;
    for (int ui = 0; So.next(ui, un); ++ui) {
        const int tg = un.pm * 8 + wave, h = un.pn, t = tg * 32 + r32;
        __syncthreads();
#pragma unroll
        for (int j = 0; j < 8; ++j) { const int q = TID + 512 * j, pp_ = q >> 11, row = (q >> 4) & 127, ch = q & 15;
            *(LAS u32x4*)(ldsb + pp_ * 32768 + row * 256 + ((ch ^ (row & 15)) * 16)) = *(const u32x4*)(SKb + ((size_t)(h * 2 + pp_) * PNK + row) * PHALF + ch * 8); }
        u32x4 qfr[2][8];
#pragma unroll
        for (int pp = 0; pp < 2; ++pp)
#pragma unroll
            for (int ks = 0; ks < 8; ++ks) qfr[pp][ks] = *(const u32x4*)(PQ + (size_t)t * PQC + h * 256 + pp * 128 + 8 * hi + 16 * ks);
        __syncthreads();
        unsigned K0[16], K1[16];
#pragma unroll
        for (int pp = 0; pp < 2; ++pp) {
            f32x16_t acc[4];
#pragma unroll
            for (int mt = 0; mt < 4; ++mt) acc[mt] = f32x16_t{};
#pragma unroll
            for (int ks = 0; ks < 8; ++ks) {
                const bf16x8_t qf = __builtin_bit_cast(bf16x8_t, qfr[pp][ks]);
#pragma unroll
                for (int mt = 0; mt < 4; ++mt) { const int row = 32 * mt + r32;
                    const bf16x8_t kf = __builtin_bit_cast(bf16x8_t, *(const LAS u32x4*)(ldsb + pp * 32768 + row * 256 + (((2 * ks + hi) ^ (row & 15)) * 16)));
                    acc[mt] = __builtin_amdgcn_mfma_f32_32x32x16_bf16(kf, qf, acc[mt], 0, 0, 0); }
            }
            unsigned L[16], L1[16], L2[16], L3[16];
            const unsigned h4 = 4u * (unsigned)hi;
#pragma unroll
            for (int r = 0; r < 16; ++r) { const unsigned lowb = (unsigned)(127 - (r & 3) - 8 * (r >> 2)) - h4;
                L[r] = (f2ord(acc[0][r]) & ~127u) | lowb; L1[r] = (f2ord(acc[1][r]) & ~127u) | (lowb - 32u); L2[r] = (f2ord(acc[2][r]) & ~127u) | (lowb - 64u); L3[r] = (f2ord(acc[3][r]) & ~127u) | (lowb - 96u); }
            tk_sort16(L); tk_sort16(L1); tk_sort16(L2); tk_sort16(L3);
            tk_merge16(L, L1); tk_merge16(L2, L3); tk_merge16(L, L2);
            unsigned M[16];
#pragma unroll
            for (int i = 0; i < 16; ++i) { const auto r_ = __builtin_amdgcn_permlane32_swap(L[i], L[i], false, false); M[i] = hi ? r_[0] : r_[1]; }
            tk_merge16(L, M);
#pragma unroll
            for (int i = 0; i < 16; ++i) { if (pp == 0) K0[i] = L[i]; else K1[i] = L[i]; }
        }
        float v0[16], v1[16]; unsigned long long t0lo = 0ull, t0hi = 0ull, t1lo = 0ull, t1hi = 0ull;
#pragma unroll
        for (int i = 0; i < 16; ++i) { v0[i] = ord2f(K0[i] & ~127u); v1[i] = ord2f(K1[i] & ~127u);
            const unsigned long long e0 = (unsigned long long)(127u - (K0[i] & 127u)) << ((i & 7) * 8), e1 = (unsigned long long)(127u - (K1[i] & 127u)) << ((i & 7) * 8);
            if (i < 8) { t0lo |= e0; t1lo |= e1; } else { t0hi |= e0; t1hi |= e1; } }
        unsigned Bk[16], B1[16], B2[16], B3[16];
#pragma unroll
        for (int i = 0; i < 16; ++i) { Bk[i] = 0u; B1[i] = 0u; B2[i] = 0u; B3[i] = 0u; }
#pragma unroll
        for (int i = 0; i < 16; ++i)
#pragma unroll
            for (int j = 0; j < 16; ++j) if ((i + 1) * (j + 1) <= 16) {
                const unsigned key = (f2ord(v0[i] + v1[j]) & ~255u) | (unsigned)(255 - (i * 16 + j));
                const int rk = tk_pair_rank(i, j);
                if ((rk >> 4) == 0) Bk[rk & 15] = key; else if ((rk >> 4) == 1) B1[rk & 15] = key; else if ((rk >> 4) == 2) B2[rk & 15] = key; else B3[rk & 15] = key; }
#pragma unroll
        for (int i = 0; i < 16; ++i) { Bk[i] = hi ? B2[i] : Bk[i]; B1[i] = hi ? B3[i] : B1[i]; }
        tk_sort16(Bk); tk_sort16(B1); tk_merge16(Bk, B1);
#pragma unroll
        for (int i = 0; i < 16; ++i) { const auto r_ = __builtin_amdgcn_permlane32_swap(Bk[i], Bk[i], false, false); B2[i] = hi ? r_[0] : r_[1]; }
        tk_merge16(Bk, B2);
        float rstd;
        { const f32x4* rp = (const f32x4*)((const float*)(p.ws + WS_RSSP) + (size_t)t * 16); const f32x4 s4 = (rp[0] + rp[1]) + (rp[2] + rp[3]);
          rstd = rsqrtf(((s4[0] + s4[1]) + (s4[2] + s4[3])) * (1.f / D) + EPS); }
        float gt[16]; int ex[16]; float sum = 0.f; const float best0 = ord2f(Bk[0] & ~255u);
#pragma unroll
        for (int r = 0; r < 16; ++r) { const float bv = ord2f(Bk[r] & ~255u); gt[r] = __expf(rstd * (bv - best0)); sum += gt[r];
            const int flat = 255 - (int)(Bk[r] & 255u); ex[r] = (int)tk_lookup(t0lo, t0hi, flat >> 4) * PNK + (int)tk_lookup(t1lo, t1hi, flat & 15); }
        const float rs = 1.f / sum;
        if (hi == 0) {
#pragma unroll
            for (int q = 0; q < 4; ++q) {
                u32x4 iv; iv.x = (unsigned)ex[4 * q]; iv.y = (unsigned)ex[4 * q + 1]; iv.z = (unsigned)ex[4 * q + 2]; iv.w = (unsigned)ex[4 * q + 3];
                *(u32x4*)(IDX + ((size_t)t * PH + h) * PK + 4 * q) = iv;
                f32x4 gv; gv[0] = gt[4 * q] * rs; gv[1] = gt[4 * q + 1] * rs; gv[2] = gt[4 * q + 2] * rs; gv[3] = gt[4 * q + 3] * rs;
                *(f32x4*)(GATE + ((size_t)t * PH + h) * PK + 4 * q) = gv; }
        }
    }
}

__device__ __forceinline__ float gelu_exact(float v) {
    const float av = fabsf(v), t = __builtin_amdgcn_rcpf(av * 0.2316418882f + 1.0f);
    float q = t * 0.5307027145f + (-0.7265760135f); q = q * t + 0.7107068705f; q = q * t + (-0.142248368f); q = q * t + 0.127414796f; q = q * t;
    const float e = __builtin_amdgcn_exp2f((v * v) * (-0.72134752044f)), m = v * (q * e);
    return v < 0.f ? m : v - m;
}
#define EX_HALVE16(d, m2, m1, m0, u2, u1, u0, r0, r1) do { float h8_[8], h4_[4]; \
        _Pragma("unroll") for (int i_ = 0; i_ < 8; ++i_) { const float k_ = (u2) ? d[i_ + 8] : d[i_], s_ = (u2) ? d[i_] : d[i_ + 8]; h8_[i_] = k_ + __shfl_xor(s_, (m2)); } \
        _Pragma("unroll") for (int i_ = 0; i_ < 4; ++i_) { const float k_ = (u1) ? h8_[i_ + 4] : h8_[i_], s_ = (u1) ? h8_[i_] : h8_[i_ + 4]; h4_[i_] = k_ + __shfl_xor(s_, (m1)); } \
        { const float k0_ = (u0) ? h4_[2] : h4_[0], s0_ = (u0) ? h4_[0] : h4_[2], k1_ = (u0) ? h4_[3] : h4_[1], s1_ = (u0) ? h4_[1] : h4_[3]; r0 = k0_ + __shfl_xor(s0_, (m0)); r1 = k1_ + __shfl_xor(s1_, (m0)); } } while (0)
#define EX_HALVE16_SWAP(d, u0, r0, r1) do { float h8_[8], h4_[4]; \
        _Pragma("unroll") for (int i_ = 0; i_ < 8; ++i_) { const auto q_ = __builtin_amdgcn_permlane32_swap(__float_as_uint(d[i_]), __float_as_uint(d[i_ + 8]), false, false); h8_[i_] = __uint_as_float(q_[0]) + __uint_as_float(q_[1]); } \
        _Pragma("unroll") for (int i_ = 0; i_ < 4; ++i_) { const auto q_ = __builtin_amdgcn_permlane16_swap(__float_as_uint(h8_[i_]), __float_as_uint(h8_[i_ + 4]), false, false); h4_[i_] = __uint_as_float(q_[0]) + __uint_as_float(q_[1]); } \
        { const float k0_ = (u0) ? h4_[2] : h4_[0], s0_ = (u0) ? h4_[0] : h4_[2], k1_ = (u0) ? h4_[3] : h4_[1], s1_ = (u0) ? h4_[1] : h4_[3]; \
          r0 = k0_ + __builtin_bit_cast(float, __builtin_amdgcn_update_dpp(0, __builtin_bit_cast(int, s0_), 0x128, 0xf, 0xf, true)); r1 = k1_ + __builtin_bit_cast(float, __builtin_amdgcn_update_dpp(0, __builtin_bit_cast(int, s1_), 0x128, 0xf, 0xf, true)); } } while (0)
#define EX_HALVE16_SWAP_I(d, u0, r0, r1) do { int h8_[8], h4_[4]; \
        _Pragma("unroll") for (int i_ = 0; i_ < 8; ++i_) { const auto q_ = __builtin_amdgcn_permlane32_swap((unsigned)d[i_], (unsigned)d[i_ + 8], false, false); h8_[i_] = (int)(q_[0] + q_[1]); } \
        _Pragma("unroll") for (int i_ = 0; i_ < 4; ++i_) { const auto q_ = __builtin_amdgcn_permlane16_swap((unsigned)h8_[i_], (unsigned)h8_[i_ + 4], false, false); h4_[i_] = (int)(q_[0] + q_[1]); } \
        { const int k0_ = (u0) ? h4_[2] : h4_[0], s0_ = (u0) ? h4_[0] : h4_[2], k1_ = (u0) ? h4_[3] : h4_[1], s1_ = (u0) ? h4_[1] : h4_[3]; \
          r0 = k0_ + __builtin_amdgcn_update_dpp(0, s0_, 0x128, 0xf, 0xf, true); r1 = k1_ + __builtin_amdgcn_update_dpp(0, s1_, 0x128, 0xf, 0xf, true); } } while (0)
struct ExIds { u32x4 i0, i1, i2, i3; };
struct ExAux { u32x4 w0; f32x4 y; };
__device__ __forceinline__ void ex_ids(ExIds& I, const P& p, int t, int g) {
    const u32x4* ip = (const u32x4*)((const int*)(p.ws + WS_IDX) + (size_t)t * 128 + 16 * g); I.i0 = ip[0]; I.i1 = ip[1]; I.i2 = ip[2]; I.i3 = ip[3]; }
template <int PASS> __device__ __forceinline__ void ex_gather(u32x4 (&buf)[16], ExAux& X, const ExIds& I, const P& p, int t, int x, int g, int c) {
    const __amdgpu_buffer_rsrc_t TAB = __builtin_amdgcn_make_buffer_rsrc((void*)(p.ws + (PASS == 0 ? WS_EU : WS_EV) + (size_t)x * ESLICE), 0, (int)ESLICE, 0x00020000);
#pragma unroll
    for (int j = 0; j < 16; ++j) { const unsigned e = (j < 4) ? I.i0[j & 3] : (j < 8) ? I.i1[j & 3] : (j < 12) ? I.i2[j & 3] : I.i3[j & 3];
        buf[j] = __builtin_amdgcn_raw_buffer_load_b128(TAB, (int)(e * 128u) + 16 * c, 0, 0); }
    if constexpr (PASS == 0) { const u32x4* hp8 = (const u32x4*)(p.ws + WS_H8 + (size_t)t * D + x * 256 + 32 * c); X.w0 = hp8[0]; X.y = __builtin_bit_cast(f32x4, hp8[1]); }
    else { X.w0 = *(const u32x4*)(p.ws + WS_A + (size_t)t * 128 + 16 * g);
           const bf16_t* hp = (const bf16_t*)(p.ws + WS_XN) + (size_t)t * D + x * 256 + 32 * c + 2 * g; const unsigned hw = *(const unsigned*)hp, hw1 = *(const unsigned*)(hp + 16);
           X.y[0] = __uint_as_float(hw << 16); X.y[1] = __uint_as_float(hw & 0xffff0000u); X.y[2] = __uint_as_float(hw1 << 16); X.y[3] = __uint_as_float(hw1 & 0xffff0000u); }
}
template <int PASS> __device__ __forceinline__ void ex_compute(const u32x4 (&buf)[16], const ExAux& X, const P& p, int t, int x, int lane, int g, int c, float asc, float cs, float& o0, float& o1) {
    float d[16];
    if constexpr (PASS == 0) {
        const u32x4 w1 = __builtin_bit_cast(u32x4, X.y);
#pragma unroll
        for (int j = 0; j < 16; ++j) { int aH = 0, aL = 0;
#pragma unroll
            for (int q = 0; q < 4; ++q) { aH = __builtin_amdgcn_sdot8((int)buf[j][q], (int)X.w0[q], aH, false); aL = __builtin_amdgcn_sdot8((int)buf[j][q], (int)w1[q], aL, false); }
            d[j] = (float)((aH << 4) + aL); }
        float r0, r1;
        EX_HALVE16(d, 4, 2, 1, (lane & 4) != 0, (lane & 2) != 0, (lane & 1) != 0, r0, r1);
        o0 += r0; o1 += r1;
    } else {
        float osq = 0.f;
#pragma unroll
        for (int hf = 0; hf < 2; ++hf) {
            int ai[16];
#pragma unroll
            for (int i = 0; i < 16; ++i) ai[i] = 0;
#pragma unroll
            for (int j4 = 0; j4 < 4; ++j4) { const int a4 = (int)X.w0[j4];
#pragma unroll
                for (int q2 = 0; q2 < 2; ++q2) { const int q = 2 * hf + q2; const unsigned r0_ = buf[4 * j4][q], r1_ = buf[4 * j4 + 1][q], r2_ = buf[4 * j4 + 2][q], r3_ = buf[4 * j4 + 3][q];
                    const unsigned t0 = __builtin_amdgcn_perm(r1_, r0_, 0x05010400u), t1 = __builtin_amdgcn_perm(r1_, r0_, 0x07030602u), t2 = __builtin_amdgcn_perm(r3_, r2_, 0x05010400u), t3 = __builtin_amdgcn_perm(r3_, r2_, 0x07030602u);
                    const unsigned c0_ = __builtin_amdgcn_perm(t2, t0, 0x05040100u), c1_ = __builtin_amdgcn_perm(t2, t0, 0x07060302u), c2_ = __builtin_amdgcn_perm(t3, t1, 0x05040100u), c3_ = __builtin_amdgcn_perm(t3, t1, 0x07060302u);
                    ai[8 * q2 + 0] = __builtin_amdgcn_sdot4((int)(c0_ & 0x0f0f0f0fu), a4, ai[8 * q2 + 0], false); ai[8 * q2 + 1] = __builtin_amdgcn_sdot4((int)c0_, a4, ai[8 * q2 + 1], false);
                    ai[8 * q2 + 2] = __builtin_amdgcn_sdot4((int)(c1_ & 0x0f0f0f0fu), a4, ai[8 * q2 + 2], false); ai[8 * q2 + 3] = __builtin_amdgcn_sdot4((int)c1_, a4, ai[8 * q2 + 3], false);
                    ai[8 * q2 + 4] = __builtin_amdgcn_sdot4((int)(c2_ & 0x0f0f0f0fu), a4, ai[8 * q2 + 4], false); ai[8 * q2 + 5] = __builtin_amdgcn_sdot4((int)c2_, a4, ai[8 * q2 + 5], false);
                    ai[8 * q2 + 6] = __builtin_amdgcn_sdot4((int)(c3_ & 0x0f0f0f0fu), a4, ai[8 * q2 + 6], false); ai[8 * q2 + 7] = __builtin_amdgcn_sdot4((int)c3_, a4, ai[8 * q2 + 7], false); }
                asm volatile("" : "+v"(ai[0]), "+v"(ai[1]), "+v"(ai[2]), "+v"(ai[3]), "+v"(ai[4]), "+v"(ai[5]), "+v"(ai[6]), "+v"(ai[7]), "+v"(ai[8]), "+v"(ai[9]), "+v"(ai[10]), "+v"(ai[11]), "+v"(ai[12]), "+v"(ai[13]), "+v"(ai[14]), "+v"(ai[15]));
                __builtin_amdgcn_sched_barrier(0); }
            int i0, i1;
            EX_HALVE16_SWAP_I(ai, (lane & 8) != 0, i0, i1);
            const float r0 = (float)i0 * asc, r1 = (float)(i1 - i0) * (asc * 0.0625f);
            f32x2v y; y[0] = X.y[2 * hf] + (r0 - 7.5f * cs); y[1] = X.y[2 * hf + 1] + (r1 + 0.5f * cs);
            *(f32x2v*)(p.out + (size_t)t * D + x * 256 + 32 * c + 16 * hf + 2 * g) = y;
            osq += y[0] * y[0] + y[1] * y[1];
        }
        o0 += osq;
    }
}
typedef float f32x2l __attribute__((ext_vector_type(2)));
template <int PASS> __device__ __forceinline__ void ex_pass(const P& p, int tb, int lane, int g, int c, LAS f32x2l* acc, const LAS float* ascl) {
    u32x4 bA[16], bB[16]; ExAux xA, xB; ExIds I;
    ex_ids(I, p, tb, g);
    ex_gather<PASS>(bA, xA, I, p, tb, 0, g, c);
    ex_ids(I, p, tb + 1, g);
    constexpr int NS = 32;
#pragma unroll 1
    for (int s_ = 0; s_ < NS; s_ += 2) {
        const int x = s_ >> 3, i = s_ & 7, s2 = min(s_ + 2, NS - 1), x2 = s2 >> 3, i2 = s2 & 7;
        ex_gather<PASS>(bB, xB, I, p, tb + i + 1, x, g, c);
        ex_ids(I, p, tb + i2, g);
        { float o0 = 0.f, o1 = 0.f; ex_compute<PASS>(bA, xA, p, tb + i, x, lane, g, c, (PASS == 1) ? ascl[i] : 0.f, (PASS == 1) ? ascl[8 + i] : 0.f, o0, o1); f32x2l v = acc[i * 64 + lane]; v[0] += o0; v[1] += o1; acc[i * 64 + lane] = v; }
        ex_gather<PASS>(bA, xA, I, p, tb + i2, x2, g, c);
        ex_ids(I, p, tb + ((i2 + 1) & 7), g);
        { float o0 = 0.f, o1 = 0.f; ex_compute<PASS>(bB, xB, p, tb + i + 1, x, lane, g, c, (PASS == 1) ? ascl[i + 1] : 0.f, (PASS == 1) ? ascl[9 + i] : 0.f, o0, o1); f32x2l v = acc[(i + 1) * 64 + lane]; v[0] += o0; v[1] += o1; acc[(i + 1) * 64 + lane] = v; }
    }
}
__device__ __forceinline__ void phase_experts(LAS unsigned char* ldsb, const P& p) {
    const int TID = otid();
    const int lane = TID & 63, wave = TID >> 6, g = lane >> 3, c = lane & 7, tb = (blockIdx.x * 8 + wave) * 8;
    const float* USC = (const float*)(p.ws + WS_USC); const float* VSC = (const float*)(p.ws + WS_VSC);
    LAS f32x2l* acc = (LAS f32x2l*)(ldsb + wave * 8192); LAS float* ascl = (LAS float*)(ldsb + wave * 8192 + 4096);
#pragma unroll
    for (int i = 0; i < 8; ++i) { f32x2l z; z[0] = 0.f; z[1] = 0.f; acc[i * 64 + lane] = z; }
    ex_pass<0>(p, tb, lane, g, c, acc, ascl);
#pragma unroll 1
    for (int i = 0; i < 8; ++i) { const int t = tb + i, k0 = 16 * g + 2 * c;
        float rstd;
        { const f32x4* rp = (const f32x4*)((const float*)(p.ws + WS_RSSP) + (size_t)t * 16); const f32x4 s4 = (rp[0] + rp[1]) + (rp[2] + rp[3]);
          rstd = rsqrtf(((s4[0] + s4[1]) + (s4[2] + s4[3])) * (1.f / D) + EPS); }
        const u32x2 e = *(const u32x2*)((const int*)(p.ws + WS_IDX) + (size_t)t * 128 + k0);
        const f32x2v gt = *(const f32x2v*)((const float*)(p.ws + WS_GATE) + (size_t)t * 128 + k0);
        const float hs = rstd * ((const float*)(p.ws + WS_HSC))[t], hc = ((const float*)(p.ws + WS_HSC))[T + t];
        f32x2l hv = acc[i * 64 + lane]; hv[0] += hc; hv[1] += hc;
        const float a0 = gt[0] * gelu_exact(hs * USC[e.x] * (hv[0] + 8.f * USC[2 * PNK * PNK + e.x])) * VSC[e.x], a1 = gt[1] * gelu_exact(hs * USC[e.y] * (hv[1] + 8.f * USC[2 * PNK * PNK + e.y])) * VSC[e.y];
        const float am = wave_max_fast(fmaxf(fabsf(a0), fabsf(a1))), sc = am > 0.f ? 127.0f / am : 1.0f;
        const int q0 = (int)rintf(a0 * sc), q1 = (int)rintf(a1 * sc);
        *(unsigned short*)(p.ws + WS_A + (size_t)t * 128 + k0) = (unsigned short)((q0 & 0xff) | ((q1 & 0xff) << 8));
        const float asum = wave_sum_fast((float)(q0 + q1)), asc_ = am > 0.f ? am * (1.0f / 127.0f) : 1.0f;
        if (lane == 0) { ascl[i] = asc_; ascl[8 + i] = asc_ * asum; }
        f32x2l z; z[0] = 0.f; z[1] = 0.f; acc[i * 64 + lane] = z; }
    asm volatile("s_waitcnt vmcnt(0) lgkmcnt(0)" ::: "memory");
    ex_pass<1>(p, tb, lane, g, c, acc, ascl);
    asm volatile("s_waitcnt vmcnt(0) lgkmcnt(0)" ::: "memory");
#pragma unroll 1
    for (int i = 0; i < 8; ++i) { const f32x2l q = acc[i * 64 + lane]; const float r2 = rsqrtf(wave_sum_fast(q[0]) * (1.f / D) + EPS);
        f32x4* orow = (f32x4*)(p.out + (size_t)(tb + i) * D);
#pragma unroll
        for (int j = 0; j < 4; ++j) { const f32x4 gf = ((const f32x4*)p.g_fin)[lane + 64 * j]; f32x4 y = orow[lane + 64 * j] * r2; y[0] *= gf[0]; y[1] *= gf[1]; y[2] *= gf[2]; y[3] *= gf[3]; orow[lane + 64 * j] = y; } }
}
#undef EX_HALVE16
#undef EX_HALVE16_SWAP
#undef EX_HALVE16_SWAP_I

#define LAS __attribute__((address_space(3)))
#define XB_TMO      128
#define XB_XCNT(j)  (256  + 64 * (j))
#define XB_XSUB(j)  (1280 + 64 * (j))
#define XB_XGEN(j)  (2304 + 64 * (j))
#define XB_TOP      3328
#define XB_TOPGEN   3392
#define XCD_BAR_WORDS 3456
#define XB_SPIN_CAP (1u << 22)
__device__ __forceinline__ unsigned xb_ld(unsigned* p)              { return __hip_atomic_load(p, __ATOMIC_RELAXED, __HIP_MEMORY_SCOPE_AGENT); }
__device__ __forceinline__ unsigned xb_add(unsigned* p, unsigned v) { return __hip_atomic_fetch_add(p, v, __ATOMIC_RELAXED, __HIP_MEMORY_SCOPE_AGENT); }
__device__ __forceinline__ unsigned xb_xcc_id() { return (unsigned)__builtin_amdgcn_s_getreg((3 << 11) | 20) & 0xFu; }
#define XB_SPIN(cond, bar) do { unsigned _sp = 0; while (cond) { __builtin_amdgcn_s_sleep(1); \
    if ((++_sp & 255u) == 0u) { if (xb_ld(&(bar)[XB_TMO])) break; if (_sp > XB_SPIN_CAP) { atomicAdd(&(bar)[XB_TMO], 1u); break; } } } } while (0)
struct XcdBarrier { unsigned* bar; unsigned x; volatile LAS unsigned* st; };
__device__ __forceinline__ XcdBarrier xcd_barrier_post(unsigned* bar, volatile LAS unsigned* st) {
    XcdBarrier b; b.bar = bar; b.x = xb_xcc_id(); b.st = st;
    if (threadIdx.x == 0) (void)xb_add(&bar[XB_XCNT(b.x)], 1u);
    return b;
}
__device__ __forceinline__ void xcd_barrier_complete(unsigned* bar, unsigned x, unsigned& nloc, unsigned& nx) {
    const unsigned G = gridDim.x * gridDim.y * gridDim.z;
    unsigned sum, cnt, mine, sp = 0u;
    for (;;) {
        sum = 0u; cnt = 0u; mine = 0u;
#pragma unroll
        for (unsigned j = 0; j < 16; ++j) { const unsigned c = xb_ld(&bar[XB_XCNT(j)]); sum += c; cnt += (c > 0u) ? 1u : 0u; mine = (j == x) ? c : mine; }
        if (sum == G) break;
        __builtin_amdgcn_s_sleep(1);
        if ((++sp & 255u) == 0u) { if (xb_ld(&bar[XB_TMO])) break; if (sp > XB_SPIN_CAP) { atomicAdd(&bar[XB_TMO], 1u); break; } }
    }
    nloc = mine > 0u ? mine : 1u; nx = cnt > 0u ? cnt : 1u;
}
__device__ __forceinline__ void xcd_barrier(const XcdBarrier& b) {
    asm volatile("s_waitcnt vmcnt(0)" ::: "memory");
    __syncthreads();
    if (threadIdx.x == 0) {
        unsigned* bar = b.bar;
        __builtin_amdgcn_s_waitcnt(0);
        unsigned nloc = b.st[0], nx = b.st[1];
        if (nloc == 0u) { xcd_barrier_complete(bar, b.x, nloc, nx); b.st[0] = nloc; b.st[1] = nx; }
        const unsigned old = xb_add(&bar[XB_XSUB(b.x)], 1u);
        const unsigned gen = old / nloc;
        if (old + 1u == (gen + 1u) * nloc) {
            __builtin_amdgcn_fence(__ATOMIC_RELEASE, "agent");
            asm volatile("s_waitcnt vmcnt(0)" ::: "memory");
            const unsigned og = xb_add(&bar[XB_TOP], 1u);
            const unsigned tg = og / nx;
            if (og + 1u == (tg + 1u) * nx) xb_add(&bar[XB_TOPGEN], 1u);
            else XB_SPIN(xb_ld(&bar[XB_TOPGEN]) == tg, bar);
            __builtin_amdgcn_fence(__ATOMIC_ACQUIRE, "agent");
            xb_add(&bar[XB_XGEN(b.x)], 1u);
            asm volatile("s_waitcnt vmcnt(0)" ::: "memory");
        } else {
            XB_SPIN(xb_ld(&bar[XB_XGEN(b.x)]) == gen, bar);
            __builtin_amdgcn_fence(__ATOMIC_ACQUIRE, "agent");
            asm volatile("s_waitcnt vmcnt(0)" ::: "memory");
        }
    }
    __syncthreads();
}

constexpr int NT = 512;
constexpr int LDS_BYTES = 147456;
constexpr int MISC_OFF = 131072;

__global__ void __launch_bounds__(NT, 2) mega(P p) {
    extern __shared__ __attribute__((aligned(16))) unsigned char lds_raw[];
    float* lds = (float*)lds_raw;
    LAS unsigned char* ldsb = (LAS unsigned char*)lds_raw;
    volatile LAS unsigned* MISC = (volatile LAS unsigned*)(ldsb + MISC_OFF);
    if (threadIdx.x < 32) MISC[threadIdx.x] = 0u;
    __syncthreads();
    XcdBarrier bar = xcd_barrier_post((unsigned*)p.ws, MISC + 8);
#define GRID_BAR() xcd_barrier(bar)
    const int G = gridDim.x;
    bf16_t* QKV = (bf16_t*)(p.ws + WS_QKV);
    phase_prologue(ldsb, p);
    GRID_BAR();
    phase_cumsum(p);
    { pg8::Gemm g{(const bf16_t*)(p.ws + WS_XN), (const bf16_t*)(p.ws + WS_WIN), T, 5120, D / 2}; pg8::StaticOrder So; So.init(T, 5120, G, (int)blockIdx.x);
      pg8::EpiProj E{QKV, (bf16_t*)(p.ws + WS_G), (const float*)(p.ws + WS_ROPE), (float*)(p.ws + WS_KMP), (float*)(p.ws + WS_FKN), (float*)(p.ws + WS_FQN)};
      pg8::gemm_phase<pg8::EpiProj, pg8::StaticOrder, true, true, true>(ldsb, g, So, E); }
    GRID_BAR();
    phase_attn((char*)lds_raw, MISC, p);
    GRID_BAR();
    phase_moba_combine(p);
    phase_expert_tables(p);
    GRID_BAR();
    { pg8::Gemm g{QKV, (const bf16_t*)(p.ws + WS_WA), T, D, 512}; pg8::StaticOrder So; So.init(T, D, G, (int)blockIdx.x);
      pg8::EpiMerge E{(bf16_t*)(p.ws + WS_MERGED), (const bf16_t*)(p.ws + WS_G), true};
      pg8::gemm_phase<pg8::EpiMerge, pg8::StaticOrder, true, true>(ldsb, g, So, E); }
    { pg8::Gemm g{QKV + SLOT, (const bf16_t*)(p.ws + WS_WB), T, D, 512}; pg8::StaticOrder So; So.init(T, D, G, (int)blockIdx.x);
      pg8::EpiMerge E{(bf16_t*)(p.ws + WS_MERGED), (const bf16_t*)(p.ws + WS_G) + (size_t)T * D, false};
      pg8::gemm_phase<pg8::EpiMerge, pg8::StaticOrder, true, true>(ldsb, g, So, E); }
    GRID_BAR();
    { pg8::Gemm g{(const bf16_t*)(p.ws + WS_MERGED), (const bf16_t*)(p.ws + WS_WOUT), T, D, D}; pg8::StaticOrder So; So.init(T, D, G, (int)blockIdx.x);
      pg8::EpiOut E{p.x, p.out, (bf16_t*)(p.ws + WS_XN), (float*)(p.ws + WS_RSSP)};
      pg8::gemm_phase<pg8::EpiOut, pg8::StaticOrder, true, true>(ldsb, g, So, E); }
    GRID_BAR();
    { pg8::Gemm g{(const bf16_t*)(p.ws + WS_XN), (const bf16_t*)(p.ws + WS_WPQ), T, PQC, D}; pg8::StaticOrder So; So.init(T, PQC, G, (int)blockIdx.x);
      pg8::EpiStore E{(bf16_t*)(p.ws + WS_PQ), PQC};
      pg8::gemm_phase<pg8::EpiStore, pg8::StaticOrder, true, true>(ldsb, g, So, E);
      phase_peer_topk(ldsb, p, So); }
    phase_h8(p);
    GRID_BAR();
    phase_experts(ldsb, p);
}

extern "C" void kernel_launch(void* const* d_in, const int* in_sizes, int n_in, void* d_out, int out_size, void* d_ws, size_t ws_size, hipStream_t stream) {
    static int grid = 0;
    if (grid == 0) {
        int dev = 0, cus = 0, per_cu = 0;
        if (hipGetDevice(&dev) != hipSuccess || hipDeviceGetAttribute(&cus, hipDeviceAttributeMultiprocessorCount, dev) != hipSuccess) { fprintf(stderr, "kernel_launch: device query failed\n"); grid = -1; return; }
        if (hipFuncSetAttribute((const void*)mega, hipFuncAttributeMaxDynamicSharedMemorySize, LDS_BYTES) != hipSuccess) { fprintf(stderr, "kernel_launch: hipFuncSetAttribute failed\n"); grid = -1; return; }
        if (hipOccupancyMaxActiveBlocksPerMultiprocessor(&per_cu, (const void*)mega, NT, LDS_BYTES) != hipSuccess || per_cu < 1) { fprintf(stderr, "kernel_launch: occupancy query says %d blocks per CU\n", per_cu); (void)hipGetLastError(); grid = -1; return; }
        if (cus < 256) { fprintf(stderr, "kernel_launch: built for a 256-CU device, found %d CUs\n", cus); grid = -1; return; }
        grid = 256;
    }
    if (grid < 0) return;
    (void)hipMemsetAsync(d_ws, 0, CTL_ZERO_BYTES, stream);
    P p{};
    p.x = (const float*)d_in[0]; p.g_mix = (const float*)d_in[1]; p.w_in = (const float*)d_in[2]; p.b_f = (const float*)d_in[3];
    p.w_a = (const float*)d_in[4]; p.w_b = (const float*)d_in[5]; p.w_out = (const float*)d_in[6]; p.g_ffn = (const float*)d_in[7];
    p.w_pq = (const float*)d_in[8]; p.sk = (const float*)d_in[9]; p.eu = (const float*)d_in[10]; p.ev = (const float*)d_in[11]; p.g_fin = (const float*)d_in[12];
    p.out = (float*)d_out; p.ws = (unsigned char*)d_ws;
    hipLaunchKernelGGL(mega, dim3(grid), dim3(NT), LDS_BYTES, stream, p);
}
```

```cpp
#include <hip/hip_runtime.h>
#include <cstdio>
#include <cstdint>
#include <cmath>

constexpr int Bn = 2, S = 8192, D = 1024, T = Bn * S;
constexpr int HD = 64, NH = 8;
constexpr int INC = 5128;
constexpr int LBLK = 256, NBLK = S / LBLK;
constexpr int PH = 8, PNK = 128, PHALF = 128, PK = 16, PQC = PH * 2 * PHALF;
constexpr float EPS = 1e-6f;
constexpr float LOG2E = 1.4426950408889634f;
constexpr float C2 = 0.125f * LOG2E;

typedef unsigned short bf16_t;
typedef float f32x4 __attribute__((ext_vector_type(4)));
typedef unsigned u32x2 __attribute__((ext_vector_type(2)));
typedef unsigned u32x4 __attribute__((ext_vector_type(4)));
#define LAS __attribute__((address_space(3)))

__device__ __forceinline__ float bf2f(bf16_t v) { return __uint_as_float((unsigned)v << 16); }
__device__ __forceinline__ unsigned f2bf(float f) { unsigned u = __float_as_uint(f); return (u + 0x7fffu + ((u >> 16) & 1u)) >> 16; }
__device__ __forceinline__ unsigned pk2(float lo, float hi) { return f2bf(lo) | (f2bf(hi) << 16); }
#define WS_DPP(v, ctrl) ((v) + __builtin_bit_cast(float, __builtin_amdgcn_update_dpp(0, __builtin_bit_cast(int, (v)), (ctrl), 0xf, 0xf, true)))
#define WM_DPP(v, ctrl) fmaxf((v), __builtin_bit_cast(float, __builtin_amdgcn_update_dpp(0, __builtin_bit_cast(int, (v)), (ctrl), 0xf, 0xf, true)))
__device__ __forceinline__ float sum_x16(float v) { const auto r = __builtin_amdgcn_permlane16_swap(__float_as_uint(v), __float_as_uint(v), false, false); return __uint_as_float(r[0]) + __uint_as_float(r[1]); }
__device__ __forceinline__ float sum_x32(float v) { const auto r = __builtin_amdgcn_permlane32_swap(__float_as_uint(v), __float_as_uint(v), false, false); return __uint_as_float(r[0]) + __uint_as_float(r[1]); }
__device__ __forceinline__ float sum_x8(float v) { return v + __builtin_bit_cast(float, __builtin_amdgcn_update_dpp(0, __builtin_bit_cast(int, v), 0x128, 0xf, 0xf, true)); }
__device__ __forceinline__ float wave_sum_fast(float v) {
    v = WS_DPP(v, 0xB1); v = WS_DPP(v, 0x4E); v = WS_DPP(v, 0x141); v = WS_DPP(v, 0x140);
    const int iv = __builtin_bit_cast(int, v);
    return (__builtin_bit_cast(float, __builtin_amdgcn_readlane(iv, 0)) + __builtin_bit_cast(float, __builtin_amdgcn_readlane(iv, 16))) + (__builtin_bit_cast(float, __builtin_amdgcn_readlane(iv, 32)) + __builtin_bit_cast(float, __builtin_amdgcn_readlane(iv, 48)));
}
__device__ __forceinline__ float wave_max_fast(float v) {
    v = WM_DPP(v, 0xB1); v = WM_DPP(v, 0x4E); v = WM_DPP(v, 0x141); v = WM_DPP(v, 0x140);
    const int iv = __builtin_bit_cast(int, v);
    return fmaxf(fmaxf(__builtin_bit_cast(float, __builtin_amdgcn_readlane(iv, 0)), __builtin_bit_cast(float, __builtin_amdgcn_readlane(iv, 16))), fmaxf(__builtin_bit_cast(float, __builtin_amdgcn_readlane(iv, 32)), __builtin_bit_cast(float, __builtin_amdgcn_readlane(iv, 48))));
}
__device__ __forceinline__ int otid() { int t = threadIdx.x; asm volatile("" : "+v"(t)); return t; }

constexpr size_t MiB = 1u << 20, KiB = 1u << 10;
constexpr size_t CTL_ZERO_BYTES = 65536;
constexpr size_t WS_ROPE = 1 * MiB;
constexpr size_t WS_C = 1 * MiB + 512 * KiB;
constexpr size_t WS_LOGF = 2 * MiB;
constexpr size_t WS_KMP = 2 * MiB + 512 * KiB;
constexpr size_t WS_MCNT = 40 * KiB;
constexpr size_t WS_FKN = 2 * MiB + 768 * KiB;
constexpr size_t WS_FQN = WS_FKN + 32 * KiB;
constexpr size_t WS_MG1 = 44 * KiB;
constexpr size_t WS_SEL3 = 4 * MiB + 512 * KiB;
constexpr size_t WS_MLIST = 5 * MiB;
constexpr size_t WS_MLSE = 13 * MiB;
constexpr size_t WS_MP2 = 23 * MiB, WS_MP3 = 39 * MiB;
constexpr size_t WS_MP0 = 215 * MiB, WS_MP1 = 231 * MiB;
constexpr size_t WS_WSUM = 3 * MiB;
constexpr size_t WS_WIN = 5 * MiB;
constexpr size_t WS_WA = 15 * MiB, WS_WB = 16 * MiB;
constexpr size_t WS_WOUT = 17 * MiB;
constexpr size_t WS_WPQ = 19 * MiB;
constexpr size_t WS_XN = 23 * MiB;
constexpr size_t WS_QKV = 55 * MiB;
constexpr size_t SLOT = (size_t)T * 512;
constexpr size_t WS_G = 151 * MiB;
constexpr size_t WS_MERGED = 215 * MiB;
constexpr size_t WS_PQ = 151 * MiB;
constexpr size_t WS_IDX = 215 * MiB;
constexpr size_t WS_GATE = 223 * MiB;
constexpr size_t WS_SK = 247 * MiB;
constexpr size_t WS_RSSP = 3 * MiB + 512 * KiB;
constexpr size_t WS_EU = 87 * MiB;
constexpr size_t WS_EV = 103 * MiB;
constexpr size_t ESLICE = (size_t)16384 * 128;
constexpr size_t WS_A = 231 * MiB;
constexpr size_t WS_H8 = 55 * MiB;
constexpr size_t WS_HSC = 71 * MiB;
constexpr size_t WS_USC = 119 * MiB;
constexpr size_t WS_VSC = 119 * MiB + 64 * KiB;

struct P {
    const float *x, *g_mix, *w_in, *b_f, *w_a, *w_b, *w_out, *g_ffn, *w_pq, *sk, *eu, *ev, *g_fin;
    float* out; unsigned char* ws;
};

namespace pg8 {
#define PG8_LAS __attribute__((address_space(3)))
typedef unsigned short bf16_t;
typedef short bf16x8 __attribute__((ext_vector_type(8)));
typedef int i32x4 __attribute__((ext_vector_type(4))); typedef int i32x8 __attribute__((ext_vector_type(8)));
typedef float f32x4 __attribute__((ext_vector_type(4)));
typedef unsigned u32x4 __attribute__((ext_vector_type(4)));
constexpr int BM = 256, BK = 64, HALF = 128, HTB = HALF * BK * 2  , STAGE_BYTES = 8 * HTB, NXCD = 8, WGM = 8;

__host__ __device__ __forceinline__ int lds_byte(int r, int c) { const int st = (r >> 4) * 2 + (c >> 5), rr = r & 15, cc = c & 31, ob = rr * 64 + cc * 2; return st * 1024 + (ob ^ (((ob >> 9) & 1) << 5)); }
__host__ __device__ __forceinline__ void stage_rc(int b, int& R, int& C) { const int st = b / 1024, sb = b % 1024, swz = sb ^ (((sb >> 9) & 1) << 5); R = (st >> 1) * 16 + swz / 64; C = (st & 1) * 32 + (swz % 64) / 2; }
__host__ __device__ __forceinline__ int perm32(int rho) { const int n = rho >> 4, i = rho & 15; return 8 * (i >> 2) + 4 * n + (i & 3); }

struct Unit { int pm, pn; };
struct Gemm { const bf16_t* A; const bf16_t* Bt; int M, N, K; };

struct StaticOrder {
    int nM, nN, nwg, G, c;
    __host__ __device__ void init(int M, int N, int G_, int c_) { nM = M / BM; nN = N / BM; nwg = nM * nN; G = G_; c = c_; }
    __host__ __device__ bool next(int i, Unit& u) const {
        const long L = (long)i * G + c; if (L >= nwg) return false;
        int wgid = (int)L; { const int q = nwg / NXCD, r = nwg % NXCD, xcd = wgid % NXCD, off = wgid / NXCD; wgid = (xcd < r ? xcd * (q + 1) : r * (q + 1) + (xcd - r) * q) + off; }
        const int nig = WGM * nN, gid = wgid / nig, fm = gid * WGM, gsz = (nM - fm) < WGM ? (nM - fm) : WGM;
        u.pm = fm + ((wgid % nig) % gsz); u.pn = (wgid % nig) / gsz; return true;
    }
    __device__ __forceinline__ void a_ready(const Unit&) const {}
    __device__ __forceinline__ void done(const Unit&) const {}
};

__device__ __forceinline__ unsigned cvt_pk_bf16(float lo, float hi) { unsigned r; asm volatile("v_cvt_pk_bf16_f32 %0, %1, %2" : "=v"(r) : "v"(lo), "v"(hi)); return r; }

typedef float f32x2_t __attribute__((ext_vector_type(2))); typedef __bf16 bf16x2_t __attribute__((ext_vector_type(2)));
__device__ __forceinline__ unsigned cvtpk_c(float lo, float hi) { f32x2_t v = {lo, hi}; bf16x2_t b = __builtin_convertvector(v, bf16x2_t); return __builtin_bit_cast(unsigned, b); }
__device__ __forceinline__ u32x4 pack8(const f32x4& v0, const f32x4& v1) { u32x4 w; w.x = cvtpk_c(v0[0], v0[1]); w.y = cvtpk_c(v0[2], v0[3]); w.z = cvtpk_c(v1[0], v1[1]); w.w = cvtpk_c(v1[2], v1[3]); return w; }
__device__ __forceinline__ void unpack8(const u32x4& w, f32x4& v0, f32x4& v1) {
    v0[0] = __uint_as_float(w.x << 16); v0[1] = __uint_as_float(w.x & 0xffff0000u); v0[2] = __uint_as_float(w.y << 16); v0[3] = __uint_as_float(w.y & 0xffff0000u);
    v1[0] = __uint_as_float(w.z << 16); v1[1] = __uint_as_float(w.z & 0xffff0000u); v1[2] = __uint_as_float(w.w << 16); v1[3] = __uint_as_float(w.w & 0xffff0000u); }

struct EpiProj {
    static constexpr bool PERM = true, AFTER_DRAIN = false;
    bf16_t* QKV; bf16_t* G; const float* ROPE; float* KMP; float* FKN; float* FQN;
    __device__ __forceinline__ void operator()(const f32x4 (&acc)[2][2][4][2], const Unit& u, int wr, int wc, int fr, int fq) const {
        const int pn = u.pn, row0 = u.pm * BM + wr * 64 + fr;
        if (pn < 12) {
            const int typ = pn >> 1;
            const int slot = (typ == 0) ? 0 : (typ == 3) ? 1 : (typ < 3) ? typ + 1 : typ;
            bf16_t* base = QKV + (size_t)slot * ((size_t)16384 * 512);
            const int colt = (pn & 1) * 256, col0 = colt + wc * 32 + 8 * fq;
            const float sc = (typ == 0 || typ == 3) ? 0.18033688011112042f : 1.0f;
            const bool rope = (typ < 2) && ((wc & 1) == 0);
            const float sgn = (fq == 0) ? -1.f : 1.f; const bool rl = fq < 2;
            f32x4 ks[2][2];
#pragma unroll
            for (int bj = 0; bj < 2; ++bj) { ks[bj][0] = (f32x4){0.f, 0.f, 0.f, 0.f}; ks[bj][1] = (f32x4){0.f, 0.f, 0.f, 0.f}; }
            const bool nrm = (typ == 3 || typ == 4);
            float nmx[2][2] = {{0.f, 0.f}, {0.f, 0.f}};
#pragma unroll
            for (int ai = 0; ai < 2; ++ai)
#pragma unroll
                for (int m = 0; m < 4; ++m) {
                    const int row = row0 + ai * HALF + m * 16;
                    f32x4 c0 = (f32x4){1.f, 1.f, 1.f, 1.f}, c1 = c0, s0 = (f32x4){0.f, 0.f, 0.f, 0.f}, s1 = s0;
                    if (rope) { const f32x4* rp = (const f32x4*)(ROPE + (size_t)(row & 8191) * 16); c0 = rp[0]; c1 = rp[1]; s0 = rp[2]; s1 = rp[3]; }
#pragma unroll
                    for (int bj = 0; bj < 2; ++bj) {
                        f32x4 v0 = acc[ai][bj][m][0], v1 = acc[ai][bj][m][1];
                        if (rope) {
                            f32x4 p0, p1;
#pragma unroll
                            for (int e = 0; e < 4; ++e) { p0[e] = __shfl_xor(v0[e], 16); p1[e] = __shfl_xor(v1[e], 16); }
                            if (rl) { v0 = v0 * c0 + sgn * (p0 * s0); v1 = v1 * c1 + sgn * (p1 * s1); }
                        }
                        if (typ == 1) { ks[bj][0] += v0; ks[bj][1] += v1; }
                        v0 = v0 * sc; v1 = v1 * sc;
                        *(u32x4*)(base + (size_t)row * 512 + col0 + bj * HALF) = pack8(v0, v1);
                        if (nrm) { float ss = ((v0[0] * v0[0] + v0[1] * v0[1]) + (v0[2] * v0[2] + v0[3] * v0[3])) + ((v1[0] * v1[0] + v1[1] * v1[1]) + (v1[2] * v1[2] + v1[3] * v1[3]));
                            { const auto r_ = __builtin_amdgcn_permlane16_swap(__float_as_uint(ss), __float_as_uint(ss), false, false); ss = __uint_as_float(r_[0]) + __uint_as_float(r_[1]); }
                            { const auto r_ = __builtin_amdgcn_permlane32_swap(__float_as_uint(ss), __float_as_uint(ss), false, false); ss = __uint_as_float(r_[0]) + __uint_as_float(r_[1]); }
                            nmx[ai][bj] = fmaxf(nmx[ai][bj], ss); }
                    }
                }
            if (nrm) {
                const int b = u.pm >> 5, nb = u.pm & 31;
#pragma unroll
                for (int bj = 0; bj < 2; ++bj) { const int head = (colt + 128 * bj + 32 * wc) >> 6;
                    float a0 = nmx[0][bj], a1 = nmx[1][bj];
                    a0 = WM_DPP(a0, 0xB1); a0 = WM_DPP(a0, 0x4E); a0 = WM_DPP(a0, 0x141); a0 = WM_DPP(a0, 0x140); a1 = WM_DPP(a1, 0xB1); a1 = WM_DPP(a1, 0x4E); a1 = WM_DPP(a1, 0x141); a1 = WM_DPP(a1, 0x140);
                    if (fr == 0 && fq == 0) {
                        if (typ == 4) { float* d = FKN + ((size_t)(b * 8 + head) * 128 + 4 * nb + wr) * 2 + (wc & 1); d[0] = a0; d[4] = a1; }
                        else FQN[(((size_t)(b * 8 + head) * 32 + nb) * 2 + wr) * 2 + (wc & 1)] = fmaxf(a0, a1); } }
            }
            if (typ == 1) {
#pragma unroll
                for (int bj = 0; bj < 2; ++bj)
#pragma unroll
                    for (int n = 0; n < 2; ++n)
#pragma unroll
                        for (int e = 0; e < 4; ++e) { float v = ks[bj][n][e]; v = WS_DPP(v, 0xB1); v = WS_DPP(v, 0x4E); v = WS_DPP(v, 0x141); v = WS_DPP(v, 0x140); ks[bj][n][e] = v; }
                if (fr == 0) {
                    const int b = u.pm >> 5, nb = u.pm & 31;
#pragma unroll
                    for (int bj = 0; bj < 2; ++bj) { const int head = (colt + 128 * bj + 32 * wc) >> 6, d = 32 * (wc & 1) + 8 * fq;
                        float* dst = KMP + ((((size_t)wr * 16 + b * 8 + head) * 32 + nb) * 64 + d); *(f32x4*)dst = ks[bj][0]; *(f32x4*)(dst + 4) = ks[bj][1]; }
                }
            }
        } else {
            const int gi = pn - 12; bf16_t* base = G + (size_t)(gi >> 2) * ((size_t)16384 * 1024);
            const int col0 = (gi & 3) * 256 + wc * 32 + 8 * fq;
#pragma unroll
            for (int ai = 0; ai < 2; ++ai)
#pragma unroll
                for (int m = 0; m < 4; ++m) { const int row = row0 + ai * HALF + m * 16;
#pragma unroll
                    for (int bj = 0; bj < 2; ++bj) { f32x4 v0 = acc[ai][bj][m][0], v1 = acc[ai][bj][m][1];
#pragma unroll
                        for (int e = 0; e < 4; ++e) { v0[e] = __builtin_amdgcn_rcpf(1.f + __builtin_amdgcn_exp2f(-1.4426950408889634f * v0[e])); v1[e] = __builtin_amdgcn_rcpf(1.f + __builtin_amdgcn_exp2f(-1.4426950408889634f * v1[e])); }
                        *(u32x4*)(base + (size_t)row * 1024 + col0 + bj * HALF) = pack8(v0, v1); } }
        }
    }
};
struct EpiMerge {
    static constexpr bool PERM = true, AFTER_DRAIN = false;
    bf16_t* Mg; const bf16_t* Gt; bool first;
    __device__ __forceinline__ void operator()(const f32x4 (&acc)[2][2][4][2], const Unit& u, int wr, int wc, int fr, int fq) const {
        const int row0 = u.pm * BM + wr * 64 + fr, col0 = u.pn * BM + wc * 32 + 8 * fq;
#pragma unroll
        for (int ai = 0; ai < 2; ++ai)
#pragma unroll
            for (int m = 0; m < 4; ++m) { const size_t off = (size_t)(row0 + ai * HALF + m * 16) * 1024 + col0;
#pragma unroll
                for (int bj = 0; bj < 2; ++bj) { f32x4 g0, g1; unpack8(*(const u32x4*)(Gt + off + bj * HALF), g0, g1);
                    f32x4 v0 = g0 * acc[ai][bj][m][0], v1 = g1 * acc[ai][bj][m][1];
                    if (!first) { f32x4 o0, o1; unpack8(*(const u32x4*)(Mg + off + bj * HALF), o0, o1); v0 += o0; v1 += o1; }
                    *(u32x4*)(Mg + off + bj * HALF) = pack8(v0, v1); } }
    }
};
struct EpiOut {
    static constexpr bool PERM = true, AFTER_DRAIN = false;
    const float* X; float* O; bf16_t* Hb; float* RSSP;
    __device__ __forceinline__ void operator()(const f32x4 (&acc)[2][2][4][2], const Unit& u, int wr, int wc, int fr, int fq) const {
        const int row0 = u.pm * BM + wr * 64 + fr, col0 = u.pn * BM + wc * 32 + 8 * fq;
#pragma unroll
        for (int ai = 0; ai < 2; ++ai)
#pragma unroll
            for (int m = 0; m < 4; ++m) { const int row = row0 + ai * HALF + m * 16; const size_t off = (size_t)row * 1024 + col0; float ss = 0.f;
#pragma unroll
                for (int bj = 0; bj < 2; ++bj) { const f32x4 x0 = *(const f32x4*)(X + off + bj * HALF), x1 = *(const f32x4*)(X + off + bj * HALF + 4);
                    const f32x4 h0 = x0 + acc[ai][bj][m][0], h1 = x1 + acc[ai][bj][m][1];
                    *(u32x4*)(Hb + off + bj * HALF) = pack8(h0, h1);
                    ss += (h0[0] * h0[0] + h0[1] * h0[1]) + (h0[2] * h0[2] + h0[3] * h0[3]) + (h1[0] * h1[0] + h1[1] * h1[1]) + (h1[2] * h1[2] + h1[3] * h1[3]); }
                ss += __shfl_xor(ss, 16); ss += __shfl_xor(ss, 32);
                if (fq == 0) RSSP[(size_t)row * 16 + u.pn * 4 + wc] = ss; }
    }
};
struct EpiStore {
    static constexpr bool PERM = true, AFTER_DRAIN = false;
    bf16_t* O; int ldc;
    __device__ __forceinline__ void operator()(const f32x4 (&acc)[2][2][4][2], const Unit& u, int wr, int wc, int fr, int fq) const {
        const int row0 = u.pm * BM + wr * 64 + fr, col0 = u.pn * BM + wc * 32 + 8 * fq;
#pragma unroll
        for (int ai = 0; ai < 2; ++ai)
#pragma unroll
            for (int m = 0; m < 4; ++m)
#pragma unroll
                for (int bj = 0; bj < 2; ++bj) *(u32x4*)(O + (size_t)(row0 + ai * HALF + m * 16) * ldc + col0 + bj * HALF) = pack8(acc[ai][bj][m][0], acc[ai][bj][m][1]);
    }
};

template <class Epi, class Sched, bool ALIGN_EPI = false, bool SP2 = false, bool F8 = false>
__device__ __forceinline__ void gemm_phase(PG8_LAS unsigned char* lds, const Gemm g, const Sched& S, const Epi& E) {
    const int tid = otid(), wid = __builtin_amdgcn_readfirstlane(tid >> 6), lane = tid & 63, wr = wid >> 2, wc = wid & 3, fr = lane & 15, fq = lane >> 4;
    int K_ = g.K; if constexpr (F8) asm volatile("" : "+s"(K_));
    const int K = K_, nt = K / BK;
    unsigned voffA[2], voffB[2];
#pragma unroll
    for (int i = 0; i < 2; ++i) { int R, C; stage_rc(tid * 16 + i * 8192, R, C); const int Rb = Epi::PERM ? ((R & ~31) + perm32(R & 31)) : R;
        voffA[i] = (unsigned)(R * K + C) * 2u; voffB[i] = (unsigned)(Rb * K + C) * 2u; }
    const size_t kstep = (size_t)(BK * 2);
    const size_t hstep = (size_t)HALF * K * 2;
    const size_t tstep = 2 * hstep;
    const unsigned ldsw = (unsigned)wid * 1024u;
    const int aoff = lds_byte(wr * 64 + fr, fq * 8), boff = lds_byte(wc * 32 + fr, fq * 8);
#define PG8_SA(b, h) (((b) * 2 + (h)) * HTB)
#define PG8_SB(b, h) ((4 + (b) * 2 + (h)) * HTB)
#define PG8_STAGE(bufoff, gbase, voff) do { _Pragma("unroll") for (int _i = 0; _i < 2; ++_i) \
        __builtin_amdgcn_global_load_lds((const unsigned*)((const char*)(gbase) + (voff)[_i]), (PG8_LAS unsigned*)(lds + (bufoff) + ldsw + _i * 8192), 16, 0, 0); } while (0)
#define PG8_LDA(dst, b, h) do { _Pragma("unroll") for (int m = 0; m < 4; ++m) { \
        if constexpr (F8) dst##8[m] = __builtin_shufflevector(*(const PG8_LAS i32x4*)(lds + PG8_SA(b, h) + aoff + m * 2048), *(const PG8_LAS i32x4*)(lds + PG8_SA(b, h) + aoff + m * 2048 + 1024), 0, 1, 2, 3, 4, 5, 6, 7); \
        else { _Pragma("unroll") for (int k = 0; k < 2; ++k) dst[m][k] = *(const PG8_LAS bf16x8*)(lds + PG8_SA(b, h) + aoff + m * 2048 + k * 1024); } } } while (0)
#define PG8_LDB(dst, b, h) do { _Pragma("unroll") for (int n = 0; n < 2; ++n) { \
        if constexpr (F8) dst##8[n] = __builtin_shufflevector(*(const PG8_LAS i32x4*)(lds + PG8_SB(b, h) + boff + n * 2048), *(const PG8_LAS i32x4*)(lds + PG8_SB(b, h) + boff + n * 2048 + 1024), 0, 1, 2, 3, 4, 5, 6, 7); \
        else { _Pragma("unroll") for (int k = 0; k < 2; ++k) dst[n][k] = *(const PG8_LAS bf16x8*)(lds + PG8_SB(b, h) + boff + n * 2048 + k * 1024); } } } while (0)
#define PG8_MMA(ai, bj, At, Bt) do { __builtin_amdgcn_s_setprio(1); _Pragma("unroll") for (int m = 0; m < 4; ++m) _Pragma("unroll") for (int n = 0; n < 2; ++n) { \
        if constexpr (F8) asm volatile("v_mfma_scale_f32_16x16x128_f8f6f4 %0, %1, %2, %0, %3, %4 op_sel_hi:[0,0,0]" : "+v"(acc[ai][bj][m][n]) : "v"(Bt##8[n]), "v"(At##8[m]), "v"(f8sb), "v"(f8sa)); \
        else { _Pragma("unroll") for (int k = 0; k < 2; ++k) acc[ai][bj][m][n] = __builtin_amdgcn_mfma_f32_16x16x32_bf16(Bt[n][k], At[m][k], acc[ai][bj][m][n], 0, 0, 0); } } \
        __builtin_amdgcn_s_setprio(0); } while (0)
#define PG8_WAIT_V(n) asm volatile("s_waitcnt vmcnt(" #n ")" ::: "memory")
#define PG8_WAIT_L(n) asm volatile("s_waitcnt lgkmcnt(" #n ")" ::: "memory")
#define PG8_BAR __builtin_amdgcn_s_barrier()
#define PG8_SCHED __builtin_amdgcn_sched_barrier(0)
    Unit cur, nxt; int ui = 0;
    if (!S.next(0, cur)) return;
    f32x4 acc[2][2][4][2];
#pragma unroll
    for (int a = 0; a < 2; ++a)
#pragma unroll
        for (int b = 0; b < 2; ++b)
#pragma unroll
            for (int m = 0; m < 4; ++m)
#pragma unroll
                for (int n = 0; n < 2; ++n) acc[a][b][m][n] = (f32x4){0.f, 0.f, 0.f, 0.f};
    bf16x8 At[4][2], B0[2][2], B1[2][2]; i32x8 At8[4], B08[2], B18[2];
    const int f8sb = 0x79797979, f8sa = 0x7d7d7d7d;
    const char* cA = (const char*)g.A + (size_t)cur.pm * tstep; const char* cB = (const char*)g.Bt + (size_t)cur.pn * tstep;
    S.a_ready(cur);
    if constexpr (SP2) {
        PG8_STAGE(PG8_SB(0, 0), cB, voffB); PG8_STAGE(PG8_SB(0, 1), cB + hstep, voffB); PG8_STAGE(PG8_SA(0, 0), cA, voffA); PG8_STAGE(PG8_SA(0, 1), cA + hstep, voffA);
        if (wr == 1) PG8_BAR;
        PG8_WAIT_V(2); PG8_BAR;
        PG8_STAGE(PG8_SB(1, 0), cB + kstep, voffB); PG8_STAGE(PG8_SA(1, 0), cA + kstep, voffA); PG8_STAGE(PG8_SB(1, 1), cB + hstep + kstep, voffB);
        PG8_WAIT_V(6); PG8_BAR;
    } else {
        PG8_STAGE(PG8_SB(0, 0), cB, voffB); PG8_STAGE(PG8_SA(0, 0), cA, voffA); PG8_STAGE(PG8_SB(0, 1), cB + hstep, voffB); PG8_STAGE(PG8_SA(0, 1), cA + hstep, voffA);
        if (wr == 1) PG8_BAR;
        PG8_WAIT_V(4); PG8_BAR;
        PG8_STAGE(PG8_SB(1, 0), cB + kstep, voffB); PG8_STAGE(PG8_SA(1, 0), cA + kstep, voffA); PG8_STAGE(PG8_SB(1, 1), cB + hstep + kstep, voffB);
        PG8_WAIT_V(6); PG8_BAR;
    }
    for (;;) {
        const bool has_next = S.next(ui + 1, nxt);
        const char* nA = has_next ? (const char*)g.A + (size_t)nxt.pm * tstep : cA; const char* nB = has_next ? (const char*)g.Bt + (size_t)nxt.pn * tstep : cB;
        for (int t = 0; t < nt; t += 2) {
            const bool last = (t == nt - 2);
            const char* a1 = cA + (size_t)(t + 1) * kstep;
            const char* a2 = last ? nA : cA + (size_t)(t + 2) * kstep; const char* b2 = last ? nB : cB + (size_t)(t + 2) * kstep;
            const char* a3 = a2 + kstep; const char* b3 = b2 + kstep;
            if (last && has_next) S.a_ready(nxt);
            if constexpr (SP2) {
            PG8_LDB(B0, 0, 0); PG8_LDB(B1, 0, 1); PG8_SCHED; PG8_LDA(At, 0, 0); PG8_STAGE(PG8_SA(1, 1), a1 + hstep, voffA);
            PG8_WAIT_V(8); PG8_WAIT_L(0); PG8_BAR; PG8_MMA(0, 0, At, B0); PG8_MMA(0, 1, At, B1); PG8_BAR; PG8_SCHED;
            PG8_LDA(At, 0, 1); PG8_STAGE(PG8_SB(0, 0), b2, voffB); PG8_STAGE(PG8_SB(0, 1), b2 + hstep, voffB); PG8_STAGE(PG8_SA(0, 0), a2, voffA);
            PG8_WAIT_V(8); PG8_WAIT_L(0); PG8_BAR; PG8_MMA(1, 0, At, B0); PG8_MMA(1, 1, At, B1); PG8_BAR; PG8_SCHED;
            PG8_LDB(B0, 1, 0); PG8_LDB(B1, 1, 1); PG8_SCHED; PG8_LDA(At, 1, 0); PG8_STAGE(PG8_SA(0, 1), a2 + hstep, voffA);
            PG8_WAIT_V(8); PG8_WAIT_L(0); PG8_BAR; PG8_MMA(0, 0, At, B0); PG8_MMA(0, 1, At, B1); PG8_BAR; PG8_SCHED;
            PG8_LDA(At, 1, 1); PG8_STAGE(PG8_SB(1, 0), b3, voffB); PG8_STAGE(PG8_SB(1, 1), b3 + hstep, voffB); PG8_STAGE(PG8_SA(1, 0), a3, voffA);
            PG8_WAIT_V(8); PG8_WAIT_L(0); PG8_BAR; PG8_MMA(1, 0, At, B0); PG8_MMA(1, 1, At, B1); PG8_BAR; PG8_SCHED;
            } else {
            PG8_LDB(B0, 0, 0); PG8_SCHED; PG8_LDA(At, 0, 0); PG8_STAGE(PG8_SA(1, 1), a1 + hstep, voffA);
            PG8_WAIT_L(8); PG8_BAR; PG8_WAIT_L(0); PG8_MMA(0, 0, At, B0); PG8_BAR; PG8_SCHED;
            PG8_LDB(B1, 0, 1); PG8_STAGE(PG8_SB(0, 0), b2, voffB);
            PG8_BAR; PG8_WAIT_L(0); PG8_MMA(0, 1, At, B1); PG8_BAR;
            PG8_LDA(At, 0, 1); PG8_STAGE(PG8_SA(0, 0), a2, voffA);
            PG8_BAR; PG8_WAIT_L(0); PG8_MMA(1, 0, At, B0); PG8_BAR; PG8_SCHED;
            PG8_STAGE(PG8_SB(0, 1), b2 + hstep, voffB);
            PG8_WAIT_V(6); PG8_BAR; PG8_MMA(1, 1, At, B1); PG8_BAR;
            PG8_LDB(B0, 1, 0); PG8_SCHED; PG8_LDA(At, 1, 0); PG8_STAGE(PG8_SA(0, 1), a2 + hstep, voffA);
            PG8_WAIT_L(8); PG8_BAR; PG8_WAIT_L(0); PG8_MMA(0, 0, At, B0); PG8_BAR; PG8_SCHED;
            PG8_LDB(B1, 1, 1); PG8_STAGE(PG8_SB(1, 0), b3, voffB);
            PG8_BAR; PG8_WAIT_L(0); PG8_MMA(0, 1, At, B1); PG8_BAR;
            PG8_LDA(At, 1, 1); PG8_STAGE(PG8_SA(1, 0), a3, voffA);
            PG8_BAR; PG8_WAIT_L(0); PG8_MMA(1, 0, At, B0); PG8_BAR; PG8_SCHED;
            PG8_STAGE(PG8_SB(1, 1), b3 + hstep, voffB);
            PG8_WAIT_V(6); PG8_BAR; PG8_MMA(1, 1, At, B1); PG8_BAR;
            }
        }
        if constexpr (ALIGN_EPI) { if (wr == 0) PG8_BAR; }
        if constexpr (F8) {
            asm volatile("s_nop 15\n\ts_nop 15" ::: "memory");
#pragma unroll
            for (int a_ = 0; a_ < 2; ++a_)
#pragma unroll
                for (int b_ = 0; b_ < 2; ++b_)
                    asm volatile("" : "+v"(acc[a_][b_][0][0]), "+v"(acc[a_][b_][0][1]), "+v"(acc[a_][b_][1][0]), "+v"(acc[a_][b_][1][1]), "+v"(acc[a_][b_][2][0]), "+v"(acc[a_][b_][2][1]), "+v"(acc[a_][b_][3][0]), "+v"(acc[a_][b_][3][1])); }
        if constexpr (!Epi::AFTER_DRAIN) { E(acc, cur, wr, wc, fr, fq); S.done(cur); }
        if (!has_next) break;
#pragma unroll
        for (int a = 0; a < 2; ++a)
#pragma unroll
            for (int b = 0; b < 2; ++b)
#pragma unroll
                for (int m = 0; m < 4; ++m)
#pragma unroll
                    for (int n = 0; n < 2; ++n) acc[a][b][m][n] = (f32x4){0.f, 0.f, 0.f, 0.f};
        cur = nxt; cA = nA; cB = nB; ++ui;
        if constexpr (ALIGN_EPI) { if (wr == 1) PG8_BAR; }
    }
    PG8_WAIT_V(0);
    if constexpr (!ALIGN_EPI) { if (wr == 0) PG8_BAR; }
    PG8_BAR;
    if constexpr (Epi::AFTER_DRAIN) { E.fused(acc, cur, wr, wc, fr, fq, lds, wid, lane); S.done(cur); }
#undef PG8_SA
#undef PG8_SB
#undef PG8_STAGE
#undef PG8_LDA
#undef PG8_LDB
#undef PG8_MMA
#undef PG8_WAIT_V
#undef PG8_WAIT_L
#undef PG8_BAR
#undef PG8_SCHED
}
}


__device__ __forceinline__ float log_sigmoid(float z) { return z >= 0.f ? -log1pf(expf(-z)) : z - log1pf(expf(z)); }
constexpr float XN8_SCALE = 4.0f, WIN8_SCALE = 64.0f;
__device__ __forceinline__ unsigned pk4_fp8(float a, float b, float c, float d) { int w = __builtin_amdgcn_cvt_pk_fp8_f32(a, b, 0, false); w = __builtin_amdgcn_cvt_pk_fp8_f32(c, d, w, true); return (unsigned)w; }
__device__ __forceinline__ void p0_transpose_item8(const float* W, int ldw, int K, int ncols, unsigned char* WT, int row_off, LAS float* scr, int item, int lane, float scale) {
    const int nblk = ncols / 32, kb = item / nblk, nb = item % nblk, k0 = 64 * kb, n0 = 32 * nb;
#pragma unroll 8
    for (int i = 0; i < 32; ++i) { const int kk = 2 * i + (lane >> 5); scr[kk * 33 + (lane & 31)] = W[(size_t)(k0 + kk) * ldw + n0 + (lane & 31)] * scale; }
    asm volatile("s_waitcnt lgkmcnt(0)" ::: "memory");
    const int c = lane & 7;
#pragma unroll
    for (int j = 0; j < 4; ++j) { const int n = (lane >> 3) + 8 * j; const LAS float* s = scr + (8 * c) * 33 + n;
        u32x2 o; o.x = pk4_fp8(s[0 * 33], s[1 * 33], s[2 * 33], s[3 * 33]); o.y = pk4_fp8(s[4 * 33], s[5 * 33], s[6 * 33], s[7 * 33]);
        *(u32x2*)(WT + (size_t)(row_off + n0 + n) * K + k0 + 8 * c) = o; }
    asm volatile("s_waitcnt lgkmcnt(0)" ::: "memory");
}
__device__ __forceinline__ void p0_transpose_item(const float* W, int ldw, int K, int ncols, bf16_t* WT, int row_off, LAS float* scr, int item, int lane, const float* ksc = nullptr) {
    const int nblk = ncols / 32, kb = item / nblk, nb = item % nblk, k0 = 64 * kb, n0 = 32 * nb;
#pragma unroll 8
    for (int i = 0; i < 32; ++i) { const int kk = 2 * i + (lane >> 5); scr[kk * 33 + (lane & 31)] = W[(size_t)(k0 + kk) * ldw + n0 + (lane & 31)] * (ksc ? ksc[k0 + kk] : 1.0f); }
    asm volatile("s_waitcnt lgkmcnt(0)" ::: "memory");
    const int c = lane & 7;
#pragma unroll
    for (int j = 0; j < 4; ++j) { const int n = (lane >> 3) + 8 * j; const LAS float* s = scr + (8 * c) * 33 + n;
        u32x4 o; o.x = pk2(s[0 * 33], s[1 * 33]); o.y = pk2(s[2 * 33], s[3 * 33]); o.z = pk2(s[4 * 33], s[5 * 33]); o.w = pk2(s[6 * 33], s[7 * 33]);
        *(u32x4*)(WT + (size_t)(row_off + n0 + n) * K + k0 + 8 * c) = o; }
    asm volatile("s_waitcnt lgkmcnt(0)" ::: "memory");
}
__device__ __forceinline__ void phase_prologue(LAS unsigned char* ldsb, const P& p) {
    const int TID = otid();
    const int lane = TID & 63, wave = TID >> 6, gw = blockIdx.x * 8 + wave, nw = gridDim.x * 8;
    LAS float* scr = (LAS float*)(ldsb + wave * 16384);
    constexpr int I1 = 16 * 96, I2 = 16 * 64, IA = 8 * 32, IO = 16 * 32, IQ = 16 * 64;
    for (int it = gw; it < I1 + I2 + 2 * IA + IO + IQ; it += nw) {
        int r = it;
        if (r < I1) { p0_transpose_item8(p.w_in, INC, D, 3072, p.ws + WS_WIN, 0, scr, r, lane, WIN8_SCALE); continue; } r -= I1;
        if (r < I2) { p0_transpose_item8(p.w_in + 3080, INC, D, 2048, p.ws + WS_WIN, 3072, scr, r, lane, WIN8_SCALE); continue; } r -= I2;
        if (r < IA) { p0_transpose_item(p.w_a, D, 512, 1024, (bf16_t*)(p.ws + WS_WA), 0, scr, r, lane); continue; } r -= IA;
        if (r < IA) { p0_transpose_item(p.w_b, D, 512, 1024, (bf16_t*)(p.ws + WS_WB), 0, scr, r, lane); continue; } r -= IA;
        if (r < IO) { p0_transpose_item(p.w_out, D, D, 1024, (bf16_t*)(p.ws + WS_WOUT), 0, scr, r, lane); continue; } r -= IO;
        p0_transpose_item(p.w_pq, PQC, D, 2048, (bf16_t*)(p.ws + WS_WPQ), 0, scr, r, lane, p.g_ffn);
    }
    { u32x4* SKo = (u32x4*)(p.ws + WS_SK);
      for (int c = blockIdx.x * 512 + TID; c < PH * 2 * PNK * PHALF / 8; c += gridDim.x * 512) { const f32x4 a0 = *(const f32x4*)(p.sk + (size_t)c * 8), a1 = *(const f32x4*)(p.sk + (size_t)c * 8 + 4);
          u32x4 o; o.x = pk2(a0.x, a0.y); o.y = pk2(a0.z, a0.w); o.z = pk2(a1.x, a1.y); o.w = pk2(a1.z, a1.w); SKo[c] = o; } }
    { float* ROPE = (float*)(p.ws + WS_ROPE);
      for (int it = blockIdx.x * 512 + TID; it < S * 8; it += gridDim.x * 512) { const int i = it & 7, pos = it >> 3;
          const float inv_freq = powf(500000.0f, -(float)i / 8.0f); const float ang = (float)pos * inv_freq;
          ROPE[pos * 16 + i] = cosf(ang); ROPE[pos * 16 + 8 + i] = sinf(ang); } }
    __syncthreads();
    { LAS float* WFt = (LAS float*)ldsb;
      for (int i = TID; i < 2 * D; i += 512) { const int col = i >> 1, half = i & 1; const f32x4 w = *(const f32x4*)(p.w_in + (size_t)col * INC + 3072 + 4 * half);
          WFt[(4 * half + 0) * D + col] = w.x; WFt[(4 * half + 1) * D + col] = w.y; WFt[(4 * half + 2) * D + col] = w.z; WFt[(4 * half + 3) * D + col] = w.w; } }
    __syncthreads();
    bf16_t* XN = (bf16_t*)(p.ws + WS_XN); float* LOGF = (float*)(p.ws + WS_LOGF); const LAS float* WFt = (const LAS float*)ldsb;
    float wsum = 0.f;
    const int fo = 4 * (lane & 1) + 2 * ((lane >> 1) & 1) + ((lane >> 2) & 1);
    const float bfo = p.b_f[fo];
#define PRO_X(x, ctrl) __builtin_bit_cast(float, __builtin_amdgcn_update_dpp(0, __builtin_bit_cast(int, (x)), (ctrl), 0xf, 0xf, true))
#pragma unroll 1
    for (int rh = 0; rh < 8; rh += 4) {
    f32x4 xv[4][4];
#pragma unroll
    for (int r8 = 0; r8 < 4; ++r8)
#pragma unroll
        for (int j = 0; j < 4; ++j) xv[r8][j] = ((const f32x4*)(p.x + (size_t)(gw * 8 + rh + r8) * D))[lane + 64 * j];
#pragma unroll
    for (int r8 = 0; r8 < 4; ++r8) {
        const int row = gw * 8 + rh + r8;
        f32x4 v[4]; float ss = 0.f;
#pragma unroll
        for (int j = 0; j < 4; ++j) { v[j] = xv[r8][j]; ss += v[j].x * v[j].x + v[j].y * v[j].y + v[j].z * v[j].z + v[j].w * v[j].w; }
        ss = wave_sum_fast(ss);
        const float rstd = rsqrtf(ss * (1.f / D) + EPS);
        float fs[8];
#pragma unroll
        for (int f = 0; f < 8; ++f) fs[f] = 0.f;
#pragma unroll
        for (int j = 0; j < 4; ++j) {
            const f32x4 g = ((const f32x4*)p.g_mix)[lane + 64 * j];
            v[j].x *= rstd * g.x; v[j].y *= rstd * g.y; v[j].z *= rstd * g.z; v[j].w *= rstd * g.w;
            *(unsigned*)((unsigned char*)XN + (size_t)row * D + 4 * (lane + 64 * j)) = pk4_fp8(v[j].x * XN8_SCALE, v[j].y * XN8_SCALE, v[j].z * XN8_SCALE, v[j].w * XN8_SCALE);
#pragma unroll
            for (int f = 0; f < 8; ++f) { const f32x4 w = *(const LAS f32x4*)(WFt + f * D + 4 * (lane + 64 * j)); fs[f] += (v[j].x * w.x + v[j].y * w.y) + (v[j].z * w.z + v[j].w * w.w); }
        }
        float h4[4], g2[2];
#pragma unroll
        for (int i = 0; i < 4; ++i) { const float a = fs[i] + PRO_X(fs[i], 0xB1), b = fs[i + 4] + PRO_X(fs[i + 4], 0xB1); h4[i] = (lane & 1) ? b : a; }
#pragma unroll
        for (int i = 0; i < 2; ++i) { const float a = h4[i] + PRO_X(h4[i], 0x4E), b = h4[i + 2] + PRO_X(h4[i + 2], 0x4E); g2[i] = (lane & 2) ? b : a; }
        float z;
        { const float a = g2[0] + __builtin_bit_cast(float, __builtin_amdgcn_ds_bpermute((lane ^ 4) << 2, __builtin_bit_cast(int, g2[0]))), b = g2[1] + __builtin_bit_cast(float, __builtin_amdgcn_ds_bpermute((lane ^ 4) << 2, __builtin_bit_cast(int, g2[1]))); z = (lane & 4) ? b : a; }
        z = sum_x8(z); z = sum_x16(z); z = sum_x32(z);
        if (lane < 8) { const float lf = log_sigmoid(z + bfo); LOGF[(size_t)row * 8 + fo] = lf; wsum += lf; }
    }
    }
#undef PRO_X
    if (lane < 8) ((float*)(p.ws + WS_WSUM))[gw * 8 + fo] = wsum;
}

__device__ __forceinline__ void phase_cumsum(const P& p) {
    const int TID = otid();
    const int lane = TID & 63, gw = blockIdx.x * 8 + (TID >> 6), b = gw >> 10, w0 = b << 10, h = lane & 7, j = lane >> 3;
    const float* WSUM = (const float*)(p.ws + WS_WSUM); const float* LOGF = (const float*)(p.ws + WS_LOGF); float* C = (float*)(p.ws + WS_C);
    float part = 0.f;
    { float p1 = 0.f, p2 = 0.f, p3 = 0.f; int w = w0 + j;
      for (; w + 24 < gw; w += 32) { part += WSUM[w * 8 + h]; p1 += WSUM[(w + 8) * 8 + h]; p2 += WSUM[(w + 16) * 8 + h]; p3 += WSUM[(w + 24) * 8 + h]; }
      for (; w < gw; w += 8) part += WSUM[w * 8 + h];
      part = (part + p1) + (p2 + p3); }
    part += __shfl_xor(part, 8); part += __shfl_xor(part, 16); part += __shfl_xor(part, 32);
    if (lane < 8) { float run = part;
#pragma unroll
        for (int r = 0; r < 8; ++r) { const int row = gw * 8 + r; run += LOGF[(size_t)row * 8 + h]; C[(size_t)(b * 8 + h) * S + (row & (S - 1))] = run * LOG2E; } }
}

#include <hip/hip_bf16.h>
namespace attn {
using bf16=__hip_bfloat16;
using bf16x8=__attribute__((ext_vector_type(8)))short;
using s16x4=__attribute__((ext_vector_type(4)))short;
using f32x16=__attribute__((ext_vector_type(16)))float;
using f32x4=__attribute__((ext_vector_type(4)))float;
using u32x4=__attribute__((ext_vector_type(4)))unsigned;
constexpr int SEQ=8192,D=64,DM=512;
constexpr int NW=8,QBLK=32,QB=QBLK*NW,KVBLK=64;
__device__ __forceinline__ int crow(int r,int hi){return (r&3)+8*(r>>2)+4*hi;}
#define SBAR() __builtin_amdgcn_sched_barrier(0)
__device__ __forceinline__ void cmask(f32x16&p0,f32x16&p1,int jb,int qrel,int hi){
  const float NEG=-INFINITY; int kb=64*jb+4*hi;
  #pragma unroll
  for(int r=0;r<16;++r){int kv=kb+(r&3)+8*(r>>2); if(kv>qrel)p0[r]=NEG; if(kv+32>qrel)p1[r]=NEG;}
}
constexpr int KSUM_P1=16*32*64;
constexpr int NSLOT=3, SLOTB=8192;
constexpr int LDS_K=0, LDS_V=NSLOT*SLOTB, LDS_WS=2*NSLOT*SLOTB, LDS_OST=LDS_WS+NW*64*4, LDS_CK=LDS_OST+NW*4096, LDS_BYTES=LDS_CK+SEQ*4;
__device__ __forceinline__ void glds16(const void*gsrc,unsigned lds_dst){unsigned keep;
  asm volatile("s_mov_b32 %0, m0\n\ts_mov_b32 m0, %2\n\ts_nop 0\n\tglobal_load_lds_dwordx4 %1, off\n\ts_mov_b32 m0, %0":"=&s"(keep):"v"(gsrc),"s"(lds_dst):"memory");}
typedef float f32x2_t __attribute__((ext_vector_type(2))); typedef __bf16 bf16x2_t __attribute__((ext_vector_type(2)));
__device__ __forceinline__ unsigned cvtpk_s(float lo,float hi){f32x2_t v={lo,hi};bf16x2_t b=__builtin_convertvector(v,bf16x2_t);return __builtin_bit_cast(unsigned,b);}
#define WAIT_BAR(N) asm volatile("s_waitcnt vmcnt(" #N ") lgkmcnt(0)\n\ts_barrier":::"memory")
typedef __attribute__((address_space(3))) const char* lds_cptr;
typedef short v4i16_t __attribute__((ext_vector_type(4)));
__device__ __forceinline__ void kload8(bf16x8*kf,lds_cptr kp){
  kf[0]=*(const __attribute__((address_space(3))) bf16x8*)(kp);      kf[1]=*(const __attribute__((address_space(3))) bf16x8*)(kp+512);
  kf[2]=*(const __attribute__((address_space(3))) bf16x8*)(kp+2048); kf[3]=*(const __attribute__((address_space(3))) bf16x8*)(kp+2560);
  kf[4]=*(const __attribute__((address_space(3))) bf16x8*)(kp+4096); kf[5]=*(const __attribute__((address_space(3))) bf16x8*)(kp+4608);
  kf[6]=*(const __attribute__((address_space(3))) bf16x8*)(kp+6144); kf[7]=*(const __attribute__((address_space(3))) bf16x8*)(kp+6656);
}
__device__ __forceinline__ void kload2(bf16x8*kf,lds_cptr kp,int j){ kf[2*j]=*(const __attribute__((address_space(3))) bf16x8*)(kp+j*2048); kf[2*j+1]=*(const __attribute__((address_space(3))) bf16x8*)(kp+j*2048+512); }
__device__ __forceinline__ s16x4 vtr(lds_cptr p){ return __builtin_bit_cast(s16x4,__builtin_amdgcn_ds_read_tr16_b64_v4i16((__attribute__((address_space(3))) v4i16_t*)p)); }
template<bool FOX> __device__ __forceinline__ void cinit(f32x16&C,const __attribute__((address_space(3))) float*ckt,float bs){
  if constexpr(FOX){
    #pragma unroll
    for(int g=0;g<4;++g){ const f32x4 kb=*(const __attribute__((address_space(3))) f32x4*)(ckt+8*g); C[4*g]=bs-kb[0]; C[4*g+1]=bs-kb[1]; C[4*g+2]=bs-kb[2]; C[4*g+3]=bs-kb[3]; }
  } else {
    #pragma unroll
    for(int r=0;r<16;++r)C[r]=bs;
  }
  asm volatile("":"+v"(C));
}
__device__ __forceinline__ void pv(f32x16*o,int vb,bf16x8 pa0,bf16x8 pa1,bf16x8 pa2,bf16x8 pa3){
  #pragma unroll
  for(int d0=0;d0<2;++d0){s16x4 lo[4],hi[4];
    #pragma unroll
    for(int ks=0;ks<4;++ks){
      asm volatile("ds_read_b64_tr_b16 %0,%1 offset:%c2":"=&v"(lo[ks]):"v"(vb),"i"(d0*4096+ks*1024):"memory");
      asm volatile("ds_read_b64_tr_b16 %0,%1 offset:%c2":"=&v"(hi[ks]):"v"(vb),"i"(d0*4096+ks*1024+512):"memory");}
    asm volatile("s_waitcnt lgkmcnt(0)":::"memory");SBAR();
    #define PK(k) (bf16x8){lo[k][0],lo[k][1],lo[k][2],lo[k][3],hi[k][0],hi[k][1],hi[k][2],hi[k][3]}
    o[d0]=__builtin_amdgcn_mfma_f32_32x32x16_bf16(pa0,PK(0),o[d0],0,0,0);
    o[d0]=__builtin_amdgcn_mfma_f32_32x32x16_bf16(pa1,PK(1),o[d0],0,0,0);
    o[d0]=__builtin_amdgcn_mfma_f32_32x32x16_bf16(pa2,PK(2),o[d0],0,0,0);
    o[d0]=__builtin_amdgcn_mfma_f32_32x32x16_bf16(pa3,PK(3),o[d0],0,0,0);
    #undef PK
  }
}
#define ATTN_STORE16(p,v) (*(u32x4*)(p)=(v))
struct MobaIo { const unsigned short* QL; int qcnt, jblk; const unsigned* SEL3; bf16* PART0; bf16* PART1; bf16* PART2; float* LSE; };
template<bool FOX,int THRL,int VAR> __device__ __forceinline__ void attn_unit(int b,int h,int qb,int t0,const bf16*Q,const bf16*__restrict__ K,const bf16*__restrict__ V,bf16*O,const float*CK2,const MobaIo&mio,char*shm){
  const int tid=otid(),lane=tid&63,r32=lane&31,hi=lane>>5; const int wid=__builtin_amdgcn_readfirstlane(tid>>6);
  const long rowbase=(long)b*SEQ; const int q0=qb*QB;
  int qidx=q0+wid*QBLK+r32; bool qvalid=true;
  if constexpr(VAR==2){ const int li=wid*QBLK+r32; qvalid=li<mio.qcnt; qidx=(int)mio.QL[qvalid?li:mio.qcnt-1]; }
  const bf16*Qrow=Q+(rowbase+qidx)*DM+h*D;
  const bf16*Kh=K+(rowbase+(long)t0*KVBLK)*DM+h*D,*Vh=V+(rowbase+(long)t0*KVBLK)*DM+h*D;
  const unsigned lds0=(unsigned)(uintptr_t)shm;
  float*wsf=(float*)(shm+LDS_WS)+wid*64;
  const bf16*ksrc=Kh+(long)lane*DM+wid*8;
  const bf16*vsrc=Vh+(long)(16*(wid&3)+(lane>>2))*DM+(wid>>2)*32+(lane&3)*8;
  const unsigned kdst=lds0+LDS_K+wid*1024, vdst=lds0+LDS_V+wid*1024;
  #define DMA_K(t,slot) glds16(ksrc+(long)(t)*KVBLK*DM,(unsigned)__builtin_amdgcn_readfirstlane(kdst+(slot)))
  #define DMA_V(t,slot) glds16(vsrc+(long)(t)*KVBLK*DM,(unsigned)__builtin_amdgcn_readfirstlane(vdst+(slot)))
  const int vb0=(int)(lds0+LDS_V)+((lane>>4)&1)*32+(lane&3)*8+(4*hi+((lane&15)>>2))*64;
  bf16x8 kf[8];
  const lds_cptr shm3=(lds_cptr)shm; const lds_cptr kp0=shm3+LDS_K+hi*1024+r32*16; const lds_cptr vp0=shm3+LDS_V+((lane>>4)&1)*32+(lane&3)*8+(4*hi+((lane&15)>>2))*64;
  const __attribute__((address_space(3))) float*ckl=(const __attribute__((address_space(3))) float*)(shm3+LDS_CK)+4*hi;
  const int NT=(VAR==2)?4:(q0+QB)/KVBLK-t0;
  DMA_K(0,0);DMA_V(0,0);DMA_K(1,SLOTB);
  bf16x8 qr[4];
  #pragma unroll
  for(int d0=0;d0<4;++d0)qr[d0]=*reinterpret_cast<const bf16x8*>(&Qrow[d0*16+hi*8]);
  float cq2=0.f;
  if constexpr(FOX){ __attribute__((address_space(3))) f32x4*ck4=(__attribute__((address_space(3))) f32x4*)(shm3+LDS_CK); const f32x4*g4=(const f32x4*)CK2+t0*16;
    for(int i=tid;i<NT*16;i+=NW*64)ck4[i]=g4[i];
    cq2=CK2[q0+wid*QBLK+r32]; }
  float mhat=0.f,l_reg=0.f;f32x16 o[2];o[0]=f32x16{};o[1]=f32x16{};
  const int qrel=wid*QBLK+r32;
  #define CMASK(P0,P1,t) do{ if constexpr(VAR!=2){ int jb_=(t)-(NT-4); if(jb_>=0)cmask(P0,P1,jb_,qrel,hi); } }while(0)
  #define BASE(t) (FOX ? (cq2-mhat) : -mhat)
  bool resc=false,nmd=true; f32x16 negm=f32x16{}; asm volatile("":"+v"(negm));
  #define RESC() do{ if(resc){ asm volatile("s_waitcnt lgkmcnt(0)":::"memory"); \
      _Pragma("unroll") for(int d_=0;d_<2;++d_) _Pragma("unroll") for(int r=0;r<16;++r)o[d_][r]*=wsf[crow(r,hi)]; } }while(0)
  #define MX3(a,b,c) __builtin_fmaxf(__builtin_fmaxf((a),(b)),(c))
  #define DECIDE(C0,C1) do{ float a=MX3(C0[0],C0[1],C1[0]),b_=MX3(C0[2],C0[3],C1[1]); a=MX3(a,C1[2],C1[3]); \
      _Pragma("unroll") for(int r=4;r<16;r+=4){a=MX3(a,C0[r],C0[r+1]);b_=MX3(b_,C0[r+2],C0[r+3]);a=MX3(a,C1[r],C1[r+1]);b_=MX3(b_,C1[r+2],C1[r+3]);} \
      float rm=__builtin_fmaxf(a,b_); { auto rr=__builtin_amdgcn_permlane32_swap(__float_as_uint(rm),__float_as_uint(rm),false,false); rm=__builtin_fmaxf(__uint_as_float(rr[0]),__uint_as_float(rr[1])); } \
      resc=false; \
      if(__builtin_expect(__any(rm>(float)THRL),0)){ const float dl=(rm>(float)THRL)?rm:0.f; mhat+=dl;     \
        _Pragma("unroll") for(int r=0;r<16;++r){C0[r]-=dl;C1[r]-=dl;} \
        const float f=__builtin_amdgcn_exp2f(-dl); l_reg*=f; if(hi==0)wsf[r32]=f; resc=true; nmd=true; } }while(0)
  f32x16 pA0,pA1,pB0,pB1;
  int sl_prev=0,sl_cur=0,sl_next=SLOTB;
  #define ROT() do{sl_prev=sl_cur;sl_cur=sl_next;sl_next=(sl_next==(NSLOT-1)*SLOTB)?0:sl_next+SLOTB;}while(0)
  DMA_K(2,2*SLOTB);
  WAIT_BAR(3);
  { const float bs=BASE(0); cinit<FOX>(pA0,ckl,bs); cinit<FOX>(pA1,ckl+32,bs);
    const char*kb=shm+LDS_K+hi*1024+r32*16;
    #pragma unroll
    for(int d0=0;d0<4;++d0){
      const bf16x8 b0=*reinterpret_cast<const bf16x8*>(kb+d0*2048);
      const bf16x8 b1=*reinterpret_cast<const bf16x8*>(kb+d0*2048+512);
      pA0=__builtin_amdgcn_mfma_f32_32x32x16_bf16(b0,qr[d0],pA0,0,0,0);pA1=__builtin_amdgcn_mfma_f32_32x32x16_bf16(b1,qr[d0],pA1,0,0,0);}
    CMASK(pA0,pA1,0);
    DECIDE(pA0,pA1); resc=false;
    _Pragma("unroll") for(int r=0;r<16;++r){pA0[r]=__builtin_amdgcn_exp2f(pA0[r]);pA1[r]=__builtin_amdgcn_exp2f(pA1[r]);} }
  WAIT_BAR(0);
  DMA_K(3,0);DMA_V(1,SLOTB);
  ROT();
  kload8(kf,kp0+sl_cur);
  WAIT_BAR(2);
  s16x4 vlo[8],vhi[8]; u32x4 pw0,pw1,pw2,pw3;
  #define PKW(P,B) cvtpk_s(P[B],P[B+1])
  #define PAF(k) __builtin_bit_cast(bf16x8,pw##k)
  #define VFR(i) (bf16x8){vlo[i][0],vlo[i][1],vlo[i][2],vlo[i][3],vhi[i][0],vhi[i][1],vhi[i][2],vhi[i][3]}
  #define PIN(x) asm volatile("":"+v"(x))
  #define GAPA(MF,A0,A1,A2,A3,W0,W1,PW) do{ MF; sacc+=A0; sacc+=A1; sacc+=A2; sacc+=A3; PIN(sacc); W0; W1; PIN(PW); SBAR(); }while(0)
  #define EX(v) __builtin_amdgcn_exp2f(v)
  #define GAPB(MF,X,B) do{ MF; X[B]=EX(X[B]); X[B+1]=EX(X[B+1]); X[B+2]=EX(X[B+2]); X[B+3]=EX(X[B+3]); PIN(X); SBAR(); }while(0)
  #define VRD(i) do{ vlo[i]=vtr(vp_+(((i)>>2)*4096+((i)&3)*1024)); vhi[i]=vtr(vp_+(((i)>>2)*4096+((i)&3)*1024+512)); }while(0)
  #define KRD(G,j) do{ if(G){ kload2(kf,kp0+sl_next,j); SBAR(); } }while(0)
  #define STEP(C0,C1,P0,P1,t,GK,GV,GL) do{ SBAR(); \
    const lds_cptr vp_=vp0+sl_prev; const float bs_=BASE(t); \
    if constexpr(FOX){ cinit<FOX>(C0,ckl+(t)*64,bs_); SBAR(); } \
    else if(nmd){ _Pragma("unroll") for(int r=0;r<16;++r)negm[r]=bs_; asm volatile("":"+v"(negm)); nmd=false; SBAR(); }     \
    VRD(0); SBAR(); float sacc=(P0[0]+P0[1]); \
    GAPA(C0=__builtin_amdgcn_mfma_f32_32x32x16_bf16(kf[0],qr[0],FOX?C0:negm,0,0,0), P0[2],P0[3],P0[4],P0[5],     pw0[0]=PKW(P0,0), pw0[1]=PKW(P0,2), pw0); \
    if constexpr(FOX){ cinit<FOX>(C1,ckl+(t)*64+32,bs_); SBAR(); } \
    VRD(4); SBAR(); GAPA(C1=__builtin_amdgcn_mfma_f32_32x32x16_bf16(kf[1],qr[0],FOX?C1:negm,0,0,0), P0[6],P0[7],P0[8],P0[9],     pw0[2]=PKW(P0,4), pw0[3]=PKW(P0,6), pw0); \
    VRD(1); SBAR(); GAPA(C0=__builtin_amdgcn_mfma_f32_32x32x16_bf16(kf[2],qr[1],C0,0,0,0),   P0[10],P0[11],P0[12],P0[13], pw1[0]=PKW(P0,8), pw1[1]=PKW(P0,10), pw1); \
    VRD(5); SBAR(); GAPA(C1=__builtin_amdgcn_mfma_f32_32x32x16_bf16(kf[3],qr[1],C1,0,0,0),   P0[14],P0[15],P1[0],P1[1],   pw1[2]=PKW(P0,12),pw1[3]=PKW(P0,14), pw1); \
    VRD(2); SBAR(); GAPA(C0=__builtin_amdgcn_mfma_f32_32x32x16_bf16(kf[4],qr[2],C0,0,0,0),   P1[2],P1[3],P1[4],P1[5],     pw2[0]=PKW(P1,0), pw2[1]=PKW(P1,2), pw2); \
    VRD(6); SBAR(); GAPA(C1=__builtin_amdgcn_mfma_f32_32x32x16_bf16(kf[5],qr[2],C1,0,0,0),   P1[6],P1[7],P1[8],P1[9],     pw2[2]=PKW(P1,4), pw2[3]=PKW(P1,6), pw2); \
    VRD(3); SBAR(); GAPA(C0=__builtin_amdgcn_mfma_f32_32x32x16_bf16(kf[6],qr[3],C0,0,0,0),   P1[10],P1[11],P1[12],P1[13], pw3[0]=PKW(P1,8), pw3[1]=PKW(P1,10), pw3); \
    VRD(7); SBAR(); GAPA(C1=__builtin_amdgcn_mfma_f32_32x32x16_bf16(kf[7],qr[3],C1,0,0,0),   P1[14],P1[15],0.f,0.f,       pw3[2]=PKW(P1,12),pw3[3]=PKW(P1,14), pw3); \
    l_reg+=sacc; \
    if(GK){DMA_K((t)+3,sl_cur);} if(GV){DMA_V((t)+1,sl_next);} \
    CMASK(C0,C1,t); \
    DECIDE(C0,C1); \
    SBAR(); \
    GAPB(o[0]=__builtin_amdgcn_mfma_f32_32x32x16_bf16(PAF(0),VFR(0),o[0],0,0,0), C0,0); \
    GAPB(o[1]=__builtin_amdgcn_mfma_f32_32x32x16_bf16(PAF(0),VFR(4),o[1],0,0,0), C0,4); \
    KRD(GL,0); GAPB(o[0]=__builtin_amdgcn_mfma_f32_32x32x16_bf16(PAF(1),VFR(1),o[0],0,0,0), C0,8); \
    KRD(GL,1); GAPB(o[1]=__builtin_amdgcn_mfma_f32_32x32x16_bf16(PAF(1),VFR(5),o[1],0,0,0), C0,12); \
    KRD(GL,2); GAPB(o[0]=__builtin_amdgcn_mfma_f32_32x32x16_bf16(PAF(2),VFR(2),o[0],0,0,0), C1,0); \
    KRD(GL,3); GAPB(o[1]=__builtin_amdgcn_mfma_f32_32x32x16_bf16(PAF(2),VFR(6),o[1],0,0,0), C1,4); \
    GAPB(o[0]=__builtin_amdgcn_mfma_f32_32x32x16_bf16(PAF(3),VFR(3),o[0],0,0,0), C1,8); \
    GAPB(o[1]=__builtin_amdgcn_mfma_f32_32x32x16_bf16(PAF(3),VFR(7),o[1],0,0,0), C1,12); \
    }while(0)
  int t=1;
  #undef CMASK
  #define CMASK(P0,P1,t) do{}while(0)
  for(;t+5<NT;t+=2){
    STEP(pB0,pB1,pA0,pA1,t,true,true,true);     WAIT_BAR(2); RESC(); ROT();
    STEP(pA0,pA1,pB0,pB1,t+1,true,true,true);   WAIT_BAR(2); RESC(); ROT();
  }
  #undef CMASK
  #define CMASK(P0,P1,t) do{ if constexpr(VAR!=2){ int jb_=(t)-(NT-4); if(jb_>=0)cmask(P0,P1,jb_,qrel,hi); } }while(0)
  #define ENDW(tt) do{ if((tt)+3<NT){WAIT_BAR(2);} else if((tt)+2<NT){WAIT_BAR(1);} else {WAIT_BAR(0);} }while(0)
  for(;t+1<NT;t+=2){
    STEP(pB0,pB1,pA0,pA1,t,(t+3<NT),(t+1<NT),(t+1<NT));       ENDW(t);   RESC(); ROT();
    STEP(pA0,pA1,pB0,pB1,t+1,(t+4<NT),(t+2<NT),(t+2<NT));     ENDW(t+1); RESC(); ROT();
  }
  STEP(pB0,pB1,pA0,pA1,NT-1,false,false,false); RESC();
  { float sacc=pB0[0]+pB0[1]; _Pragma("unroll") for(int r=2;r<16;++r)sacc+=pB0[r]; _Pragma("unroll") for(int r=0;r<16;++r)sacc+=pB1[r]; l_reg+=sacc;
    pw0=(u32x4){PKW(pB0,0),PKW(pB0,2),PKW(pB0,4),PKW(pB0,6)};pw1=(u32x4){PKW(pB0,8),PKW(pB0,10),PKW(pB0,12),PKW(pB0,14)};pw2=(u32x4){PKW(pB1,0),PKW(pB1,2),PKW(pB1,4),PKW(pB1,6)};pw3=(u32x4){PKW(pB1,8),PKW(pB1,10),PKW(pB1,12),PKW(pB1,14)};
    SBAR(); pv(o,vb0+sl_cur,PAF(0),PAF(1),PAF(2),PAF(3)); }
  #undef PKW
  #undef PAF
  #undef VFR
  #undef PIN
  #undef MX3
  #undef GAPA
  #undef GAPB
  #undef EX
  #undef VRD
  #undef KRD
  #undef STEP
  #undef ENDW
  #undef DECIDE
  #undef BASE
  {auto rr=__builtin_amdgcn_permlane32_swap(__float_as_uint(l_reg),__float_as_uint(l_reg),false,false);l_reg=__uint_as_float(rr[0])+__uint_as_float(rr[1]);}
  int pslot=0;
  if constexpr(VAR==2){ const unsigned s3=mio.SEL3[qidx]; pslot=((int)(s3&31u)==mio.jblk)?0:(((int)((s3>>5)&31u)==mio.jblk)?1:2); }
  if(hi==0){ wsf[32+r32]=l_reg; if constexpr(VAR==2) wsf[r32]=__int_as_float(qvalid?(qidx*4+pslot):-1); }
  asm volatile("s_waitcnt lgkmcnt(0)":::"memory");
  if constexpr(VAR>=1){ if(hi==0&&qvalid) mio.LSE[(long)qidx*4+((VAR==1)?3:pslot)]=mhat+__builtin_amdgcn_logf(l_reg); }
  float rli[16];
  #pragma unroll
  for(int r=0;r<16;++r)rli[r]=__builtin_amdgcn_rcpf(wsf[32+crow(r,hi)]);
  { bf16*stg=(bf16*)(shm+LDS_OST)+wid*2048;
    #pragma unroll
    for(int r=0;r<16;++r){const int orow=crow(r,hi);
      #pragma unroll
      for(int d0=0;d0<2;++d0)stg[orow*64+d0*32+r32]=__float2bfloat16(o[d0][r]*rli[r]);}
    asm volatile("s_waitcnt lgkmcnt(0)":::"memory");
    if constexpr(VAR==2){
      #pragma unroll
      for(int i=0;i<4;++i){const int row=i*8+(lane>>3),ch=lane&7; const u32x4 v=*(const u32x4*)(stg+row*64+ch*8); const int inf=__float_as_int(wsf[row]);
        if(inf>=0){ bf16*pb=((inf&3)==0)?mio.PART0:(((inf&3)==1)?mio.PART1:mio.PART2); ATTN_STORE16(pb+(long)(inf>>2)*D+ch*8,v); } }
    } else if constexpr(VAR==1){
      bf16*Ow=mio.PART0+(long)(q0+wid*QBLK)*D;
      #pragma unroll
      for(int i=0;i<4;++i){const int row=i*8+(lane>>3),ch=lane&7; const u32x4 v=*(const u32x4*)(stg+row*64+ch*8); ATTN_STORE16(Ow+(long)row*D+ch*8,v);}
    } else {
      bf16*Ow=O+(rowbase+q0+wid*QBLK)*DM+h*D;
      #pragma unroll
      for(int i=0;i<4;++i){const int row=i*8+(lane>>3),ch=lane&7; const u32x4 v=*(const u32x4*)(stg+row*64+ch*8); ATTN_STORE16(Ow+(long)row*DM+ch*8,v);} } }
  asm volatile("s_waitcnt lgkmcnt(0)\n\ts_barrier":::"memory");
  #undef DMA_K
  #undef DMA_V
  #undef CMASK
  #undef RESC
  #undef ROT
}
template<bool OWN> __device__ __forceinline__ void moba4_unit(int b,int h,int qb,int jblk,int cnt,const bf16*Q,const bf16*__restrict__ K,const bf16*__restrict__ V,const MobaIo&mio,char*shm){
  constexpr bool FOX=false; constexpr int THRL=8, VAR=OWN?1:2; constexpr int LK=0,LV=4*SLOTB,LWS=8*SLOTB,LOST=LWS+NW*128*4;
  const int t0=4*jblk; bf16*O=nullptr; const float*CK2=nullptr; (void)O; (void)CK2;
  const int tid=otid(),lane=tid&63,r32=lane&31,hi=lane>>5; const int wid=__builtin_amdgcn_readfirstlane(tid>>6);
  const long rowbase=(long)b*SEQ; const int q0=qb*QB;
  const bf16*Kh=K+(rowbase+(long)t0*KVBLK)*DM+h*D,*Vh=V+(rowbase+(long)t0*KVBLK)*DM+h*D;
  const unsigned lds0=(unsigned)(uintptr_t)shm;
  float*wsf=(float*)(shm+LWS)+wid*128;
  const bf16*ksrc=Kh+(long)lane*DM+wid*8;
  const bf16*vsrc=Vh+(long)(16*(wid&3)+(lane>>2))*DM+(wid>>2)*32+(lane&3)*8;
  const unsigned kdst=lds0+LK+wid*1024, vdst=lds0+LV+wid*1024;
  #define DMA_K(t,slot) glds16(ksrc+(long)(t)*KVBLK*DM,(unsigned)__builtin_amdgcn_readfirstlane(kdst+(slot)))
  #define DMA_V(t,slot) glds16(vsrc+(long)(t)*KVBLK*DM,(unsigned)__builtin_amdgcn_readfirstlane(vdst+(slot)))
  const int vb0=(int)(lds0+LV)+((lane>>4)&1)*32+(lane&3)*8+(4*hi+((lane&15)>>2))*64;
  bf16x8 kf[8];
  const lds_cptr shm3=(lds_cptr)shm; const lds_cptr kp0=shm3+LK+hi*1024+r32*16; const lds_cptr vp0=shm3+LV+((lane>>4)&1)*32+(lane&3)*8+(4*hi+((lane&15)>>2))*64;
  const __attribute__((address_space(3))) float*ckl=(const __attribute__((address_space(3))) float*)(shm3+LWS)+4*hi;
  constexpr int NT=4; const float cq2=0.f; (void)cq2;
  DMA_K(0,0);DMA_V(0,0);DMA_K(1,SLOTB);DMA_V(1,SLOTB);DMA_K(2,2*SLOTB);DMA_V(2,2*SLOTB);DMA_K(3,3*SLOTB);DMA_V(3,3*SLOTB);
  const int nch=OWN?1:(cnt+QB-1)/QB;
  int qidx=q0+wid*QBLK+r32,qnext=0; unsigned s3=0u; bf16x8 qr[4];
  if constexpr(VAR==2){ qidx=(int)mio.QL[min(wid*QBLK+r32,cnt-1)]; s3=mio.SEL3[qidx]; qnext=(int)mio.QL[min(QB+wid*QBLK+r32,cnt-1)]; }
  { const bf16*Qrow=Q+(rowbase+qidx)*DM+h*D;
    #pragma unroll
    for(int d0=0;d0<4;++d0)qr[d0]=*reinterpret_cast<const bf16x8*>(&Qrow[d0*16+hi*8]); }
  for(int c_=0;c_<nch;++c_){
  bool qvalid=true; int pslot=0;
  if constexpr(VAR==2){ qvalid=(c_*QB+wid*QBLK+r32)<cnt; pslot=((int)(s3&31u)==jblk)?0:(((int)((s3>>5)&31u)==jblk)?1:2); }
  wsf[64+lane]=__int_as_float(qvalid?(qidx*4+(OWN?3:pslot)):-1);
  float mhat=0.f,l_reg=0.f;f32x16 o[2];o[0]=f32x16{};o[1]=f32x16{};
  const int qrel=wid*QBLK+r32;
  #define CMASK(P0,P1,t) do{ if constexpr(VAR!=2){ int jb_=(t)-(NT-4); if(jb_>=0)cmask(P0,P1,jb_,qrel,hi); } }while(0)
  #define BASE(t) (FOX ? (cq2-mhat) : -mhat)
  bool resc=false,nmd=true; f32x16 negm=f32x16{}; asm volatile("":"+v"(negm));
  #define RESC() do{ if(resc){ asm volatile("s_waitcnt lgkmcnt(0)":::"memory"); \
      _Pragma("unroll") for(int d_=0;d_<2;++d_) _Pragma("unroll") for(int r=0;r<16;++r)o[d_][r]*=wsf[crow(r,hi)]; } }while(0)
  #define MX3(a,b,c) __builtin_fmaxf(__builtin_fmaxf((a),(b)),(c))
  #define DECIDE(C0,C1) do{ float a=MX3(C0[0],C0[1],C1[0]),b_=MX3(C0[2],C0[3],C1[1]); a=MX3(a,C1[2],C1[3]); \
      _Pragma("unroll") for(int r=4;r<16;r+=4){a=MX3(a,C0[r],C0[r+1]);b_=MX3(b_,C0[r+2],C0[r+3]);a=MX3(a,C1[r],C1[r+1]);b_=MX3(b_,C1[r+2],C1[r+3]);} \
      float rm=__builtin_fmaxf(a,b_); { auto rr=__builtin_amdgcn_permlane32_swap(__float_as_uint(rm),__float_as_uint(rm),false,false); rm=__builtin_fmaxf(__uint_as_float(rr[0]),__uint_as_float(rr[1])); } \
      resc=false; \
      if(__builtin_expect(__any(rm>(float)THRL),0)){ const float dl=(rm>(float)THRL)?rm:0.f; mhat+=dl;     \
        _Pragma("unroll") for(int r=0;r<16;++r){C0[r]-=dl;C1[r]-=dl;} \
        const float f=__builtin_amdgcn_exp2f(-dl); l_reg*=f; if(hi==0)wsf[r32]=f; resc=true; nmd=true; } }while(0)
  f32x16 pA0,pA1,pB0,pB1;
  int sl_prev=0,sl_cur=0,sl_next=SLOTB;
  #define ROT() do{sl_prev=sl_cur;sl_cur=sl_next;sl_next=sl_next+SLOTB;}while(0)
  #define WAIT_NB() asm volatile("s_waitcnt lgkmcnt(0)":::"memory")
  if(c_==0){ WAIT_BAR(0); }
  { const float bs=BASE(0); cinit<FOX>(pA0,ckl,bs); cinit<FOX>(pA1,ckl+32,bs);
    const char*kb=shm+LK+hi*1024+r32*16;
    #pragma unroll
    for(int d0=0;d0<4;++d0){
      const bf16x8 b0=*reinterpret_cast<const bf16x8*>(kb+d0*2048);
      const bf16x8 b1=*reinterpret_cast<const bf16x8*>(kb+d0*2048+512);
      pA0=__builtin_amdgcn_mfma_f32_32x32x16_bf16(b0,qr[d0],pA0,0,0,0);pA1=__builtin_amdgcn_mfma_f32_32x32x16_bf16(b1,qr[d0],pA1,0,0,0);}
    CMASK(pA0,pA1,0);
    DECIDE(pA0,pA1); resc=false;
    _Pragma("unroll") for(int r=0;r<16;++r){pA0[r]=__builtin_amdgcn_exp2f(pA0[r]);pA1[r]=__builtin_amdgcn_exp2f(pA1[r]);} }
  WAIT_NB();
  ROT();
  kload8(kf,kp0+sl_cur);
  WAIT_NB();
  s16x4 vlo[8],vhi[8]; u32x4 pw0,pw1,pw2,pw3;
  #define PKW(P,B) cvtpk_s(P[B],P[B+1])
  #define PAF(k) __builtin_bit_cast(bf16x8,pw##k)
  #define VFR(i) (bf16x8){vlo[i][0],vlo[i][1],vlo[i][2],vlo[i][3],vhi[i][0],vhi[i][1],vhi[i][2],vhi[i][3]}
  #define PIN(x) asm volatile("":"+v"(x))
  #define GAPA(MF,A0,A1,A2,A3,W0,W1,PW) do{ MF; sacc+=A0; sacc+=A1; sacc+=A2; sacc+=A3; PIN(sacc); W0; W1; PIN(PW); SBAR(); }while(0)
  #define EX(v) __builtin_amdgcn_exp2f(v)
  #define GAPB(MF,X,B) do{ MF; X[B]=EX(X[B]); X[B+1]=EX(X[B+1]); X[B+2]=EX(X[B+2]); X[B+3]=EX(X[B+3]); PIN(X); SBAR(); }while(0)
  #define VRD(i) do{ vlo[i]=vtr(vp_+(((i)>>2)*4096+((i)&3)*1024)); vhi[i]=vtr(vp_+(((i)>>2)*4096+((i)&3)*1024+512)); }while(0)
  #define KRD(G,j) do{ if(G){ kload2(kf,kp0+sl_next,j); SBAR(); } }while(0)
  #define STEP(C0,C1,P0,P1,t,GK,GV,GL) do{ SBAR(); \
    const lds_cptr vp_=vp0+sl_prev; const float bs_=BASE(t); \
    if constexpr(FOX){ cinit<FOX>(C0,ckl+(t)*64,bs_); SBAR(); } \
    else if(nmd){ _Pragma("unroll") for(int r=0;r<16;++r)negm[r]=bs_; asm volatile("":"+v"(negm)); nmd=false; SBAR(); }     \
    VRD(0); SBAR(); float sacc=(P0[0]+P0[1]); \
    GAPA(C0=__builtin_amdgcn_mfma_f32_32x32x16_bf16(kf[0],qr[0],FOX?C0:negm,0,0,0), P0[2],P0[3],P0[4],P0[5],     pw0[0]=PKW(P0,0), pw0[1]=PKW(P0,2), pw0); \
    if constexpr(FOX){ cinit<FOX>(C1,ckl+(t)*64+32,bs_); SBAR(); } \
    VRD(4); SBAR(); GAPA(C1=__builtin_amdgcn_mfma_f32_32x32x16_bf16(kf[1],qr[0],FOX?C1:negm,0,0,0), P0[6],P0[7],P0[8],P0[9],     pw0[2]=PKW(P0,4), pw0[3]=PKW(P0,6), pw0); \
    VRD(1); SBAR(); GAPA(C0=__builtin_amdgcn_mfma_f32_32x32x16_bf16(kf[2],qr[1],C0,0,0,0),   P0[10],P0[11],P0[12],P0[13], pw1[0]=PKW(P0,8), pw1[1]=PKW(P0,10), pw1); \
    VRD(5); SBAR(); GAPA(C1=__builtin_amdgcn_mfma_f32_32x32x16_bf16(kf[3],qr[1],C1,0,0,0),   P0[14],P0[15],P1[0],P1[1],   pw1[2]=PKW(P0,12),pw1[3]=PKW(P0,14), pw1); \
    VRD(2); SBAR(); GAPA(C0=__builtin_amdgcn_mfma_f32_32x32x16_bf16(kf[4],qr[2],C0,0,0,0),   P1[2],P1[3],P1[4],P1[5],     pw2[0]=PKW(P1,0), pw2[1]=PKW(P1,2), pw2); \
    VRD(6); SBAR(); GAPA(C1=__builtin_amdgcn_mfma_f32_32x32x16_bf16(kf[5],qr[2],C1,0,0,0),   P1[6],P1[7],P1[8],P1[9],     pw2[2]=PKW(P1,4), pw2[3]=PKW(P1,6), pw2); \
    VRD(3); SBAR(); GAPA(C0=__builtin_amdgcn_mfma_f32_32x32x16_bf16(kf[6],qr[3],C0,0,0,0),   P1[10],P1[11],P1[12],P1[13], pw3[0]=PKW(P1,8), pw3[1]=PKW(P1,10), pw3); \
    VRD(7); SBAR(); GAPA(C1=__builtin_amdgcn_mfma_f32_32x32x16_bf16(kf[7],qr[3],C1,0,0,0),   P1[14],P1[15],0.f,0.f,       pw3[2]=PKW(P1,12),pw3[3]=PKW(P1,14), pw3); \
    l_reg+=sacc; \
    if(GK){DMA_K((t)+3,sl_cur);} if(GV){DMA_V((t)+1,sl_next);} \
    CMASK(C0,C1,t); \
    DECIDE(C0,C1); \
    SBAR(); \
    GAPB(o[0]=__builtin_amdgcn_mfma_f32_32x32x16_bf16(PAF(0),VFR(0),o[0],0,0,0), C0,0); \
    GAPB(o[1]=__builtin_amdgcn_mfma_f32_32x32x16_bf16(PAF(0),VFR(4),o[1],0,0,0), C0,4); \
    KRD(GL,0); GAPB(o[0]=__builtin_amdgcn_mfma_f32_32x32x16_bf16(PAF(1),VFR(1),o[0],0,0,0), C0,8); \
    KRD(GL,1); GAPB(o[1]=__builtin_amdgcn_mfma_f32_32x32x16_bf16(PAF(1),VFR(5),o[1],0,0,0), C0,12); \
    KRD(GL,2); GAPB(o[0]=__builtin_amdgcn_mfma_f32_32x32x16_bf16(PAF(2),VFR(2),o[0],0,0,0), C1,0); \
    KRD(GL,3); GAPB(o[1]=__builtin_amdgcn_mfma_f32_32x32x16_bf16(PAF(2),VFR(6),o[1],0,0,0), C1,4); \
    GAPB(o[0]=__builtin_amdgcn_mfma_f32_32x32x16_bf16(PAF(3),VFR(3),o[0],0,0,0), C1,8); \
    GAPB(o[1]=__builtin_amdgcn_mfma_f32_32x32x16_bf16(PAF(3),VFR(7),o[1],0,0,0), C1,12); \
    }while(0)
  int t=1;
  #undef CMASK
  #define CMASK(P0,P1,t) do{}while(0)
  for(;t+5<NT;t+=2){
    STEP(pB0,pB1,pA0,pA1,t,false,false,true);     WAIT_NB(); RESC(); ROT();
    STEP(pA0,pA1,pB0,pB1,t+1,false,false,true);   WAIT_NB(); RESC(); ROT();
  }
  #undef CMASK
  #define CMASK(P0,P1,t) do{ if constexpr(VAR!=2){ int jb_=(t)-(NT-4); if(jb_>=0)cmask(P0,P1,jb_,qrel,hi); } }while(0)
  #define ENDW(tt) WAIT_NB()
  for(;t+1<NT;t+=2){
    STEP(pB0,pB1,pA0,pA1,t,false,false,(t+1<NT));       ENDW(t);   RESC(); ROT();
    STEP(pA0,pA1,pB0,pB1,t+1,false,false,(t+2<NT));     ENDW(t+1); RESC(); ROT();
  }
  STEP(pB0,pB1,pA0,pA1,NT-1,false,false,false); RESC();
  if constexpr(VAR==2){ if(c_+1<nch){ qidx=qnext; const bf16*Qrow=Q+(rowbase+qidx)*DM+h*D;
      #pragma unroll
      for(int d0=0;d0<4;++d0)qr[d0]=*reinterpret_cast<const bf16x8*>(&Qrow[d0*16+hi*8]);
      s3=mio.SEL3[qidx]; qnext=(int)mio.QL[min((c_+2)*QB+wid*QBLK+r32,cnt-1)]; } }
  { float sacc=pB0[0]+pB0[1]; _Pragma("unroll") for(int r=2;r<16;++r)sacc+=pB0[r]; _Pragma("unroll") for(int r=0;r<16;++r)sacc+=pB1[r]; l_reg+=sacc;
    pw0=(u32x4){PKW(pB0,0),PKW(pB0,2),PKW(pB0,4),PKW(pB0,6)};pw1=(u32x4){PKW(pB0,8),PKW(pB0,10),PKW(pB0,12),PKW(pB0,14)};pw2=(u32x4){PKW(pB1,0),PKW(pB1,2),PKW(pB1,4),PKW(pB1,6)};pw3=(u32x4){PKW(pB1,8),PKW(pB1,10),PKW(pB1,12),PKW(pB1,14)};
    SBAR(); pv(o,vb0+sl_cur,PAF(0),PAF(1),PAF(2),PAF(3)); }
  #undef PKW
  #undef PAF
  #undef VFR
  #undef PIN
  #undef MX3
  #undef GAPA
  #undef GAPB
  #undef EX
  #undef VRD
  #undef KRD
  #undef STEP
  #undef ENDW
  #undef DECIDE
  #undef BASE
  {auto rr=__builtin_amdgcn_permlane32_swap(__float_as_uint(l_reg),__float_as_uint(l_reg),false,false);l_reg=__uint_as_float(rr[0])+__uint_as_float(rr[1]);}
  const int info=__float_as_int(wsf[64+lane]);
  if(hi==0){ wsf[32+r32]=l_reg; if constexpr(VAR==2) wsf[r32]=__int_as_float(info); }
  asm volatile("s_waitcnt lgkmcnt(0)":::"memory");
  if(hi==0&&info>=0) mio.LSE[info]=mhat+__builtin_amdgcn_logf(l_reg);
  float rli[16];
  #pragma unroll
  for(int r=0;r<16;++r)rli[r]=__builtin_amdgcn_rcpf(wsf[32+crow(r,hi)]);
  { bf16*stg=(bf16*)(shm+LOST)+wid*2048;
    #pragma unroll
    for(int r=0;r<16;++r){const int orow=crow(r,hi);
      #pragma unroll
      for(int d0=0;d0<2;++d0)stg[orow*64+d0*32+r32]=__float2bfloat16(o[d0][r]*rli[r]);}
    asm volatile("s_waitcnt lgkmcnt(0)":::"memory");
    if constexpr(VAR==2){
      #pragma unroll
      for(int i=0;i<4;++i){const int row=i*8+(lane>>3),ch=lane&7; const u32x4 v=*(const u32x4*)(stg+row*64+ch*8); const int inf=__float_as_int(wsf[row]);
        if(inf>=0){ bf16*pb=((inf&3)==0)?mio.PART0:(((inf&3)==1)?mio.PART1:mio.PART2); ATTN_STORE16(pb+(long)(inf>>2)*D+ch*8,v); } }
    } else if constexpr(VAR==1){
      bf16*Ow=mio.PART0+(long)(q0+wid*QBLK)*D;
      #pragma unroll
      for(int i=0;i<4;++i){const int row=i*8+(lane>>3),ch=lane&7; const u32x4 v=*(const u32x4*)(stg+row*64+ch*8); ATTN_STORE16(Ow+(long)row*D+ch*8,v);}
    } else {
      bf16*Ow=O+(rowbase+q0+wid*QBLK)*DM+h*D;
      #pragma unroll
      for(int i=0;i<4;++i){const int row=i*8+(lane>>3),ch=lane&7; const u32x4 v=*(const u32x4*)(stg+row*64+ch*8); ATTN_STORE16(Ow+(long)row*DM+ch*8,v);} } }
  asm volatile("s_waitcnt lgkmcnt(0)":::"memory");
  }
  #undef WAIT_NB
  #undef DMA_K
  #undef DMA_V
  #undef CMASK
  #undef RESC
  #undef ROT
}

__device__ __forceinline__ void moba_gate_item(int b,int h,int qb,const bf16*Q,const float*KSUM,unsigned*SEL3,unsigned*CNT,unsigned short*LIST){
  const int tid=otid(),lane=tid&63,r32=lane&31,hi=lane>>5; const int wid=__builtin_amdgcn_readfirstlane(tid>>6);
  const int q=qb*QB+wid*QBLK+r32;
  const bf16*Qrow=Q+((long)b*SEQ+q)*DM+h*D;
  bf16x8 qr[4];
  #pragma unroll
  for(int d0=0;d0<4;++d0)qr[d0]=*reinterpret_cast<const bf16x8*>(&Qrow[d0*16+hi*8]);
  f32x16 ga=f32x16{};
  const float*km=KSUM+r32*64+8*hi;
  #pragma unroll
  for(int ks=0;ks<4;++ks){
    const f32x4 a0=*(const f32x4*)(km+16*ks),a1=*(const f32x4*)(km+16*ks+4),c0=*(const f32x4*)(km+KSUM_P1+16*ks),c1=*(const f32x4*)(km+KSUM_P1+16*ks+4);
    float x[8]; u32x4 fh,fl;
    #pragma unroll
    for(int e=0;e<4;++e){x[e]=a0[e]+c0[e];x[4+e]=a1[e]+c1[e];}
    #pragma unroll
    for(int e=0;e<4;++e){ const unsigned hw=cvtpk_s(x[2*e],x[2*e+1]); fh[e]=hw; fl[e]=cvtpk_s(x[2*e]-__uint_as_float(hw<<16),x[2*e+1]-__uint_as_float(hw&0xffff0000u)); }
    ga=__builtin_amdgcn_mfma_f32_32x32x16_bf16(__builtin_bit_cast(bf16x8,fh),qr[ks],ga,0,0,0);
    ga=__builtin_amdgcn_mfma_f32_32x32x16_bf16(__builtin_bit_cast(bf16x8,fl),qr[ks],ga,0,0,0);
  }
  unsigned t0=0u,t1=0u,t2=0u;
  #define INS3(x) do{ unsigned x_=(x); unsigned m_=max(t0,x_); x_=min(t0,x_); t0=m_; m_=max(t1,x_); x_=min(t1,x_); t1=m_; t2=max(t2,x_); }while(0)
  #pragma unroll
  for(int r=0;r<16;++r){ const int n=(r&3)+8*(r>>2)+4*hi; const unsigned u_=__float_as_uint(ga[r]); const unsigned o_=u_^((unsigned)((int)u_>>31)|0x80000000u);
    const unsigned key=(n<qb)?((o_&~31u)|(unsigned)(31-n)):0u; INS3(key); }
  { const unsigned p0=(unsigned)__shfl_xor((int)t0,32),p1=(unsigned)__shfl_xor((int)t1,32),p2=(unsigned)__shfl_xor((int)t2,32); INS3(p0); INS3(p1); INS3(p2); }
  #undef INS3
  const int n0=t0?(int)(31u-(t0&31u)):-1,n1=t1?(int)(31u-(t1&31u)):-1,n2=t2?(int)(31u-(t2&31u)):-1;
  const unsigned cntv=(t0?1u:0u)+(t1?1u:0u)+(t2?1u:0u);
  if(hi==0)SEL3[q]=(unsigned)(n0&31)|((unsigned)(n1&31)<<5)|((unsigned)(n2&31)<<10)|(cntv<<15);
  unsigned mycnt=0u; int rk0=0,rk1=0,rk2=0; const unsigned long long below=(1ull<<r32)-1ull;
  for(int j=0;j<qb;++j){ const unsigned long long m=__ballot(hi==0&&(n0==j||n1==j||n2==j))&0xffffffffull; const int pc=__builtin_popcountll(m);
    if(lane==j)mycnt=(unsigned)pc; const int rk=__builtin_popcountll(m&below); if(n0==j)rk0=rk; if(n1==j)rk1=rk; if(n2==j)rk2=rk; }
  unsigned basev=0u;
  if(lane<qb&&mycnt)basev=__hip_atomic_fetch_add(CNT+lane,mycnt,__ATOMIC_RELAXED,__HIP_MEMORY_SCOPE_AGENT);
  const unsigned b0=(unsigned)__shfl((int)basev,n0<0?0:n0),b1=(unsigned)__shfl((int)basev,n1<0?0:n1),b2=(unsigned)__shfl((int)basev,n2<0?0:n2);
  if(hi==0){ if(n0>=0)LIST[(long)n0*SEQ+b0+rk0]=(unsigned short)q; if(n1>=0)LIST[(long)n1*SEQ+b1+rk1]=(unsigned short)q; if(n2>=0)LIST[(long)n2*SEQ+b2+rk2]=(unsigned short)q; }
}
#undef SBAR
#undef WAIT_BAR
}

constexpr float FOX_SKIP = 32.0f;
constexpr size_t WS_QCTR = 32 * KiB;
__device__ __forceinline__ void phase_attn(char* lds, volatile LAS unsigned* misc, const P& p) {
    attn::bf16* QKVb = (attn::bf16*)(p.ws + WS_QKV);
    unsigned* qctr = (unsigned*)(p.ws + WS_QCTR); unsigned* MCNT = (unsigned*)(p.ws + WS_MCNT); unsigned* MG1 = (unsigned*)(p.ws + WS_MG1);
    bool g1seen = false; const attn::MobaIo mio0{};
    volatile LAS unsigned* CNL = misc + 64;
    for (;;) {
        if (threadIdx.x == 0) misc[16] = __hip_atomic_fetch_add(qctr, 1u, __ATOMIC_RELAXED, __HIP_MEMORY_SCOPE_AGENT);
        __syncthreads();
        const int u = (int)__builtin_amdgcn_readfirstlane((int)misc[16]);
        __syncthreads();
        if (u >= 2032) break;
        if (u < 512) {
            const int bh = u & 15, qb = u >> 4;
            attn::moba_gate_item(bh >> 3, bh & 7, qb, QKVb, (const float*)(p.ws + WS_KMP) + (size_t)bh * 32 * 64, (unsigned*)(p.ws + WS_SEL3) + (size_t)bh * S, MCNT + bh * 32, (unsigned short*)(p.ws + WS_MLIST) + (size_t)bh * 32 * S);
            asm volatile("s_waitcnt vmcnt(0)" ::: "memory");
            __syncthreads();
            if (threadIdx.x == 0) { __builtin_amdgcn_fence(__ATOMIC_RELEASE, "agent"); asm volatile("s_waitcnt vmcnt(0)" ::: "memory");
                const unsigned old = __hip_atomic_fetch_add(MG1, 1u, __ATOMIC_RELAXED, __HIP_MEMORY_SCOPE_AGENT);
                if (old == 511u) { __builtin_amdgcn_fence(__ATOMIC_ACQ_REL, "agent"); asm volatile("s_waitcnt vmcnt(0)" ::: "memory"); __hip_atomic_store(MG1 + 64, 1u, __ATOMIC_RELAXED, __HIP_MEMORY_SCOPE_AGENT); } }
            continue;
        }
        if (u >= 1008 && u < 1520) {
            const int v = u - 1008, qb = 31 - (v >> 4), bh = v & 15;
            const float* c2 = (const float*)(p.ws + WS_C) + (size_t)bh * S; const int lane = threadIdx.x & 63, nt = 4 * qb + 4;
            const float cq = c2[qb * 256];
            const float* FK = (const float*)(p.ws + WS_FKN) + (size_t)bh * 256; const float* FQ = (const float*)(p.ws + WS_FQN) + ((size_t)bh * 32 + qb) * 4;
#define FOX_KN(t) sqrtf(FK[2 * (t)] + FK[2 * (t) + 1])
            const float qm = sqrtf(fmaxf(FQ[0] + FQ[1], FQ[2] + FQ[3])), ko = fmaxf(fmaxf(FOX_KN(4 * qb), FOX_KN(4 * qb + 1)), fmaxf(FOX_KN(4 * qb + 2), FOX_KN(4 * qb + 3)));
            const float th0 = (lane < nt) ? 1.01f * qm * (FOX_KN(lane) + ko) + FOX_SKIP : 0.f, th1 = (lane + 64 < nt) ? 1.01f * qm * (FOX_KN(lane + 64) + ko) + FOX_SKIP : 0.f;
#undef FOX_KN
            const bool keep0 = (lane < nt) ? (cq - c2[64 * lane + 63] >= -th0) : true, keep1 = (lane + 64 < nt) ? (cq - c2[64 * (lane + 64) + 63] >= -th1) : true;
            const unsigned long long m0 = __ballot(keep0), m1 = __ballot(keep1);
            int first = m0 ? __builtin_ctzll(m0) : 64 + __builtin_ctzll(m1);
            int t0 = first & ~1; if (t0 > nt - 4) t0 = nt - 4;
            t0 = __builtin_amdgcn_readfirstlane(t0);
            attn::attn_unit<true, 24, 0>(bh >> 3, bh & 7, qb, t0, QKVb + SLOT, QKVb + 4 * SLOT, QKVb + 5 * SLOT, QKVb + SLOT, c2, mio0, lds);
            continue;
        }
        if (!g1seen) {
            if (threadIdx.x == 0) { unsigned sp = 0u;
                while (__hip_atomic_load(MG1 + 64, __ATOMIC_RELAXED, __HIP_MEMORY_SCOPE_AGENT) == 0u) { __builtin_amdgcn_s_sleep(8); if (++sp > (1u << 22)) break; }
                __builtin_amdgcn_fence(__ATOMIC_ACQUIRE, "agent"); asm volatile("s_waitcnt vmcnt(0)" ::: "memory"); }
            __syncthreads();
            CNL[threadIdx.x] = __hip_atomic_load(MCNT + threadIdx.x, __ATOMIC_RELAXED, __HIP_MEMORY_SCOPE_AGENT);
            __syncthreads();
            g1seen = true;
        }
        attn::MobaIo mio{};
        if (u < 1008) {
            const int v = u - 512, j = v >> 4, bh = v & 15, cnt = (int)__builtin_amdgcn_readfirstlane((int)CNL[bh * 32 + j]);
            if (cnt == 0) continue;
            mio.QL = (const unsigned short*)(p.ws + WS_MLIST) + ((size_t)bh * 32 + j) * S; mio.SEL3 = (const unsigned*)(p.ws + WS_SEL3) + (size_t)bh * S; mio.LSE = (float*)(p.ws + WS_MLSE) + (size_t)bh * S * 4;
            mio.PART0 = (attn::bf16*)(p.ws + WS_MP0) + (size_t)bh * S * 64; mio.PART1 = (attn::bf16*)(p.ws + WS_MP1) + (size_t)bh * S * 64; mio.PART2 = (attn::bf16*)(p.ws + WS_MP2) + (size_t)bh * S * 64;
            attn::moba4_unit<false>(bh >> 3, bh & 7, 0, j, cnt, QKVb, QKVb + 2 * SLOT, QKVb + 3 * SLOT, mio, lds);
        } else {
            const int v = u - 1520, qb = v >> 4, bh = v & 15;
            mio.LSE = (float*)(p.ws + WS_MLSE) + (size_t)bh * S * 4; mio.PART0 = (attn::bf16*)(p.ws + WS_MP3) + (size_t)bh * S * 64;
            attn::moba4_unit<true>(bh >> 3, bh & 7, qb, qb, 256, QKVb, QKVb + 2 * SLOT, QKVb + 3 * SLOT, mio, lds);
        }
    }
}
__device__ __forceinline__ void phase_moba_combine(const P& p) {
    const int TID = otid();
    bf16_t* OA = (bf16_t*)(p.ws + WS_QKV); const unsigned* SEL3 = (const unsigned*)(p.ws + WS_SEL3); const float* LSE = (const float*)(p.ws + WS_MLSE);
    const bf16_t* P0 = (const bf16_t*)(p.ws + WS_MP0); const bf16_t* P1 = (const bf16_t*)(p.ws + WS_MP1); const bf16_t* P2 = (const bf16_t*)(p.ws + WS_MP2); const bf16_t* P3 = (const bf16_t*)(p.ws + WS_MP3);
    for (int it = blockIdx.x * 512 + TID; it < Bn * NH * S * 8; it += gridDim.x * 512) {
        const int ch = it & 7, bq = it >> 3, bh = bq >> 13, q = bq & (S - 1), b = bh >> 3, h = bh & 7;
        const unsigned n = SEL3[bq] >> 15;
        bf16_t* orow = OA + ((size_t)b * S + q) * 512 + h * 64 + ch * 8;
        const u32x4 own = *(const u32x4*)(P3 + (size_t)bq * 64 + ch * 8);
        if (n == 0u) { *(u32x4*)orow = own; continue; }
        const f32x4 ls = *(const f32x4*)(LSE + (size_t)bq * 4);
        float m = fmaxf(ls[3], ls[0]); if (n > 1u) m = fmaxf(m, ls[1]); if (n > 2u) m = fmaxf(m, ls[2]);
        const float w3 = __builtin_amdgcn_exp2f(ls[3] - m), w0 = __builtin_amdgcn_exp2f(ls[0] - m), w1 = (n > 1u) ? __builtin_amdgcn_exp2f(ls[1] - m) : 0.f, w2 = (n > 2u) ? __builtin_amdgcn_exp2f(ls[2] - m) : 0.f;
        const float rw = 1.f / (w3 + w0 + w1 + w2);
        f32x4 a0, a1, x0, x1; pg8::unpack8(own, a0, a1); a0 = a0 * w3; a1 = a1 * w3;
        pg8::unpack8(*(const u32x4*)(P0 + (size_t)bq * 64 + ch * 8), x0, x1); a0 += x0 * w0; a1 += x1 * w0;
        if (n > 1u) { pg8::unpack8(*(const u32x4*)(P1 + (size_t)bq * 64 + ch * 8), x0, x1); a0 += x0 * w1; a1 += x1 * w1; }
        if (n > 2u) { pg8::unpack8(*(const u32x4*)(P2 + (size_t)bq * 64 + ch * 8), x0, x1); a0 += x0 * w2; a1 += x1 * w2; }
        *(u32x4*)orow = pg8::pack8(a0 * rw, a1 * rw);
    }
}

typedef float f32x2v __attribute__((ext_vector_type(2)));
__device__ __forceinline__ unsigned q8_pack(const f32x4& a, float sc, int bias) {
    const int q0 = (int)rintf(a[0] * sc) + bias, q1 = (int)rintf(a[1] * sc) + bias, q2 = (int)rintf(a[2] * sc) + bias, q3 = (int)rintf(a[3] * sc) + bias;
    return (unsigned)(q0 & 0xff) | ((unsigned)(q1 & 0xff) << 8) | ((unsigned)(q2 & 0xff) << 16) | ((unsigned)(q3 & 0xff) << 24); }
__device__ __forceinline__ void q8_row(const float* src, const float* gain, unsigned char* dst, size_t sstride, float* scale_out, int lane, int bias) {
    f32x4 a[4]; float am = 0.f;
#pragma unroll
    for (int q = 0; q < 4; ++q) { a[q] = *(const f32x4*)(src + 16 * lane + 4 * q);
        if (gain) { const f32x4 g = *(const f32x4*)(gain + 16 * lane + 4 * q); a[q][0] *= g[0]; a[q][1] *= g[1]; a[q][2] *= g[2]; a[q][3] *= g[3]; }
        am = fmaxf(fmaxf(am, fmaxf(fabsf(a[q][0]), fabsf(a[q][1]))), fmaxf(fabsf(a[q][2]), fabsf(a[q][3]))); }
    am = wave_max_fast(am);
    const float sc = am > 0.f ? 127.0f / am : 1.0f;
    u32x4 o;
#pragma unroll
    for (int q = 0; q < 4; ++q) o[q] = q8_pack(a[q], sc, bias);
    *(u32x4*)(dst + (sstride ? (size_t)(lane >> 3) * sstride + 16 * (lane & 7) : (size_t)16 * lane)) = o;
    if (lane == 0) *scale_out = am > 0.f ? am * (1.0f / 127.0f) : 1.0f;
}
__device__ __forceinline__ void q4_load(f32x4 (&a)[4], const float* src, int lane) {
#pragma unroll
    for (int q = 0; q < 4; ++q) a[q] = *(const f32x4*)(src + 16 * lane + 4 * q); }
template <bool USGN> __device__ __forceinline__ void q4_row(f32x4 (&a)[4], const float* gain, unsigned char* dst, float* scale_out, int lane) {
    float ss = 0.f;
#pragma unroll
    for (int q = 0; q < 4; ++q) {
        if (gain) { const f32x4 g = *(const f32x4*)(gain + 16 * lane + 4 * q); a[q][0] *= g[0]; a[q][1] *= g[1]; a[q][2] *= g[2]; a[q][3] *= g[3]; }
        ss += (a[q][0] * a[q][0] + a[q][1] * a[q][1]) + (a[q][2] * a[q][2] + a[q][3] * a[q][3]); }
    ss = wave_sum_fast(ss);
    const float step = sqrtf(ss * (1.f / D)) * 0.3352f, inv = step > 0.f ? 1.0f / step : 0.f;
    u32x2 o; o[0] = 0u; o[1] = 0u;
    int qs = 0;
#pragma unroll
    for (int i = 0; i < 16; ++i) { int q = (int)floorf(a[i >> 2][i & 3] * inv); q = min(max(q, -8), 7); qs += q;
        o[i >> 3] |= (unsigned)((USGN || (i & 1)) ? (q & 15) : (q + 8)) << (4 * (i & 7)); }
    *(u32x2*)(dst + (size_t)(lane >> 4) * ESLICE + 8 * (lane & 15)) = o;
    if (USGN) { const float rs = wave_sum_fast((float)qs); if (lane == 0) scale_out[2 * PNK * PNK] = rs; }
    if (lane == 0) *scale_out = step > 0.f ? step : 1.0f;
}
__device__ __forceinline__ void phase_combine_tables(const P& p) {
    const int TID = otid();
    const int lane = TID & 63, gw = (blockIdx.x * 512 + TID) >> 6, nw = (gridDim.x * 512) >> 6, stride = gridDim.x * 512;
    bf16_t* OA = (bf16_t*)(p.ws + WS_QKV); const unsigned* SEL3 = (const unsigned*)(p.ws + WS_SEL3); const float* LSE = (const float*)(p.ws + WS_MLSE);
    const bf16_t* P0 = (const bf16_t*)(p.ws + WS_MP0); const bf16_t* P1 = (const bf16_t*)(p.ws + WS_MP1); const bf16_t* P2 = (const bf16_t*)(p.ws + WS_MP2); const bf16_t* P3 = (const bf16_t*)(p.ws + WS_MP3);
#pragma unroll 1
    for (int k = 0; k < 8; ++k) {
        const int r = gw + k * nw, it = blockIdx.x * 512 + TID + k * stride, ch = it & 7, bq = it >> 3;
        const size_t po = (size_t)bq * 64 + ch * 8;
        f32x4 au[4], av[4];
        q4_load(au, p.eu + (size_t)r * D, lane); q4_load(av, p.ev + (size_t)r * D, lane);
        const unsigned nn = SEL3[bq]; const f32x4 ls = *(const f32x4*)(LSE + (size_t)bq * 4);
        const u32x4 own = *(const u32x4*)(P3 + po), q0 = *(const u32x4*)(P0 + po), q1 = *(const u32x4*)(P1 + po), q2 = *(const u32x4*)(P2 + po);
        {
            const int bh = bq >> 13, q = bq & (S - 1), b = bh >> 3, h = bh & 7; const unsigned n = nn >> 15;
            bf16_t* orow = OA + ((size_t)b * S + q) * 512 + h * 64 + ch * 8;
            float m = ls[3]; if (n > 0u) m = fmaxf(m, ls[0]); if (n > 1u) m = fmaxf(m, ls[1]); if (n > 2u) m = fmaxf(m, ls[2]);
            const float w3 = __builtin_amdgcn_exp2f(ls[3] - m), w0 = (n > 0u) ? __builtin_amdgcn_exp2f(ls[0] - m) : 0.f, w1 = (n > 1u) ? __builtin_amdgcn_exp2f(ls[1] - m) : 0.f, w2 = (n > 2u) ? __builtin_amdgcn_exp2f(ls[2] - m) : 0.f;
            const float rw = 1.f / (w3 + w0 + w1 + w2);
            const u32x4 z = {0u, 0u, 0u, 0u};
            f32x4 a0, a1, x0, x1; pg8::unpack8(own, a0, a1); a0 = a0 * w3; a1 = a1 * w3;
            pg8::unpack8((n > 0u) ? q0 : z, x0, x1); a0 += x0 * w0; a1 += x1 * w0;
            pg8::unpack8((n > 1u) ? q1 : z, x0, x1); a0 += x0 * w1; a1 += x1 * w1;
            pg8::unpack8((n > 2u) ? q2 : z, x0, x1); a0 += x0 * w2; a1 += x1 * w2;
            *(u32x4*)orow = (n == 0u) ? own : pg8::pack8(a0 * rw, a1 * rw); }
        q4_row<true>(au, p.g_ffn, p.ws + WS_EU + (size_t)r * 128, (float*)(p.ws + WS_USC) + r, lane);
        q4_row<false>(av, nullptr, p.ws + WS_EV + (size_t)r * 128, (float*)(p.ws + WS_VSC) + r, lane);
    }
}

typedef short bf16x8_t __attribute__((ext_vector_type(8)));
typedef float f32x16_t __attribute__((ext_vector_type(16)));
__device__ __forceinline__ unsigned f2ord(float f) { const unsigned u = __float_as_uint(f); return u ^ ((unsigned)((int)u >> 31) | 0x80000000u); }
__device__ __forceinline__ float ord2f(unsigned k) { return __uint_as_float((k & 0x80000000u) ? (k ^ 0x80000000u) : ~k); }
#define TK_CAS(a, b, desc) do { const unsigned hi__ = max(a, b), lo__ = min(a, b); if (desc) { a = hi__; b = lo__; } else { a = lo__; b = hi__; } } while (0)
__device__ __forceinline__ void tk_sort16(unsigned (&v)[16]) {
#define C(i, j) TK_CAS(v[i], v[j], true);
    C(0,1) C(2,3) C(0,2) C(1,3) C(1,2) C(4,5) C(6,7) C(4,6) C(5,7) C(5,6) C(0,4) C(2,6) C(2,4) C(1,5) C(3,7) C(3,5) C(1,2) C(3,4) C(5,6) C(8,9) C(10,11) C(8,10) C(9,11) C(9,10) C(12,13) C(14,15) C(12,14) C(13,15) C(13,14) C(8,12) C(10,14) C(10,12) C(9,13) C(11,15) C(11,13) C(9,10) C(11,12) C(13,14) C(0,8) C(4,12) C(4,8) C(2,10) C(6,14) C(6,10) C(2,4) C(6,8) C(10,12) C(1,9) C(5,13) C(5,9) C(3,11) C(7,15) C(7,11) C(3,5) C(7,9) C(11,13) C(1,2) C(3,4) C(5,6) C(7,8) C(9,10) C(11,12) C(13,14)
#undef C
}
__device__ __forceinline__ void tk_merge16(unsigned (&a)[16], const unsigned (&b)[16]) {
#pragma unroll
    for (int i = 0; i < 16; ++i) a[i] = max(a[i], b[15 - i]);
#pragma unroll
    for (int st = 8; st >= 1; st >>= 1)
#pragma unroll
        for (int i = 0; i < 16; ++i) if ((i & st) == 0) TK_CAS(a[i], a[i + st], true);
}
__host__ __device__ constexpr int tk_pair_rank(int i, int j) { int c = 0; for (int a = 0; a < 16; ++a) for (int b = 0; b < 16; ++b) { if (a == i && b == j) return c; if ((a + 1) * (b + 1) <= 16) ++c; } return c; }
__device__ __forceinline__ unsigned tk_lookup(unsigned long long lo, unsigned long long hi, int i) {
    const unsigned long long w = (i & 8) ? hi : lo; return (unsigned)(w >> ((i & 7) * 8)) & 0xffu; }
__device__ __forceinline__ void phase_h8(const P& p) {
    const int TID = otid();
    const int lane = TID & 63, gw = (blockIdx.x * blockDim.x + TID) >> 6, nw = (gridDim.x * blockDim.x) >> 6;
    for (int t = gw; t < T; t += nw) {
        const bf16_t* hb = (const bf16_t*)(p.ws + WS_XN) + (size_t)t * D + 16 * lane; const u32x4 h0 = *(const u32x4*)hb, h1 = *(const u32x4*)(hb + 8);
        f32x4 a[4]; float am = 0.f;
#pragma unroll
        for (int w = 0; w < 4; ++w) { const unsigned d = (w < 2) ? h0[2 * w] : h1[2 * (w - 2)], e = (w < 2) ? h0[2 * w + 1] : h1[2 * (w - 2) + 1];
            a[w][0] = __uint_as_float(d << 16); a[w][1] = __uint_as_float(d & 0xffff0000u); a[w][2] = __uint_as_float(e << 16); a[w][3] = __uint_as_float(e & 0xffff0000u);
            am = fmaxf(fmaxf(am, fmaxf(fabsf(a[w][0]), fabsf(a[w][1]))), fmaxf(fabsf(a[w][2]), fabsf(a[w][3]))); }
        am = wave_max_fast(am);
        const float sc = am > 0.f ? 127.0f / am : 1.0f;
        int hs = 0; u32x2 hh, hl; hh[0] = 0u; hh[1] = 0u; hl[0] = 0u; hl[1] = 0u;
#pragma unroll
        for (int w = 0; w < 4; ++w)
#pragma unroll
            for (int k = 0; k < 4; ++k) { const int qv = (int)rintf(a[w][k] * sc); hs += qv; const int n = 4 * (w & 1) + k;
                hh[w >> 1] |= (unsigned)((qv >> 4) & 15) << (4 * n); hl[w >> 1] |= (unsigned)((qv & 15) ^ 8) << (4 * n); }
        unsigned char* hb8 = p.ws + WS_H8 + (size_t)t * D + 32 * (lane >> 1) + 8 * (lane & 1);
        *(u32x2*)hb8 = hh; *(u32x2*)(hb8 + 16) = hl;
        const float hc = wave_sum_fast(0.5f * (float)hs);
        if (lane == 0) { ((float*)(p.ws + WS_HSC))[t] = am > 0.f ? am * (1.0f / 127.0f) : 1.0f; ((float*)(p.ws + WS_HSC))[T + t] = hc; }
    }
}
__device__ __forceinline__ void phase_peer_topk(LAS unsigned char* ldsb, const P& p, const pg8::StaticOrder& So) {
    const int TID = otid();
    const int lane = TID & 63, r32 = lane & 31, hi = lane >> 5, wave = TID >> 6;
    const bf16_t* PQ = (const bf16_t*)(p.ws + WS_PQ); const bf16_t* SKb = (const bf16_t*)(p.ws + WS_SK); int* IDX = (int*)(p.ws + WS_IDX); float* GATE = (float*)(p.ws + WS_GATE);
    pg8::Unit un;
    for (int ui = 0; So.next(ui, un); ++ui) {
        const int tg = un.pm * 8 + wave, h = un.pn, t = tg * 32 + r32;
        __syncthreads();
#pragma unroll
        for (int j = 0; j < 8; ++j) { const int q = TID + 512 * j, pp_ = q >> 11, row = (q >> 4) & 127, ch = q & 15;
            *(LAS u32x4*)(ldsb + pp_ * 32768 + row * 256 + ((ch ^ (row & 15)) * 16)) = *(const u32x4*)(SKb + ((size_t)(h * 2 + pp_) * PNK + row) * PHALF + ch * 8); }
        u32x4 qfr[2][8];
#pragma unroll
        for (int pp = 0; pp < 2; ++pp)
#pragma unroll
            for (int ks = 0; ks < 8; ++ks) qfr[pp][ks] = *(const u32x4*)(PQ + (size_t)t * PQC + h * 256 + pp * 128 + 8 * hi + 16 * ks);
        __syncthreads();
        unsigned K0[16], K1[16];
#pragma unroll
        for (int pp = 0; pp < 2; ++pp) {
            f32x16_t acc[4];
#pragma unroll
            for (int mt = 0; mt < 4; ++mt) acc[mt] = f32x16_t{};
#pragma unroll
            for (int ks = 0; ks < 8; ++ks) {
                const bf16x8_t qf = __builtin_bit_cast(bf16x8_t, qfr[pp][ks]);
#pragma unroll
                for (int mt = 0; mt < 4; ++mt) { const int row = 32 * mt + r32;
                    const bf16x8_t kf = __builtin_bit_cast(bf16x8_t, *(const LAS u32x4*)(ldsb + pp * 32768 + row * 256 + (((2 * ks + hi) ^ (row & 15)) * 16)));
                    acc[mt] = __builtin_amdgcn_mfma_f32_32x32x16_bf16(kf, qf, acc[mt], 0, 0, 0); }
            }
            unsigned L[16], L1[16], L2[16], L3[16];
            const unsigned h4 = 4u * (unsigned)hi;
#pragma unroll
            for (int r = 0; r < 16; ++r) { const unsigned lowb = (unsigned)(127 - (r & 3) - 8 * (r >> 2)) - h4;
                L[r] = (f2ord(acc[0][r]) & ~127u) | lowb; L1[r] = (f2ord(acc[1][r]) & ~127u) | (lowb - 32u); L2[r] = (f2ord(acc[2][r]) & ~127u) | (lowb - 64u); L3[r] = (f2ord(acc[3][r]) & ~127u) | (lowb - 96u); }
            tk_sort16(L); tk_sort16(L1); tk_sort16(L2); tk_sort16(L3);
            tk_merge16(L, L1); tk_merge16(L2, L3); tk_merge16(L, L2);
            unsigned M[16];
#pragma unroll
            for (int i = 0; i < 16; ++i) { const auto r_ = __builtin_amdgcn_permlane32_swap(L[i], L[i], false, false); M[i] = hi ? r_[0] : r_[1]; }
            tk_merge16(L, M);
#pragma unroll
            for (int i = 0; i < 16; ++i) { if (pp == 0) K0[i] = L[i]; else K1[i] = L[i]; }
        }
        float v0[16], v1[16]; unsigned long long t0lo = 0ull, t0hi = 0ull, t1lo = 0ull, t1hi = 0ull;
#pragma unroll
        for (int i = 0; i < 16; ++i) { v0[i] = ord2f(K0[i] & ~127u); v1[i] = ord2f(K1[i] & ~127u);
            const unsigned long long e0 = (unsigned long long)(127u - (K0[i] & 127u)) << ((i & 7) * 8), e1 = (unsigned long long)(127u - (K1[i] & 127u)) << ((i & 7) * 8);
            if (i < 8) { t0lo |= e0; t1lo |= e1; } else { t0hi |= e0; t1hi |= e1; } }
        unsigned Bk[16], B1[16], B2[16], B3[16];
#pragma unroll
        for (int i = 0; i < 16; ++i) { Bk[i] = 0u; B1[i] = 0u; B2[i] = 0u; B3[i] = 0u; }
#pragma unroll
        for (int i = 0; i < 16; ++i)
#pragma unroll
            for (int j = 0; j < 16; ++j) if ((i + 1) * (j + 1) <= 16) {
                const unsigned key = (f2ord(v0[i] + v1[j]) & ~255u) | (unsigned)(255 - (i * 16 + j));
                const int rk = tk_pair_rank(i, j);
                if ((rk >> 4) == 0) Bk[rk & 15] = key; else if ((rk >> 4) == 1) B1[rk & 15] = key; else if ((rk >> 4) == 2) B2[rk & 15] = key; else B3[rk & 15] = key; }
#pragma unroll
        for (int i = 0; i < 16; ++i) { Bk[i] = hi ? B2[i] : Bk[i]; B1[i] = hi ? B3[i] : B1[i]; }
        tk_sort16(Bk); tk_sort16(B1); tk_merge16(Bk, B1);
#pragma unroll
        for (int i = 0; i < 16; ++i) { const auto r_ = __builtin_amdgcn_permlane32_swap(Bk[i], Bk[i], false, false); B2[i] = hi ? r_[0] : r_[1]; }
        tk_merge16(Bk, B2);
        float rstd;
        { const f32x4* rp = (const f32x4*)((const float*)(p.ws + WS_RSSP) + (size_t)t * 16); const f32x4 s4 = (rp[0] + rp[1]) + (rp[2] + rp[3]);
          rstd = rsqrtf(((s4[0] + s4[1]) + (s4[2] + s4[3])) * (1.f / D) + EPS); }
        float gt[16]; int ex[16]; float sum = 0.f; const float best0 = ord2f(Bk[0] & ~255u);
#pragma unroll
        for (int r = 0; r < 16; ++r) { const float bv = ord2f(Bk[r] & ~255u); gt[r] = __expf(rstd * (bv - best0)); sum += gt[r];
            const int flat = 255 - (int)(Bk[r] & 255u); ex[r] = (int)tk_lookup(t0lo, t0hi, flat >> 4) * PNK + (int)tk_lookup(t1lo, t1hi, flat & 15); }
        const float rs = 1.f / sum;
        if (hi == 0) {
#pragma unroll
            for (int q = 0; q < 4; ++q) {
                u32x4 iv; iv.x = (unsigned)ex[4 * q]; iv.y = (unsigned)ex[4 * q + 1]; iv.z = (unsigned)ex[4 * q + 2]; iv.w = (unsigned)ex[4 * q + 3];
                *(u32x4*)(IDX + ((size_t)t * PH + h) * PK + 4 * q) = iv;
                f32x4 gv; gv[0] = gt[4 * q] * rs; gv[1] = gt[4 * q + 1] * rs; gv[2] = gt[4 * q + 2] * rs; gv[3] = gt[4 * q + 3] * rs;
                *(f32x4*)(GATE + ((size_t)t * PH + h) * PK + 4 * q) = gv; }
        }
    }
}

__device__ __forceinline__ float gelu_exact(float v) {
    const float av = fabsf(v), t = __builtin_amdgcn_rcpf(av * 0.2316418882f + 1.0f);
    float q = t * 0.5307027145f + (-0.7265760135f); q = q * t + 0.7107068705f; q = q * t + (-0.142248368f); q = q * t + 0.127414796f; q = q * t;
    const float e = __builtin_amdgcn_exp2f((v * v) * (-0.72134752044f)), m = v * (q * e);
    return v < 0.f ? m : v - m;
}
#define EX_HALVE16(d, m2, m1, m0, u2, u1, u0, r0, r1) do { float h8_[8], h4_[4]; \
        _Pragma("unroll") for (int i_ = 0; i_ < 8; ++i_) { const float k_ = (u2) ? d[i_ + 8] : d[i_], s_ = (u2) ? d[i_] : d[i_ + 8]; h8_[i_] = k_ + __shfl_xor(s_, (m2)); } \
        _Pragma("unroll") for (int i_ = 0; i_ < 4; ++i_) { const float k_ = (u1) ? h8_[i_ + 4] : h8_[i_], s_ = (u1) ? h8_[i_] : h8_[i_ + 4]; h4_[i_] = k_ + __shfl_xor(s_, (m1)); } \
        { const float k0_ = (u0) ? h4_[2] : h4_[0], s0_ = (u0) ? h4_[0] : h4_[2], k1_ = (u0) ? h4_[3] : h4_[1], s1_ = (u0) ? h4_[1] : h4_[3]; r0 = k0_ + __shfl_xor(s0_, (m0)); r1 = k1_ + __shfl_xor(s1_, (m0)); } } while (0)
#define EX_HALVE16_SWAP(d, u0, r0, r1) do { float h8_[8], h4_[4]; \
        _Pragma("unroll") for (int i_ = 0; i_ < 8; ++i_) { const auto q_ = __builtin_amdgcn_permlane32_swap(__float_as_uint(d[i_]), __float_as_uint(d[i_ + 8]), false, false); h8_[i_] = __uint_as_float(q_[0]) + __uint_as_float(q_[1]); } \
        _Pragma("unroll") for (int i_ = 0; i_ < 4; ++i_) { const auto q_ = __builtin_amdgcn_permlane16_swap(__float_as_uint(h8_[i_]), __float_as_uint(h8_[i_ + 4]), false, false); h4_[i_] = __uint_as_float(q_[0]) + __uint_as_float(q_[1]); } \
        { const float k0_ = (u0) ? h4_[2] : h4_[0], s0_ = (u0) ? h4_[0] : h4_[2], k1_ = (u0) ? h4_[3] : h4_[1], s1_ = (u0) ? h4_[1] : h4_[3]; \
          r0 = k0_ + __builtin_bit_cast(float, __builtin_amdgcn_update_dpp(0, __builtin_bit_cast(int, s0_), 0x128, 0xf, 0xf, true)); r1 = k1_ + __builtin_bit_cast(float, __builtin_amdgcn_update_dpp(0, __builtin_bit_cast(int, s1_), 0x128, 0xf, 0xf, true)); } } while (0)
#define EX_HALVE16_SWAP_I(d, u0, r0, r1) do { int h8_[8], h4_[4]; \
        _Pragma("unroll") for (int i_ = 0; i_ < 8; ++i_) { const auto q_ = __builtin_amdgcn_permlane32_swap((unsigned)d[i_], (unsigned)d[i_ + 8], false, false); h8_[i_] = (int)(q_[0] + q_[1]); } \
        _Pragma("unroll") for (int i_ = 0; i_ < 4; ++i_) { const auto q_ = __builtin_amdgcn_permlane16_swap((unsigned)h8_[i_], (unsigned)h8_[i_ + 4], false, false); h4_[i_] = (int)(q_[0] + q_[1]); } \
        { const int k0_ = (u0) ? h4_[2] : h4_[0], s0_ = (u0) ? h4_[0] : h4_[2], k1_ = (u0) ? h4_[3] : h4_[1], s1_ = (u0) ? h4_[1] : h4_[3]; \
          r0 = k0_ + __builtin_amdgcn_update_dpp(0, s0_, 0x128, 0xf, 0xf, true); r1 = k1_ + __builtin_amdgcn_update_dpp(0, s1_, 0x128, 0xf, 0xf, true); } } while (0)
struct ExIds { u32x4 i0, i1, i2, i3; };
struct ExAux { u32x4 w0; f32x4 y; };
__device__ __forceinline__ void ex_ids(ExIds& I, const P& p, int t, int g) {
    const u32x4* ip = (const u32x4*)((const int*)(p.ws + WS_IDX) + (size_t)t * 128 + 16 * g); I.i0 = ip[0]; I.i1 = ip[1]; I.i2 = ip[2]; I.i3 = ip[3]; }
template <int PASS> __device__ __forceinline__ void ex_gather(u32x4 (&buf)[16], ExAux& X, const ExIds& I, const P& p, int t, int x, int g, int c) {
    const __amdgpu_buffer_rsrc_t TAB = __builtin_amdgcn_make_buffer_rsrc((void*)(p.ws + (PASS == 0 ? WS_EU : WS_EV) + (size_t)x * ESLICE), 0, (int)ESLICE, 0x00020000);
#pragma unroll
    for (int j = 0; j < 16; ++j) { const unsigned e = (j < 4) ? I.i0[j & 3] : (j < 8) ? I.i1[j & 3] : (j < 12) ? I.i2[j & 3] : I.i3[j & 3];
        buf[j] = __builtin_amdgcn_raw_buffer_load_b128(TAB, (int)(e * 128u) + 16 * c, 0, 0); }
    if constexpr (PASS == 0) { const u32x4* hp8 = (const u32x4*)(p.ws + WS_H8 + (size_t)t * D + x * 256 + 32 * c); X.w0 = hp8[0]; X.y = __builtin_bit_cast(f32x4, hp8[1]); }
    else { X.w0 = *(const u32x4*)(p.ws + WS_A + (size_t)t * 128 + 16 * g);
           const bf16_t* hp = (const bf16_t*)(p.ws + WS_XN) + (size_t)t * D + x * 256 + 32 * c + 2 * g; const unsigned hw = *(const unsigned*)hp, hw1 = *(const unsigned*)(hp + 16);
           X.y[0] = __uint_as_float(hw << 16); X.y[1] = __uint_as_float(hw & 0xffff0000u); X.y[2] = __uint_as_float(hw1 << 16); X.y[3] = __uint_as_float(hw1 & 0xffff0000u); }
}
template <int PASS> __device__ __forceinline__ void ex_compute(const u32x4 (&buf)[16], const ExAux& X, const P& p, int t, int x, int lane, int g, int c, float asc, float cs, float& o0, float& o1) {
    float d[16];
    if constexpr (PASS == 0) {
        const u32x4 w1 = __builtin_bit_cast(u32x4, X.y);
#pragma unroll
        for (int j = 0; j < 16; ++j) { int aH = 0, aL = 0;
#pragma unroll
            for (int q = 0; q < 4; ++q) { aH = __builtin_amdgcn_sdot8((int)buf[j][q], (int)X.w0[q], aH, false); aL = __builtin_amdgcn_sdot8((int)buf[j][q], (int)w1[q], aL, false); }
            d[j] = (float)((aH << 4) + aL); }
        float r0, r1;
        EX_HALVE16(d, 4, 2, 1, (lane & 4) != 0, (lane & 2) != 0, (lane & 1) != 0, r0, r1);
        o0 += r0; o1 += r1;
    } else {
        float osq = 0.f;
#pragma unroll
        for (int hf = 0; hf < 2; ++hf) {
            int ai[16];
#pragma unroll
            for (int i = 0; i < 16; ++i) ai[i] = 0;
#pragma unroll
            for (int j4 = 0; j4 < 4; ++j4) { const int a4 = (int)X.w0[j4];
#pragma unroll
                for (int q2 = 0; q2 < 2; ++q2) { const int q = 2 * hf + q2; const unsigned r0_ = buf[4 * j4][q], r1_ = buf[4 * j4 + 1][q], r2_ = buf[4 * j4 + 2][q], r3_ = buf[4 * j4 + 3][q];
                    const unsigned t0 = __builtin_amdgcn_perm(r1_, r0_, 0x05010400u), t1 = __builtin_amdgcn_perm(r1_, r0_, 0x07030602u), t2 = __builtin_amdgcn_perm(r3_, r2_, 0x05010400u), t3 = __builtin_amdgcn_perm(r3_, r2_, 0x07030602u);
                    const unsigned c0_ = __builtin_amdgcn_perm(t2, t0, 0x05040100u), c1_ = __builtin_amdgcn_perm(t2, t0, 0x07060302u), c2_ = __builtin_amdgcn_perm(t3, t1, 0x05040100u), c3_ = __builtin_amdgcn_perm(t3, t1, 0x07060302u);
                    ai[8 * q2 + 0] = __builtin_amdgcn_sdot4((int)(c0_ & 0x0f0f0f0fu), a4, ai[8 * q2 + 0], false); ai[8 * q2 + 1] = __builtin_amdgcn_sdot4((int)c0_, a4, ai[8 * q2 + 1], false);
                    ai[8 * q2 + 2] = __builtin_amdgcn_sdot4((int)(c1_ & 0x0f0f0f0fu), a4, ai[8 * q2 + 2], false); ai[8 * q2 + 3] = __builtin_amdgcn_sdot4((int)c1_, a4, ai[8 * q2 + 3], false);
                    ai[8 * q2 + 4] = __builtin_amdgcn_sdot4((int)(c2_ & 0x0f0f0f0fu), a4, ai[8 * q2 + 4], false); ai[8 * q2 + 5] = __builtin_amdgcn_sdot4((int)c2_, a4, ai[8 * q2 + 5], false);
                    ai[8 * q2 + 6] = __builtin_amdgcn_sdot4((int)(c3_ & 0x0f0f0f0fu), a4, ai[8 * q2 + 6], false); ai[8 * q2 + 7] = __builtin_amdgcn_sdot4((int)c3_, a4, ai[8 * q2 + 7], false); }
                asm volatile("" : "+v"(ai[0]), "+v"(ai[1]), "+v"(ai[2]), "+v"(ai[3]), "+v"(ai[4]), "+v"(ai[5]), "+v"(ai[6]), "+v"(ai[7]), "+v"(ai[8]), "+v"(ai[9]), "+v"(ai[10]), "+v"(ai[11]), "+v"(ai[12]), "+v"(ai[13]), "+v"(ai[14]), "+v"(ai[15]));
                __builtin_amdgcn_sched_barrier(0); }
            int i0, i1;
            EX_HALVE16_SWAP_I(ai, (lane & 8) != 0, i0, i1);
            const float r0 = (float)i0 * asc, r1 = (float)(i1 - i0) * (asc * 0.0625f);
            f32x2v y; y[0] = X.y[2 * hf] + (r0 - 7.5f * cs); y[1] = X.y[2 * hf + 1] + (r1 + 0.5f * cs);
            *(f32x2v*)(p.out + (size_t)t * D + x * 256 + 32 * c + 16 * hf + 2 * g) = y;
            osq += y[0] * y[0] + y[1] * y[1];
        }
        o0 += osq;
    }
}
typedef float f32x2l __attribute__((ext_vector_type(2)));
template <int PASS> __device__ __forceinline__ void ex_pass(const P& p, int tb, int lane, int g, int c, LAS f32x2l* acc, const LAS float* ascl) {
    u32x4 bA[16], bB[16]; ExAux xA, xB; ExIds I;
    ex_ids(I, p, tb, g);
    ex_gather<PASS>(bA, xA, I, p, tb, 0, g, c);
    ex_ids(I, p, tb + 1, g);
    constexpr int NS = 32;
#pragma unroll 1
    for (int s_ = 0; s_ < NS; s_ += 2) {
        const int x = s_ >> 3, i = s_ & 7, s2 = min(s_ + 2, NS - 1), x2 = s2 >> 3, i2 = s2 & 7;
        ex_gather<PASS>(bB, xB, I, p, tb + i + 1, x, g, c);
        ex_ids(I, p, tb + i2, g);
        { float o0 = 0.f, o1 = 0.f; ex_compute<PASS>(bA, xA, p, tb + i, x, lane, g, c, (PASS == 1) ? ascl[i] : 0.f, (PASS == 1) ? ascl[8 + i] : 0.f, o0, o1); f32x2l v = acc[i * 64 + lane]; v[0] += o0; v[1] += o1; acc[i * 64 + lane] = v; }
        ex_gather<PASS>(bA, xA, I, p, tb + i2, x2, g, c);
        ex_ids(I, p, tb + ((i2 + 1) & 7), g);
        { float o0 = 0.f, o1 = 0.f; ex_compute<PASS>(bB, xB, p, tb + i + 1, x, lane, g, c, (PASS == 1) ? ascl[i + 1] : 0.f, (PASS == 1) ? ascl[9 + i] : 0.f, o0, o1); f32x2l v = acc[(i + 1) * 64 + lane]; v[0] += o0; v[1] += o1; acc[(i + 1) * 64 + lane] = v; }
    }
}
__device__ __forceinline__ void phase_experts(LAS unsigned char* ldsb, const P& p) {
    const int TID = otid();
    const int lane = TID & 63, wave = TID >> 6, g = lane >> 3, c = lane & 7, tb = (blockIdx.x * 8 + wave) * 8;
    const float* USC = (const float*)(p.ws + WS_USC); const float* VSC = (const float*)(p.ws + WS_VSC);
    LAS f32x2l* acc = (LAS f32x2l*)(ldsb + wave * 8192); LAS float* ascl = (LAS float*)(ldsb + wave * 8192 + 4096);
#pragma unroll
    for (int i = 0; i < 8; ++i) { f32x2l z; z[0] = 0.f; z[1] = 0.f; acc[i * 64 + lane] = z; }
    ex_pass<0>(p, tb, lane, g, c, acc, ascl);
#pragma unroll 1
    for (int i = 0; i < 8; ++i) { const int t = tb + i, k0 = 16 * g + 2 * c;
        float rstd;
        { const f32x4* rp = (const f32x4*)((const float*)(p.ws + WS_RSSP) + (size_t)t * 16); const f32x4 s4 = (rp[0] + rp[1]) + (rp[2] + rp[3]);
          rstd = rsqrtf(((s4[0] + s4[1]) + (s4[2] + s4[3])) * (1.f / D) + EPS); }
        const u32x2 e = *(const u32x2*)((const int*)(p.ws + WS_IDX) + (size_t)t * 128 + k0);
        const f32x2v gt = *(const f32x2v*)((const float*)(p.ws + WS_GATE) + (size_t)t * 128 + k0);
        const float hs = rstd * ((const float*)(p.ws + WS_HSC))[t], hc = ((const float*)(p.ws + WS_HSC))[T + t];
        f32x2l hv = acc[i * 64 + lane]; hv[0] += hc; hv[1] += hc;
        const float a0 = gt[0] * gelu_exact(hs * USC[e.x] * (hv[0] + 8.f * USC[2 * PNK * PNK + e.x])) * VSC[e.x], a1 = gt[1] * gelu_exact(hs * USC[e.y] * (hv[1] + 8.f * USC[2 * PNK * PNK + e.y])) * VSC[e.y];
        const float am = wave_max_fast(fmaxf(fabsf(a0), fabsf(a1))), sc = am > 0.f ? 127.0f / am : 1.0f;
        const int q0 = (int)rintf(a0 * sc), q1 = (int)rintf(a1 * sc);
        *(unsigned short*)(p.ws + WS_A + (size_t)t * 128 + k0) = (unsigned short)((q0 & 0xff) | ((q1 & 0xff) << 8));
        const float asum = wave_sum_fast((float)(q0 + q1)), asc_ = am > 0.f ? am * (1.0f / 127.0f) : 1.0f;
        if (lane == 0) { ascl[i] = asc_; ascl[8 + i] = asc_ * asum; }
        f32x2l z; z[0] = 0.f; z[1] = 0.f; acc[i * 64 + lane] = z; }
    asm volatile("s_waitcnt vmcnt(0) lgkmcnt(0)" ::: "memory");
    ex_pass<1>(p, tb, lane, g, c, acc, ascl);
    asm volatile("s_waitcnt vmcnt(0) lgkmcnt(0)" ::: "memory");
#pragma unroll 1
    for (int i = 0; i < 8; ++i) { const f32x2l q = acc[i * 64 + lane]; const float r2 = rsqrtf(wave_sum_fast(q[0]) * (1.f / D) + EPS);
        f32x4* orow = (f32x4*)(p.out + (size_t)(tb + i) * D);
#pragma unroll
        for (int j = 0; j < 4; ++j) { const f32x4 gf = ((const f32x4*)p.g_fin)[lane + 64 * j]; f32x4 y = orow[lane + 64 * j] * r2; y[0] *= gf[0]; y[1] *= gf[1]; y[2] *= gf[2]; y[3] *= gf[3]; orow[lane + 64 * j] = y; } }
}
#undef EX_HALVE16
#undef EX_HALVE16_SWAP
#undef EX_HALVE16_SWAP_I

#define LAS __attribute__((address_space(3)))
#define XB_TMO      128
#define XB_XCNT(j)  (256  + 64 * (j))
#define XB_XSUB(j)  (1280 + 64 * (j))
#define XB_XGEN(j)  (2304 + 64 * (j))
#define XB_TOP      3328
#define XB_TOPGEN   3392
#define XCD_BAR_WORDS 3456
#define XB_SPIN_CAP (1u << 22)
__device__ __forceinline__ unsigned xb_ld(unsigned* p)              { return __hip_atomic_load(p, __ATOMIC_RELAXED, __HIP_MEMORY_SCOPE_AGENT); }
__device__ __forceinline__ unsigned xb_add(unsigned* p, unsigned v) { return __hip_atomic_fetch_add(p, v, __ATOMIC_RELAXED, __HIP_MEMORY_SCOPE_AGENT); }
__device__ __forceinline__ unsigned xb_xcc_id() { return (unsigned)__builtin_amdgcn_s_getreg((3 << 11) | 20) & 0xFu; }
#define XB_SPIN(cond, bar) do { unsigned _sp = 0; while (cond) { __builtin_amdgcn_s_sleep(1); \
    if ((++_sp & 255u) == 0u) { if (xb_ld(&(bar)[XB_TMO])) break; if (_sp > XB_SPIN_CAP) { atomicAdd(&(bar)[XB_TMO], 1u); break; } } } } while (0)
struct XcdBarrier { unsigned* bar; unsigned x; volatile LAS unsigned* st; };
__device__ __forceinline__ XcdBarrier xcd_barrier_post(unsigned* bar, volatile LAS unsigned* st) {
    XcdBarrier b; b.bar = bar; b.x = xb_xcc_id(); b.st = st;
    if (threadIdx.x == 0) (void)xb_add(&bar[XB_XCNT(b.x)], 1u);
    return b;
}
__device__ __forceinline__ void xcd_barrier_complete(unsigned* bar, unsigned x, unsigned& nloc, unsigned& nx) {
    const unsigned G = gridDim.x * gridDim.y * gridDim.z;
    unsigned sum, cnt, mine, sp = 0u;
    for (;;) {
        sum = 0u; cnt = 0u; mine = 0u;
#pragma unroll
        for (unsigned j = 0; j < 16; ++j) { const unsigned c = xb_ld(&bar[XB_XCNT(j)]); sum += c; cnt += (c > 0u) ? 1u : 0u; mine = (j == x) ? c : mine; }
        if (sum == G) break;
        __builtin_amdgcn_s_sleep(1);
        if ((++sp & 255u) == 0u) { if (xb_ld(&bar[XB_TMO])) break; if (sp > XB_SPIN_CAP) { atomicAdd(&bar[XB_TMO], 1u); break; } }
    }
    nloc = mine > 0u ? mine : 1u; nx = cnt > 0u ? cnt : 1u;
}
__device__ __forceinline__ void xcd_barrier(const XcdBarrier& b) {
    asm volatile("s_waitcnt vmcnt(0)" ::: "memory");
    __syncthreads();
    if (threadIdx.x == 0) {
        unsigned* bar = b.bar;
        __builtin_amdgcn_s_waitcnt(0);
        unsigned nloc = b.st[0], nx = b.st[1];
        if (nloc == 0u) { xcd_barrier_complete(bar, b.x, nloc, nx); b.st[0] = nloc; b.st[1] = nx; }
        const unsigned old = xb_add(&bar[XB_XSUB(b.x)], 1u);
        const unsigned gen = old / nloc;
        if (old + 1u == (gen + 1u) * nloc) {
            __builtin_amdgcn_fence(__ATOMIC_RELEASE, "agent");
            asm volatile("s_waitcnt vmcnt(0)" ::: "memory");
            const unsigned og = xb_add(&bar[XB_TOP], 1u);
            const unsigned tg = og / nx;
            if (og + 1u == (tg + 1u) * nx) xb_add(&bar[XB_TOPGEN], 1u);
            else XB_SPIN(xb_ld(&bar[XB_TOPGEN]) == tg, bar);
            __builtin_amdgcn_fence(__ATOMIC_ACQUIRE, "agent");
            xb_add(&bar[XB_XGEN(b.x)], 1u);
            asm volatile("s_waitcnt vmcnt(0)" ::: "memory");
        } else {
            XB_SPIN(xb_ld(&bar[XB_XGEN(b.x)]) == gen, bar);
            __builtin_amdgcn_fence(__ATOMIC_ACQUIRE, "agent");
            asm volatile("s_waitcnt vmcnt(0)" ::: "memory");
        }
    }
    __syncthreads();
}

constexpr int NT = 512;
constexpr int LDS_BYTES = 147456;
constexpr int MISC_OFF = 131072;

__global__ void __launch_bounds__(NT, 2) mega(P p) {
    extern __shared__ __attribute__((aligned(16))) unsigned char lds_raw[];
    float* lds = (float*)lds_raw;
    LAS unsigned char* ldsb = (LAS unsigned char*)lds_raw;
    volatile LAS unsigned* MISC = (volatile LAS unsigned*)(ldsb + MISC_OFF);
    if (threadIdx.x < 32) MISC[threadIdx.x] = 0u;
    __syncthreads();
    XcdBarrier bar = xcd_barrier_post((unsigned*)p.ws, MISC + 8);
#define GRID_BAR() xcd_barrier(bar)
    const int G = gridDim.x;
    bf16_t* QKV = (bf16_t*)(p.ws + WS_QKV);
    phase_prologue(ldsb, p);
    GRID_BAR();
    phase_cumsum(p);
    { pg8::Gemm g{(const bf16_t*)(p.ws + WS_XN), (const bf16_t*)(p.ws + WS_WIN), T, 5120, D / 2}; pg8::StaticOrder So; So.init(T, 5120, G, (int)blockIdx.x);
      pg8::EpiProj E{QKV, (bf16_t*)(p.ws + WS_G), (const float*)(p.ws + WS_ROPE), (float*)(p.ws + WS_KMP), (float*)(p.ws + WS_FKN), (float*)(p.ws + WS_FQN)};
      pg8::gemm_phase<pg8::EpiProj, pg8::StaticOrder, true, true, true>(ldsb, g, So, E); }
    GRID_BAR();
    phase_attn((char*)lds_raw, MISC, p);
    GRID_BAR();
    phase_combine_tables(p);
    GRID_BAR();
    { pg8::Gemm g{QKV, (const bf16_t*)(p.ws + WS_WA), T, D, 512}; pg8::StaticOrder So; So.init(T, D, G, (int)blockIdx.x);
      pg8::EpiMerge E{(bf16_t*)(p.ws + WS_MERGED), (const bf16_t*)(p.ws + WS_G), true};
      pg8::gemm_phase<pg8::EpiMerge, pg8::StaticOrder, true, true>(ldsb, g, So, E); }
    { pg8::Gemm g{QKV + SLOT, (const bf16_t*)(p.ws + WS_WB), T, D, 512}; pg8::StaticOrder So; So.init(T, D, G, (int)blockIdx.x);
      pg8::EpiMerge E{(bf16_t*)(p.ws + WS_MERGED), (const bf16_t*)(p.ws + WS_G) + (size_t)T * D, false};
      pg8::gemm_phase<pg8::EpiMerge, pg8::StaticOrder, true, true>(ldsb, g, So, E); }
    GRID_BAR();
    { pg8::Gemm g{(const bf16_t*)(p.ws + WS_MERGED), (const bf16_t*)(p.ws + WS_WOUT), T, D, D}; pg8::StaticOrder So; So.init(T, D, G, (int)blockIdx.x);
      pg8::EpiOut E{p.x, p.out, (bf16_t*)(p.ws + WS_XN), (float*)(p.ws + WS_RSSP)};
      pg8::gemm_phase<pg8::EpiOut, pg8::StaticOrder, true, true>(ldsb, g, So, E); }
    GRID_BAR();
    { pg8::Gemm g{(const bf16_t*)(p.ws + WS_XN), (const bf16_t*)(p.ws + WS_WPQ), T, PQC, D}; pg8::StaticOrder So; So.init(T, PQC, G, (int)blockIdx.x);
      pg8::EpiStore E{(bf16_t*)(p.ws + WS_PQ), PQC};
      pg8::gemm_phase<pg8::EpiStore, pg8::StaticOrder, true, true>(ldsb, g, So, E);
      phase_peer_topk(ldsb, p, So); }
    phase_h8(p);
    GRID_BAR();
    phase_experts(ldsb, p);
}

extern "C" void kernel_launch(void* const* d_in, const int* in_sizes, int n_in, void* d_out, int out_size, void* d_ws, size_t ws_size, hipStream_t stream) {
    static int grid = 0;
    if (grid == 0) {
        int dev = 0, cus = 0, per_cu = 0;
        if (hipGetDevice(&dev) != hipSuccess || hipDeviceGetAttribute(&cus, hipDeviceAttributeMultiprocessorCount, dev) != hipSuccess) { fprintf(stderr, "kernel_launch: device query failed\n"); grid = -1; return; }
        if (hipFuncSetAttribute((const void*)mega, hipFuncAttributeMaxDynamicSharedMemorySize, LDS_BYTES) != hipSuccess) { fprintf(stderr, "kernel_launch: hipFuncSetAttribute failed\n"); grid = -1; return; }
        if (hipOccupancyMaxActiveBlocksPerMultiprocessor(&per_cu, (const void*)mega, NT, LDS_BYTES) != hipSuccess || per_cu < 1) { fprintf(stderr, "kernel_launch: occupancy query says %d blocks per CU\n", per_cu); (void)hipGetLastError(); grid = -1; return; }
        if (cus < 256) { fprintf(stderr, "kernel_launch: built for a 256-CU device, found %d CUs\n", cus); grid = -1; return; }
        grid = 256;
    }
    if (grid < 0) return;
    (void)hipMemsetAsync(d_ws, 0, CTL_ZERO_BYTES, stream);
    P p{};
    p.x = (const float*)d_in[0]; p.g_mix = (const float*)d_in[1]; p.w_in = (const float*)d_in[2]; p.b_f = (const float*)d_in[3];
    p.w_a = (const float*)d_in[4]; p.w_b = (const float*)d_in[5]; p.w_out = (const float*)d_in[6]; p.g_ffn = (const float*)d_in[7];
    p.w_pq = (const float*)d_in[8]; p.sk = (const float*)d_in[9]; p.eu = (const float*)d_in[10]; p.ev = (const float*)d_in[11]; p.g_fin = (const float*)d_in[12];
    p.out = (float*)d_out; p.ws = (unsigned char*)d_ws;
    hipLaunchKernelGGL(mega, dim3(grid), dim3(NT), LDS_BYTES, stream, p);
}
```

```cpp
#include <hip/hip_runtime.h>
#include <cstdio>
#include <cstdint>
#include <cmath>

constexpr int Bn = 2, S = 8192, D = 1024, T = Bn * S;
constexpr int HD = 64, NH = 8;
constexpr int INC = 5128;
constexpr int LBLK = 256, NBLK = S / LBLK;
constexpr int PH = 8, PNK = 128, PHALF = 128, PK = 16, PQC = PH * 2 * PHALF;
constexpr float EPS = 1e-6f;
constexpr float LOG2E = 1.4426950408889634f;
constexpr float C2 = 0.125f * LOG2E;

typedef unsigned short bf16_t;
typedef float f32x4 __attribute__((ext_vector_type(4)));
typedef unsigned u32x2 __attribute__((ext_vector_type(2)));
typedef unsigned u32x4 __attribute__((ext_vector_type(4)));
#define LAS __attribute__((address_space(3)))

__device__ __forceinline__ float bf2f(bf16_t v) { return __uint_as_float((unsigned)v << 16); }
__device__ __forceinline__ unsigned f2bf(float f) { unsigned u = __float_as_uint(f); return (u + 0x7fffu + ((u >> 16) & 1u)) >> 16; }
__device__ __forceinline__ unsigned pk2(float lo, float hi) { return f2bf(lo) | (f2bf(hi) << 16); }
#define WS_DPP(v, ctrl) ((v) + __builtin_bit_cast(float, __builtin_amdgcn_update_dpp(0, __builtin_bit_cast(int, (v)), (ctrl), 0xf, 0xf, true)))
#define WM_DPP(v, ctrl) fmaxf((v), __builtin_bit_cast(float, __builtin_amdgcn_update_dpp(0, __builtin_bit_cast(int, (v)), (ctrl), 0xf, 0xf, true)))
__device__ __forceinline__ float sum_x16(float v) { const auto r = __builtin_amdgcn_permlane16_swap(__float_as_uint(v), __float_as_uint(v), false, false); return __uint_as_float(r[0]) + __uint_as_float(r[1]); }
__device__ __forceinline__ float sum_x32(float v) { const auto r = __builtin_amdgcn_permlane32_swap(__float_as_uint(v), __float_as_uint(v), false, false); return __uint_as_float(r[0]) + __uint_as_float(r[1]); }
__device__ __forceinline__ float sum_x8(float v) { return v + __builtin_bit_cast(float, __builtin_amdgcn_update_dpp(0, __builtin_bit_cast(int, v), 0x128, 0xf, 0xf, true)); }
__device__ __forceinline__ float wave_sum_fast(float v) {
    v = WS_DPP(v, 0xB1); v = WS_DPP(v, 0x4E); v = WS_DPP(v, 0x141); v = WS_DPP(v, 0x140);
    const int iv = __builtin_bit_cast(int, v);
    return (__builtin_bit_cast(float, __builtin_amdgcn_readlane(iv, 0)) + __builtin_bit_cast(float, __builtin_amdgcn_readlane(iv, 16))) + (__builtin_bit_cast(float, __builtin_amdgcn_readlane(iv, 32)) + __builtin_bit_cast(float, __builtin_amdgcn_readlane(iv, 48)));
}
__device__ __forceinline__ float wave_max_fast(float v) {
    v = WM_DPP(v, 0xB1); v = WM_DPP(v, 0x4E); v = WM_DPP(v, 0x141); v = WM_DPP(v, 0x140);
    const int iv = __builtin_bit_cast(int, v);
    return fmaxf(fmaxf(__builtin_bit_cast(float, __builtin_amdgcn_readlane(iv, 0)), __builtin_bit_cast(float, __builtin_amdgcn_readlane(iv, 16))), fmaxf(__builtin_bit_cast(float, __builtin_amdgcn_readlane(iv, 32)), __builtin_bit_cast(float, __builtin_amdgcn_readlane(iv, 48))));
}
__device__ __forceinline__ int otid() { int t = threadIdx.x; asm volatile("" : "+v"(t)); return t; }

constexpr size_t MiB = 1u << 20, KiB = 1u << 10;
constexpr size_t CTL_ZERO_BYTES = 65536;
constexpr size_t WS_ROPE = 1 * MiB;
constexpr size_t WS_C = 1 * MiB + 512 * KiB;
constexpr size_t WS_LOGF = 2 * MiB;
constexpr size_t WS_KMP = 2 * MiB + 512 * KiB;
constexpr size_t WS_MCNT = 40 * KiB;
constexpr size_t WS_FKN = 2 * MiB + 768 * KiB;
constexpr size_t WS_FQN = WS_FKN + 32 * KiB;
constexpr size_t WS_MG1 = 44 * KiB;
constexpr size_t WS_SEL3 = 4 * MiB + 512 * KiB;
constexpr size_t WS_MLIST = 5 * MiB;
constexpr size_t WS_MLSE = 13 * MiB;
constexpr size_t WS_MP2 = 23 * MiB, WS_MP3 = 39 * MiB;
constexpr size_t WS_MP0 = 215 * MiB, WS_MP1 = 231 * MiB;
constexpr size_t WS_WSUM = 3 * MiB;
constexpr size_t WS_WIN = 5 * MiB;
constexpr size_t WS_WA = 15 * MiB, WS_WB = 16 * MiB;
constexpr size_t WS_WOUT = 17 * MiB;
constexpr size_t WS_WPQ = 19 * MiB;
constexpr size_t WS_XN = 23 * MiB;
constexpr size_t WS_QKV = 55 * MiB;
constexpr size_t SLOT = (size_t)T * 512;
constexpr size_t WS_G = 151 * MiB;
constexpr size_t WS_MERGED = 215 * MiB;
constexpr size_t WS_PQ = 151 * MiB;
constexpr size_t WS_IDX = 215 * MiB;
constexpr size_t WS_GATE = 223 * MiB;
constexpr size_t WS_SK = 247 * MiB;
constexpr size_t WS_RSSP = 3 * MiB + 512 * KiB;
constexpr size_t WS_EU = 87 * MiB;
constexpr size_t WS_EV = 103 * MiB;
constexpr size_t ESLICE = (size_t)16384 * 128;
constexpr size_t WS_A = 231 * MiB;
constexpr size_t WS_H8 = 55 * MiB;
constexpr size_t WS_HSC = 71 * MiB;
constexpr size_t WS_USC = 119 * MiB;
constexpr size_t WS_VSC = 119 * MiB + 64 * KiB;

struct P {
    const float *x, *g_mix, *w_in, *b_f, *w_a, *w_b, *w_out, *g_ffn, *w_pq, *sk, *eu, *ev, *g_fin;
    float* out; unsigned char* ws;
};

namespace pg8 {
#define PG8_LAS __attribute__((address_space(3)))
typedef unsigned short bf16_t;
typedef short bf16x8 __attribute__((ext_vector_type(8)));
typedef int i32x4 __attribute__((ext_vector_type(4))); typedef int i32x8 __attribute__((ext_vector_type(8)));
typedef float f32x4 __attribute__((ext_vector_type(4)));
typedef unsigned u32x4 __attribute__((ext_vector_type(4)));
constexpr int BM = 256, BK = 64, HALF = 128, HTB = HALF * BK * 2  , STAGE_BYTES = 8 * HTB, NXCD = 8, WGM = 8;

__host__ __device__ __forceinline__ int lds_byte(int r, int c) { const int st = (r >> 4) * 2 + (c >> 5), rr = r & 15, cc = c & 31, ob = rr * 64 + cc * 2; return st * 1024 + (ob ^ (((ob >> 9) & 1) << 5)); }
__host__ __device__ __forceinline__ void stage_rc(int b, int& R, int& C) { const int st = b / 1024, sb = b % 1024, swz = sb ^ (((sb >> 9) & 1) << 5); R = (st >> 1) * 16 + swz / 64; C = (st & 1) * 32 + (swz % 64) / 2; }
__host__ __device__ __forceinline__ int perm32(int rho) { const int n = rho >> 4, i = rho & 15; return 8 * (i >> 2) + 4 * n + (i & 3); }

struct Unit { int pm, pn; };
struct Gemm { const bf16_t* A; const bf16_t* Bt; int M, N, K; };

struct StaticOrder {
    int nM, nN, nwg, G, c;
    __host__ __device__ void init(int M, int N, int G_, int c_) { nM = M / BM; nN = N / BM; nwg = nM * nN; G = G_; c = c_; }
    __host__ __device__ bool next(int i, Unit& u) const {
        const long L = (long)i * G + c; if (L >= nwg) return false;
        int wgid = (int)L; { const int q = nwg / NXCD, r = nwg % NXCD, xcd = wgid % NXCD, off = wgid / NXCD; wgid = (xcd < r ? xcd * (q + 1) : r * (q + 1) + (xcd - r) * q) + off; }
        const int nig = WGM * nN, gid = wgid / nig, fm = gid * WGM, gsz = (nM - fm) < WGM ? (nM - fm) : WGM;
        u.pm = fm + ((wgid % nig) % gsz); u.pn = (wgid % nig) / gsz; return true;
    }
    __device__ __forceinline__ void a_ready(const Unit&) const {}
    __device__ __forceinline__ void done(const Unit&) const {}
};

__device__ __forceinline__ unsigned cvt_pk_bf16(float lo, float hi) { unsigned r; asm volatile("v_cvt_pk_bf16_f32 %0, %1, %2" : "=v"(r) : "v"(lo), "v"(hi)); return r; }

typedef float f32x2_t __attribute__((ext_vector_type(2))); typedef __bf16 bf16x2_t __attribute__((ext_vector_type(2)));
__device__ __forceinline__ unsigned cvtpk_c(float lo, float hi) { f32x2_t v = {lo, hi}; bf16x2_t b = __builtin_convertvector(v, bf16x2_t); return __builtin_bit_cast(unsigned, b); }
__device__ __forceinline__ u32x4 pack8(const f32x4& v0, const f32x4& v1) { u32x4 w; w.x = cvtpk_c(v0[0], v0[1]); w.y = cvtpk_c(v0[2], v0[3]); w.z = cvtpk_c(v1[0], v1[1]); w.w = cvtpk_c(v1[2], v1[3]); return w; }
__device__ __forceinline__ void unpack8(const u32x4& w, f32x4& v0, f32x4& v1) {
    v0[0] = __uint_as_float(w.x << 16); v0[1] = __uint_as_float(w.x & 0xffff0000u); v0[2] = __uint_as_float(w.y << 16); v0[3] = __uint_as_float(w.y & 0xffff0000u);
    v1[0] = __uint_as_float(w.z << 16); v1[1] = __uint_as_float(w.z & 0xffff0000u); v1[2] = __uint_as_float(w.w << 16); v1[3] = __uint_as_float(w.w & 0xffff0000u); }

struct EpiProj {
    static constexpr bool PERM = true, AFTER_DRAIN = false;
    bf16_t* QKV; bf16_t* G; const float* ROPE; float* KMP; float* FKN; float* FQN;
    __device__ __forceinline__ void operator()(const f32x4 (&acc)[2][2][4][2], const Unit& u, int wr, int wc, int fr, int fq) const {
        const int pn = u.pn, row0 = u.pm * BM + wr * 64 + fr;
        if (pn < 12) {
            const int typ = pn >> 1;
            const int slot = (typ == 0) ? 0 : (typ == 3) ? 1 : (typ < 3) ? typ + 1 : typ;
            bf16_t* base = QKV + (size_t)slot * ((size_t)16384 * 512);
            const int colt = (pn & 1) * 256, col0 = colt + wc * 32 + 8 * fq;
            const float sc = (typ == 0 || typ == 3) ? 0.18033688011112042f : 1.0f;
            const bool rope = (typ < 2) && ((wc & 1) == 0);
            const float sgn = (fq == 0) ? -1.f : 1.f; const bool rl = fq < 2;
            f32x4 ks[2][2];
#pragma unroll
            for (int bj = 0; bj < 2; ++bj) { ks[bj][0] = (f32x4){0.f, 0.f, 0.f, 0.f}; ks[bj][1] = (f32x4){0.f, 0.f, 0.f, 0.f}; }
            const bool nrm = (typ == 3 || typ == 4);
            float nmx[2][2] = {{0.f, 0.f}, {0.f, 0.f}};
#pragma unroll
            for (int ai = 0; ai < 2; ++ai)
#pragma unroll
                for (int m = 0; m < 4; ++m) {
                    const int row = row0 + ai * HALF + m * 16;
                    f32x4 c0 = (f32x4){1.f, 1.f, 1.f, 1.f}, c1 = c0, s0 = (f32x4){0.f, 0.f, 0.f, 0.f}, s1 = s0;
                    if (rope) { const f32x4* rp = (const f32x4*)(ROPE + (size_t)(row & 8191) * 16); c0 = rp[0]; c1 = rp[1]; s0 = rp[2]; s1 = rp[3]; }
#pragma unroll
                    for (int bj = 0; bj < 2; ++bj) {
                        f32x4 v0 = acc[ai][bj][m][0], v1 = acc[ai][bj][m][1];
                        if (rope) {
                            f32x4 p0, p1;
#pragma unroll
                            for (int e = 0; e < 4; ++e) { p0[e] = __shfl_xor(v0[e], 16); p1[e] = __shfl_xor(v1[e], 16); }
                            if (rl) { v0 = v0 * c0 + sgn * (p0 * s0); v1 = v1 * c1 + sgn * (p1 * s1); }
                        }
                        if (typ == 1) { ks[bj][0] += v0; ks[bj][1] += v1; }
                        v0 = v0 * sc; v1 = v1 * sc;
                        *(u32x4*)(base + (size_t)row * 512 + col0 + bj * HALF) = pack8(v0, v1);
                        if (nrm) { float ss = ((v0[0] * v0[0] + v0[1] * v0[1]) + (v0[2] * v0[2] + v0[3] * v0[3])) + ((v1[0] * v1[0] + v1[1] * v1[1]) + (v1[2] * v1[2] + v1[3] * v1[3]));
                            { const auto r_ = __builtin_amdgcn_permlane16_swap(__float_as_uint(ss), __float_as_uint(ss), false, false); ss = __uint_as_float(r_[0]) + __uint_as_float(r_[1]); }
                            { const auto r_ = __builtin_amdgcn_permlane32_swap(__float_as_uint(ss), __float_as_uint(ss), false, false); ss = __uint_as_float(r_[0]) + __uint_as_float(r_[1]); }
                            nmx[ai][bj] = fmaxf(nmx[ai][bj], ss); }
                    }
                }
            if (nrm) {
                const int b = u.pm >> 5, nb = u.pm & 31;
#pragma unroll
                for (int bj = 0; bj < 2; ++bj) { const int head = (colt + 128 * bj + 32 * wc) >> 6;
                    float a0 = nmx[0][bj], a1 = nmx[1][bj];
                    a0 = WM_DPP(a0, 0xB1); a0 = WM_DPP(a0, 0x4E); a0 = WM_DPP(a0, 0x141); a0 = WM_DPP(a0, 0x140); a1 = WM_DPP(a1, 0xB1); a1 = WM_DPP(a1, 0x4E); a1 = WM_DPP(a1, 0x141); a1 = WM_DPP(a1, 0x140);
                    if (fr == 0 && fq == 0) {
                        if (typ == 4) { float* d = FKN + ((size_t)(b * 8 + head) * 128 + 4 * nb + wr) * 2 + (wc & 1); d[0] = a0; d[4] = a1; }
                        else FQN[(((size_t)(b * 8 + head) * 32 + nb) * 2 + wr) * 2 + (wc & 1)] = fmaxf(a0, a1); } }
            }
            if (typ == 1) {
#pragma unroll
                for (int bj = 0; bj < 2; ++bj)
#pragma unroll
                    for (int n = 0; n < 2; ++n)
#pragma unroll
                        for (int e = 0; e < 4; ++e) { float v = ks[bj][n][e]; v = WS_DPP(v, 0xB1); v = WS_DPP(v, 0x4E); v = WS_DPP(v, 0x141); v = WS_DPP(v, 0x140); ks[bj][n][e] = v; }
                if (fr == 0) {
                    const int b = u.pm >> 5, nb = u.pm & 31;
#pragma unroll
                    for (int bj = 0; bj < 2; ++bj) { const int head = (colt + 128 * bj + 32 * wc) >> 6, d = 32 * (wc & 1) + 8 * fq;
                        float* dst = KMP + ((((size_t)wr * 16 + b * 8 + head) * 32 + nb) * 64 + d); *(f32x4*)dst = ks[bj][0]; *(f32x4*)(dst + 4) = ks[bj][1]; }
                }
            }
        } else {
            const int gi = pn - 12; bf16_t* base = G + (size_t)(gi >> 2) * ((size_t)16384 * 1024);
            const int col0 = (gi & 3) * 256 + wc * 32 + 8 * fq;
#pragma unroll
            for (int ai = 0; ai < 2; ++ai)
#pragma unroll
                for (int m = 0; m < 4; ++m) { const int row = row0 + ai * HALF + m * 16;
#pragma unroll
                    for (int bj = 0; bj < 2; ++bj) { f32x4 v0 = acc[ai][bj][m][0], v1 = acc[ai][bj][m][1];
#pragma unroll
                        for (int e = 0; e < 4; ++e) { v0[e] = __builtin_amdgcn_rcpf(1.f + __builtin_amdgcn_exp2f(-1.4426950408889634f * v0[e])); v1[e] = __builtin_amdgcn_rcpf(1.f + __builtin_amdgcn_exp2f(-1.4426950408889634f * v1[e])); }
                        *(u32x4*)(base + (size_t)row * 1024 + col0 + bj * HALF) = pack8(v0, v1); } }
        }
    }
};
struct EpiMerge {
    static constexpr bool PERM = true, AFTER_DRAIN = false;
    bf16_t* Mg; const bf16_t* Gt; bool first;
    __device__ __forceinline__ void operator()(const f32x4 (&acc)[2][2][4][2], const Unit& u, int wr, int wc, int fr, int fq) const {
        const int row0 = u.pm * BM + wr * 64 + fr, col0 = u.pn * BM + wc * 32 + 8 * fq;
#pragma unroll
        for (int ai = 0; ai < 2; ++ai)
#pragma unroll
            for (int m = 0; m < 4; ++m) { const size_t off = (size_t)(row0 + ai * HALF + m * 16) * 1024 + col0;
#pragma unroll
                for (int bj = 0; bj < 2; ++bj) { f32x4 g0, g1; unpack8(*(const u32x4*)(Gt + off + bj * HALF), g0, g1);
                    f32x4 v0 = g0 * acc[ai][bj][m][0], v1 = g1 * acc[ai][bj][m][1];
                    if (!first) { f32x4 o0, o1; unpack8(*(const u32x4*)(Mg + off + bj * HALF), o0, o1); v0 += o0; v1 += o1; }
                    *(u32x4*)(Mg + off + bj * HALF) = pack8(v0, v1); } }
    }
};
struct EpiOut {
    static constexpr bool PERM = true, AFTER_DRAIN = false;
    const float* X; float* O; bf16_t* Hb; float* RSSP;
    __device__ __forceinline__ void operator()(const f32x4 (&acc)[2][2][4][2], const Unit& u, int wr, int wc, int fr, int fq) const {
        const int row0 = u.pm * BM + wr * 64 + fr, col0 = u.pn * BM + wc * 32 + 8 * fq;
#pragma unroll
        for (int ai = 0; ai < 2; ++ai)
#pragma unroll
            for (int m = 0; m < 4; ++m) { const int row = row0 + ai * HALF + m * 16; const size_t off = (size_t)row * 1024 + col0; float ss = 0.f;
#pragma unroll
                for (int bj = 0; bj < 2; ++bj) { const f32x4 x0 = *(const f32x4*)(X + off + bj * HALF), x1 = *(const f32x4*)(X + off + bj * HALF + 4);
                    const f32x4 h0 = x0 + acc[ai][bj][m][0], h1 = x1 + acc[ai][bj][m][1];
                    *(u32x4*)(Hb + off + bj * HALF) = pack8(h0, h1);
                    ss += (h0[0] * h0[0] + h0[1] * h0[1]) + (h0[2] * h0[2] + h0[3] * h0[3]) + (h1[0] * h1[0] + h1[1] * h1[1]) + (h1[2] * h1[2] + h1[3] * h1[3]); }
                ss += __shfl_xor(ss, 16); ss += __shfl_xor(ss, 32);
                if (fq == 0) RSSP[(size_t)row * 16 + u.pn * 4 + wc] = ss; }
    }
};
struct EpiStore {
    static constexpr bool PERM = true, AFTER_DRAIN = false;
    bf16_t* O; int ldc;
    __device__ __forceinline__ void operator()(const f32x4 (&acc)[2][2][4][2], const Unit& u, int wr, int wc, int fr, int fq) const {
        const int row0 = u.pm * BM + wr * 64 + fr, col0 = u.pn * BM + wc * 32 + 8 * fq;
#pragma unroll
        for (int ai = 0; ai < 2; ++ai)
#pragma unroll
            for (int m = 0; m < 4; ++m)
#pragma unroll
                for (int bj = 0; bj < 2; ++bj) *(u32x4*)(O + (size_t)(row0 + ai * HALF + m * 16) * ldc + col0 + bj * HALF) = pack8(acc[ai][bj][m][0], acc[ai][bj][m][1]);
    }
};

template <class Epi, class Sched, bool ALIGN_EPI = false, bool SP2 = false, bool F8 = false>
__device__ __forceinline__ void gemm_phase(PG8_LAS unsigned char* lds, const Gemm g, const Sched& S, const Epi& E) {
    const int tid = otid(), wid = __builtin_amdgcn_readfirstlane(tid >> 6), lane = tid & 63, wr = wid >> 2, wc = wid & 3, fr = lane & 15, fq = lane >> 4;
    int K_ = g.K; if constexpr (F8) asm volatile("" : "+s"(K_));
    const int K = K_, nt = K / BK;
    unsigned voffA[2], voffB[2];
#pragma unroll
    for (int i = 0; i < 2; ++i) { int R, C; stage_rc(tid * 16 + i * 8192, R, C); const int Rb = Epi::PERM ? ((R & ~31) + perm32(R & 31)) : R;
        voffA[i] = (unsigned)(R * K + C) * 2u; voffB[i] = (unsigned)(Rb * K + C) * 2u; }
    const size_t kstep = (size_t)(BK * 2);
    const size_t hstep = (size_t)HALF * K * 2;
    const size_t tstep = 2 * hstep;
    const unsigned ldsw = (unsigned)wid * 1024u;
    const int aoff = lds_byte(wr * 64 + fr, fq * 8), boff = lds_byte(wc * 32 + fr, fq * 8);
#define PG8_SA(b, h) (((b) * 2 + (h)) * HTB)
#define PG8_SB(b, h) ((4 + (b) * 2 + (h)) * HTB)
#define PG8_STAGE(bufoff, gbase, voff) do { _Pragma("unroll") for (int _i = 0; _i < 2; ++_i) \
        __builtin_amdgcn_global_load_lds((const unsigned*)((const char*)(gbase) + (voff)[_i]), (PG8_LAS unsigned*)(lds + (bufoff) + ldsw + _i * 8192), 16, 0, 0); } while (0)
#define PG8_LDA(dst, b, h) do { _Pragma("unroll") for (int m = 0; m < 4; ++m) { \
        if constexpr (F8) dst##8[m] = __builtin_shufflevector(*(const PG8_LAS i32x4*)(lds + PG8_SA(b, h) + aoff + m * 2048), *(const PG8_LAS i32x4*)(lds + PG8_SA(b, h) + aoff + m * 2048 + 1024), 0, 1, 2, 3, 4, 5, 6, 7); \
        else { _Pragma("unroll") for (int k = 0; k < 2; ++k) dst[m][k] = *(const PG8_LAS bf16x8*)(lds + PG8_SA(b, h) + aoff + m * 2048 + k * 1024); } } } while (0)
#define PG8_LDB(dst, b, h) do { _Pragma("unroll") for (int n = 0; n < 2; ++n) { \
        if constexpr (F8) dst##8[n] = __builtin_shufflevector(*(const PG8_LAS i32x4*)(lds + PG8_SB(b, h) + boff + n * 2048), *(const PG8_LAS i32x4*)(lds + PG8_SB(b, h) + boff + n * 2048 + 1024), 0, 1, 2, 3, 4, 5, 6, 7); \
        else { _Pragma("unroll") for (int k = 0; k < 2; ++k) dst[n][k] = *(const PG8_LAS bf16x8*)(lds + PG8_SB(b, h) + boff + n * 2048 + k * 1024); } } } while (0)
#define PG8_MMA(ai, bj, At, Bt) do { __builtin_amdgcn_s_setprio(1); _Pragma("unroll") for (int m = 0; m < 4; ++m) _Pragma("unroll") for (int n = 0; n < 2; ++n) { \
        if constexpr (F8) asm volatile("v_mfma_scale_f32_16x16x128_f8f6f4 %0, %1, %2, %0, %3, %4 op_sel_hi:[0,0,0]" : "+v"(acc[ai][bj][m][n]) : "v"(Bt##8[n]), "v"(At##8[m]), "v"(f8sb), "v"(f8sa)); \
        else { _Pragma("unroll") for (int k = 0; k < 2; ++k) acc[ai][bj][m][n] = __builtin_amdgcn_mfma_f32_16x16x32_bf16(Bt[n][k], At[m][k], acc[ai][bj][m][n], 0, 0, 0); } } \
        __builtin_amdgcn_s_setprio(0); } while (0)
#define PG8_WAIT_V(n) asm volatile("s_waitcnt vmcnt(" #n ")" ::: "memory")
#define PG8_WAIT_L(n) asm volatile("s_waitcnt lgkmcnt(" #n ")" ::: "memory")
#define PG8_BAR __builtin_amdgcn_s_barrier()
#define PG8_SCHED __builtin_amdgcn_sched_barrier(0)
    Unit cur, nxt; int ui = 0;
    if (!S.next(0, cur)) return;
    f32x4 acc[2][2][4][2];
#pragma unroll
    for (int a = 0; a < 2; ++a)
#pragma unroll
        for (int b = 0; b < 2; ++b)
#pragma unroll
            for (int m = 0; m < 4; ++m)
#pragma unroll
                for (int n = 0; n < 2; ++n) acc[a][b][m][n] = (f32x4){0.f, 0.f, 0.f, 0.f};
    bf16x8 At[4][2], B0[2][2], B1[2][2]; i32x8 At8[4], B08[2], B18[2];
    const int f8sb = 0x79797979, f8sa = 0x7d7d7d7d;
    const char* cA = (const char*)g.A + (size_t)cur.pm * tstep; const char* cB = (const char*)g.Bt + (size_t)cur.pn * tstep;
    S.a_ready(cur);
    if constexpr (SP2) {
        PG8_STAGE(PG8_SB(0, 0), cB, voffB); PG8_STAGE(PG8_SB(0, 1), cB + hstep, voffB); PG8_STAGE(PG8_SA(0, 0), cA, voffA); PG8_STAGE(PG8_SA(0, 1), cA + hstep, voffA);
        if (wr == 1) PG8_BAR;
        PG8_WAIT_V(2); PG8_BAR;
        PG8_STAGE(PG8_SB(1, 0), cB + kstep, voffB); PG8_STAGE(PG8_SA(1, 0), cA + kstep, voffA); PG8_STAGE(PG8_SB(1, 1), cB + hstep + kstep, voffB);
        PG8_WAIT_V(6); PG8_BAR;
    } else {
        PG8_STAGE(PG8_SB(0, 0), cB, voffB); PG8_STAGE(PG8_SA(0, 0), cA, voffA); PG8_STAGE(PG8_SB(0, 1), cB + hstep, voffB); PG8_STAGE(PG8_SA(0, 1), cA + hstep, voffA);
        if (wr == 1) PG8_BAR;
        PG8_WAIT_V(4); PG8_BAR;
        PG8_STAGE(PG8_SB(1, 0), cB + kstep, voffB); PG8_STAGE(PG8_SA(1, 0), cA + kstep, voffA); PG8_STAGE(PG8_SB(1, 1), cB + hstep + kstep, voffB);
        PG8_WAIT_V(6); PG8_BAR;
    }
    for (;;) {
        const bool has_next = S.next(ui + 1, nxt);
        const char* nA = has_next ? (const char*)g.A + (size_t)nxt.pm * tstep : cA; const char* nB = has_next ? (const char*)g.Bt + (size_t)nxt.pn * tstep : cB;
        for (int t = 0; t < nt; t += 2) {
            const bool last = (t == nt - 2);
            const char* a1 = cA + (size_t)(t + 1) * kstep;
            const char* a2 = last ? nA : cA + (size_t)(t + 2) * kstep; const char* b2 = last ? nB : cB + (size_t)(t + 2) * kstep;
            const char* a3 = a2 + kstep; const char* b3 = b2 + kstep;
            if (last && has_next) S.a_ready(nxt);
            if constexpr (SP2) {
            PG8_LDB(B0, 0, 0); PG8_LDB(B1, 0, 1); PG8_SCHED; PG8_LDA(At, 0, 0); PG8_STAGE(PG8_SA(1, 1), a1 + hstep, voffA);
            PG8_WAIT_V(8); PG8_WAIT_L(0); PG8_BAR; PG8_MMA(0, 0, At, B0); PG8_MMA(0, 1, At, B1); PG8_BAR; PG8_SCHED;
            PG8_LDA(At, 0, 1); PG8_STAGE(PG8_SB(0, 0), b2, voffB); PG8_STAGE(PG8_SB(0, 1), b2 + hstep, voffB); PG8_STAGE(PG8_SA(0, 0), a2, voffA);
            PG8_WAIT_V(8); PG8_WAIT_L(0); PG8_BAR; PG8_MMA(1, 0, At, B0); PG8_MMA(1, 1, At, B1); PG8_BAR; PG8_SCHED;
            PG8_LDB(B0, 1, 0); PG8_LDB(B1, 1, 1); PG8_SCHED; PG8_LDA(At, 1, 0); PG8_STAGE(PG8_SA(0, 1), a2 + hstep, voffA);
            PG8_WAIT_V(8); PG8_WAIT_L(0); PG8_BAR; PG8_MMA(0, 0, At, B0); PG8_MMA(0, 1, At, B1); PG8_BAR; PG8_SCHED;
            PG8_LDA(At, 1, 1); PG8_STAGE(PG8_SB(1, 0), b3, voffB); PG8_STAGE(PG8_SB(1, 1), b3 + hstep, voffB); PG8_STAGE(PG8_SA(1, 0), a3, voffA);
            PG8_WAIT_V(8); PG8_WAIT_L(0); PG8_BAR; PG8_MMA(1, 0, At, B0); PG8_MMA(1, 1, At, B1); PG8_BAR; PG8_SCHED;
            } else {
            PG8_LDB(B0, 0, 0); PG8_SCHED; PG8_LDA(At, 0, 0); PG8_STAGE(PG8_SA(1, 1), a1 + hstep, voffA);
            PG8_WAIT_L(8); PG8_BAR; PG8_WAIT_L(0); PG8_MMA(0, 0, At, B0); PG8_BAR; PG8_SCHED;
            PG8_LDB(B1, 0, 1); PG8_STAGE(PG8_SB(0, 0), b2, voffB);
            PG8_BAR; PG8_WAIT_L(0); PG8_MMA(0, 1, At, B1); PG8_BAR;
            PG8_LDA(At, 0, 1); PG8_STAGE(PG8_SA(0, 0), a2, voffA);
            PG8_BAR; PG8_WAIT_L(0); PG8_MMA(1, 0, At, B0); PG8_BAR; PG8_SCHED;
            PG8_STAGE(PG8_SB(0, 1), b2 + hstep, voffB);
            PG8_WAIT_V(6); PG8_BAR; PG8_MMA(1, 1, At, B1); PG8_BAR;
            PG8_LDB(B0, 1, 0); PG8_SCHED; PG8_LDA(At, 1, 0); PG8_STAGE(PG8_SA(0, 1), a2 + hstep, voffA);
            PG8_WAIT_L(8); PG8_BAR; PG8_WAIT_L(0); PG8_MMA(0, 0, At, B0); PG8_BAR; PG8_SCHED;
            PG8_LDB(B1, 1, 1); PG8_STAGE(PG8_SB(1, 0), b3, voffB);
            PG8_BAR; PG8_WAIT_L(0); PG8_MMA(0, 1, At, B1); PG8_BAR;
            PG8_LDA(At, 1, 1); PG8_STAGE(PG8_SA(1, 0), a3, voffA);
            PG8_BAR; PG8_WAIT_L(0); PG8_MMA(1, 0, At, B0); PG8_BAR; PG8_SCHED;
            PG8_STAGE(PG8_SB(1, 1), b3 + hstep, voffB);
            PG8_WAIT_V(6); PG8_BAR; PG8_MMA(1, 1, At, B1); PG8_BAR;
            }
        }
        if constexpr (ALIGN_EPI) { if (wr == 0) PG8_BAR; }
        if constexpr (F8) {
            asm volatile("s_nop 15\n\ts_nop 15" ::: "memory");
#pragma unroll
            for (int a_ = 0; a_ < 2; ++a_)
#pragma unroll
                for (int b_ = 0; b_ < 2; ++b_)
                    asm volatile("" : "+v"(acc[a_][b_][0][0]), "+v"(acc[a_][b_][0][1]), "+v"(acc[a_][b_][1][0]), "+v"(acc[a_][b_][1][1]), "+v"(acc[a_][b_][2][0]), "+v"(acc[a_][b_][2][1]), "+v"(acc[a_][b_][3][0]), "+v"(acc[a_][b_][3][1])); }
        if constexpr (!Epi::AFTER_DRAIN) { E(acc, cur, wr, wc, fr, fq); S.done(cur); }
        if (!has_next) break;
#pragma unroll
        for (int a = 0; a < 2; ++a)
#pragma unroll
            for (int b = 0; b < 2; ++b)
#pragma unroll
                for (int m = 0; m < 4; ++m)
#pragma unroll
                    for (int n = 0; n < 2; ++n) acc[a][b][m][n] = (f32x4){0.f, 0.f, 0.f, 0.f};
        cur = nxt; cA = nA; cB = nB; ++ui;
        if constexpr (ALIGN_EPI) { if (wr == 1) PG8_BAR; }
    }
    PG8_WAIT_V(0);
    if constexpr (!ALIGN_EPI) { if (wr == 0) PG8_BAR; }
    PG8_BAR;
    if constexpr (Epi::AFTER_DRAIN) { E.fused(acc, cur, wr, wc, fr, fq, lds, wid, lane); S.done(cur); }
#undef PG8_SA
#undef PG8_SB
#undef PG8_STAGE
#undef PG8_LDA
#undef PG8_LDB
#undef PG8_MMA
#undef PG8_WAIT_V
#undef PG8_WAIT_L
#undef PG8_BAR
#undef PG8_SCHED
}
}


__device__ __forceinline__ float log_sigmoid(float z) { return z >= 0.f ? -log1pf(expf(-z)) : z - log1pf(expf(z)); }
constexpr float XN8_SCALE = 4.0f, WIN8_SCALE = 64.0f;
__device__ __forceinline__ unsigned pk4_fp8(float a, float b, float c, float d) { int w = __builtin_amdgcn_cvt_pk_fp8_f32(a, b, 0, false); w = __builtin_amdgcn_cvt_pk_fp8_f32(c, d, w, true); return (unsigned)w; }
__device__ __forceinline__ void p0_transpose_item8(const float* W, int ldw, int K, int ncols, unsigned char* WT, int row_off, LAS float* scr, int item, int lane, float scale) {
    const int nblk = ncols / 32, kb = item / nblk, nb = item % nblk, k0 = 64 * kb, n0 = 32 * nb;
#pragma unroll 8
    for (int i = 0; i < 32; ++i) { const int kk = 2 * i + (lane >> 5); scr[kk * 33 + (lane & 31)] = W[(size_t)(k0 + kk) * ldw + n0 + (lane & 31)] * scale; }
    asm volatile("s_waitcnt lgkmcnt(0)" ::: "memory");
    const int c = lane & 7;
#pragma unroll
    for (int j = 0; j < 4; ++j) { const int n = (lane >> 3) + 8 * j; const LAS float* s = scr + (8 * c) * 33 + n;
        u32x2 o; o.x = pk4_fp8(s[0 * 33], s[1 * 33], s[2 * 33], s[3 * 33]); o.y = pk4_fp8(s[4 * 33], s[5 * 33], s[6 * 33], s[7 * 33]);
        *(u32x2*)(WT + (size_t)(row_off + n0 + n) * K + k0 + 8 * c) = o; }
    asm volatile("s_waitcnt lgkmcnt(0)" ::: "memory");
}
__device__ __forceinline__ void p0_transpose_item(const float* W, int ldw, int K, int ncols, bf16_t* WT, int row_off, LAS float* scr, int item, int lane, const float* ksc = nullptr) {
    const int nblk = ncols / 32, kb = item / nblk, nb = item % nblk, k0 = 64 * kb, n0 = 32 * nb;
#pragma unroll 8
    for (int i = 0; i < 32; ++i) { const int kk = 2 * i + (lane >> 5); scr[kk * 33 + (lane & 31)] = W[(size_t)(k0 + kk) * ldw + n0 + (lane & 31)] * (ksc ? ksc[k0 + kk] : 1.0f); }
    asm volatile("s_waitcnt lgkmcnt(0)" ::: "memory");
    const int c = lane & 7;
#pragma unroll
    for (int j = 0; j < 4; ++j) { const int n = (lane >> 3) + 8 * j; const LAS float* s = scr + (8 * c) * 33 + n;
        u32x4 o; o.x = pk2(s[0 * 33], s[1 * 33]); o.y = pk2(s[2 * 33], s[3 * 33]); o.z = pk2(s[4 * 33], s[5 * 33]); o.w = pk2(s[6 * 33], s[7 * 33]);
        *(u32x4*)(WT + (size_t)(row_off + n0 + n) * K + k0 + 8 * c) = o; }
    asm volatile("s_waitcnt lgkmcnt(0)" ::: "memory");
}
__device__ __forceinline__ void phase_prologue(LAS unsigned char* ldsb, const P& p) {
    const int TID = otid();
    const int lane = TID & 63, wave = TID >> 6, gw = blockIdx.x * 8 + wave, nw = gridDim.x * 8;
    LAS float* scr = (LAS float*)(ldsb + wave * 16384);
    constexpr int I1 = 16 * 96, I2 = 16 * 64, IA = 8 * 32, IO = 16 * 32, IQ = 16 * 64;
    for (int it = gw; it < I1 + I2 + 2 * IA + IO + IQ; it += nw) {
        int r = it;
        if (r < I1) { p0_transpose_item8(p.w_in, INC, D, 3072, p.ws + WS_WIN, 0, scr, r, lane, WIN8_SCALE); continue; } r -= I1;
        if (r < I2) { p0_transpose_item8(p.w_in + 3080, INC, D, 2048, p.ws + WS_WIN, 3072, scr, r, lane, WIN8_SCALE); continue; } r -= I2;
        if (r < IA) { p0_transpose_item(p.w_a, D, 512, 1024, (bf16_t*)(p.ws + WS_WA), 0, scr, r, lane); continue; } r -= IA;
        if (r < IA) { p0_transpose_item(p.w_b, D, 512, 1024, (bf16_t*)(p.ws + WS_WB), 0, scr, r, lane); continue; } r -= IA;
        if (r < IO) { p0_transpose_item(p.w_out, D, D, 1024, (bf16_t*)(p.ws + WS_WOUT), 0, scr, r, lane); continue; } r -= IO;
        p0_transpose_item(p.w_pq, PQC, D, 2048, (bf16_t*)(p.ws + WS_WPQ), 0, scr, r, lane, p.g_ffn);
    }
    { u32x4* SKo = (u32x4*)(p.ws + WS_SK);
      for (int c = blockIdx.x * 512 + TID; c < PH * 2 * PNK * PHALF / 8; c += gridDim.x * 512) { const f32x4 a0 = *(const f32x4*)(p.sk + (size_t)c * 8), a1 = *(const f32x4*)(p.sk + (size_t)c * 8 + 4);
          u32x4 o; o.x = pk2(a0.x, a0.y); o.y = pk2(a0.z, a0.w); o.z = pk2(a1.x, a1.y); o.w = pk2(a1.z, a1.w); SKo[c] = o; } }
    { float* ROPE = (float*)(p.ws + WS_ROPE);
      for (int it = blockIdx.x * 512 + TID; it < S * 8; it += gridDim.x * 512) { const int i = it & 7, pos = it >> 3;
          const float inv_freq = powf(500000.0f, -(float)i / 8.0f); const float ang = (float)pos * inv_freq;
          ROPE[pos * 16 + i] = cosf(ang); ROPE[pos * 16 + 8 + i] = sinf(ang); } }
    __syncthreads();
    { LAS float* WFt = (LAS float*)ldsb;
      for (int i = TID; i < 2 * D; i += 512) { const int col = i >> 1, half = i & 1; const f32x4 w = *(const f32x4*)(p.w_in + (size_t)col * INC + 3072 + 4 * half);
          WFt[(4 * half + 0) * D + col] = w.x; WFt[(4 * half + 1) * D + col] = w.y; WFt[(4 * half + 2) * D + col] = w.z; WFt[(4 * half + 3) * D + col] = w.w; } }
    __syncthreads();
    bf16_t* XN = (bf16_t*)(p.ws + WS_XN); float* LOGF = (float*)(p.ws + WS_LOGF); const LAS float* WFt = (const LAS float*)ldsb;
    float wsum = 0.f;
    const int fo = 4 * (lane & 1) + 2 * ((lane >> 1) & 1) + ((lane >> 2) & 1);
    const float bfo = p.b_f[fo];
#define PRO_X(x, ctrl) __builtin_bit_cast(float, __builtin_amdgcn_update_dpp(0, __builtin_bit_cast(int, (x)), (ctrl), 0xf, 0xf, true))
#pragma unroll 1
    for (int rh = 0; rh < 8; rh += 4) {
    f32x4 xv[4][4];
#pragma unroll
    for (int r8 = 0; r8 < 4; ++r8)
#pragma unroll
        for (int j = 0; j < 4; ++j) xv[r8][j] = ((const f32x4*)(p.x + (size_t)(gw * 8 + rh + r8) * D))[lane + 64 * j];
#pragma unroll
    for (int r8 = 0; r8 < 4; ++r8) {
        const int row = gw * 8 + rh + r8;
        f32x4 v[4]; float ss = 0.f;
#pragma unroll
        for (int j = 0; j < 4; ++j) { v[j] = xv[r8][j]; ss += v[j].x * v[j].x + v[j].y * v[j].y + v[j].z * v[j].z + v[j].w * v[j].w; }
        ss = wave_sum_fast(ss);
        const float rstd = rsqrtf(ss * (1.f / D) + EPS);
        float fs[8];
#pragma unroll
        for (int f = 0; f < 8; ++f) fs[f] = 0.f;
#pragma unroll
        for (int j = 0; j < 4; ++j) {
            const f32x4 g = ((const f32x4*)p.g_mix)[lane + 64 * j];
            v[j].x *= rstd * g.x; v[j].y *= rstd * g.y; v[j].z *= rstd * g.z; v[j].w *= rstd * g.w;
            *(unsigned*)((unsigned char*)XN + (size_t)row * D + 4 * (lane + 64 * j)) = pk4_fp8(v[j].x * XN8_SCALE, v[j].y * XN8_SCALE, v[j].z * XN8_SCALE, v[j].w * XN8_SCALE);
#pragma unroll
            for (int f = 0; f < 8; ++f) { const f32x4 w = *(const LAS f32x4*)(WFt + f * D + 4 * (lane + 64 * j)); fs[f] += (v[j].x * w.x + v[j].y * w.y) + (v[j].z * w.z + v[j].w * w.w); }
        }
        float h4[4], g2[2];
#pragma unroll
        for (int i = 0; i < 4; ++i) { const float a = fs[i] + PRO_X(fs[i], 0xB1), b = fs[i + 4] + PRO_X(fs[i + 4], 0xB1); h4[i] = (lane & 1) ? b : a; }
#pragma unroll
        for (int i = 0; i < 2; ++i) { const float a = h4[i] + PRO_X(h4[i], 0x4E), b = h4[i + 2] + PRO_X(h4[i + 2], 0x4E); g2[i] = (lane & 2) ? b : a; }
        float z;
        { const float a = g2[0] + __builtin_bit_cast(float, __builtin_amdgcn_ds_bpermute((lane ^ 4) << 2, __builtin_bit_cast(int, g2[0]))), b = g2[1] + __builtin_bit_cast(float, __builtin_amdgcn_ds_bpermute((lane ^ 4) << 2, __builtin_bit_cast(int, g2[1]))); z = (lane & 4) ? b : a; }
        z = sum_x8(z); z = sum_x16(z); z = sum_x32(z);
        if (lane < 8) { const float lf = log_sigmoid(z + bfo); LOGF[(size_t)row * 8 + fo] = lf; wsum += lf; }
    }
    }
#undef PRO_X
    if (lane < 8) ((float*)(p.ws + WS_WSUM))[gw * 8 + fo] = wsum;
}

__device__ __forceinline__ void phase_cumsum(const P& p) {
    const int TID = otid();
    const int lane = TID & 63, gw = blockIdx.x * 8 + (TID >> 6), b = gw >> 10, w0 = b << 10, h = lane & 7, j = lane >> 3;
    const float* WSUM = (const float*)(p.ws + WS_WSUM); const float* LOGF = (const float*)(p.ws + WS_LOGF); float* C = (float*)(p.ws + WS_C);
    float part = 0.f;
    { float p1 = 0.f, p2 = 0.f, p3 = 0.f; int w = w0 + j;
      for (; w + 24 < gw; w += 32) { part += WSUM[w * 8 + h]; p1 += WSUM[(w + 8) * 8 + h]; p2 += WSUM[(w + 16) * 8 + h]; p3 += WSUM[(w + 24) * 8 + h]; }
      for (; w < gw; w += 8) part += WSUM[w * 8 + h];
      part = (part + p1) + (p2 + p3); }
    part += __shfl_xor(part, 8); part += __shfl_xor(part, 16); part += __shfl_xor(part, 32);
    if (lane < 8) { float run = part;
#pragma unroll
        for (int r = 0; r < 8; ++r) { const int row = gw * 8 + r; run += LOGF[(size_t)row * 8 + h]; C[(size_t)(b * 8 + h) * S + (row & (S - 1))] = run * LOG2E; } }
}

#include <hip/hip_bf16.h>
namespace attn {
using bf16=__hip_bfloat16;
using bf16x8=__attribute__((ext_vector_type(8)))short;
using s16x4=__attribute__((ext_vector_type(4)))short;
using f32x16=__attribute__((ext_vector_type(16)))float;
using f32x4=__attribute__((ext_vector_type(4)))float;
using u32x4=__attribute__((ext_vector_type(4)))unsigned;
constexpr int SEQ=8192,D=64,DM=512;
constexpr int NW=8,QBLK=32,QB=QBLK*NW,KVBLK=64;
__device__ __forceinline__ int crow(int r,int hi){return (r&3)+8*(r>>2)+4*hi;}
#define SBAR() __builtin_amdgcn_sched_barrier(0)
__device__ __forceinline__ void cmask(f32x16&p0,f32x16&p1,int jb,int qrel,int hi){
  const float NEG=-INFINITY; int kb=64*jb+4*hi;
  #pragma unroll
  for(int r=0;r<16;++r){int kv=kb+(r&3)+8*(r>>2); if(kv>qrel)p0[r]=NEG; if(kv+32>qrel)p1[r]=NEG;}
}
constexpr int KSUM_P1=16*32*64;
constexpr int NSLOT=3, SLOTB=8192;
constexpr int LDS_K=0, LDS_V=NSLOT*SLOTB, LDS_WS=2*NSLOT*SLOTB, LDS_OST=LDS_WS+NW*64*4, LDS_CK=LDS_OST+NW*4096, LDS_BYTES=LDS_CK+SEQ*4;
__device__ __forceinline__ void glds16(const void*gsrc,unsigned lds_dst){unsigned keep;
  asm volatile("s_mov_b32 %0, m0\n\ts_mov_b32 m0, %2\n\ts_nop 0\n\tglobal_load_lds_dwordx4 %1, off\n\ts_mov_b32 m0, %0":"=&s"(keep):"v"(gsrc),"s"(lds_dst):"memory");}
typedef float f32x2_t __attribute__((ext_vector_type(2))); typedef __bf16 bf16x2_t __attribute__((ext_vector_type(2)));
__device__ __forceinline__ unsigned cvtpk_s(float lo,float hi){f32x2_t v={lo,hi};bf16x2_t b=__builtin_convertvector(v,bf16x2_t);return __builtin_bit_cast(unsigned,b);}
#define WAIT_BAR(N) asm volatile("s_waitcnt vmcnt(" #N ") lgkmcnt(0)\n\ts_barrier":::"memory")
typedef __attribute__((address_space(3))) const char* lds_cptr;
typedef short v4i16_t __attribute__((ext_vector_type(4)));
__device__ __forceinline__ void kload8(bf16x8*kf,lds_cptr kp){
  kf[0]=*(const __attribute__((address_space(3))) bf16x8*)(kp);      kf[1]=*(const __attribute__((address_space(3))) bf16x8*)(kp+512);
  kf[2]=*(const __attribute__((address_space(3))) bf16x8*)(kp+2048); kf[3]=*(const __attribute__((address_space(3))) bf16x8*)(kp+2560);
  kf[4]=*(const __attribute__((address_space(3))) bf16x8*)(kp+4096); kf[5]=*(const __attribute__((address_space(3))) bf16x8*)(kp+4608);
  kf[6]=*(const __attribute__((address_space(3))) bf16x8*)(kp+6144); kf[7]=*(const __attribute__((address_space(3))) bf16x8*)(kp+6656);
}
__device__ __forceinline__ void kload2(bf16x8*kf,lds_cptr kp,int j){ kf[2*j]=*(const __attribute__((address_space(3))) bf16x8*)(kp+j*2048); kf[2*j+1]=*(const __attribute__((address_space(3))) bf16x8*)(kp+j*2048+512); }
__device__ __forceinline__ s16x4 vtr(lds_cptr p){ return __builtin_bit_cast(s16x4,__builtin_amdgcn_ds_read_tr16_b64_v4i16((__attribute__((address_space(3))) v4i16_t*)p)); }
template<bool FOX> __device__ __forceinline__ void cinit(f32x16&C,const __attribute__((address_space(3))) float*ckt,float bs){
  if constexpr(FOX){
    #pragma unroll
    for(int g=0;g<4;++g){ const f32x4 kb=*(const __attribute__((address_space(3))) f32x4*)(ckt+8*g); C[4*g]=bs-kb[0]; C[4*g+1]=bs-kb[1]; C[4*g+2]=bs-kb[2]; C[4*g+3]=bs-kb[3]; }
  } else {
    #pragma unroll
    for(int r=0;r<16;++r)C[r]=bs;
  }
  asm volatile("":"+v"(C));
}
__device__ __forceinline__ void pv(f32x16*o,int vb,bf16x8 pa0,bf16x8 pa1,bf16x8 pa2,bf16x8 pa3){
  #pragma unroll
  for(int d0=0;d0<2;++d0){s16x4 lo[4],hi[4];
    #pragma unroll
    for(int ks=0;ks<4;++ks){
      asm volatile("ds_read_b64_tr_b16 %0,%1 offset:%c2":"=&v"(lo[ks]):"v"(vb),"i"(d0*4096+ks*1024):"memory");
      asm volatile("ds_read_b64_tr_b16 %0,%1 offset:%c2":"=&v"(hi[ks]):"v"(vb),"i"(d0*4096+ks*1024+512):"memory");}
    asm volatile("s_waitcnt lgkmcnt(0)":::"memory");SBAR();
    #define PK(k) (bf16x8){lo[k][0],lo[k][1],lo[k][2],lo[k][3],hi[k][0],hi[k][1],hi[k][2],hi[k][3]}
    o[d0]=__builtin_amdgcn_mfma_f32_32x32x16_bf16(pa0,PK(0),o[d0],0,0,0);
    o[d0]=__builtin_amdgcn_mfma_f32_32x32x16_bf16(pa1,PK(1),o[d0],0,0,0);
    o[d0]=__builtin_amdgcn_mfma_f32_32x32x16_bf16(pa2,PK(2),o[d0],0,0,0);
    o[d0]=__builtin_amdgcn_mfma_f32_32x32x16_bf16(pa3,PK(3),o[d0],0,0,0);
    #undef PK
  }
}
#define ATTN_STORE16(p,v) (*(u32x4*)(p)=(v))
struct MobaIo { const unsigned short* QL; int qcnt, jblk; const unsigned* SEL3; bf16* PART0; bf16* PART1; bf16* PART2; float* LSE; };
template<bool FOX,int THRL,int VAR> __device__ __forceinline__ void attn_unit(int b,int h,int qb,int t0,const bf16*Q,const bf16*__restrict__ K,const bf16*__restrict__ V,bf16*O,const float*CK2,const MobaIo&mio,char*shm){
  const int tid=otid(),lane=tid&63,r32=lane&31,hi=lane>>5; const int wid=__builtin_amdgcn_readfirstlane(tid>>6);
  const long rowbase=(long)b*SEQ; const int q0=qb*QB;
  int qidx=q0+wid*QBLK+r32; bool qvalid=true;
  if constexpr(VAR==2){ const int li=wid*QBLK+r32; qvalid=li<mio.qcnt; qidx=(int)mio.QL[qvalid?li:mio.qcnt-1]; }
  const bf16*Qrow=Q+(rowbase+qidx)*DM+h*D;
  const bf16*Kh=K+(rowbase+(long)t0*KVBLK)*DM+h*D,*Vh=V+(rowbase+(long)t0*KVBLK)*DM+h*D;
  const unsigned lds0=(unsigned)(uintptr_t)shm;
  float*wsf=(float*)(shm+LDS_WS)+wid*64;
  const bf16*ksrc=Kh+(long)lane*DM+wid*8;
  const bf16*vsrc=Vh+(long)(16*(wid&3)+(lane>>2))*DM+(wid>>2)*32+(lane&3)*8;
  const unsigned kdst=lds0+LDS_K+wid*1024, vdst=lds0+LDS_V+wid*1024;
  #define DMA_K(t,slot) glds16(ksrc+(long)(t)*KVBLK*DM,(unsigned)__builtin_amdgcn_readfirstlane(kdst+(slot)))
  #define DMA_V(t,slot) glds16(vsrc+(long)(t)*KVBLK*DM,(unsigned)__builtin_amdgcn_readfirstlane(vdst+(slot)))
  const int vb0=(int)(lds0+LDS_V)+((lane>>4)&1)*32+(lane&3)*8+(4*hi+((lane&15)>>2))*64;
  bf16x8 kf[8];
  const lds_cptr shm3=(lds_cptr)shm; const lds_cptr kp0=shm3+LDS_K+hi*1024+r32*16; const lds_cptr vp0=shm3+LDS_V+((lane>>4)&1)*32+(lane&3)*8+(4*hi+((lane&15)>>2))*64;
  const __attribute__((address_space(3))) float*ckl=(const __attribute__((address_space(3))) float*)(shm3+LDS_CK)+4*hi;
  const int NT=(VAR==2)?4:(q0+QB)/KVBLK-t0;
  DMA_K(0,0);DMA_V(0,0);DMA_K(1,SLOTB);
  bf16x8 qr[4];
  #pragma unroll
  for(int d0=0;d0<4;++d0)qr[d0]=*reinterpret_cast<const bf16x8*>(&Qrow[d0*16+hi*8]);
  float cq2=0.f;
  if constexpr(FOX){ __attribute__((address_space(3))) f32x4*ck4=(__attribute__((address_space(3))) f32x4*)(shm3+LDS_CK); const f32x4*g4=(const f32x4*)CK2+t0*16;
    for(int i=tid;i<NT*16;i+=NW*64)ck4[i]=g4[i];
    cq2=CK2[q0+wid*QBLK+r32]; }
  float mhat=0.f,l_reg=0.f;f32x16 o[2];o[0]=f32x16{};o[1]=f32x16{};
  const int qrel=wid*QBLK+r32;
  #define CMASK(P0,P1,t) do{ if constexpr(VAR!=2){ int jb_=(t)-(NT-4); if(jb_>=0)cmask(P0,P1,jb_,qrel,hi); } }while(0)
  #define BASE(t) (FOX ? (cq2-mhat) : -mhat)
  bool resc=false,nmd=true; f32x16 negm=f32x16{}; asm volatile("":"+v"(negm));
  #define RESC() do{ if(resc){ asm volatile("s_waitcnt lgkmcnt(0)":::"memory"); \
      _Pragma("unroll") for(int d_=0;d_<2;++d_) _Pragma("unroll") for(int r=0;r<16;++r)o[d_][r]*=wsf[crow(r,hi)]; } }while(0)
  #define MX3(a,b,c) __builtin_fmaxf(__builtin_fmaxf((a),(b)),(c))
  #define DECIDE(C0,C1) do{ float a=MX3(C0[0],C0[1],C1[0]),b_=MX3(C0[2],C0[3],C1[1]); a=MX3(a,C1[2],C1[3]); \
      _Pragma("unroll") for(int r=4;r<16;r+=4){a=MX3(a,C0[r],C0[r+1]);b_=MX3(b_,C0[r+2],C0[r+3]);a=MX3(a,C1[r],C1[r+1]);b_=MX3(b_,C1[r+2],C1[r+3]);} \
      float rm=__builtin_fmaxf(a,b_); { auto rr=__builtin_amdgcn_permlane32_swap(__float_as_uint(rm),__float_as_uint(rm),false,false); rm=__builtin_fmaxf(__uint_as_float(rr[0]),__uint_as_float(rr[1])); } \
      resc=false; \
      if(__builtin_expect(__any(rm>(float)THRL),0)){ const float dl=(rm>(float)THRL)?rm:0.f; mhat+=dl;     \
        _Pragma("unroll") for(int r=0;r<16;++r){C0[r]-=dl;C1[r]-=dl;} \
        const float f=__builtin_amdgcn_exp2f(-dl); l_reg*=f; if(hi==0)wsf[r32]=f; resc=true; nmd=true; } }while(0)
  f32x16 pA0,pA1,pB0,pB1;
  int sl_prev=0,sl_cur=0,sl_next=SLOTB;
  #define ROT() do{sl_prev=sl_cur;sl_cur=sl_next;sl_next=(sl_next==(NSLOT-1)*SLOTB)?0:sl_next+SLOTB;}while(0)
  DMA_K(2,2*SLOTB);
  WAIT_BAR(3);
  { const float bs=BASE(0); cinit<FOX>(pA0,ckl,bs); cinit<FOX>(pA1,ckl+32,bs);
    const char*kb=shm+LDS_K+hi*1024+r32*16;
    #pragma unroll
    for(int d0=0;d0<4;++d0){
      const bf16x8 b0=*reinterpret_cast<const bf16x8*>(kb+d0*2048);
      const bf16x8 b1=*reinterpret_cast<const bf16x8*>(kb+d0*2048+512);
      pA0=__builtin_amdgcn_mfma_f32_32x32x16_bf16(b0,qr[d0],pA0,0,0,0);pA1=__builtin_amdgcn_mfma_f32_32x32x16_bf16(b1,qr[d0],pA1,0,0,0);}
    CMASK(pA0,pA1,0);
    DECIDE(pA0,pA1); resc=false;
    _Pragma("unroll") for(int r=0;r<16;++r){pA0[r]=__builtin_amdgcn_exp2f(pA0[r]);pA1[r]=__builtin_amdgcn_exp2f(pA1[r]);} }
  WAIT_BAR(0);
  DMA_K(3,0);DMA_V(1,SLOTB);
  ROT();
  kload8(kf,kp0+sl_cur);
  WAIT_BAR(2);
  s16x4 vlo[8],vhi[8]; u32x4 pw0,pw1,pw2,pw3;
  #define PKW(P,B) cvtpk_s(P[B],P[B+1])
  #define PAF(k) __builtin_bit_cast(bf16x8,pw##k)
  #define VFR(i) (bf16x8){vlo[i][0],vlo[i][1],vlo[i][2],vlo[i][3],vhi[i][0],vhi[i][1],vhi[i][2],vhi[i][3]}
  #define PIN(x) asm volatile("":"+v"(x))
  #define GAPA(MF,A0,A1,A2,A3,W0,W1,PW) do{ MF; sacc+=A0; sacc+=A1; sacc+=A2; sacc+=A3; PIN(sacc); W0; W1; PIN(PW); SBAR(); }while(0)
  #define EX(v) __builtin_amdgcn_exp2f(v)
  #define GAPB(MF,X,B) do{ MF; X[B]=EX(X[B]); X[B+1]=EX(X[B+1]); X[B+2]=EX(X[B+2]); X[B+3]=EX(X[B+3]); PIN(X); SBAR(); }while(0)
  #define VRD(i) do{ vlo[i]=vtr(vp_+(((i)>>2)*4096+((i)&3)*1024)); vhi[i]=vtr(vp_+(((i)>>2)*4096+((i)&3)*1024+512)); }while(0)
  #define KRD(G,j) do{ if(G){ kload2(kf,kp0+sl_next,j); SBAR(); } }while(0)
  #define STEP(C0,C1,P0,P1,t,GK,GV,GL) do{ SBAR(); \
    const lds_cptr vp_=vp0+sl_prev; const float bs_=BASE(t); \
    if constexpr(FOX){ cinit<FOX>(C0,ckl+(t)*64,bs_); SBAR(); } \
    else if(nmd){ _Pragma("unroll") for(int r=0;r<16;++r)negm[r]=bs_; asm volatile("":"+v"(negm)); nmd=false; SBAR(); }     \
    VRD(0); SBAR(); float sacc=(P0[0]+P0[1]); \
    GAPA(C0=__builtin_amdgcn_mfma_f32_32x32x16_bf16(kf[0],qr[0],FOX?C0:negm,0,0,0), P0[2],P0[3],P0[4],P0[5],     pw0[0]=PKW(P0,0), pw0[1]=PKW(P0,2), pw0); \
    if constexpr(FOX){ cinit<FOX>(C1,ckl+(t)*64+32,bs_); SBAR(); } \
    VRD(4); SBAR(); GAPA(C1=__builtin_amdgcn_mfma_f32_32x32x16_bf16(kf[1],qr[0],FOX?C1:negm,0,0,0), P0[6],P0[7],P0[8],P0[9],     pw0[2]=PKW(P0,4), pw0[3]=PKW(P0,6), pw0); \
    VRD(1); SBAR(); GAPA(C0=__builtin_amdgcn_mfma_f32_32x32x16_bf16(kf[2],qr[1],C0,0,0,0),   P0[10],P0[11],P0[12],P0[13], pw1[0]=PKW(P0,8), pw1[1]=PKW(P0,10), pw1); \
    VRD(5); SBAR(); GAPA(C1=__builtin_amdgcn_mfma_f32_32x32x16_bf16(kf[3],qr[1],C1,0,0,0),   P0[14],P0[15],P1[0],P1[1],   pw1[2]=PKW(P0,12),pw1[3]=PKW(P0,14), pw1); \
    VRD(2); SBAR(); GAPA(C0=__builtin_amdgcn_mfma_f32_32x32x16_bf16(kf[4],qr[2],C0,0,0,0),   P1[2],P1[3],P1[4],P1[5],     pw2[0]=PKW(P1,0), pw2[1]=PKW(P1,2), pw2); \
    VRD(6); SBAR(); GAPA(C1=__builtin_amdgcn_mfma_f32_32x32x16_bf16(kf[5],qr[2],C1,0,0,0),   P1[6],P1[7],P1[8],P1[9],     pw2[2]=PKW(P1,4), pw2[3]=PKW(P1,6), pw2); \
    VRD(3); SBAR(); GAPA(C0=__builtin_amdgcn_mfma_f32_32x32x16_bf16(kf[6],qr[3],C0,0,0,0),   P1[10],P1[11],P1[12],P1[13], pw3[0]=PKW(P1,8), pw3[1]=PKW(P1,10), pw3); \
    VRD(7); SBAR(); GAPA(C1=__builtin_amdgcn_mfma_f32_32x32x16_bf16(kf[7],qr[3],C1,0,0,0),   P1[14],P1[15],0.f,0.f,       pw3[2]=PKW(P1,12),pw3[3]=PKW(P1,14), pw3); \
    l_reg+=sacc; \
    if(GK){DMA_K((t)+3,sl_cur);} if(GV){DMA_V((t)+1,sl_next);} \
    CMASK(C0,C1,t); \
    DECIDE(C0,C1); \
    SBAR(); \
    GAPB(o[0]=__builtin_amdgcn_mfma_f32_32x32x16_bf16(PAF(0),VFR(0),o[0],0,0,0), C0,0); \
    GAPB(o[1]=__builtin_amdgcn_mfma_f32_32x32x16_bf16(PAF(0),VFR(4),o[1],0,0,0), C0,4); \
    KRD(GL,0); GAPB(o[0]=__builtin_amdgcn_mfma_f32_32x32x16_bf16(PAF(1),VFR(1),o[0],0,0,0), C0,8); \
    KRD(GL,1); GAPB(o[1]=__builtin_amdgcn_mfma_f32_32x32x16_bf16(PAF(1),VFR(5),o[1],0,0,0), C0,12); \
    KRD(GL,2); GAPB(o[0]=__builtin_amdgcn_mfma_f32_32x32x16_bf16(PAF(2),VFR(2),o[0],0,0,0), C1,0); \
    KRD(GL,3); GAPB(o[1]=__builtin_amdgcn_mfma_f32_32x32x16_bf16(PAF(2),VFR(6),o[1],0,0,0), C1,4); \
    GAPB(o[0]=__builtin_amdgcn_mfma_f32_32x32x16_bf16(PAF(3),VFR(3),o[0],0,0,0), C1,8); \
    GAPB(o[1]=__builtin_amdgcn_mfma_f32_32x32x16_bf16(PAF(3),VFR(7),o[1],0,0,0), C1,12); \
    }while(0)
  int t=1;
  #undef CMASK
  #define CMASK(P0,P1,t) do{}while(0)
  for(;t+5<NT;t+=2){
    STEP(pB0,pB1,pA0,pA1,t,true,true,true);     WAIT_BAR(2); RESC(); ROT();
    STEP(pA0,pA1,pB0,pB1,t+1,true,true,true);   WAIT_BAR(2); RESC(); ROT();
  }
  #undef CMASK
  #define CMASK(P0,P1,t) do{ if constexpr(VAR!=2){ int jb_=(t)-(NT-4); if(jb_>=0)cmask(P0,P1,jb_,qrel,hi); } }while(0)
  #define ENDW(tt) do{ if((tt)+3<NT){WAIT_BAR(2);} else if((tt)+2<NT){WAIT_BAR(1);} else {WAIT_BAR(0);} }while(0)
  for(;t+1<NT;t+=2){
    STEP(pB0,pB1,pA0,pA1,t,(t+3<NT),(t+1<NT),(t+1<NT));       ENDW(t);   RESC(); ROT();
    STEP(pA0,pA1,pB0,pB1,t+1,(t+4<NT),(t+2<NT),(t+2<NT));     ENDW(t+1); RESC(); ROT();
  }
  STEP(pB0,pB1,pA0,pA1,NT-1,false,false,false); RESC();
  { float sacc=pB0[0]+pB0[1]; _Pragma("unroll") for(int r=2;r<16;++r)sacc+=pB0[r]; _Pragma("unroll") for(int r=0;r<16;++r)sacc+=pB1[r]; l_reg+=sacc;
    pw0=(u32x4){PKW(pB0,0),PKW(pB0,2),PKW(pB0,4),PKW(pB0,6)};pw1=(u32x4){PKW(pB0,8),PKW(pB0,10),PKW(pB0,12),PKW(pB0,14)};pw2=(u32x4){PKW(pB1,0),PKW(pB1,2),PKW(pB1,4),PKW(pB1,6)};pw3=(u32x4){PKW(pB1,8),PKW(pB1,10),PKW(pB1,12),PKW(pB1,14)};
    SBAR(); pv(o,vb0+sl_cur,PAF(0),PAF(1),PAF(2),PAF(3)); }
  #undef PKW
  #undef PAF
  #undef VFR
  #undef PIN
  #undef MX3
  #undef GAPA
  #undef GAPB
  #undef EX
  #undef VRD
  #undef KRD
  #undef STEP
  #undef ENDW
  #undef DECIDE
  #undef BASE
  {auto rr=__builtin_amdgcn_permlane32_swap(__float_as_uint(l_reg),__float_as_uint(l_reg),false,false);l_reg=__uint_as_float(rr[0])+__uint_as_float(rr[1]);}
  int pslot=0;
  if constexpr(VAR==2){ const unsigned s3=mio.SEL3[qidx]; pslot=((int)(s3&31u)==mio.jblk)?0:(((int)((s3>>5)&31u)==mio.jblk)?1:2); }
  if(hi==0){ wsf[32+r32]=l_reg; if constexpr(VAR==2) wsf[r32]=__int_as_float(qvalid?(qidx*4+pslot):-1); }
  asm volatile("s_waitcnt lgkmcnt(0)":::"memory");
  if constexpr(VAR>=1){ if(hi==0&&qvalid) mio.LSE[(long)qidx*4+((VAR==1)?3:pslot)]=mhat+__builtin_amdgcn_logf(l_reg); }
  float rli[16];
  #pragma unroll
  for(int r=0;r<16;++r)rli[r]=__builtin_amdgcn_rcpf(wsf[32+crow(r,hi)]);
  { bf16*stg=(bf16*)(shm+LDS_OST)+wid*2048;
    #pragma unroll
    for(int r=0;r<16;++r){const int orow=crow(r,hi);
      #pragma unroll
      for(int d0=0;d0<2;++d0)stg[orow*64+d0*32+r32]=__float2bfloat16(o[d0][r]*rli[r]);}
    asm volatile("s_waitcnt lgkmcnt(0)":::"memory");
    if constexpr(VAR==2){
      #pragma unroll
      for(int i=0;i<4;++i){const int row=i*8+(lane>>3),ch=lane&7; const u32x4 v=*(const u32x4*)(stg+row*64+ch*8); const int inf=__float_as_int(wsf[row]);
        if(inf>=0){ bf16*pb=((inf&3)==0)?mio.PART0:(((inf&3)==1)?mio.PART1:mio.PART2); ATTN_STORE16(pb+(long)(inf>>2)*D+ch*8,v); } }
    } else if constexpr(VAR==1){
      bf16*Ow=mio.PART0+(long)(q0+wid*QBLK)*D;
      #pragma unroll
      for(int i=0;i<4;++i){const int row=i*8+(lane>>3),ch=lane&7; const u32x4 v=*(const u32x4*)(stg+row*64+ch*8); ATTN_STORE16(Ow+(long)row*D+ch*8,v);}
    } else {
      bf16*Ow=O+(rowbase+q0+wid*QBLK)*DM+h*D;
      #pragma unroll
      for(int i=0;i<4;++i){const int row=i*8+(lane>>3),ch=lane&7; const u32x4 v=*(const u32x4*)(stg+row*64+ch*8); ATTN_STORE16(Ow+(long)row*DM+ch*8,v);} } }
  asm volatile("s_waitcnt lgkmcnt(0)\n\ts_barrier":::"memory");
  #undef DMA_K
  #undef DMA_V
  #undef CMASK
  #undef RESC
  #undef ROT
}
template<bool OWN> __device__ __forceinline__ void moba4_unit(int b,int h,int qb,int jblk,int cnt,const bf16*Q,const bf16*__restrict__ K,const bf16*__restrict__ V,const MobaIo&mio,char*shm){
  constexpr bool FOX=false; constexpr int THRL=8, VAR=OWN?1:2; constexpr int LK=0,LV=4*SLOTB,LWS=8*SLOTB,LOST=LWS+NW*128*4;
  const int t0=4*jblk; bf16*O=nullptr; const float*CK2=nullptr; (void)O; (void)CK2;
  const int tid=otid(),lane=tid&63,r32=lane&31,hi=lane>>5; const int wid=__builtin_amdgcn_readfirstlane(tid>>6);
  const long rowbase=(long)b*SEQ; const int q0=qb*QB;
  const bf16*Kh=K+(rowbase+(long)t0*KVBLK)*DM+h*D,*Vh=V+(rowbase+(long)t0*KVBLK)*DM+h*D;
  const unsigned lds0=(unsigned)(uintptr_t)shm;
  float*wsf=(float*)(shm+LWS)+wid*128;
  const bf16*ksrc=Kh+(long)lane*DM+wid*8;
  const bf16*vsrc=Vh+(long)(16*(wid&3)+(lane>>2))*DM+(wid>>2)*32+(lane&3)*8;
  const unsigned kdst=lds0+LK+wid*1024, vdst=lds0+LV+wid*1024;
  #define DMA_K(t,slot) glds16(ksrc+(long)(t)*KVBLK*DM,(unsigned)__builtin_amdgcn_readfirstlane(kdst+(slot)))
  #define DMA_V(t,slot) glds16(vsrc+(long)(t)*KVBLK*DM,(unsigned)__builtin_amdgcn_readfirstlane(vdst+(slot)))
  const int vb0=(int)(lds0+LV)+((lane>>4)&1)*32+(lane&3)*8+(4*hi+((lane&15)>>2))*64;
  bf16x8 kf[8];
  const lds_cptr shm3=(lds_cptr)shm; const lds_cptr kp0=shm3+LK+hi*1024+r32*16; const lds_cptr vp0=shm3+LV+((lane>>4)&1)*32+(lane&3)*8+(4*hi+((lane&15)>>2))*64;
  const __attribute__((address_space(3))) float*ckl=(const __attribute__((address_space(3))) float*)(shm3+LWS)+4*hi;
  constexpr int NT=4; const float cq2=0.f; (void)cq2;
  DMA_K(0,0);DMA_V(0,0);DMA_K(1,SLOTB);DMA_V(1,SLOTB);DMA_K(2,2*SLOTB);DMA_V(2,2*SLOTB);DMA_K(3,3*SLOTB);DMA_V(3,3*SLOTB);
  const int nch=OWN?1:(cnt+QB-1)/QB;
  int qidx=q0+wid*QBLK+r32,qnext=0; unsigned s3=0u; bf16x8 qr[4];
  if constexpr(VAR==2){ qidx=(int)mio.QL[min(wid*QBLK+r32,cnt-1)]; s3=mio.SEL3[qidx]; qnext=(int)mio.QL[min(QB+wid*QBLK+r32,cnt-1)]; }
  { const bf16*Qrow=Q+(rowbase+qidx)*DM+h*D;
    #pragma unroll
    for(int d0=0;d0<4;++d0)qr[d0]=*reinterpret_cast<const bf16x8*>(&Qrow[d0*16+hi*8]); }
  for(int c_=0;c_<nch;++c_){
  bool qvalid=true; int pslot=0;
  if constexpr(VAR==2){ qvalid=(c_*QB+wid*QBLK+r32)<cnt; pslot=((int)(s3&31u)==jblk)?0:(((int)((s3>>5)&31u)==jblk)?1:2); }
  wsf[64+lane]=__int_as_float(qvalid?(qidx*4+(OWN?3:pslot)):-1);
  float mhat=0.f,l_reg=0.f;f32x16 o[2];o[0]=f32x16{};o[1]=f32x16{};
  const int qrel=wid*QBLK+r32;
  #define CMASK(P0,P1,t) do{ if constexpr(VAR!=2){ int jb_=(t)-(NT-4); if(jb_>=0)cmask(P0,P1,jb_,qrel,hi); } }while(0)
  #define BASE(t) (FOX ? (cq2-mhat) : -mhat)
  bool resc=false,nmd=true; f32x16 negm=f32x16{}; asm volatile("":"+v"(negm));
  #define RESC() do{ if(resc){ asm volatile("s_waitcnt lgkmcnt(0)":::"memory"); \
      _Pragma("unroll") for(int d_=0;d_<2;++d_) _Pragma("unroll") for(int r=0;r<16;++r)o[d_][r]*=wsf[crow(r,hi)]; } }while(0)
  #define MX3(a,b,c) __builtin_fmaxf(__builtin_fmaxf((a),(b)),(c))
  #define DECIDE(C0,C1) do{ float a=MX3(C0[0],C0[1],C1[0]),b_=MX3(C0[2],C0[3],C1[1]); a=MX3(a,C1[2],C1[3]); \
      _Pragma("unroll") for(int r=4;r<16;r+=4){a=MX3(a,C0[r],C0[r+1]);b_=MX3(b_,C0[r+2],C0[r+3]);a=MX3(a,C1[r],C1[r+1]);b_=MX3(b_,C1[r+2],C1[r+3]);} \
      float rm=__builtin_fmaxf(a,b_); { auto rr=__builtin_amdgcn_permlane32_swap(__float_as_uint(rm),__float_as_uint(rm),false,false); rm=__builtin_fmaxf(__uint_as_float(rr[0]),__uint_as_float(rr[1])); } \
      resc=false; \
      if(__builtin_expect(__any(rm>(float)THRL),0)){ const float dl=(rm>(float)THRL)?rm:0.f; mhat+=dl;     \
        _Pragma("unroll") for(int r=0;r<16;++r){C0[r]-=dl;C1[r]-=dl;} \
        const float f=__builtin_amdgcn_exp2f(-dl); l_reg*=f; if(hi==0)wsf[r32]=f; resc=true; nmd=true; } }while(0)
  f32x16 pA0,pA1,pB0,pB1;
  int sl_prev=0,sl_cur=0,sl_next=SLOTB;
  #define ROT() do{sl_prev=sl_cur;sl_cur=sl_next;sl_next=sl_next+SLOTB;}while(0)
  #define WAIT_NB() asm volatile("s_waitcnt lgkmcnt(0)":::"memory")
  if(c_==0){ WAIT_BAR(0); }
  { const float bs=BASE(0); cinit<FOX>(pA0,ckl,bs); cinit<FOX>(pA1,ckl+32,bs);
    const char*kb=shm+LK+hi*1024+r32*16;
    #pragma unroll
    for(int d0=0;d0<4;++d0){
      const bf16x8 b0=*reinterpret_cast<const bf16x8*>(kb+d0*2048);
      const bf16x8 b1=*reinterpret_cast<const bf16x8*>(kb+d0*2048+512);
      pA0=__builtin_amdgcn_mfma_f32_32x32x16_bf16(b0,qr[d0],pA0,0,0,0);pA1=__builtin_amdgcn_mfma_f32_32x32x16_bf16(b1,qr[d0],pA1,0,0,0);}
    CMASK(pA0,pA1,0);
    DECIDE(pA0,pA1); resc=false;
    _Pragma("unroll") for(int r=0;r<16;++r){pA0[r]=__builtin_amdgcn_exp2f(pA0[r]);pA1[r]=__builtin_amdgcn_exp2f(pA1[r]);} }
  WAIT_NB();
  ROT();
  kload8(kf,kp0+sl_cur);
  WAIT_NB();
  s16x4 vlo[8],vhi[8]; u32x4 pw0,pw1,pw2,pw3;
  #define PKW(P,B) cvtpk_s(P[B],P[B+1])
  #define PAF(k) __builtin_bit_cast(bf16x8,pw##k)
  #define VFR(i) (bf16x8){vlo[i][0],vlo[i][1],vlo[i][2],vlo[i][3],vhi[i][0],vhi[i][1],vhi[i][2],vhi[i][3]}
  #define PIN(x) asm volatile("":"+v"(x))
  #define GAPA(MF,A0,A1,A2,A3,W0,W1,PW) do{ MF; sacc+=A0; sacc+=A1; sacc+=A2; sacc+=A3; PIN(sacc); W0; W1; PIN(PW); SBAR(); }while(0)
  #define EX(v) __builtin_amdgcn_exp2f(v)
  #define GAPB(MF,X,B) do{ MF; X[B]=EX(X[B]); X[B+1]=EX(X[B+1]); X[B+2]=EX(X[B+2]); X[B+3]=EX(X[B+3]); PIN(X); SBAR(); }while(0)
  #define VRD(i) do{ vlo[i]=vtr(vp_+(((i)>>2)*4096+((i)&3)*1024)); vhi[i]=vtr(vp_+(((i)>>2)*4096+((i)&3)*1024+512)); }while(0)
  #define KRD(G,j) do{ if(G){ kload2(kf,kp0+sl_next,j); SBAR(); } }while(0)
  #define STEP(C0,C1,P0,P1,t,GK,GV,GL) do{ SBAR(); \
    const lds_cptr vp_=vp0+sl_prev; const float bs_=BASE(t); \
    if constexpr(FOX){ cinit<FOX>(C0,ckl+(t)*64,bs_); SBAR(); } \
    else if(nmd){ _Pragma("unroll") for(int r=0;r<16;++r)negm[r]=bs_; asm volatile("":"+v"(negm)); nmd=false; SBAR(); }     \
    VRD(0); SBAR(); float sacc=(P0[0]+P0[1]); \
    GAPA(C0=__builtin_amdgcn_mfma_f32_32x32x16_bf16(kf[0],qr[0],FOX?C0:negm,0,0,0), P0[2],P0[3],P0[4],P0[5],     pw0[0]=PKW(P0,0), pw0[1]=PKW(P0,2), pw0); \
    if constexpr(FOX){ cinit<FOX>(C1,ckl+(t)*64+32,bs_); SBAR(); } \
    VRD(4); SBAR(); GAPA(C1=__builtin_amdgcn_mfma_f32_32x32x16_bf16(kf[1],qr[0],FOX?C1:negm,0,0,0), P0[6],P0[7],P0[8],P0[9],     pw0[2]=PKW(P0,4), pw0[3]=PKW(P0,6), pw0); \
    VRD(1); SBAR(); GAPA(C0=__builtin_amdgcn_mfma_f32_32x32x16_bf16(kf[2],qr[1],C0,0,0,0),   P0[10],P0[11],P0[12],P0[13], pw1[0]=PKW(P0,8), pw1[1]=PKW(P0,10), pw1); \
    VRD(5); SBAR(); GAPA(C1=__builtin_amdgcn_mfma_f32_32x32x16_bf16(kf[3],qr[1],C1,0,0,0),   P0[14],P0[15],P1[0],P1[1],   pw1[2]=PKW(P0,12),pw1[3]=PKW(P0,14), pw1); \
    VRD(2); SBAR(); GAPA(C0=__builtin_amdgcn_mfma_f32_32x32x16_bf16(kf[4],qr[2],C0,0,0,0),   P1[2],P1[3],P1[4],P1[5],     pw2[0]=PKW(P1,0), pw2[1]=PKW(P1,2), pw2); \
    VRD(6); SBAR(); GAPA(C1=__builtin_amdgcn_mfma_f32_32x32x16_bf16(kf[5],qr[2],C1,0,0,0),   P1[6],P1[7],P1[8],P1[9],     pw2[2]=PKW(P1,4), pw2[3]=PKW(P1,6), pw2); \
    VRD(3); SBAR(); GAPA(C0=__builtin_amdgcn_mfma_f32_32x32x16_bf16(kf[6],qr[3],C0,0,0,0),   P1[10],P1[11],P1[12],P1[13], pw3[0]=PKW(P1,8), pw3[1]=PKW(P1,10), pw3); \
    VRD(7); SBAR(); GAPA(C1=__builtin_amdgcn_mfma_f32_32x32x16_bf16(kf[7],qr[3],C1,0,0,0),   P1[14],P1[15],0.f,0.f,       pw3[2]=PKW(P1,12),pw3[3]=PKW(P1,14), pw3); \
    l_reg+=sacc; \
    if(GK){DMA_K((t)+3,sl_cur);} if(GV){DMA_V((t)+1,sl_next);} \
    CMASK(C0,C1,t); \
    DECIDE(C0,C1); \
    SBAR(); \
    GAPB(o[0]=__builtin_amdgcn_mfma_f32_32x32x16_bf16(PAF(0),VFR(0),o[0],0,0,0), C0,0); \
    GAPB(o[1]=__builtin_amdgcn_mfma_f32_32x32x16_bf16(PAF(0),VFR(4),o[1],0,0,0), C0,4); \
    KRD(GL,0); GAPB(o[0]=__builtin_amdgcn_mfma_f32_32x32x16_bf16(PAF(1),VFR(1),o[0],0,0,0), C0,8); \
    KRD(GL,1); GAPB(o[1]=__builtin_amdgcn_mfma_f32_32x32x16_bf16(PAF(1),VFR(5),o[1],0,0,0), C0,12); \
    KRD(GL,2); GAPB(o[0]=__builtin_amdgcn_mfma_f32_32x32x16_bf16(PAF(2),VFR(2),o[0],0,0,0), C1,0); \
    KRD(GL,3); GAPB(o[1]=__builtin_amdgcn_mfma_f32_32x32x16_bf16(PAF(2),VFR(6),o[1],0,0,0), C1,4); \
    GAPB(o[0]=__builtin_amdgcn_mfma_f32_32x32x16_bf16(PAF(3),VFR(3),o[0],0,0,0), C1,8); \
    GAPB(o[1]=__builtin_amdgcn_mfma_f32_32x32x16_bf16(PAF(3),VFR(7),o[1],0,0,0), C1,12); \
    }while(0)
  int t=1;
  #undef CMASK
  #define CMASK(P0,P1,t) do{}while(0)
  for(;t+5<NT;t+=2){
    STEP(pB0,pB1,pA0,pA1,t,false,false,true);     WAIT_NB(); RESC(); ROT();
    STEP(pA0,pA1,pB0,pB1,t+1,false,false,true);   WAIT_NB(); RESC(); ROT();
  }
  #undef CMASK
  #define CMASK(P0,P1,t) do{ if constexpr(VAR!=2){ int jb_=(t)-(NT-4); if(jb_>=0)cmask(P0,P1,jb_,qrel,hi); } }while(0)
  #define ENDW(tt) WAIT_NB()
  for(;t+1<NT;t+=2){
    STEP(pB0,pB1,pA0,pA1,t,false,false,(t+1<NT));       ENDW(t);   RESC(); ROT();
    STEP(pA0,pA1,pB0,pB1,t+1,false,false,(t+2<NT));     ENDW(t+1); RESC(); ROT();
  }
  STEP(pB0,pB1,pA0,pA1,NT-1,false,false,false); RESC();
  if constexpr(VAR==2){ if(c_+1<nch){ qidx=qnext; const bf16*Qrow=Q+(rowbase+qidx)*DM+h*D;
      #pragma unroll
      for(int d0=0;d0<4;++d0)qr[d0]=*reinterpret_cast<const bf16x8*>(&Qrow[d0*16+hi*8]);
      s3=mio.SEL3[qidx]; qnext=(int)mio.QL[min((c_+2)*QB+wid*QBLK+r32,cnt-1)]; } }
  { float sacc=pB0[0]+pB0[1]; _Pragma("unroll") for(int r=2;r<16;++r)sacc+=pB0[r]; _Pragma("unroll") for(int r=0;r<16;++r)sacc+=pB1[r]; l_reg+=sacc;
    pw0=(u32x4){PKW(pB0,0),PKW(pB0,2),PKW(pB0,4),PKW(pB0,6)};pw1=(u32x4){PKW(pB0,8),PKW(pB0,10),PKW(pB0,12),PKW(pB0,14)};pw2=(u32x4){PKW(pB1,0),PKW(pB1,2),PKW(pB1,4),PKW(pB1,6)};pw3=(u32x4){PKW(pB1,8),PKW(pB1,10),PKW(pB1,12),PKW(pB1,14)};
    SBAR(); pv(o,vb0+sl_cur,PAF(0),PAF(1),PAF(2),PAF(3)); }
  #undef PKW
  #undef PAF
  #undef VFR
  #undef PIN
  #undef MX3
  #undef GAPA
  #undef GAPB
  #undef EX
  #undef VRD
  #undef KRD
  #undef STEP
  #undef ENDW
  #undef DECIDE
  #undef BASE
  {auto rr=__builtin_amdgcn_permlane32_swap(__float_as_uint(l_reg),__float_as_uint(l_reg),false,false);l_reg=__uint_as_float(rr[0])+__uint_as_float(rr[1]);}
  const int info=__float_as_int(wsf[64+lane]);
  if(hi==0){ wsf[32+r32]=l_reg; if constexpr(VAR==2) wsf[r32]=__int_as_float(info); }
  asm volatile("s_waitcnt lgkmcnt(0)":::"memory");
  if(hi==0&&info>=0) mio.LSE[info]=mhat+__builtin_amdgcn_logf(l_reg);
  float rli[16];
  #pragma unroll
  for(int r=0;r<16;++r)rli[r]=__builtin_amdgcn_rcpf(wsf[32+crow(r,hi)]);
  { bf16*stg=(bf16*)(shm+LOST)+wid*2048;
    #pragma unroll
    for(int r=0;r<16;++r){const int orow=crow(r,hi);
      #pragma unroll
      for(int d0=0;d0<2;++d0)stg[orow*64+d0*32+r32]=__float2bfloat16(o[d0][r]*rli[r]);}
    asm volatile("s_waitcnt lgkmcnt(0)":::"memory");
    if constexpr(VAR==2){
      #pragma unroll
      for(int i=0;i<4;++i){const int row=i*8+(lane>>3),ch=lane&7; const u32x4 v=*(const u32x4*)(stg+row*64+ch*8); const int inf=__float_as_int(wsf[row]);
        if(inf>=0){ bf16*pb=((inf&3)==0)?mio.PART0:(((inf&3)==1)?mio.PART1:mio.PART2); ATTN_STORE16(pb+(long)(inf>>2)*D+ch*8,v); } }
    } else if constexpr(VAR==1){
      bf16*Ow=mio.PART0+(long)(q0+wid*QBLK)*D;
      #pragma unroll
      for(int i=0;i<4;++i){const int row=i*8+(lane>>3),ch=lane&7; const u32x4 v=*(const u32x4*)(stg+row*64+ch*8); ATTN_STORE16(Ow+(long)row*D+ch*8,v);}
    } else {
      bf16*Ow=O+(rowbase+q0+wid*QBLK)*DM+h*D;
      #pragma unroll
      for(int i=0;i<4;++i){const int row=i*8+(lane>>3),ch=lane&7; const u32x4 v=*(const u32x4*)(stg+row*64+ch*8); ATTN_STORE16(Ow+(long)row*DM+ch*8,v);} } }
  asm volatile("s_waitcnt lgkmcnt(0)":::"memory");
  }
  #undef WAIT_NB
  #undef DMA_K
  #undef DMA_V
  #undef CMASK
  #undef RESC
  #undef ROT
}

__device__ __forceinline__ void moba_gate_item(int b,int h,int qb,const bf16*Q,const float*KSUM,unsigned*SEL3,unsigned*CNT,unsigned short*LIST){
  const int tid=otid(),lane=tid&63,r32=lane&31,hi=lane>>5; const int wid=__builtin_amdgcn_readfirstlane(tid>>6);
  const int q=qb*QB+wid*QBLK+r32;
  const bf16*Qrow=Q+((long)b*SEQ+q)*DM+h*D;
  bf16x8 qr[4];
  #pragma unroll
  for(int d0=0;d0<4;++d0)qr[d0]=*reinterpret_cast<const bf16x8*>(&Qrow[d0*16+hi*8]);
  f32x16 ga=f32x16{};
  const float*km=KSUM+r32*64+8*hi;
  #pragma unroll
  for(int ks=0;ks<4;++ks){
    const f32x4 a0=*(const f32x4*)(km+16*ks),a1=*(const f32x4*)(km+16*ks+4),c0=*(const f32x4*)(km+KSUM_P1+16*ks),c1=*(const f32x4*)(km+KSUM_P1+16*ks+4);
    float x[8]; u32x4 fh,fl;
    #pragma unroll
    for(int e=0;e<4;++e){x[e]=a0[e]+c0[e];x[4+e]=a1[e]+c1[e];}
    #pragma unroll
    for(int e=0;e<4;++e){ const unsigned hw=cvtpk_s(x[2*e],x[2*e+1]); fh[e]=hw; fl[e]=cvtpk_s(x[2*e]-__uint_as_float(hw<<16),x[2*e+1]-__uint_as_float(hw&0xffff0000u)); }
    ga=__builtin_amdgcn_mfma_f32_32x32x16_bf16(__builtin_bit_cast(bf16x8,fh),qr[ks],ga,0,0,0);
    ga=__builtin_amdgcn_mfma_f32_32x32x16_bf16(__builtin_bit_cast(bf16x8,fl),qr[ks],ga,0,0,0);
  }
  unsigned t0=0u,t1=0u,t2=0u;
  #define INS3(x) do{ unsigned x_=(x); unsigned m_=max(t0,x_); x_=min(t0,x_); t0=m_; m_=max(t1,x_); x_=min(t1,x_); t1=m_; t2=max(t2,x_); }while(0)
  #pragma unroll
  for(int r=0;r<16;++r){ const int n=(r&3)+8*(r>>2)+4*hi; const unsigned u_=__float_as_uint(ga[r]); const unsigned o_=u_^((unsigned)((int)u_>>31)|0x80000000u);
    const unsigned key=(n<qb)?((o_&~31u)|(unsigned)(31-n)):0u; INS3(key); }
  { const unsigned p0=(unsigned)__shfl_xor((int)t0,32),p1=(unsigned)__shfl_xor((int)t1,32),p2=(unsigned)__shfl_xor((int)t2,32); INS3(p0); INS3(p1); INS3(p2); }
  #undef INS3
  const int n0=t0?(int)(31u-(t0&31u)):-1,n1=t1?(int)(31u-(t1&31u)):-1,n2=t2?(int)(31u-(t2&31u)):-1;
  const unsigned cntv=(t0?1u:0u)+(t1?1u:0u)+(t2?1u:0u);
  if(hi==0)SEL3[q]=(unsigned)(n0&31)|((unsigned)(n1&31)<<5)|((unsigned)(n2&31)<<10)|(cntv<<15);
  unsigned mycnt=0u; int rk0=0,rk1=0,rk2=0; const unsigned long long below=(1ull<<r32)-1ull;
  for(int j=0;j<qb;++j){ const unsigned long long m=__ballot(hi==0&&(n0==j||n1==j||n2==j))&0xffffffffull; const int pc=__builtin_popcountll(m);
    if(lane==j)mycnt=(unsigned)pc; const int rk=__builtin_popcountll(m&below); if(n0==j)rk0=rk; if(n1==j)rk1=rk; if(n2==j)rk2=rk; }
  unsigned basev=0u;
  if(lane<qb&&mycnt)basev=__hip_atomic_fetch_add(CNT+lane,mycnt,__ATOMIC_RELAXED,__HIP_MEMORY_SCOPE_AGENT);
  const unsigned b0=(unsigned)__shfl((int)basev,n0<0?0:n0),b1=(unsigned)__shfl((int)basev,n1<0?0:n1),b2=(unsigned)__shfl((int)basev,n2<0?0:n2);
  if(hi==0){ if(n0>=0)LIST[(long)n0*SEQ+b0+rk0]=(unsigned short)q; if(n1>=0)LIST[(long)n1*SEQ+b1+rk1]=(unsigned short)q; if(n2>=0)LIST[(long)n2*SEQ+b2+rk2]=(unsigned short)q; }
}
#undef SBAR
#undef WAIT_BAR
}

constexpr float FOX_SKIP = 32.0f;
constexpr size_t WS_QCTR = 32 * KiB;
__device__ __forceinline__ void phase_attn(char* lds, volatile LAS unsigned* misc, const P& p) {
    attn::bf16* QKVb = (attn::bf16*)(p.ws + WS_QKV);
    unsigned* qctr = (unsigned*)(p.ws + WS_QCTR); unsigned* MCNT = (unsigned*)(p.ws + WS_MCNT); unsigned* MG1 = (unsigned*)(p.ws + WS_MG1);
    bool g1seen = false; const attn::MobaIo mio0{};
    volatile LAS unsigned* CNL = misc + 64;
    for (;;) {
        if (threadIdx.x == 0) misc[16] = __hip_atomic_fetch_add(qctr, 1u, __ATOMIC_RELAXED, __HIP_MEMORY_SCOPE_AGENT);
        __syncthreads();
        const int up = (int)__builtin_amdgcn_readfirstlane((int)misc[16]);
        __syncthreads();
        if (up >= 2032) break;
        const int u = (up < 512 || up >= 1520) ? up : (up < 768 ? up + 496 : (up < 1264 ? up - 256 : up));
        if (u < 512) {
            const int bh = u & 15, qb = u >> 4;
            attn::moba_gate_item(bh >> 3, bh & 7, qb, QKVb, (const float*)(p.ws + WS_KMP) + (size_t)bh * 32 * 64, (unsigned*)(p.ws + WS_SEL3) + (size_t)bh * S, MCNT + bh * 32, (unsigned short*)(p.ws + WS_MLIST) + (size_t)bh * 32 * S);
            asm volatile("s_waitcnt vmcnt(0)" ::: "memory");
            __syncthreads();
            if (threadIdx.x == 0) { __builtin_amdgcn_fence(__ATOMIC_RELEASE, "agent"); asm volatile("s_waitcnt vmcnt(0)" ::: "memory");
                const unsigned old = __hip_atomic_fetch_add(MG1, 1u, __ATOMIC_RELAXED, __HIP_MEMORY_SCOPE_AGENT);
                if (old == 511u) { __builtin_amdgcn_fence(__ATOMIC_ACQ_REL, "agent"); asm volatile("s_waitcnt vmcnt(0)" ::: "memory"); __hip_atomic_store(MG1 + 64, 1u, __ATOMIC_RELAXED, __HIP_MEMORY_SCOPE_AGENT); } }
            continue;
        }
        if (u >= 1008 && u < 1520) {
            const int v = u - 1008, qb = 31 - (v >> 4), bh = v & 15;
            const float* c2 = (const float*)(p.ws + WS_C) + (size_t)bh * S; const int lane = threadIdx.x & 63, nt = 4 * qb + 4;
            const float cq = c2[qb * 256];
            const float* FK = (const float*)(p.ws + WS_FKN) + (size_t)bh * 256; const float* FQ = (const float*)(p.ws + WS_FQN) + ((size_t)bh * 32 + qb) * 4;
#define FOX_KN(t) sqrtf(FK[2 * (t)] + FK[2 * (t) + 1])
            const float qm = sqrtf(fmaxf(FQ[0] + FQ[1], FQ[2] + FQ[3])), ko = fmaxf(fmaxf(FOX_KN(4 * qb), FOX_KN(4 * qb + 1)), fmaxf(FOX_KN(4 * qb + 2), FOX_KN(4 * qb + 3)));
            const float th0 = (lane < nt) ? 1.01f * qm * (FOX_KN(lane) + ko) + FOX_SKIP : 0.f, th1 = (lane + 64 < nt) ? 1.01f * qm * (FOX_KN(lane + 64) + ko) + FOX_SKIP : 0.f;
#undef FOX_KN
            const bool keep0 = (lane < nt) ? (cq - c2[64 * lane + 63] >= -th0) : true, keep1 = (lane + 64 < nt) ? (cq - c2[64 * (lane + 64) + 63] >= -th1) : true;
            const unsigned long long m0 = __ballot(keep0), m1 = __ballot(keep1);
            int first = m0 ? __builtin_ctzll(m0) : 64 + __builtin_ctzll(m1);
            int t0 = first & ~1; if (t0 > nt - 4) t0 = nt - 4;
            t0 = __builtin_amdgcn_readfirstlane(t0);
            attn::attn_unit<true, 24, 0>(bh >> 3, bh & 7, qb, t0, QKVb + SLOT, QKVb + 4 * SLOT, QKVb + 5 * SLOT, QKVb + SLOT, c2, mio0, lds);
            continue;
        }
        if (!g1seen) {
            if (threadIdx.x == 0) { unsigned sp = 0u;
                while (__hip_atomic_load(MG1 + 64, __ATOMIC_RELAXED, __HIP_MEMORY_SCOPE_AGENT) == 0u) { __builtin_amdgcn_s_sleep(8); if (++sp > (1u << 22)) break; }
                __builtin_amdgcn_fence(__ATOMIC_ACQUIRE, "agent"); asm volatile("s_waitcnt vmcnt(0)" ::: "memory"); }
            __syncthreads();
            CNL[threadIdx.x] = __hip_atomic_load(MCNT + threadIdx.x, __ATOMIC_RELAXED, __HIP_MEMORY_SCOPE_AGENT);
            __syncthreads();
            g1seen = true;
        }
        attn::MobaIo mio{};
        if (u < 1008) {
            const int v = u - 512, j = v >> 4, bh = v & 15, cnt = (int)__builtin_amdgcn_readfirstlane((int)CNL[bh * 32 + j]);
            if (cnt == 0) continue;
            mio.QL = (const unsigned short*)(p.ws + WS_MLIST) + ((size_t)bh * 32 + j) * S; mio.SEL3 = (const unsigned*)(p.ws + WS_SEL3) + (size_t)bh * S; mio.LSE = (float*)(p.ws + WS_MLSE) + (size_t)bh * S * 4;
            mio.PART0 = (attn::bf16*)(p.ws + WS_MP0) + (size_t)bh * S * 64; mio.PART1 = (attn::bf16*)(p.ws + WS_MP1) + (size_t)bh * S * 64; mio.PART2 = (attn::bf16*)(p.ws + WS_MP2) + (size_t)bh * S * 64;
            attn::moba4_unit<false>(bh >> 3, bh & 7, 0, j, cnt, QKVb, QKVb + 2 * SLOT, QKVb + 3 * SLOT, mio, lds);
        } else {
            const int v = u - 1520, qb = v >> 4, bh = v & 15;
            mio.LSE = (float*)(p.ws + WS_MLSE) + (size_t)bh * S * 4; mio.PART0 = (attn::bf16*)(p.ws + WS_MP3) + (size_t)bh * S * 64;
            attn::moba4_unit<true>(bh >> 3, bh & 7, qb, qb, 256, QKVb, QKVb + 2 * SLOT, QKVb + 3 * SLOT, mio, lds);
        }
    }
}
__device__ __forceinline__ void phase_moba_combine(const P& p) {
    const int TID = otid();
    bf16_t* OA = (bf16_t*)(p.ws + WS_QKV); const unsigned* SEL3 = (const unsigned*)(p.ws + WS_SEL3); const float* LSE = (const float*)(p.ws + WS_MLSE);
    const bf16_t* P0 = (const bf16_t*)(p.ws + WS_MP0); const bf16_t* P1 = (const bf16_t*)(p.ws + WS_MP1); const bf16_t* P2 = (const bf16_t*)(p.ws + WS_MP2); const bf16_t* P3 = (const bf16_t*)(p.ws + WS_MP3);
    for (int it = blockIdx.x * 512 + TID; it < Bn * NH * S * 8; it += gridDim.x * 512) {
        const int ch = it & 7, bq = it >> 3, bh = bq >> 13, q = bq & (S - 1), b = bh >> 3, h = bh & 7;
        const unsigned n = SEL3[bq] >> 15;
        bf16_t* orow = OA + ((size_t)b * S + q) * 512 + h * 64 + ch * 8;
        const u32x4 own = *(const u32x4*)(P3 + (size_t)bq * 64 + ch * 8);
        if (n == 0u) { *(u32x4*)orow = own; continue; }
        const f32x4 ls = *(const f32x4*)(LSE + (size_t)bq * 4);
        float m = fmaxf(ls[3], ls[0]); if (n > 1u) m = fmaxf(m, ls[1]); if (n > 2u) m = fmaxf(m, ls[2]);
        const float w3 = __builtin_amdgcn_exp2f(ls[3] - m), w0 = __builtin_amdgcn_exp2f(ls[0] - m), w1 = (n > 1u) ? __builtin_amdgcn_exp2f(ls[1] - m) : 0.f, w2 = (n > 2u) ? __builtin_amdgcn_exp2f(ls[2] - m) : 0.f;
        const float rw = 1.f / (w3 + w0 + w1 + w2);
        f32x4 a0, a1, x0, x1; pg8::unpack8(own, a0, a1); a0 = a0 * w3; a1 = a1 * w3;
        pg8::unpack8(*(const u32x4*)(P0 + (size_t)bq * 64 + ch * 8), x0, x1); a0 += x0 * w0; a1 += x1 * w0;
        if (n > 1u) { pg8::unpack8(*(const u32x4*)(P1 + (size_t)bq * 64 + ch * 8), x0, x1); a0 += x0 * w1; a1 += x1 * w1; }
        if (n > 2u) { pg8::unpack8(*(const u32x4*)(P2 + (size_t)bq * 64 + ch * 8), x0, x1); a0 += x0 * w2; a1 += x1 * w2; }
        *(u32x4*)orow = pg8::pack8(a0 * rw, a1 * rw);
    }
}

typedef float f32x2v __attribute__((ext_vector_type(2)));
__device__ __forceinline__ unsigned q8_pack(const f32x4& a, float sc, int bias) {
    const int q0 = (int)rintf(a[0] * sc) + bias, q1 = (int)rintf(a[1] * sc) + bias, q2 = (int)rintf(a[2] * sc) + bias, q3 = (int)rintf(a[3] * sc) + bias;
    return (unsigned)(q0 & 0xff) | ((unsigned)(q1 & 0xff) << 8) | ((unsigned)(q2 & 0xff) << 16) | ((unsigned)(q3 & 0xff) << 24); }
__device__ __forceinline__ void q8_row(const float* src, const float* gain, unsigned char* dst, size_t sstride, float* scale_out, int lane, int bias) {
    f32x4 a[4]; float am = 0.f;
#pragma unroll
    for (int q = 0; q < 4; ++q) { a[q] = *(const f32x4*)(src + 16 * lane + 4 * q);
        if (gain) { const f32x4 g = *(const f32x4*)(gain + 16 * lane + 4 * q); a[q][0] *= g[0]; a[q][1] *= g[1]; a[q][2] *= g[2]; a[q][3] *= g[3]; }
        am = fmaxf(fmaxf(am, fmaxf(fabsf(a[q][0]), fabsf(a[q][1]))), fmaxf(fabsf(a[q][2]), fabsf(a[q][3]))); }
    am = wave_max_fast(am);
    const float sc = am > 0.f ? 127.0f / am : 1.0f;
    u32x4 o;
#pragma unroll
    for (int q = 0; q < 4; ++q) o[q] = q8_pack(a[q], sc, bias);
    *(u32x4*)(dst + (sstride ? (size_t)(lane >> 3) * sstride + 16 * (lane & 7) : (size_t)16 * lane)) = o;
    if (lane == 0) *scale_out = am > 0.f ? am * (1.0f / 127.0f) : 1.0f;
}
__device__ __forceinline__ void q4_load(f32x4 (&a)[4], const float* src, int lane) {
#pragma unroll
    for (int q = 0; q < 4; ++q) a[q] = *(const f32x4*)(src + 16 * lane + 4 * q); }
template <bool USGN> __device__ __forceinline__ void q4_row(f32x4 (&a)[4], const float* gain, unsigned char* dst, float* scale_out, int lane) {
    float ss = 0.f;
#pragma unroll
    for (int q = 0; q < 4; ++q) {
        if (gain) { const f32x4 g = *(const f32x4*)(gain + 16 * lane + 4 * q); a[q][0] *= g[0]; a[q][1] *= g[1]; a[q][2] *= g[2]; a[q][3] *= g[3]; }
        ss += (a[q][0] * a[q][0] + a[q][1] * a[q][1]) + (a[q][2] * a[q][2] + a[q][3] * a[q][3]); }
    ss = wave_sum_fast(ss);
    const float step = sqrtf(ss * (1.f / D)) * 0.3352f, inv = step > 0.f ? 1.0f / step : 0.f;
    u32x2 o; o[0] = 0u; o[1] = 0u;
    int qs = 0;
#pragma unroll
    for (int i = 0; i < 16; ++i) { int q = (int)floorf(a[i >> 2][i & 3] * inv); q = min(max(q, -8), 7); qs += q;
        o[i >> 3] |= (unsigned)((USGN || (i & 1)) ? (q & 15) : (q + 8)) << (4 * (i & 7)); }
    *(u32x2*)(dst + (size_t)(lane >> 4) * ESLICE + 8 * (lane & 15)) = o;
    if (USGN) { const float rs = wave_sum_fast((float)qs); if (lane == 0) scale_out[2 * PNK * PNK] = rs; }
    if (lane == 0) *scale_out = step > 0.f ? step : 1.0f;
}
__device__ __forceinline__ void phase_combine_tables(const P& p) {
    const int TID = otid();
    const int lane = TID & 63, gw = (blockIdx.x * 512 + TID) >> 6, nw = (gridDim.x * 512) >> 6, stride = gridDim.x * 512;
    bf16_t* OA = (bf16_t*)(p.ws + WS_QKV); const unsigned* SEL3 = (const unsigned*)(p.ws + WS_SEL3); const float* LSE = (const float*)(p.ws + WS_MLSE);
    const bf16_t* P0 = (const bf16_t*)(p.ws + WS_MP0); const bf16_t* P1 = (const bf16_t*)(p.ws + WS_MP1); const bf16_t* P2 = (const bf16_t*)(p.ws + WS_MP2); const bf16_t* P3 = (const bf16_t*)(p.ws + WS_MP3);
#pragma unroll 1
    for (int k = 0; k < 8; ++k) {
        const int r = gw + k * nw, it = blockIdx.x * 512 + TID + k * stride, ch = it & 7, bq = it >> 3;
        const size_t po = (size_t)bq * 64 + ch * 8;
        f32x4 au[4], av[4];
        q4_load(au, p.eu + (size_t)r * D, lane); q4_load(av, p.ev + (size_t)r * D, lane);
        const unsigned nn = SEL3[bq]; const f32x4 ls = *(const f32x4*)(LSE + (size_t)bq * 4);
        const u32x4 own = *(const u32x4*)(P3 + po), q0 = *(const u32x4*)(P0 + po), q1 = *(const u32x4*)(P1 + po), q2 = *(const u32x4*)(P2 + po);
        {
            const int bh = bq >> 13, q = bq & (S - 1), b = bh >> 3, h = bh & 7; const unsigned n = nn >> 15;
            bf16_t* orow = OA + ((size_t)b * S + q) * 512 + h * 64 + ch * 8;
            float m = ls[3]; if (n > 0u) m = fmaxf(m, ls[0]); if (n > 1u) m = fmaxf(m, ls[1]); if (n > 2u) m = fmaxf(m, ls[2]);
            const float w3 = __builtin_amdgcn_exp2f(ls[3] - m), w0 = (n > 0u) ? __builtin_amdgcn_exp2f(ls[0] - m) : 0.f, w1 = (n > 1u) ? __builtin_amdgcn_exp2f(ls[1] - m) : 0.f, w2 = (n > 2u) ? __builtin_amdgcn_exp2f(ls[2] - m) : 0.f;
            const float rw = 1.f / (w3 + w0 + w1 + w2);
            const u32x4 z = {0u, 0u, 0u, 0u};
            f32x4 a0, a1, x0, x1; pg8::unpack8(own, a0, a1); a0 = a0 * w3; a1 = a1 * w3;
            pg8::unpack8((n > 0u) ? q0 : z, x0, x1); a0 += x0 * w0; a1 += x1 * w0;
            pg8::unpack8((n > 1u) ? q1 : z, x0, x1); a0 += x0 * w1; a1 += x1 * w1;
            pg8::unpack8((n > 2u) ? q2 : z, x0, x1); a0 += x0 * w2; a1 += x1 * w2;
            *(u32x4*)orow = (n == 0u) ? own : pg8::pack8(a0 * rw, a1 * rw); }
        q4_row<true>(au, p.g_ffn, p.ws + WS_EU + (size_t)r * 128, (float*)(p.ws + WS_USC) + r, lane);
        q4_row<false>(av, nullptr, p.ws + WS_EV + (size_t)r * 128, (float*)(p.ws + WS_VSC) + r, lane);
    }
}

typedef short bf16x8_t __attribute__((ext_vector_type(8)));
typedef float f32x16_t __attribute__((ext_vector_type(16)));
__device__ __forceinline__ unsigned f2ord(float f) { const unsigned u = __float_as_uint(f); return u ^ ((unsigned)((int)u >> 31) | 0x80000000u); }
__device__ __forceinline__ float ord2f(unsigned k) { return __uint_as_float((k & 0x80000000u) ? (k ^ 0x80000000u) : ~k); }
#define TK_CAS(a, b, desc) do { const unsigned hi__ = max(a, b), lo__ = min(a, b); if (desc) { a = hi__; b = lo__; } else { a = lo__; b = hi__; } } while (0)
__device__ __forceinline__ void tk_sort16(unsigned (&v)[16]) {
#define C(i, j) TK_CAS(v[i], v[j], true);
    C(0,1) C(2,3) C(0,2) C(1,3) C(1,2) C(4,5) C(6,7) C(4,6) C(5,7) C(5,6) C(0,4) C(2,6) C(2,4) C(1,5) C(3,7) C(3,5) C(1,2) C(3,4) C(5,6) C(8,9) C(10,11) C(8,10) C(9,11) C(9,10) C(12,13) C(14,15) C(12,14) C(13,15) C(13,14) C(8,12) C(10,14) C(10,12) C(9,13) C(11,15) C(11,13) C(9,10) C(11,12) C(13,14) C(0,8) C(4,12) C(4,8) C(2,10) C(6,14) C(6,10) C(2,4) C(6,8) C(10,12) C(1,9) C(5,13) C(5,9) C(3,11) C(7,15) C(7,11) C(3,5) C(7,9) C(11,13) C(1,2) C(3,4) C(5,6) C(7,8) C(9,10) C(11,12) C(13,14)
#undef C
}
__device__ __forceinline__ void tk_merge16(unsigned (&a)[16], const unsigned (&b)[16]) {
#pragma unroll
    for (int i = 0; i < 16; ++i) a[i] = max(a[i], b[15 - i]);
#pragma unroll
    for (int st = 8; st >= 1; st >>= 1)
#pragma unroll
        for (int i = 0; i < 16; ++i) if ((i & st) == 0) TK_CAS(a[i], a[i + st], true);
}
__host__ __device__ constexpr int tk_pair_rank(int i, int j) { int c = 0; for (int a = 0; a < 16; ++a) for (int b = 0; b < 16; ++b) { if (a == i && b == j) return c; if ((a + 1) * (b + 1) <= 16) ++c; } return c; }
__device__ __forceinline__ unsigned tk_lookup(unsigned long long lo, unsigned long long hi, int i) {
    const unsigned long long w = (i & 8) ? hi : lo; return (unsigned)(w >> ((i & 7) * 8)) & 0xffu; }
__device__ __forceinline__ void phase_h8(const P& p) {
    const int TID = otid();
    const int lane = TID & 63, gw = (blockIdx.x * blockDim.x + TID) >> 6, nw = (gridDim.x * blockDim.x) >> 6;
    for (int t = gw; t < T; t += nw) {
        const bf16_t* hb = (const bf16_t*)(p.ws + WS_XN) + (size_t)t * D + 16 * lane; const u32x4 h0 = *(const u32x4*)hb, h1 = *(const u32x4*)(hb + 8);
        f32x4 a[4]; float am = 0.f;
#pragma unroll
        for (int w = 0; w < 4; ++w) { const unsigned d = (w < 2) ? h0[2 * w] : h1[2 * (w - 2)], e = (w < 2) ? h0[2 * w + 1] : h1[2 * (w - 2) + 1];
            a[w][0] = __uint_as_float(d << 16); a[w][1] = __uint_as_float(d & 0xffff0000u); a[w][2] = __uint_as_float(e << 16); a[w][3] = __uint_as_float(e & 0xffff0000u);
            am = fmaxf(fmaxf(am, fmaxf(fabsf(a[w][0]), fabsf(a[w][1]))), fmaxf(fabsf(a[w][2]), fabsf(a[w][3]))); }
        am = wave_max_fast(am);
        const float sc = am > 0.f ? 127.0f / am : 1.0f;
        int hs = 0; u32x2 hh, hl; hh[0] = 0u; hh[1] = 0u; hl[0] = 0u; hl[1] = 0u;
#pragma unroll
        for (int w = 0; w < 4; ++w)
#pragma unroll
            for (int k = 0; k < 4; ++k) { const int qv = (int)rintf(a[w][k] * sc); hs += qv; const int n = 4 * (w & 1) + k;
                hh[w >> 1] |= (unsigned)((qv >> 4) & 15) << (4 * n); hl[w >> 1] |= (unsigned)((qv & 15) ^ 8) << (4 * n); }
        unsigned char* hb8 = p.ws + WS_H8 + (size_t)t * D + 32 * (lane >> 1) + 8 * (lane & 1);
        *(u32x2*)hb8 = hh; *(u32x2*)(hb8 + 16) = hl;
        const float hc = wave_sum_fast(0.5f * (float)hs);
        if (lane == 0) { ((float*)(p.ws + WS_HSC))[t] = am > 0.f ? am * (1.0f / 127.0f) : 1.0f; ((float*)(p.ws + WS_HSC))[T + t] = hc; }
    }
}
__device__ __forceinline__ void phase_peer_topk(LAS unsigned char* ldsb, const P& p, const pg8::StaticOrder& So) {
    const int TID = otid();
    const int lane = TID & 63, r32 = lane & 31, hi = lane >> 5, wave = TID >> 6;
    const bf16_t* PQ = (const bf16_t*)(p.ws + WS_PQ); const bf16_t* SKb = (const bf16_t*)(p.ws + WS_SK); int* IDX = (int*)(p.ws + WS_IDX); float* GATE = (float*)(p.ws + WS_GATE);
    pg8::Unit un;
    for (int ui = 0; So.next(ui, un); ++ui) {
        const int tg = un.pm * 8 + wave, h = un.pn, t = tg * 32 + r32;
        __syncthreads();
#pragma unroll
        for (int j = 0; j < 8; ++j) { const int q = TID + 512 * j, pp_ = q >> 11, row = (q >> 4) & 127, ch = q & 15;
            *(LAS u32x4*)(ldsb + pp_ * 32768 + row * 256 + ((ch ^ (row & 15)) * 16)) = *(const u32x4*)(SKb + ((size_t)(h * 2 + pp_) * PNK + row) * PHALF + ch * 8); }
        u32x4 qfr[2][8];
#pragma unroll
        for (int pp = 0; pp < 2; ++pp)
#pragma unroll
            for (int ks = 0; ks < 8; ++ks) qfr[pp][ks] = *(const u32x4*)(PQ + (size_t)t * PQC + h * 256 + pp * 128 + 8 * hi + 16 * ks);
        __syncthreads();
        unsigned K0[16], K1[16];
#pragma unroll
        for (int pp = 0; pp < 2; ++pp) {
            f32x16_t acc[4];
#pragma unroll
            for (int mt = 0; mt < 4; ++mt) acc[mt] = f32x16_t{};
#pragma unroll
            for (int ks = 0; ks < 8; ++ks) {
                const bf16x8_t qf = __builtin_bit_cast(bf16x8_t, qfr[pp][ks]);
#pragma unroll
                for (int mt = 0; mt < 4; ++mt) { const int row = 32 * mt + r32;
                    const bf16x8_t kf = __builtin_bit_cast(bf16x8_t, *(const LAS u32x4*)(ldsb + pp * 32768 + row * 256 + (((2 * ks + hi) ^ (row & 15)) * 16)));
                    acc[mt] = __builtin_amdgcn_mfma_f32_32x32x16_bf16(kf, qf, acc[mt], 0, 0, 0); }
            }
            unsigned L[16], L1[16], L2[16], L3[16];
            const unsigned h4 = 4u * (unsigned)hi;
#pragma unroll
            for (int r = 0; r < 16; ++r) { const unsigned lowb = (unsigned)(127 - (r & 3) - 8 * (r >> 2)) - h4;
                L[r] = (f2ord(acc[0][r]) & ~127u) | lowb; L1[r] = (f2ord(acc[1][r]) & ~127u) | (lowb - 32u); L2[r] = (f2ord(acc[2][r]) & ~127u) | (lowb - 64u); L3[r] = (f2ord(acc[3][r]) & ~127u) | (lowb - 96u); }
            tk_sort16(L); tk_sort16(L1); tk_sort16(L2); tk_sort16(L3);
            tk_merge16(L, L1); tk_merge16(L2, L3); tk_merge16(L, L2);
            unsigned M[16];
#pragma unroll
            for (int i = 0; i < 16; ++i) { const auto r_ = __builtin_amdgcn_permlane32_swap(L[i], L[i], false, false); M[i] = hi ? r_[0] : r_[1]; }
            tk_merge16(L, M);
#pragma unroll
            for (int i = 0; i < 16; ++i) { if (pp == 0) K0[i] = L[i]; else K1[i] = L[i]; }
        }
        float v0[16], v1[16]; unsigned long long t0lo = 0ull, t0hi = 0ull, t1lo = 0ull, t1hi = 0ull;
#pragma unroll
        for (int i = 0; i < 16; ++i) { v0[i] = ord2f(K0[i] & ~127u); v1[i] = ord2f(K1[i] & ~127u);
            const unsigned long long e0 = (unsigned long long)(127u - (K0[i] & 127u)) << ((i & 7) * 8), e1 = (unsigned long long)(127u - (K1[i] & 127u)) << ((i & 7) * 8);
            if (i < 8) { t0lo |= e0; t1lo |= e1; } else { t0hi |= e0; t1hi |= e1; } }
        unsigned Bk[16], B1[16], B2[16], B3[16];
#pragma unroll
        for (int i = 0; i < 16; ++i) { Bk[i] = 0u; B1[i] = 0u; B2[i] = 0u; B3[i] = 0u; }
#pragma unroll
        for (int i = 0; i < 16; ++i)
#pragma unroll
            for (int j = 0; j < 16; ++j) if ((i + 1) * (j + 1) <= 16) {
                const unsigned key = (f2ord(v0[i] + v1[j]) & ~255u) | (unsigned)(255 - (i * 16 + j));
                const int rk = tk_pair_rank(i, j);
                if ((rk >> 4) == 0) Bk[rk & 15] = key; else if ((rk >> 4) == 1) B1[rk & 15] = key; else if ((rk >> 4) == 2) B2[rk & 15] = key; else B3[rk & 15] = key; }
#pragma unroll
        for (int i = 0; i < 16; ++i) { Bk[i] = hi ? B2[i] : Bk[i]; B1[i] = hi ? B3[i] : B1[i]; }
        tk_sort16(Bk); tk_sort16(B1); tk_merge16(Bk, B1);
#pragma unroll
        for (int i = 0; i < 16; ++i) { const auto r_ = __builtin_amdgcn_permlane32_swap(Bk[i], Bk[i], false, false); B2[i] = hi ? r_[0] : r_[1]; }
        tk_merge16(Bk, B2);
        float rstd;
        { const f32x4* rp = (const f32x4*)((const float*)(p.ws + WS_RSSP) + (size_t)t * 16); const f32x4 s4 = (rp[0] + rp[1]) + (rp[2] + rp[3]);
          rstd = rsqrtf(((s4[0] + s4[1]) + (s4[2] + s4[3])) * (1.f / D) + EPS); }
        float gt[16]; int ex[16]; float sum = 0.f; const float best0 = ord2f(Bk[0] & ~255u);
#pragma unroll
        for (int r = 0; r < 16; ++r) { const float bv = ord2f(Bk[r] & ~255u); gt[r] = __expf(rstd * (bv - best0)); sum += gt[r];
            const int flat = 255 - (int)(Bk[r] & 255u); ex[r] = (int)tk_lookup(t0lo, t0hi, flat >> 4) * PNK + (int)tk_lookup(t1lo, t1hi, flat & 15); }
        const float rs = 1.f / sum;
        if (hi == 0) {
#pragma unroll
            for (int q = 0; q < 4; ++q) {
                u32x4 iv; iv.x = (unsigned)ex[4 * q]; iv.y = (unsigned)ex[4 * q + 1]; iv.z = (unsigned)ex[4 * q + 2]; iv.w = (unsigned)ex[4 * q + 3];
                *(u32x4*)(IDX + ((size_t)t * PH + h) * PK + 4 * q) = iv;
                f32x4 gv; gv[0] = gt[4 * q] * rs; gv[1] = gt[4 * q + 1] * rs; gv[2] = gt[4 * q + 2] * rs; gv[3] = gt[4 * q + 3] * rs;
                *(f32x4*)(GATE + ((size_t)t * PH + h) * PK + 4 * q) = gv; }
        }
    }
}

__device__ __forceinline__ float gelu_exact(float v) {
    const float av = fabsf(v), t = __builtin_amdgcn_rcpf(av * 0.2316418882f + 1.0f);
    float q = t * 0.5307027145f + (-0.7265760135f); q = q * t + 0.7107068705f; q = q * t + (-0.142248368f); q = q * t + 0.127414796f; q = q * t;
    const float e = __builtin_amdgcn_exp2f((v * v) * (-0.72134752044f)), m = v * (q * e);
    return v < 0.f ? m : v - m;
}
#define EX_HALVE16(d, m2, m1, m0, u2, u1, u0, r0, r1) do { float h8_[8], h4_[4]; \
        _Pragma("unroll") for (int i_ = 0; i_ < 8; ++i_) { const float k_ = (u2) ? d[i_ + 8] : d[i_], s_ = (u2) ? d[i_] : d[i_ + 8]; h8_[i_] = k_ + __shfl_xor(s_, (m2)); } \
        _Pragma("unroll") for (int i_ = 0; i_ < 4; ++i_) { const float k_ = (u1) ? h8_[i_ + 4] : h8_[i_], s_ = (u1) ? h8_[i_] : h8_[i_ + 4]; h4_[i_] = k_ + __shfl_xor(s_, (m1)); } \
        { const float k0_ = (u0) ? h4_[2] : h4_[0], s0_ = (u0) ? h4_[0] : h4_[2], k1_ = (u0) ? h4_[3] : h4_[1], s1_ = (u0) ? h4_[1] : h4_[3]; r0 = k0_ + __shfl_xor(s0_, (m0)); r1 = k1_ + __shfl_xor(s1_, (m0)); } } while (0)
#define EX_HALVE16_SWAP(d, u0, r0, r1) do { float h8_[8], h4_[4]; \
        _Pragma("unroll") for (int i_ = 0; i_ < 8; ++i_) { const auto q_ = __builtin_amdgcn_permlane32_swap(__float_as_uint(d[i_]), __float_as_uint(d[i_ + 8]), false, false); h8_[i_] = __uint_as_float(q_[0]) + __uint_as_float(q_[1]); } \
        _Pragma("unroll") for (int i_ = 0; i_ < 4; ++i_) { const auto q_ = __builtin_amdgcn_permlane16_swap(__float_as_uint(h8_[i_]), __float_as_uint(h8_[i_ + 4]), false, false); h4_[i_] = __uint_as_float(q_[0]) + __uint_as_float(q_[1]); } \
        { const float k0_ = (u0) ? h4_[2] : h4_[0], s0_ = (u0) ? h4_[0] : h4_[2], k1_ = (u0) ? h4_[3] : h4_[1], s1_ = (u0) ? h4_[1] : h4_[3]; \
          r0 = k0_ + __builtin_bit_cast(float, __builtin_amdgcn_update_dpp(0, __builtin_bit_cast(int, s0_), 0x128, 0xf, 0xf, true)); r1 = k1_ + __builtin_bit_cast(float, __builtin_amdgcn_update_dpp(0, __builtin_bit_cast(int, s1_), 0x128, 0xf, 0xf, true)); } } while (0)
#define EX_HALVE16_SWAP_I(d, u0, r0, r1) do { int h8_[8], h4_[4]; \
        _Pragma("unroll") for (int i_ = 0; i_ < 8; ++i_) { const auto q_ = __builtin_amdgcn_permlane32_swap((unsigned)d[i_], (unsigned)d[i_ + 8], false, false); h8_[i_] = (int)(q_[0] + q_[1]); } \
        _Pragma("unroll") for (int i_ = 0; i_ < 4; ++i_) { const auto q_ = __builtin_amdgcn_permlane16_swap((unsigned)h8_[i_], (unsigned)h8_[i_ + 4], false, false); h4_[i_] = (int)(q_[0] + q_[1]); } \
        { const int k0_ = (u0) ? h4_[2] : h4_[0], s0_ = (u0) ? h4_[0] : h4_[2], k1_ = (u0) ? h4_[3] : h4_[1], s1_ = (u0) ? h4_[1] : h4_[3]; \
          r0 = k0_ + __builtin_amdgcn_update_dpp(0, s0_, 0x128, 0xf, 0xf, true); r1 = k1_ + __builtin_amdgcn_update_dpp(0, s1_, 0x128, 0xf, 0xf, true); } } while (0)
struct ExIds { u32x4 i0, i1, i2, i3; };
struct ExAux { u32x4 w0; f32x4 y; };
__device__ __forceinline__ void ex_ids(ExIds& I, const P& p, int t, int g) {
    const u32x4* ip = (const u32x4*)((const int*)(p.ws + WS_IDX) + (size_t)t * 128 + 16 * g); I.i0 = ip[0]; I.i1 = ip[1]; I.i2 = ip[2]; I.i3 = ip[3]; }
template <int PASS> __device__ __forceinline__ void ex_gather(u32x4 (&buf)[16], ExAux& X, const ExIds& I, const P& p, int t, int x, int g, int c) {
    const __amdgpu_buffer_rsrc_t TAB = __builtin_amdgcn_make_buffer_rsrc((void*)(p.ws + (PASS == 0 ? WS_EU : WS_EV) + (size_t)x * ESLICE), 0, (int)ESLICE, 0x00020000);
#pragma unroll
    for (int j = 0; j < 16; ++j) { const unsigned e = (j < 4) ? I.i0[j & 3] : (j < 8) ? I.i1[j & 3] : (j < 12) ? I.i2[j & 3] : I.i3[j & 3];
        buf[j] = __builtin_amdgcn_raw_buffer_load_b128(TAB, (int)(e * 128u) + 16 * c, 0, 0); }
    if constexpr (PASS == 0) { const u32x4* hp8 = (const u32x4*)(p.ws + WS_H8 + (size_t)t * D + x * 256 + 32 * c); X.w0 = hp8[0]; X.y = __builtin_bit_cast(f32x4, hp8[1]); }
    else { X.w0 = *(const u32x4*)(p.ws + WS_A + (size_t)t * 128 + 16 * g);
           const bf16_t* hp = (const bf16_t*)(p.ws + WS_XN) + (size_t)t * D + x * 256 + 32 * c + 2 * g; const unsigned hw = *(const unsigned*)hp, hw1 = *(const unsigned*)(hp + 16);
           X.y[0] = __uint_as_float(hw << 16); X.y[1] = __uint_as_float(hw & 0xffff0000u); X.y[2] = __uint_as_float(hw1 << 16); X.y[3] = __uint_as_float(hw1 & 0xffff0000u); }
}
template <int PASS> __device__ __forceinline__ void ex_compute(const u32x4 (&buf)[16], const ExAux& X, const P& p, int t, int x, int lane, int g, int c, float asc, float cs, float& o0, float& o1) {
    float d[16];
    if constexpr (PASS == 0) {
        const u32x4 w1 = __builtin_bit_cast(u32x4, X.y);
#pragma unroll
        for (int j = 0; j < 16; ++j) { int aH = 0, aL = 0;
#pragma unroll
            for (int q = 0; q < 4; ++q) { aH = __builtin_amdgcn_sdot8((int)buf[j][q], (int)X.w0[q], aH, false); aL = __builtin_amdgcn_sdot8((int)buf[j][q], (int)w1[q], aL, false); }
            d[j] = (float)((aH << 4) + aL); }
        float r0, r1;
        EX_HALVE16(d, 4, 2, 1, (lane & 4) != 0, (lane & 2) != 0, (lane & 1) != 0, r0, r1);
        o0 += r0; o1 += r1;
    } else {
        float osq = 0.f;
#pragma unroll
        for (int hf = 0; hf < 2; ++hf) {
            int ai[16];
#pragma unroll
            for (int i = 0; i < 16; ++i) ai[i] = 0;
#pragma unroll
            for (int j4 = 0; j4 < 4; ++j4) { const int a4 = (int)X.w0[j4];
#pragma unroll
                for (int q2 = 0; q2 < 2; ++q2) { const int q = 2 * hf + q2; const unsigned r0_ = buf[4 * j4][q], r1_ = buf[4 * j4 + 1][q], r2_ = buf[4 * j4 + 2][q], r3_ = buf[4 * j4 + 3][q];
                    const unsigned t0 = __builtin_amdgcn_perm(r1_, r0_, 0x05010400u), t1 = __builtin_amdgcn_perm(r1_, r0_, 0x07030602u), t2 = __builtin_amdgcn_perm(r3_, r2_, 0x05010400u), t3 = __builtin_amdgcn_perm(r3_, r2_, 0x07030602u);
                    const unsigned c0_ = __builtin_amdgcn_perm(t2, t0, 0x05040100u), c1_ = __builtin_amdgcn_perm(t2, t0, 0x07060302u), c2_ = __builtin_amdgcn_perm(t3, t1, 0x05040100u), c3_ = __builtin_amdgcn_perm(t3, t1, 0x07060302u);
                    ai[8 * q2 + 0] = __builtin_amdgcn_sdot4((int)(c0_ & 0x0f0f0f0fu), a4, ai[8 * q2 + 0], false); ai[8 * q2 + 1] = __builtin_amdgcn_sdot4((int)c0_, a4, ai[8 * q2 + 1], false);
                    ai[8 * q2 + 2] = __builtin_amdgcn_sdot4((int)(c1_ & 0x0f0f0f0fu), a4, ai[8 * q2 + 2], false); ai[8 * q2 + 3] = __builtin_amdgcn_sdot4((int)c1_, a4, ai[8 * q2 + 3], false);
                    ai[8 * q2 + 4] = __builtin_amdgcn_sdot4((int)(c2_ & 0x0f0f0f0fu), a4, ai[8 * q2 + 4], false); ai[8 * q2 + 5] = __builtin_amdgcn_sdot4((int)c2_, a4, ai[8 * q2 + 5], false);
                    ai[8 * q2 + 6] = __builtin_amdgcn_sdot4((int)(c3_ & 0x0f0f0f0fu), a4, ai[8 * q2 + 6], false); ai[8 * q2 + 7] = __builtin_amdgcn_sdot4((int)c3_, a4, ai[8 * q2 + 7], false); }
                asm volatile("" : "+v"(ai[0]), "+v"(ai[1]), "+v"(ai[2]), "+v"(ai[3]), "+v"(ai[4]), "+v"(ai[5]), "+v"(ai[6]), "+v"(ai[7]), "+v"(ai[8]), "+v"(ai[9]), "+v"(ai[10]), "+v"(ai[11]), "+v"(ai[12]), "+v"(ai[13]), "+v"(ai[14]), "+v"(ai[15]));
                __builtin_amdgcn_sched_barrier(0); }
            int i0, i1;
            EX_HALVE16_SWAP_I(ai, (lane & 8) != 0, i0, i1);
            const float r0 = (float)i0 * asc, r1 = (float)(i1 - i0) * (asc * 0.0625f);
            f32x2v y; y[0] = X.y[2 * hf] + (r0 - 7.5f * cs); y[1] = X.y[2 * hf + 1] + (r1 + 0.5f * cs);
            *(f32x2v*)(p.out + (size_t)t * D + x * 256 + 32 * c + 16 * hf + 2 * g) = y;
            osq += y[0] * y[0] + y[1] * y[1];
        }
        o0 += osq;
    }
}
typedef float f32x2l __attribute__((ext_vector_type(2)));
template <int PASS> __device__ __forceinline__ void ex_pass(const P& p, int tb, int lane, int g, int c, LAS f32x2l* acc, const LAS float* ascl) {
    u32x4 bA[16], bB[16]; ExAux xA, xB; ExIds I;
    ex_ids(I, p, tb, g);
    ex_gather<PASS>(bA, xA, I, p, tb, 0, g, c);
    ex_ids(I, p, tb + 1, g);
    constexpr int NS = 32;
#pragma unroll 1
    for (int s_ = 0; s_ < NS; s_ += 2) {
        const int x = s_ >> 3, i = s_ & 7, s2 = min(s_ + 2, NS - 1), x2 = s2 >> 3, i2 = s2 & 7;
        ex_gather<PASS>(bB, xB, I, p, tb + i + 1, x, g, c);
        ex_ids(I, p, tb + i2, g);
        { float o0 = 0.f, o1 = 0.f; ex_compute<PASS>(bA, xA, p, tb + i, x, lane, g, c, (PASS == 1) ? ascl[i] : 0.f, (PASS == 1) ? ascl[8 + i] : 0.f, o0, o1); f32x2l v = acc[i * 64 + lane]; v[0] += o0; v[1] += o1; acc[i * 64 + lane] = v; }
        ex_gather<PASS>(bA, xA, I, p, tb + i2, x2, g, c);
        ex_ids(I, p, tb + ((i2 + 1) & 7), g);
        { float o0 = 0.f, o1 = 0.f; ex_compute<PASS>(bB, xB, p, tb + i + 1, x, lane, g, c, (PASS == 1) ? ascl[i + 1] : 0.f, (PASS == 1) ? ascl[9 + i] : 0.f, o0, o1); f32x2l v = acc[(i + 1) * 64 + lane]; v[0] += o0; v[1] += o1; acc[(i + 1) * 64 + lane] = v; }
    }
}
__device__ __forceinline__ void phase_experts(LAS unsigned char* ldsb, const P& p) {
    const int TID = otid();
    const int lane = TID & 63, wave = TID >> 6, g = lane >> 3, c = lane & 7, tb = (blockIdx.x * 8 + wave) * 8;
    const float* USC = (const float*)(p.ws + WS_USC); const float* VSC = (const float*)(p.ws + WS_VSC);
    LAS f32x2l* acc = (LAS f32x2l*)(ldsb + wave * 8192); LAS float* ascl = (LAS float*)(ldsb + wave * 8192 + 4096);
#pragma unroll
    for (int i = 0; i < 8; ++i) { f32x2l z; z[0] = 0.f; z[1] = 0.f; acc[i * 64 + lane] = z; }
    ex_pass<0>(p, tb, lane, g, c, acc, ascl);
#pragma unroll 1
    for (int i = 0; i < 8; ++i) { const int t = tb + i, k0 = 16 * g + 2 * c;
        float rstd;
        { const f32x4* rp = (const f32x4*)((const float*)(p.ws + WS_RSSP) + (size_t)t * 16); const f32x4 s4 = (rp[0] + rp[1]) + (rp[2] + rp[3]);
          rstd = rsqrtf(((s4[0] + s4[1]) + (s4[2] + s4[3])) * (1.f / D) + EPS); }
        const u32x2 e = *(const u32x2*)((const int*)(p.ws + WS_IDX) + (size_t)t * 128 + k0);
        const f32x2v gt = *(const f32x2v*)((const float*)(p.ws + WS_GATE) + (size_t)t * 128 + k0);
        const float hs = rstd * ((const float*)(p.ws + WS_HSC))[t], hc = ((const float*)(p.ws + WS_HSC))[T + t];
        f32x2l hv = acc[i * 64 + lane]; hv[0] += hc; hv[1] += hc;
        const float a0 = gt[0] * gelu_exact(hs * USC[e.x] * (hv[0] + 8.f * USC[2 * PNK * PNK + e.x])) * VSC[e.x], a1 = gt[1] * gelu_exact(hs * USC[e.y] * (hv[1] + 8.f * USC[2 * PNK * PNK + e.y])) * VSC[e.y];
        const float am = wave_max_fast(fmaxf(fabsf(a0), fabsf(a1))), sc = am > 0.f ? 127.0f / am : 1.0f;
        const int q0 = (int)rintf(a0 * sc), q1 = (int)rintf(a1 * sc);
        *(unsigned short*)(p.ws + WS_A + (size_t)t * 128 + k0) = (unsigned short)((q0 & 0xff) | ((q1 & 0xff) << 8));
        const float asum = wave_sum_fast((float)(q0 + q1)), asc_ = am > 0.f ? am * (1.0f / 127.0f) : 1.0f;
        if (lane == 0) { ascl[i] = asc_; ascl[8 + i] = asc_ * asum; }
        f32x2l z; z[0] = 0.f; z[1] = 0.f; acc[i * 64 + lane] = z; }
    asm volatile("s_waitcnt vmcnt(0) lgkmcnt(0)" ::: "memory");
    ex_pass<1>(p, tb, lane, g, c, acc, ascl);
    asm volatile("s_waitcnt vmcnt(0) lgkmcnt(0)" ::: "memory");
#pragma unroll 1
    for (int i = 0; i < 8; ++i) { const f32x2l q = acc[i * 64 + lane]; const float r2 = rsqrtf(wave_sum_fast(q[0]) * (1.f / D) + EPS);
        f32x4* orow = (f32x4*)(p.out + (size_t)(tb + i) * D);
#pragma unroll
        for (int j = 0; j < 4; ++j) { const f32x4 gf = ((const f32x4*)p.g_fin)[lane + 64 * j]; f32x4 y = orow[lane + 64 * j] * r2; y[0] *= gf[0]; y[1] *= gf[1]; y[2] *= gf[2]; y[3] *= gf[3]; orow[lane + 64 * j] = y; } }
}
#undef EX_HALVE16
#undef EX_HALVE16_SWAP
#undef EX_HALVE16_SWAP_I

#define LAS __attribute__((address_space(3)))
#define XB_TMO      128
#define XB_XCNT(j)  (256  + 64 * (j))
#define XB_XSUB(j)  (1280 + 64 * (j))
#define XB_XGEN(j)  (2304 + 64 * (j))
#define XB_TOP      3328
#define XB_TOPGEN   3392
#define XCD_BAR_WORDS 3456
#define XB_SPIN_CAP (1u << 22)
__device__ __forceinline__ unsigned xb_ld(unsigned* p)              { return __hip_atomic_load(p, __ATOMIC_RELAXED, __HIP_MEMORY_SCOPE_AGENT); }
__device__ __forceinline__ unsigned xb_add(unsigned* p, unsigned v) { return __hip_atomic_fetch_add(p, v, __ATOMIC_RELAXED, __HIP_MEMORY_SCOPE_AGENT); }
__device__ __forceinline__ unsigned xb_xcc_id() { return (unsigned)__builtin_amdgcn_s_getreg((3 << 11) | 20) & 0xFu; }
#define XB_SPIN(cond, bar) do { unsigned _sp = 0; while (cond) { __builtin_amdgcn_s_sleep(1); \
    if ((++_sp & 255u) == 0u) { if (xb_ld(&(bar)[XB_TMO])) break; if (_sp > XB_SPIN_CAP) { atomicAdd(&(bar)[XB_TMO], 1u); break; } } } } while (0)
struct XcdBarrier { unsigned* bar; unsigned x; volatile LAS unsigned* st; };
__device__ __forceinline__ XcdBarrier xcd_barrier_post(unsigned* bar, volatile LAS unsigned* st) {
    XcdBarrier b; b.bar = bar; b.x = xb_xcc_id(); b.st = st;
    if (threadIdx.x == 0) (void)xb_add(&bar[XB_XCNT(b.x)], 1u);
    return b;
}
__device__ __forceinline__ void xcd_barrier_complete(unsigned* bar, unsigned x, unsigned& nloc, unsigned& nx) {
    const unsigned G = gridDim.x * gridDim.y * gridDim.z;
    unsigned sum, cnt, mine, sp = 0u;
    for (;;) {
        sum = 0u; cnt = 0u; mine = 0u;
#pragma unroll
        for (unsigned j = 0; j < 16; ++j) { const unsigned c = xb_ld(&bar[XB_XCNT(j)]); sum += c; cnt += (c > 0u) ? 1u : 0u; mine = (j == x) ? c : mine; }
        if (sum == G) break;
        __builtin_amdgcn_s_sleep(1);
        if ((++sp & 255u) == 0u) { if (xb_ld(&bar[XB_TMO])) break; if (sp > XB_SPIN_CAP) { atomicAdd(&bar[XB_TMO], 1u); break; } }
    }
    nloc = mine > 0u ? mine : 1u; nx = cnt > 0u ? cnt : 1u;
}
__device__ __forceinline__ void xcd_barrier(const XcdBarrier& b) {
    asm volatile("s_waitcnt vmcnt(0)" ::: "memory");
    __syncthreads();
    if (threadIdx.x == 0) {
        unsigned* bar = b.bar;
        __builtin_amdgcn_s_waitcnt(0);
        unsigned nloc = b.st[0], nx = b.st[1];
        if (nloc == 0u) { xcd_barrier_complete(bar, b.x, nloc, nx); b.st[0] = nloc; b.st[1] = nx; }
        const unsigned old = xb_add(&bar[XB_XSUB(b.x)], 1u);
        const unsigned gen = old / nloc;
        if (old + 1u == (gen + 1u) * nloc) {
            __builtin_amdgcn_fence(__ATOMIC_RELEASE, "agent");
            asm volatile("s_waitcnt vmcnt(0)" ::: "memory");
            const unsigned og = xb_add(&bar[XB_TOP], 1u);
            const unsigned tg = og / nx;
            if (og + 1u == (tg + 1u) * nx) xb_add(&bar[XB_TOPGEN], 1u);
            else XB_SPIN(xb_ld(&bar[XB_TOPGEN]) == tg, bar);
            __builtin_amdgcn_fence(__ATOMIC_ACQUIRE, "agent");
            xb_add(&bar[XB_XGEN(b.x)], 1u);
            asm volatile("s_waitcnt vmcnt(0)" ::: "memory");
        } else {
            XB_SPIN(xb_ld(&bar[XB_XGEN(b.x)]) == gen, bar);
            __builtin_amdgcn_fence(__ATOMIC_ACQUIRE, "agent");
            asm volatile("s_waitcnt vmcnt(0)" ::: "memory");
        }
    }
    __syncthreads();
}

constexpr int NT = 512;
constexpr int LDS_BYTES = 147456;
constexpr int MISC_OFF = 131072;

__global__ void __launch_bounds__(NT, 2) mega(P p) {
    extern __shared__ __attribute__((aligned(16))) unsigned char lds_raw[];
    float* lds = (float*)lds_raw;
    LAS unsigned char* ldsb = (LAS unsigned char*)lds_raw;
    volatile LAS unsigned* MISC = (volatile LAS unsigned*)(ldsb + MISC_OFF);
    if (threadIdx.x < 32) MISC[threadIdx.x] = 0u;
    __syncthreads();
    XcdBarrier bar = xcd_barrier_post((unsigned*)p.ws, MISC + 8);
#define GRID_BAR() xcd_barrier(bar)
    const int G = gridDim.x;
    bf16_t* QKV = (bf16_t*)(p.ws + WS_QKV);
    phase_prologue(ldsb, p);
    GRID_BAR();
    phase_cumsum(p);
    { pg8::Gemm g{(const bf16_t*)(p.ws + WS_XN), (const bf16_t*)(p.ws + WS_WIN), T, 5120, D / 2}; pg8::StaticOrder So; So.init(T, 5120, G, (int)blockIdx.x);
      pg8::EpiProj E{QKV, (bf16_t*)(p.ws + WS_G), (const float*)(p.ws + WS_ROPE), (float*)(p.ws + WS_KMP), (float*)(p.ws + WS_FKN), (float*)(p.ws + WS_FQN)};
      pg8::gemm_phase<pg8::EpiProj, pg8::StaticOrder, true, true, true>(ldsb, g, So, E); }
    GRID_BAR();
    phase_attn((char*)lds_raw, MISC, p);
    GRID_BAR();
    phase_combine_tables(p);
    GRID_BAR();
    { pg8::Gemm g{QKV, (const bf16_t*)(p.ws + WS_WA), T, D, 512}; pg8::StaticOrder So; So.init(T, D, G, (int)blockIdx.x);
      pg8::EpiMerge E{(bf16_t*)(p.ws + WS_MERGED), (const bf16_t*)(p.ws + WS_G), true};
      pg8::gemm_phase<pg8::EpiMerge, pg8::StaticOrder, true, true>(ldsb, g, So, E); }
    { pg8::Gemm g{QKV + SLOT, (const bf16_t*)(p.ws + WS_WB), T, D, 512}; pg8::StaticOrder So; So.init(T, D, G, (int)blockIdx.x);
      pg8::EpiMerge E{(bf16_t*)(p.ws + WS_MERGED), (const bf16_t*)(p.ws + WS_G) + (size_t)T * D, false};
      pg8::gemm_phase<pg8::EpiMerge, pg8::StaticOrder, true, true>(ldsb, g, So, E); }
    GRID_BAR();
    { pg8::Gemm g{(const bf16_t*)(p.ws + WS_MERGED), (const bf16_t*)(p.ws + WS_WOUT), T, D, D}; pg8::StaticOrder So; So.init(T, D, G, (int)blockIdx.x);
      pg8::EpiOut E{p.x, p.out, (bf16_t*)(p.ws + WS_XN), (float*)(p.ws + WS_RSSP)};
      pg8::gemm_phase<pg8::EpiOut, pg8::StaticOrder, true, true>(ldsb, g, So, E); }
    GRID_BAR();
    { pg8::Gemm g{(const bf16_t*)(p.ws + WS_XN), (const bf16_t*)(p.ws + WS_WPQ), T, PQC, D}; pg8::StaticOrder So; So.init(T, PQC, G, (int)blockIdx.x);
      pg8::EpiStore E{(bf16_t*)(p.ws + WS_PQ), PQC};
      pg8::gemm_phase<pg8::EpiStore, pg8::StaticOrder, true, true>(ldsb, g, So, E);
      phase_peer_topk(ldsb, p, So); }
    phase_h8(p);
    GRID_BAR();
    phase_experts(ldsb, p);
}

extern "C" void kernel_launch(void* const* d_in, const int* in_sizes, int n_in, void* d_out, int out_size, void* d_ws, size_t ws_size, hipStream_t stream) {
    static int grid = 0;
    if (grid == 0) {
        int dev = 0, cus = 0, per_cu = 0;
        if (hipGetDevice(&dev) != hipSuccess || hipDeviceGetAttribute(&cus, hipDeviceAttributeMultiprocessorCount, dev) != hipSuccess) { fprintf(stderr, "kernel_launch: device query failed\n"); grid = -1; return; }
        if (hipFuncSetAttribute((const void*)mega, hipFuncAttributeMaxDynamicSharedMemorySize, LDS_BYTES) != hipSuccess) { fprintf(stderr, "kernel_launch: hipFuncSetAttribute failed\n"); grid = -1; return; }
        if (hipOccupancyMaxActiveBlocksPerMultiprocessor(&per_cu, (const void*)mega, NT, LDS_BYTES) != hipSuccess || per_cu < 1) { fprintf(stderr, "kernel_launch: occupancy query says %d blocks per CU\n", per_cu); (void)hipGetLastError(); grid = -1; return; }
        if (cus < 256) { fprintf(stderr, "kernel_launch: built for a 256-CU device, found %d CUs\n", cus); grid = -1; return; }
        grid = 256;
    }
    if (grid < 0) return;
    (void)hipMemsetAsync(d_ws, 0, CTL_ZERO_BYTES, stream);
    P p{};
    p.x = (const float*)d_in[0]; p.g_mix = (const float*)d_in[1]; p.w_in = (const float*)d_in[2]; p.b_f = (const float*)d_in[3];
    p.w_a = (const float*)d_in[4]; p.w_b = (const float*)d_in[5]; p.w_out = (const float*)d_in[6]; p.g_ffn = (const float*)d_in[7];
    p.w_pq = (const float*)d_in[8]; p.sk = (const float*)d_in[9]; p.eu = (const float*)d_in[10]; p.ev = (const float*)d_in[11]; p.g_fin = (const float*)d_in[12];
    p.out = (float*)d_out; p.ws = (unsigned char*)d_ws;
    hipLaunchKernelGGL(mega, dim3(grid), dim3(NT), LDS_BYTES, stream, p);
}
```

```cpp
#include <hip/hip_runtime.h>
#include <cstdio>
#include <cstdint>
#include <cmath>

constexpr int Bn = 2, S = 8192, D = 1024, T = Bn * S;
constexpr int HD = 64, NH = 8;
constexpr int INC = 5128;
constexpr int LBLK = 256, NBLK = S / LBLK;
constexpr int PH = 8, PNK = 128, PHALF = 128, PK = 16, PQC = PH * 2 * PHALF;
constexpr float EPS = 1e-6f;
constexpr float LOG2E = 1.4426950408889634f;
constexpr float C2 = 0.125f * LOG2E;

typedef unsigned short bf16_t;
typedef float f32x4 __attribute__((ext_vector_type(4)));
typedef unsigned u32x2 __attribute__((ext_vector_type(2)));
typedef unsigned u32x4 __attribute__((ext_vector_type(4)));
#define LAS __attribute__((address_space(3)))

__device__ __forceinline__ float bf2f(bf16_t v) { return __uint_as_float((unsigned)v << 16); }
__device__ __forceinline__ unsigned f2bf(float f) { unsigned u = __float_as_uint(f); return (u + 0x7fffu + ((u >> 16) & 1u)) >> 16; }
__device__ __forceinline__ unsigned pk2(float lo, float hi) { return f2bf(lo) | (f2bf(hi) << 16); }
#define WS_DPP(v, ctrl) ((v) + __builtin_bit_cast(float, __builtin_amdgcn_update_dpp(0, __builtin_bit_cast(int, (v)), (ctrl), 0xf, 0xf, true)))
#define WM_DPP(v, ctrl) fmaxf((v), __builtin_bit_cast(float, __builtin_amdgcn_update_dpp(0, __builtin_bit_cast(int, (v)), (ctrl), 0xf, 0xf, true)))
__device__ __forceinline__ float sum_x16(float v) { const auto r = __builtin_amdgcn_permlane16_swap(__float_as_uint(v), __float_as_uint(v), false, false); return __uint_as_float(r[0]) + __uint_as_float(r[1]); }
__device__ __forceinline__ float sum_x32(float v) { const auto r = __builtin_amdgcn_permlane32_swap(__float_as_uint(v), __float_as_uint(v), false, false); return __uint_as_float(r[0]) + __uint_as_float(r[1]); }
__device__ __forceinline__ float sum_x8(float v) { return v + __builtin_bit_cast(float, __builtin_amdgcn_update_dpp(0, __builtin_bit_cast(int, v), 0x128, 0xf, 0xf, true)); }
__device__ __forceinline__ float wave_sum_fast(float v) {
    v = WS_DPP(v, 0xB1); v = WS_DPP(v, 0x4E); v = WS_DPP(v, 0x141); v = WS_DPP(v, 0x140);
    const int iv = __builtin_bit_cast(int, v);
    return (__builtin_bit_cast(float, __builtin_amdgcn_readlane(iv, 0)) + __builtin_bit_cast(float, __builtin_amdgcn_readlane(iv, 16))) + (__builtin_bit_cast(float, __builtin_amdgcn_readlane(iv, 32)) + __builtin_bit_cast(float, __builtin_amdgcn_readlane(iv, 48)));
}
__device__ __forceinline__ float wave_max_fast(float v) {
    v = WM_DPP(v, 0xB1); v = WM_DPP(v, 0x4E); v = WM_DPP(v, 0x141); v = WM_DPP(v, 0x140);
    const int iv = __builtin_bit_cast(int, v);
    return fmaxf(fmaxf(__builtin_bit_cast(float, __builtin_amdgcn_readlane(iv, 0)), __builtin_bit_cast(float, __builtin_amdgcn_readlane(iv, 16))), fmaxf(__builtin_bit_cast(float, __builtin_amdgcn_readlane(iv, 32)), __builtin_bit_cast(float, __builtin_amdgcn_readlane(iv, 48))));
}
__device__ __forceinline__ int otid() { int t = threadIdx.x; asm volatile("" : "+v"(t)); return t; }

constexpr size_t MiB = 1u << 20, KiB = 1u << 10;
constexpr size_t CTL_ZERO_BYTES = 65536;
constexpr size_t WS_ROPE = 1 * MiB;
constexpr size_t WS_C = 1 * MiB + 512 * KiB;
constexpr size_t WS_LOGF = 2 * MiB;
constexpr size_t WS_KMP = 2 * MiB + 512 * KiB;
constexpr size_t WS_MCNT = 40 * KiB;
constexpr size_t WS_FKN = 2 * MiB + 768 * KiB;
constexpr size_t WS_FQN = WS_FKN + 32 * KiB;
constexpr size_t WS_MG1 = 44 * KiB;
constexpr size_t WS_SEL3 = 4 * MiB + 512 * KiB;
constexpr size_t WS_MLIST = 5 * MiB;
constexpr size_t WS_MLSE = 13 * MiB;
constexpr size_t WS_MP2 = 23 * MiB, WS_MP3 = 39 * MiB;
constexpr size_t WS_MP0 = 215 * MiB, WS_MP1 = 231 * MiB;
constexpr size_t WS_WSUM = 3 * MiB;
constexpr size_t WS_WIN = 5 * MiB;
constexpr size_t WS_WA = 15 * MiB, WS_WB = 16 * MiB;
constexpr size_t WS_WOUT = 17 * MiB;
constexpr size_t WS_WPQ = 19 * MiB;
constexpr size_t WS_XN = 23 * MiB;
constexpr size_t WS_QKV = 55 * MiB;
constexpr size_t SLOT = (size_t)T * 512;
constexpr size_t WS_G = 151 * MiB;
constexpr size_t WS_MERGED = 183 * MiB;
constexpr size_t WS_Y16 = 151 * MiB;
constexpr size_t WS_PQ = 151 * MiB;
constexpr size_t WS_IDX = 215 * MiB;
constexpr size_t WS_GATE = 223 * MiB;
constexpr size_t WS_SK = 247 * MiB;
constexpr size_t WS_RSSP = 3 * MiB + 512 * KiB;
constexpr size_t WS_EU = 87 * MiB;
constexpr size_t WS_EV = 103 * MiB;
constexpr size_t ESLICE = (size_t)16384 * 128;
constexpr size_t WS_A = 231 * MiB;
constexpr size_t WS_H8 = 55 * MiB;
constexpr size_t WS_HSC = 71 * MiB;
constexpr size_t WS_USC = 119 * MiB;
constexpr size_t WS_VSC = 119 * MiB + 64 * KiB;

struct P {
    const float *x, *g_mix, *w_in, *b_f, *w_a, *w_b, *w_out, *g_ffn, *w_pq, *sk, *eu, *ev, *g_fin;
    float* out; unsigned char* ws;
};

namespace pg8 {
#define PG8_LAS __attribute__((address_space(3)))
typedef unsigned short bf16_t;
typedef short bf16x8 __attribute__((ext_vector_type(8)));
typedef int i32x4 __attribute__((ext_vector_type(4))); typedef int i32x8 __attribute__((ext_vector_type(8)));
typedef float f32x4 __attribute__((ext_vector_type(4)));
typedef unsigned u32x4 __attribute__((ext_vector_type(4)));
constexpr int BM = 256, BK = 64, HALF = 128, HTB = HALF * BK * 2  , STAGE_BYTES = 8 * HTB, NXCD = 8, WGM = 8;

__host__ __device__ __forceinline__ int lds_byte(int r, int c) { const int st = (r >> 4) * 2 + (c >> 5), rr = r & 15, cc = c & 31, ob = rr * 64 + cc * 2; return st * 1024 + (ob ^ (((ob >> 9) & 1) << 5)); }
__host__ __device__ __forceinline__ void stage_rc(int b, int& R, int& C) { const int st = b / 1024, sb = b % 1024, swz = sb ^ (((sb >> 9) & 1) << 5); R = (st >> 1) * 16 + swz / 64; C = (st & 1) * 32 + (swz % 64) / 2; }
__host__ __device__ __forceinline__ int perm32(int rho) { const int n = rho >> 4, i = rho & 15; return 8 * (i >> 2) + 4 * n + (i & 3); }

struct Unit { int pm, pn; };
struct Gemm { const bf16_t* A; const bf16_t* Bt; int M, N, K; };

struct StaticOrder {
    int nM, nN, nwg, G, c;
    __host__ __device__ void init(int M, int N, int G_, int c_) { nM = M / BM; nN = N / BM; nwg = nM * nN; G = G_; c = c_; }
    __host__ __device__ bool next(int i, Unit& u) const {
        const long L = (long)i * G + c; if (L >= nwg) return false;
        int wgid = (int)L; { const int q = nwg / NXCD, r = nwg % NXCD, xcd = wgid % NXCD, off = wgid / NXCD; wgid = (xcd < r ? xcd * (q + 1) : r * (q + 1) + (xcd - r) * q) + off; }
        const int nig = WGM * nN, gid = wgid / nig, fm = gid * WGM, gsz = (nM - fm) < WGM ? (nM - fm) : WGM;
        u.pm = fm + ((wgid % nig) % gsz); u.pn = (wgid % nig) / gsz; return true;
    }
    __device__ __forceinline__ void a_ready(const Unit&) const {}
    __device__ __forceinline__ void done(const Unit&) const {}
};

__device__ __forceinline__ unsigned cvt_pk_bf16(float lo, float hi) { unsigned r; asm volatile("v_cvt_pk_bf16_f32 %0, %1, %2" : "=v"(r) : "v"(lo), "v"(hi)); return r; }

typedef float f32x2_t __attribute__((ext_vector_type(2))); typedef __bf16 bf16x2_t __attribute__((ext_vector_type(2)));
__device__ __forceinline__ unsigned cvtpk_c(float lo, float hi) { f32x2_t v = {lo, hi}; bf16x2_t b = __builtin_convertvector(v, bf16x2_t); return __builtin_bit_cast(unsigned, b); }
__device__ __forceinline__ u32x4 pack8(const f32x4& v0, const f32x4& v1) { u32x4 w; w.x = cvtpk_c(v0[0], v0[1]); w.y = cvtpk_c(v0[2], v0[3]); w.z = cvtpk_c(v1[0], v1[1]); w.w = cvtpk_c(v1[2], v1[3]); return w; }
__device__ __forceinline__ void unpack8(const u32x4& w, f32x4& v0, f32x4& v1) {
    v0[0] = __uint_as_float(w.x << 16); v0[1] = __uint_as_float(w.x & 0xffff0000u); v0[2] = __uint_as_float(w.y << 16); v0[3] = __uint_as_float(w.y & 0xffff0000u);
    v1[0] = __uint_as_float(w.z << 16); v1[1] = __uint_as_float(w.z & 0xffff0000u); v1[2] = __uint_as_float(w.w << 16); v1[3] = __uint_as_float(w.w & 0xffff0000u); }

struct EpiProj {
    static constexpr bool PERM = true, AFTER_DRAIN = false;
    bf16_t* QKV; bf16_t* G; const float* ROPE; float* KMP; float* FKN; float* FQN;
    __device__ __forceinline__ void operator()(const f32x4 (&acc)[2][2][4][2], const Unit& u, int wr, int wc, int fr, int fq) const {
        const int pn = u.pn, row0 = u.pm * BM + wr * 64 + fr;
        if (pn < 12) {
            const int typ = pn >> 1;
            const int slot = (typ == 0) ? 0 : (typ == 3) ? 1 : (typ < 3) ? typ + 1 : typ;
            bf16_t* base = QKV + (size_t)slot * ((size_t)16384 * 512);
            const int colt = (pn & 1) * 256, col0 = colt + wc * 32 + 8 * fq;
            const float sc = (typ == 0 || typ == 3) ? 0.18033688011112042f : 1.0f;
            const bool rope = (typ < 2) && ((wc & 1) == 0);
            const float sgn = (fq == 0) ? -1.f : 1.f; const bool rl = fq < 2;
            f32x4 ks[2][2];
#pragma unroll
            for (int bj = 0; bj < 2; ++bj) { ks[bj][0] = (f32x4){0.f, 0.f, 0.f, 0.f}; ks[bj][1] = (f32x4){0.f, 0.f, 0.f, 0.f}; }
            const bool nrm = (typ == 3 || typ == 4);
            float nmx[2][2] = {{0.f, 0.f}, {0.f, 0.f}};
#pragma unroll
            for (int ai = 0; ai < 2; ++ai)
#pragma unroll
                for (int m = 0; m < 4; ++m) {
                    const int row = row0 + ai * HALF + m * 16;
                    f32x4 c0 = (f32x4){1.f, 1.f, 1.f, 1.f}, c1 = c0, s0 = (f32x4){0.f, 0.f, 0.f, 0.f}, s1 = s0;
                    if (rope) { const f32x4* rp = (const f32x4*)(ROPE + (size_t)(row & 8191) * 16); c0 = rp[0]; c1 = rp[1]; s0 = rp[2]; s1 = rp[3]; }
#pragma unroll
                    for (int bj = 0; bj < 2; ++bj) {
                        f32x4 v0 = acc[ai][bj][m][0], v1 = acc[ai][bj][m][1];
                        if (rope) {
                            f32x4 p0, p1;
#pragma unroll
                            for (int e = 0; e < 4; ++e) { p0[e] = __shfl_xor(v0[e], 16); p1[e] = __shfl_xor(v1[e], 16); }
                            if (rl) { v0 = v0 * c0 + sgn * (p0 * s0); v1 = v1 * c1 + sgn * (p1 * s1); }
                        }
                        if (typ == 1) { ks[bj][0] += v0; ks[bj][1] += v1; }
                        v0 = v0 * sc; v1 = v1 * sc;
                        *(u32x4*)(base + (size_t)row * 512 + col0 + bj * HALF) = pack8(v0, v1);
                        if (nrm) { float ss = ((v0[0] * v0[0] + v0[1] * v0[1]) + (v0[2] * v0[2] + v0[3] * v0[3])) + ((v1[0] * v1[0] + v1[1] * v1[1]) + (v1[2] * v1[2] + v1[3] * v1[3]));
                            { const auto r_ = __builtin_amdgcn_permlane16_swap(__float_as_uint(ss), __float_as_uint(ss), false, false); ss = __uint_as_float(r_[0]) + __uint_as_float(r_[1]); }
                            { const auto r_ = __builtin_amdgcn_permlane32_swap(__float_as_uint(ss), __float_as_uint(ss), false, false); ss = __uint_as_float(r_[0]) + __uint_as_float(r_[1]); }
                            nmx[ai][bj] = fmaxf(nmx[ai][bj], ss); }
                    }
                }
            if (nrm) {
                const int b = u.pm >> 5, nb = u.pm & 31;
#pragma unroll
                for (int bj = 0; bj < 2; ++bj) { const int head = (colt + 128 * bj + 32 * wc) >> 6;
                    float a0 = nmx[0][bj], a1 = nmx[1][bj];
                    a0 = WM_DPP(a0, 0xB1); a0 = WM_DPP(a0, 0x4E); a0 = WM_DPP(a0, 0x141); a0 = WM_DPP(a0, 0x140); a1 = WM_DPP(a1, 0xB1); a1 = WM_DPP(a1, 0x4E); a1 = WM_DPP(a1, 0x141); a1 = WM_DPP(a1, 0x140);
                    if (fr == 0 && fq == 0) {
                        if (typ == 4) { float* d = FKN + ((size_t)(b * 8 + head) * 128 + 4 * nb + wr) * 2 + (wc & 1); d[0] = a0; d[4] = a1; }
                        else FQN[(((size_t)(b * 8 + head) * 32 + nb) * 2 + wr) * 2 + (wc & 1)] = fmaxf(a0, a1); } }
            }
            if (typ == 1) {
#pragma unroll
                for (int bj = 0; bj < 2; ++bj)
#pragma unroll
                    for (int n = 0; n < 2; ++n)
#pragma unroll
                        for (int e = 0; e < 4; ++e) { float v = ks[bj][n][e]; v = WS_DPP(v, 0xB1); v = WS_DPP(v, 0x4E); v = WS_DPP(v, 0x141); v = WS_DPP(v, 0x140); ks[bj][n][e] = v; }
                if (fr == 0) {
                    const int b = u.pm >> 5, nb = u.pm & 31;
#pragma unroll
                    for (int bj = 0; bj < 2; ++bj) { const int head = (colt + 128 * bj + 32 * wc) >> 6, d = 32 * (wc & 1) + 8 * fq;
                        float* dst = KMP + ((((size_t)wr * 16 + b * 8 + head) * 32 + nb) * 64 + d); *(f32x4*)dst = ks[bj][0]; *(f32x4*)(dst + 4) = ks[bj][1]; }
                }
            }
        } else {
            const int gi = pn - 12; unsigned char* base = (unsigned char*)G + (size_t)(gi >> 2) * ((size_t)16384 * 1024);
            const int col0 = (gi & 3) * 256 + wc * 32 + 8 * fq;
#pragma unroll
            for (int ai = 0; ai < 2; ++ai)
#pragma unroll
                for (int m = 0; m < 4; ++m) { const int row = row0 + ai * HALF + m * 16;
#pragma unroll
                    for (int bj = 0; bj < 2; ++bj) {
                        const f32x4 v0 = acc[ai][bj][m][0], v1 = acc[ai][bj][m][1]; u32x2 w;
                        { int t_ = __builtin_amdgcn_cvt_pk_fp8_f32(v0[0], v0[1], 0, false); w.x = (unsigned)__builtin_amdgcn_cvt_pk_fp8_f32(v0[2], v0[3], t_, true); }
                        { int t_ = __builtin_amdgcn_cvt_pk_fp8_f32(v1[0], v1[1], 0, false); w.y = (unsigned)__builtin_amdgcn_cvt_pk_fp8_f32(v1[2], v1[3], t_, true); }
                        *(u32x2*)(base + (size_t)row * 1024 + col0 + bj * HALF) = w; } }
        }
    }
};
struct EpiMerge {
    static constexpr bool PERM = true, AFTER_DRAIN = false;
    bf16_t* Mg; const unsigned char* Gt; bool first;
    __device__ __forceinline__ void operator()(const f32x4 (&acc)[2][2][4][2], const Unit& u, int wr, int wc, int fr, int fq) const {
        const int row0 = u.pm * BM + wr * 64 + fr, col0 = u.pn * BM + wc * 32 + 8 * fq;
#pragma unroll
        for (int ai = 0; ai < 2; ++ai)
#pragma unroll
            for (int m = 0; m < 4; ++m) { const size_t off = (size_t)(row0 + ai * HALF + m * 16) * 1024 + col0;
#pragma unroll
                for (int bj = 0; bj < 2; ++bj) { f32x4 g0, g1; { const u32x2 gw = *(const u32x2*)(Gt + off + bj * HALF);
                        const auto a_ = __builtin_amdgcn_cvt_pk_f32_fp8((int)gw.x, false), b_ = __builtin_amdgcn_cvt_pk_f32_fp8((int)gw.x, true), c_ = __builtin_amdgcn_cvt_pk_f32_fp8((int)gw.y, false), d_ = __builtin_amdgcn_cvt_pk_f32_fp8((int)gw.y, true);
                        g0[0] = a_[0]; g0[1] = a_[1]; g0[2] = b_[0]; g0[3] = b_[1]; g1[0] = c_[0]; g1[1] = c_[1]; g1[2] = d_[0]; g1[3] = d_[1]; }
#pragma unroll
                    for (int e = 0; e < 4; ++e) { g0[e] = __builtin_amdgcn_rcpf(1.f + __builtin_amdgcn_exp2f(-1.4426950408889634f * g0[e])); g1[e] = __builtin_amdgcn_rcpf(1.f + __builtin_amdgcn_exp2f(-1.4426950408889634f * g1[e])); }
                    f32x4 v0 = g0 * acc[ai][bj][m][0], v1 = g1 * acc[ai][bj][m][1];
                    if (!first) { f32x4 o0, o1; unpack8(*(const u32x4*)(Mg + off + bj * HALF), o0, o1); v0 += o0; v1 += o1; }
                    *(u32x4*)(Mg + off + bj * HALF) = pack8(v0, v1); } }
    }
};
struct EpiOut {
    static constexpr bool PERM = true, AFTER_DRAIN = false;
    const float* X; float* O; bf16_t* Hb; float* RSSP;
    __device__ __forceinline__ void operator()(const f32x4 (&acc)[2][2][4][2], const Unit& u, int wr, int wc, int fr, int fq) const {
        const int row0 = u.pm * BM + wr * 64 + fr, col0 = u.pn * BM + wc * 32 + 8 * fq;
#pragma unroll
        for (int ai = 0; ai < 2; ++ai) {
            f32x4 xr[4][2][2];
#pragma unroll
            for (int m = 0; m < 4; ++m)
#pragma unroll
                for (int bj = 0; bj < 2; ++bj) { const size_t off = (size_t)(row0 + ai * HALF + m * 16) * 1024 + col0 + bj * HALF; xr[m][bj][0] = *(const f32x4*)(X + off); xr[m][bj][1] = *(const f32x4*)(X + off + 4); }
            asm volatile("" ::: "memory");
#pragma unroll
            for (int m = 0; m < 4; ++m) { const int row = row0 + ai * HALF + m * 16; const size_t off = (size_t)row * 1024 + col0; float ss = 0.f;
#pragma unroll
                for (int bj = 0; bj < 2; ++bj) { const f32x4 x0 = xr[m][bj][0], x1 = xr[m][bj][1];
                    const f32x4 h0 = x0 + acc[ai][bj][m][0], h1 = x1 + acc[ai][bj][m][1];
                    *(u32x4*)(Hb + off + bj * HALF) = pack8(h0, h1);
                    ss += (h0[0] * h0[0] + h0[1] * h0[1]) + (h0[2] * h0[2] + h0[3] * h0[3]) + (h1[0] * h1[0] + h1[1] * h1[1]) + (h1[2] * h1[2] + h1[3] * h1[3]); }
                ss += __shfl_xor(ss, 16); ss += __shfl_xor(ss, 32);
                if (fq == 0) RSSP[(size_t)row * 16 + u.pn * 4 + wc] = ss; }
        }
    }
};
struct EpiStore {
    static constexpr bool PERM = true, AFTER_DRAIN = false;
    bf16_t* O; int ldc;
    __device__ __forceinline__ void operator()(const f32x4 (&acc)[2][2][4][2], const Unit& u, int wr, int wc, int fr, int fq) const {
        const int row0 = u.pm * BM + wr * 64 + fr, col0 = u.pn * BM + wc * 32 + 8 * fq;
#pragma unroll
        for (int ai = 0; ai < 2; ++ai)
#pragma unroll
            for (int m = 0; m < 4; ++m)
#pragma unroll
                for (int bj = 0; bj < 2; ++bj) *(u32x4*)(O + (size_t)(row0 + ai * HALF + m * 16) * ldc + col0 + bj * HALF) = pack8(acc[ai][bj][m][0], acc[ai][bj][m][1]);
    }
};

template <class Epi, class Sched, bool ALIGN_EPI = false, bool SP2 = false, bool F8 = false>
__device__ __forceinline__ void gemm_phase(PG8_LAS unsigned char* lds, const Gemm g, const Sched& S, const Epi& E) {
    const int tid = otid(), wid = __builtin_amdgcn_readfirstlane(tid >> 6), lane = tid & 63, wr = wid >> 2, wc = wid & 3, fr = lane & 15, fq = lane >> 4;
    int K_ = g.K; if constexpr (F8) asm volatile("" : "+s"(K_));
    const int K = K_, nt = K / BK;
    unsigned voffA[2], voffB[2];
#pragma unroll
    for (int i = 0; i < 2; ++i) { int R, C; stage_rc(tid * 16 + i * 8192, R, C); const int Rb = Epi::PERM ? ((R & ~31) + perm32(R & 31)) : R;
        voffA[i] = (unsigned)(R * K + C) * 2u; voffB[i] = (unsigned)(Rb * K + C) * 2u; }
    const size_t kstep = (size_t)(BK * 2);
    const size_t hstep = (size_t)HALF * K * 2;
    const size_t tstep = 2 * hstep;
    const unsigned ldsw = (unsigned)wid * 1024u;
    const int aoff = lds_byte(wr * 64 + fr, fq * 8), boff = lds_byte(wc * 32 + fr, fq * 8);
#define PG8_SA(b, h) (((b) * 2 + (h)) * HTB)
#define PG8_SB(b, h) ((4 + (b) * 2 + (h)) * HTB)
#define PG8_STAGE(bufoff, gbase, voff) do { _Pragma("unroll") for (int _i = 0; _i < 2; ++_i) \
        __builtin_amdgcn_global_load_lds((const unsigned*)((const char*)(gbase) + (voff)[_i]), (PG8_LAS unsigned*)(lds + (bufoff) + ldsw + _i * 8192), 16, 0, 0); } while (0)
#define PG8_LDA(dst, b, h) do { _Pragma("unroll") for (int m = 0; m < 4; ++m) { \
        if constexpr (F8) dst##8[m] = __builtin_shufflevector(*(const PG8_LAS i32x4*)(lds + PG8_SA(b, h) + aoff + m * 2048), *(const PG8_LAS i32x4*)(lds + PG8_SA(b, h) + aoff + m * 2048 + 1024), 0, 1, 2, 3, 4, 5, 6, 7); \
        else { _Pragma("unroll") for (int k = 0; k < 2; ++k) dst[m][k] = *(const PG8_LAS bf16x8*)(lds + PG8_SA(b, h) + aoff + m * 2048 + k * 1024); } } } while (0)
#define PG8_LDB(dst, b, h) do { _Pragma("unroll") for (int n = 0; n < 2; ++n) { \
        if constexpr (F8) dst##8[n] = __builtin_shufflevector(*(const PG8_LAS i32x4*)(lds + PG8_SB(b, h) + boff + n * 2048), *(const PG8_LAS i32x4*)(lds + PG8_SB(b, h) + boff + n * 2048 + 1024), 0, 1, 2, 3, 4, 5, 6, 7); \
        else { _Pragma("unroll") for (int k = 0; k < 2; ++k) dst[n][k] = *(const PG8_LAS bf16x8*)(lds + PG8_SB(b, h) + boff + n * 2048 + k * 1024); } } } while (0)
#define PG8_MMA(ai, bj, At, Bt) do { __builtin_amdgcn_s_setprio(1); _Pragma("unroll") for (int m = 0; m < 4; ++m) _Pragma("unroll") for (int n = 0; n < 2; ++n) { \
        if constexpr (F8) asm volatile("v_mfma_scale_f32_16x16x128_f8f6f4 %0, %1, %2, %0, %3, %4 op_sel_hi:[0,0,0]" : "+v"(acc[ai][bj][m][n]) : "v"(Bt##8[n]), "v"(At##8[m]), "v"(f8sb), "v"(f8sa)); \
        else { _Pragma("unroll") for (int k = 0; k < 2; ++k) acc[ai][bj][m][n] = __builtin_amdgcn_mfma_f32_16x16x32_bf16(Bt[n][k], At[m][k], acc[ai][bj][m][n], 0, 0, 0); } } \
        __builtin_amdgcn_s_setprio(0); } while (0)
#define PG8_WAIT_V(n) asm volatile("s_waitcnt vmcnt(" #n ")" ::: "memory")
#define PG8_WAIT_L(n) asm volatile("s_waitcnt lgkmcnt(" #n ")" ::: "memory")
#define PG8_BAR __builtin_amdgcn_s_barrier()
#define PG8_SCHED __builtin_amdgcn_sched_barrier(0)
    Unit cur, nxt; int ui = 0;
    if (!S.next(0, cur)) return;
    f32x4 acc[2][2][4][2];
#pragma unroll
    for (int a = 0; a < 2; ++a)
#pragma unroll
        for (int b = 0; b < 2; ++b)
#pragma unroll
            for (int m = 0; m < 4; ++m)
#pragma unroll
                for (int n = 0; n < 2; ++n) acc[a][b][m][n] = (f32x4){0.f, 0.f, 0.f, 0.f};
    bf16x8 At[4][2], B0[2][2], B1[2][2]; i32x8 At8[4], B08[2], B18[2];
    const int f8sb = 0x79797979, f8sa = 0x7d7d7d7d;
    const char* cA = (const char*)g.A + (size_t)cur.pm * tstep; const char* cB = (const char*)g.Bt + (size_t)cur.pn * tstep;
    S.a_ready(cur);
    if constexpr (SP2) {
        PG8_STAGE(PG8_SB(0, 0), cB, voffB); PG8_STAGE(PG8_SB(0, 1), cB + hstep, voffB); PG8_STAGE(PG8_SA(0, 0), cA, voffA); PG8_STAGE(PG8_SA(0, 1), cA + hstep, voffA);
        if (wr == 1) PG8_BAR;
        PG8_WAIT_V(2); PG8_BAR;
        PG8_STAGE(PG8_SB(1, 0), cB + kstep, voffB); PG8_STAGE(PG8_SA(1, 0), cA + kstep, voffA); PG8_STAGE(PG8_SB(1, 1), cB + hstep + kstep, voffB);
        PG8_WAIT_V(6); PG8_BAR;
    } else {
        PG8_STAGE(PG8_SB(0, 0), cB, voffB); PG8_STAGE(PG8_SA(0, 0), cA, voffA); PG8_STAGE(PG8_SB(0, 1), cB + hstep, voffB); PG8_STAGE(PG8_SA(0, 1), cA + hstep, voffA);
        if (wr == 1) PG8_BAR;
        PG8_WAIT_V(4); PG8_BAR;
        PG8_STAGE(PG8_SB(1, 0), cB + kstep, voffB); PG8_STAGE(PG8_SA(1, 0), cA + kstep, voffA); PG8_STAGE(PG8_SB(1, 1), cB + hstep + kstep, voffB);
        PG8_WAIT_V(6); PG8_BAR;
    }
    for (;;) {
        const bool has_next = S.next(ui + 1, nxt);
        const char* nA = has_next ? (const char*)g.A + (size_t)nxt.pm * tstep : cA; const char* nB = has_next ? (const char*)g.Bt + (size_t)nxt.pn * tstep : cB;
        for (int t = 0; t < nt; t += 2) {
            const bool last = (t == nt - 2);
            const char* a1 = cA + (size_t)(t + 1) * kstep;
            const char* a2 = last ? nA : cA + (size_t)(t + 2) * kstep; const char* b2 = last ? nB : cB + (size_t)(t + 2) * kstep;
            const char* a3 = a2 + kstep; const char* b3 = b2 + kstep;
            if (last && has_next) S.a_ready(nxt);
            if constexpr (SP2) {
            PG8_LDB(B0, 0, 0); PG8_LDB(B1, 0, 1); PG8_SCHED; PG8_LDA(At, 0, 0); PG8_STAGE(PG8_SA(1, 1), a1 + hstep, voffA);
            PG8_WAIT_V(8); PG8_WAIT_L(0); PG8_BAR; PG8_MMA(0, 0, At, B0); PG8_MMA(0, 1, At, B1); PG8_BAR; PG8_SCHED;
            PG8_LDA(At, 0, 1); PG8_STAGE(PG8_SB(0, 0), b2, voffB); PG8_STAGE(PG8_SB(0, 1), b2 + hstep, voffB); PG8_STAGE(PG8_SA(0, 0), a2, voffA);
            PG8_WAIT_V(8); PG8_WAIT_L(0); PG8_BAR; PG8_MMA(1, 0, At, B0); PG8_MMA(1, 1, At, B1); PG8_BAR; PG8_SCHED;
            PG8_LDB(B0, 1, 0); PG8_LDB(B1, 1, 1); PG8_SCHED; PG8_LDA(At, 1, 0); PG8_STAGE(PG8_SA(0, 1), a2 + hstep, voffA);
            PG8_WAIT_V(8); PG8_WAIT_L(0); PG8_BAR; PG8_MMA(0, 0, At, B0); PG8_MMA(0, 1, At, B1); PG8_BAR; PG8_SCHED;
            PG8_LDA(At, 1, 1); PG8_STAGE(PG8_SB(1, 0), b3, voffB); PG8_STAGE(PG8_SB(1, 1), b3 + hstep, voffB); PG8_STAGE(PG8_SA(1, 0), a3, voffA);
            PG8_WAIT_V(8); PG8_WAIT_L(0); PG8_BAR; PG8_MMA(1, 0, At, B0); PG8_MMA(1, 1, At, B1); PG8_BAR; PG8_SCHED;
            } else {
            PG8_LDB(B0, 0, 0); PG8_SCHED; PG8_LDA(At, 0, 0); PG8_STAGE(PG8_SA(1, 1), a1 + hstep, voffA);
            PG8_WAIT_L(8); PG8_BAR; PG8_WAIT_L(0); PG8_MMA(0, 0, At, B0); PG8_BAR; PG8_SCHED;
            PG8_LDB(B1, 0, 1); PG8_STAGE(PG8_SB(0, 0), b2, voffB);
            PG8_BAR; PG8_WAIT_L(0); PG8_MMA(0, 1, At, B1); PG8_BAR;
            PG8_LDA(At, 0, 1); PG8_STAGE(PG8_SA(0, 0), a2, voffA);
            PG8_BAR; PG8_WAIT_L(0); PG8_MMA(1, 0, At, B0); PG8_BAR; PG8_SCHED;
            PG8_STAGE(PG8_SB(0, 1), b2 + hstep, voffB);
            PG8_WAIT_V(6); PG8_BAR; PG8_MMA(1, 1, At, B1); PG8_BAR;
            PG8_LDB(B0, 1, 0); PG8_SCHED; PG8_LDA(At, 1, 0); PG8_STAGE(PG8_SA(0, 1), a2 + hstep, voffA);
            PG8_WAIT_L(8); PG8_BAR; PG8_WAIT_L(0); PG8_MMA(0, 0, At, B0); PG8_BAR; PG8_SCHED;
            PG8_LDB(B1, 1, 1); PG8_STAGE(PG8_SB(1, 0), b3, voffB);
            PG8_BAR; PG8_WAIT_L(0); PG8_MMA(0, 1, At, B1); PG8_BAR;
            PG8_LDA(At, 1, 1); PG8_STAGE(PG8_SA(1, 0), a3, voffA);
            PG8_BAR; PG8_WAIT_L(0); PG8_MMA(1, 0, At, B0); PG8_BAR; PG8_SCHED;
            PG8_STAGE(PG8_SB(1, 1), b3 + hstep, voffB);
            PG8_WAIT_V(6); PG8_BAR; PG8_MMA(1, 1, At, B1); PG8_BAR;
            }
        }
        if constexpr (ALIGN_EPI) { if (wr == 0) PG8_BAR; }
        if constexpr (F8) {
            asm volatile("s_nop 15\n\ts_nop 15" ::: "memory");
#pragma unroll
            for (int a_ = 0; a_ < 2; ++a_)
#pragma unroll
                for (int b_ = 0; b_ < 2; ++b_)
                    asm volatile("" : "+v"(acc[a_][b_][0][0]), "+v"(acc[a_][b_][0][1]), "+v"(acc[a_][b_][1][0]), "+v"(acc[a_][b_][1][1]), "+v"(acc[a_][b_][2][0]), "+v"(acc[a_][b_][2][1]), "+v"(acc[a_][b_][3][0]), "+v"(acc[a_][b_][3][1])); }
        if constexpr (!Epi::AFTER_DRAIN) { E(acc, cur, wr, wc, fr, fq); S.done(cur); }
        if (!has_next) break;
#pragma unroll
        for (int a = 0; a < 2; ++a)
#pragma unroll
            for (int b = 0; b < 2; ++b)
#pragma unroll
                for (int m = 0; m < 4; ++m)
#pragma unroll
                    for (int n = 0; n < 2; ++n) acc[a][b][m][n] = (f32x4){0.f, 0.f, 0.f, 0.f};
        cur = nxt; cA = nA; cB = nB; ++ui;
        if constexpr (ALIGN_EPI) { if (wr == 1) PG8_BAR; }
    }
    PG8_WAIT_V(0);
    if constexpr (!ALIGN_EPI) { if (wr == 0) PG8_BAR; }
    PG8_BAR;
    if constexpr (Epi::AFTER_DRAIN) { E.fused(acc, cur, wr, wc, fr, fq, lds, wid, lane); S.done(cur); }
#undef PG8_SA
#undef PG8_SB
#undef PG8_STAGE
#undef PG8_LDA
#undef PG8_LDB
#undef PG8_MMA
#undef PG8_WAIT_V
#undef PG8_WAIT_L
#undef PG8_BAR
#undef PG8_SCHED
}
}


__device__ __forceinline__ float log_sigmoid(float z) { return z >= 0.f ? -log1pf(expf(-z)) : z - log1pf(expf(z)); }
constexpr float XN8_SCALE = 4.0f, WIN8_SCALE = 64.0f;
__device__ __forceinline__ unsigned pk4_fp8(float a, float b, float c, float d) { int w = __builtin_amdgcn_cvt_pk_fp8_f32(a, b, 0, false); w = __builtin_amdgcn_cvt_pk_fp8_f32(c, d, w, true); return (unsigned)w; }
__device__ __forceinline__ void p0_transpose_item8(const float* W, int ldw, int K, int ncols, unsigned char* WT, int row_off, LAS float* scr, int item, int lane, float scale) {
    const int nblk = ncols / 32, kb = item / nblk, nb = item % nblk, k0 = 64 * kb, n0 = 32 * nb;
#pragma unroll 4
    for (int i = 0; i < 8; ++i) { const int kk = 8 * i + (lane >> 3), n4 = 4 * (lane & 7); const f32x4 w = *(const f32x4*)(W + (size_t)(k0 + kk) * ldw + n0 + n4);
        LAS float* d = scr + kk * 33 + n4; d[0] = w.x * scale; d[1] = w.y * scale; d[2] = w.z * scale; d[3] = w.w * scale; }
    asm volatile("s_waitcnt lgkmcnt(0)" ::: "memory");
    const int c = lane & 7;
#pragma unroll
    for (int j = 0; j < 4; ++j) { const int n = (lane >> 3) + 8 * j; const LAS float* s = scr + (8 * c) * 33 + n;
        u32x2 o; o.x = pk4_fp8(s[0 * 33], s[1 * 33], s[2 * 33], s[3 * 33]); o.y = pk4_fp8(s[4 * 33], s[5 * 33], s[6 * 33], s[7 * 33]);
        *(u32x2*)(WT + (size_t)(row_off + n0 + n) * K + k0 + 8 * c) = o; }
    asm volatile("s_waitcnt lgkmcnt(0)" ::: "memory");
}
__device__ __forceinline__ void p0_transpose_item(const float* W, int ldw, int K, int ncols, bf16_t* WT, int row_off, LAS float* scr, int item, int lane, const float* ksc = nullptr) {
    const int nblk = ncols / 32, kb = item / nblk, nb = item % nblk, k0 = 64 * kb, n0 = 32 * nb;
#pragma unroll 4
    for (int i = 0; i < 8; ++i) { const int kk = 8 * i + (lane >> 3), n4 = 4 * (lane & 7); const f32x4 w = *(const f32x4*)(W + (size_t)(k0 + kk) * ldw + n0 + n4); const float sc_ = ksc ? ksc[k0 + kk] : 1.0f;
        LAS float* d = scr + kk * 33 + n4; d[0] = w.x * sc_; d[1] = w.y * sc_; d[2] = w.z * sc_; d[3] = w.w * sc_; }
    asm volatile("s_waitcnt lgkmcnt(0)" ::: "memory");
    const int c = lane & 7;
#pragma unroll
    for (int j = 0; j < 4; ++j) { const int n = (lane >> 3) + 8 * j; const LAS float* s = scr + (8 * c) * 33 + n;
        u32x4 o; o.x = pk2(s[0 * 33], s[1 * 33]); o.y = pk2(s[2 * 33], s[3 * 33]); o.z = pk2(s[4 * 33], s[5 * 33]); o.w = pk2(s[6 * 33], s[7 * 33]);
        *(u32x4*)(WT + (size_t)(row_off + n0 + n) * K + k0 + 8 * c) = o; }
    asm volatile("s_waitcnt lgkmcnt(0)" ::: "memory");
}
__device__ __forceinline__ void phase_prologue(LAS unsigned char* ldsb, const P& p) {
    const int TID = otid();
    const int lane = TID & 63, wave = TID >> 6, gw = blockIdx.x * 8 + wave, nw = gridDim.x * 8;
    LAS float* scr = (LAS float*)(ldsb + wave * 16384);
    constexpr int I1 = 16 * 96, I2 = 16 * 64, IA = 8 * 32, IO = 16 * 32, IQ = 16 * 64;
    for (int it = gw; it < I1 + I2 + IA; it += nw) {
        int r = it;
        if (r < I1) { p0_transpose_item8(p.w_in, INC, D, 3072, p.ws + WS_WIN, 0, scr, r, lane, WIN8_SCALE); continue; } r -= I1;
        if (r < I2) { p0_transpose_item8(p.w_in + 3080, INC, D, 2048, p.ws + WS_WIN, 3072, scr, r, lane, WIN8_SCALE); continue; } r -= I2;
        p0_transpose_item(p.w_b, D, 512, 1024, (bf16_t*)(p.ws + WS_WB), 0, scr, r, lane);
    }
    (void)IA; (void)IO; (void)IQ;
    { u32x4* SKo = (u32x4*)(p.ws + WS_SK);
      for (int c = blockIdx.x * 512 + TID; c < PH * 2 * PNK * PHALF / 8; c += gridDim.x * 512) { const f32x4 a0 = *(const f32x4*)(p.sk + (size_t)c * 8), a1 = *(const f32x4*)(p.sk + (size_t)c * 8 + 4);
          u32x4 o; o.x = pk2(a0.x, a0.y); o.y = pk2(a0.z, a0.w); o.z = pk2(a1.x, a1.y); o.w = pk2(a1.z, a1.w); SKo[c] = o; } }
    { float* ROPE = (float*)(p.ws + WS_ROPE);
      for (int it = blockIdx.x * 512 + TID; it < S * 8; it += gridDim.x * 512) { const int i = it & 7, pos = it >> 3;
          const float inv_freq = powf(500000.0f, -(float)i / 8.0f); const float ang = (float)pos * inv_freq;
          ROPE[pos * 16 + i] = cosf(ang); ROPE[pos * 16 + 8 + i] = sinf(ang); } }
    __syncthreads();
    { LAS float* WFt = (LAS float*)ldsb;
      for (int i = TID; i < 2 * D; i += 512) { const int col = i >> 1, half = i & 1; const f32x4 w = *(const f32x4*)(p.w_in + (size_t)col * INC + 3072 + 4 * half);
          WFt[(4 * half + 0) * D + col] = w.x; WFt[(4 * half + 1) * D + col] = w.y; WFt[(4 * half + 2) * D + col] = w.z; WFt[(4 * half + 3) * D + col] = w.w; } }
    __syncthreads();
    bf16_t* XN = (bf16_t*)(p.ws + WS_XN); float* LOGF = (float*)(p.ws + WS_LOGF); const LAS float* WFt = (const LAS float*)ldsb;
    float wsum = 0.f;
    f32x4 gmx[4];
#pragma unroll
    for (int j = 0; j < 4; ++j) gmx[j] = ((const f32x4*)p.g_mix)[lane + 64 * j];
    const int fo = 4 * (lane & 1) + 2 * ((lane >> 1) & 1) + ((lane >> 2) & 1);
    const float bfo = p.b_f[fo];
#define PRO_X(x, ctrl) __builtin_bit_cast(float, __builtin_amdgcn_update_dpp(0, __builtin_bit_cast(int, (x)), (ctrl), 0xf, 0xf, true))
#pragma unroll 1
    for (int rh = 0; rh < 8; rh += 4) {
    f32x4 xv[4][4];
#pragma unroll
    for (int r8 = 0; r8 < 4; ++r8)
#pragma unroll
        for (int j = 0; j < 4; ++j) xv[r8][j] = ((const f32x4*)(p.x + (size_t)(gw * 8 + rh + r8) * D))[lane + 64 * j];
#pragma unroll
    for (int r8 = 0; r8 < 4; ++r8) {
        const int row = gw * 8 + rh + r8;
        f32x4 v[4]; float ss = 0.f;
#pragma unroll
        for (int j = 0; j < 4; ++j) { v[j] = xv[r8][j]; ss += v[j].x * v[j].x + v[j].y * v[j].y + v[j].z * v[j].z + v[j].w * v[j].w; }
        ss = wave_sum_fast(ss);
        const float rstd = rsqrtf(ss * (1.f / D) + EPS);
        float fs[8];
#pragma unroll
        for (int f = 0; f < 8; ++f) fs[f] = 0.f;
#pragma unroll
        for (int j = 0; j < 4; ++j) {
            const f32x4 g = gmx[j];
            v[j].x *= rstd * g.x; v[j].y *= rstd * g.y; v[j].z *= rstd * g.z; v[j].w *= rstd * g.w;
            *(unsigned*)((unsigned char*)XN + (size_t)row * D + 4 * (lane + 64 * j)) = pk4_fp8(v[j].x * XN8_SCALE, v[j].y * XN8_SCALE, v[j].z * XN8_SCALE, v[j].w * XN8_SCALE);
#pragma unroll
            for (int f = 0; f < 8; ++f) { const f32x4 w = *(const LAS f32x4*)(WFt + f * D + 4 * (lane + 64 * j)); fs[f] += (v[j].x * w.x + v[j].y * w.y) + (v[j].z * w.z + v[j].w * w.w); }
        }
        float h4[4], g2[2];
#pragma unroll
        for (int i = 0; i < 4; ++i) { const float a = fs[i] + PRO_X(fs[i], 0xB1), b = fs[i + 4] + PRO_X(fs[i + 4], 0xB1); h4[i] = (lane & 1) ? b : a; }
#pragma unroll
        for (int i = 0; i < 2; ++i) { const float a = h4[i] + PRO_X(h4[i], 0x4E), b = h4[i + 2] + PRO_X(h4[i + 2], 0x4E); g2[i] = (lane & 2) ? b : a; }
        float z;
        { const float a = g2[0] + __builtin_bit_cast(float, __builtin_amdgcn_ds_bpermute((lane ^ 4) << 2, __builtin_bit_cast(int, g2[0]))), b = g2[1] + __builtin_bit_cast(float, __builtin_amdgcn_ds_bpermute((lane ^ 4) << 2, __builtin_bit_cast(int, g2[1]))); z = (lane & 4) ? b : a; }
        z = sum_x8(z); z = sum_x16(z); z = sum_x32(z);
        if (lane < 8) { const float lf = log_sigmoid(z + bfo); LOGF[(size_t)row * 8 + fo] = lf; wsum += lf; }
    }
    }
#undef PRO_X
    if (lane < 8) ((float*)(p.ws + WS_WSUM))[gw * 8 + fo] = wsum;
}

__device__ __forceinline__ void phase_cumsum(const P& p) {
    const int TID = otid();
    const int lane = TID & 63, gw = blockIdx.x * 8 + (TID >> 6), b = gw >> 10, w0 = b << 10, h = lane & 7, j = lane >> 3;
    const float* WSUM = (const float*)(p.ws + WS_WSUM); const float* LOGF = (const float*)(p.ws + WS_LOGF); float* C = (float*)(p.ws + WS_C);
    float part = 0.f;
    { float p1 = 0.f, p2 = 0.f, p3 = 0.f; int w = w0 + j;
      for (; w + 24 < gw; w += 32) { part += WSUM[w * 8 + h]; p1 += WSUM[(w + 8) * 8 + h]; p2 += WSUM[(w + 16) * 8 + h]; p3 += WSUM[(w + 24) * 8 + h]; }
      for (; w < gw; w += 8) part += WSUM[w * 8 + h];
      part = (part + p1) + (p2 + p3); }
    part += __shfl_xor(part, 8); part += __shfl_xor(part, 16); part += __shfl_xor(part, 32);
    if (lane < 8) { float run = part;
#pragma unroll
        for (int r = 0; r < 8; ++r) { const int row = gw * 8 + r; run += LOGF[(size_t)row * 8 + h]; C[(size_t)(b * 8 + h) * S + (row & (S - 1))] = run * LOG2E; } }
}

#include <hip/hip_bf16.h>
namespace attn {
using bf16=__hip_bfloat16;
using bf16x8=__attribute__((ext_vector_type(8)))short;
using s16x4=__attribute__((ext_vector_type(4)))short;
using f32x16=__attribute__((ext_vector_type(16)))float;
using f32x4=__attribute__((ext_vector_type(4)))float;
using u32x4=__attribute__((ext_vector_type(4)))unsigned;
constexpr int SEQ=8192,D=64,DM=512;
constexpr int NW=8,QBLK=32,QB=QBLK*NW,KVBLK=64;
__device__ __forceinline__ int crow(int r,int hi){return (r&3)+8*(r>>2)+4*hi;}
#define SBAR() __builtin_amdgcn_sched_barrier(0)
__device__ __forceinline__ void cmask(f32x16&p0,f32x16&p1,int jb,int qrel,int hi){
  const float NEG=-INFINITY; int kb=64*jb+4*hi;
  #pragma unroll
  for(int r=0;r<16;++r){int kv=kb+(r&3)+8*(r>>2); if(kv>qrel)p0[r]=NEG; if(kv+32>qrel)p1[r]=NEG;}
}
constexpr int KSUM_P1=16*32*64;
constexpr int NSLOT=3, SLOTB=8192;
constexpr int LDS_K=0, LDS_V=NSLOT*SLOTB, LDS_WS=2*NSLOT*SLOTB, LDS_OST=LDS_WS+NW*64*4, LDS_CK=LDS_OST+NW*4096, LDS_BYTES=LDS_CK+SEQ*4;
__device__ __forceinline__ void glds16(const void*gsrc,unsigned lds_dst){unsigned keep;
  asm volatile("s_mov_b32 %0, m0\n\ts_mov_b32 m0, %2\n\ts_nop 0\n\tglobal_load_lds_dwordx4 %1, off\n\ts_mov_b32 m0, %0":"=&s"(keep):"v"(gsrc),"s"(lds_dst):"memory");}
typedef float f32x2_t __attribute__((ext_vector_type(2))); typedef __bf16 bf16x2_t __attribute__((ext_vector_type(2)));
__device__ __forceinline__ unsigned cvtpk_s(float lo,float hi){f32x2_t v={lo,hi};bf16x2_t b=__builtin_convertvector(v,bf16x2_t);return __builtin_bit_cast(unsigned,b);}
#define WAIT_BAR(N) asm volatile("s_waitcnt vmcnt(" #N ") lgkmcnt(0)\n\ts_barrier":::"memory")
typedef __attribute__((address_space(3))) const char* lds_cptr;
typedef short v4i16_t __attribute__((ext_vector_type(4)));
__device__ __forceinline__ void kload8(bf16x8*kf,lds_cptr kp){
  kf[0]=*(const __attribute__((address_space(3))) bf16x8*)(kp);      kf[1]=*(const __attribute__((address_space(3))) bf16x8*)(kp+512);
  kf[2]=*(const __attribute__((address_space(3))) bf16x8*)(kp+2048); kf[3]=*(const __attribute__((address_space(3))) bf16x8*)(kp+2560);
  kf[4]=*(const __attribute__((address_space(3))) bf16x8*)(kp+4096); kf[5]=*(const __attribute__((address_space(3))) bf16x8*)(kp+4608);
  kf[6]=*(const __attribute__((address_space(3))) bf16x8*)(kp+6144); kf[7]=*(const __attribute__((address_space(3))) bf16x8*)(kp+6656);
}
__device__ __forceinline__ void kload2(bf16x8*kf,lds_cptr kp,int j){ kf[2*j]=*(const __attribute__((address_space(3))) bf16x8*)(kp+j*2048); kf[2*j+1]=*(const __attribute__((address_space(3))) bf16x8*)(kp+j*2048+512); }
__device__ __forceinline__ s16x4 vtr(lds_cptr p){ return __builtin_bit_cast(s16x4,__builtin_amdgcn_ds_read_tr16_b64_v4i16((__attribute__((address_space(3))) v4i16_t*)p)); }
template<bool FOX> __device__ __forceinline__ void cinit(f32x16&C,const __attribute__((address_space(3))) float*ckt,float bs){
  if constexpr(FOX){
    #pragma unroll
    for(int g=0;g<4;++g){ const f32x4 kb=*(const __attribute__((address_space(3))) f32x4*)(ckt+8*g); C[4*g]=bs-kb[0]; C[4*g+1]=bs-kb[1]; C[4*g+2]=bs-kb[2]; C[4*g+3]=bs-kb[3]; }
  } else {
    #pragma unroll
    for(int r=0;r<16;++r)C[r]=bs;
  }
  asm volatile("":"+v"(C));
}
__device__ __forceinline__ void pv(f32x16*o,int vb,bf16x8 pa0,bf16x8 pa1,bf16x8 pa2,bf16x8 pa3){
  #pragma unroll
  for(int d0=0;d0<2;++d0){s16x4 lo[4],hi[4];
    #pragma unroll
    for(int ks=0;ks<4;++ks){
      asm volatile("ds_read_b64_tr_b16 %0,%1 offset:%c2":"=&v"(lo[ks]):"v"(vb),"i"(d0*4096+ks*1024):"memory");
      asm volatile("ds_read_b64_tr_b16 %0,%1 offset:%c2":"=&v"(hi[ks]):"v"(vb),"i"(d0*4096+ks*1024+512):"memory");}
    asm volatile("s_waitcnt lgkmcnt(0)":::"memory");SBAR();
    #define PK(k) (bf16x8){lo[k][0],lo[k][1],lo[k][2],lo[k][3],hi[k][0],hi[k][1],hi[k][2],hi[k][3]}
    o[d0]=__builtin_amdgcn_mfma_f32_32x32x16_bf16(pa0,PK(0),o[d0],0,0,0);
    o[d0]=__builtin_amdgcn_mfma_f32_32x32x16_bf16(pa1,PK(1),o[d0],0,0,0);
    o[d0]=__builtin_amdgcn_mfma_f32_32x32x16_bf16(pa2,PK(2),o[d0],0,0,0);
    o[d0]=__builtin_amdgcn_mfma_f32_32x32x16_bf16(pa3,PK(3),o[d0],0,0,0);
    #undef PK
  }
}
#define ATTN_STORE16(p,v) (*(u32x4*)(p)=(v))
struct MobaIo { const unsigned short* QL; int qcnt, jblk; const unsigned* SEL3; bf16* PART0; bf16* PART1; bf16* PART2; float* LSE; };
template<bool FOX,int THRL,int VAR> __device__ __forceinline__ void attn_unit(int b,int h,int qb,int t0,const bf16*Q,const bf16*__restrict__ K,const bf16*__restrict__ V,bf16*O,const float*CK2,const MobaIo&mio,char*shm){
  const int tid=otid(),lane=tid&63,r32=lane&31,hi=lane>>5; const int wid=__builtin_amdgcn_readfirstlane(tid>>6);
  const long rowbase=(long)b*SEQ; const int q0=qb*QB;
  int qidx=q0+wid*QBLK+r32; bool qvalid=true;
  if constexpr(VAR==2){ const int li=wid*QBLK+r32; qvalid=li<mio.qcnt; qidx=(int)mio.QL[qvalid?li:mio.qcnt-1]; }
  const bf16*Qrow=Q+(rowbase+qidx)*DM+h*D;
  const bf16*Kh=K+(rowbase+(long)t0*KVBLK)*DM+h*D,*Vh=V+(rowbase+(long)t0*KVBLK)*DM+h*D;
  const unsigned lds0=(unsigned)(uintptr_t)shm;
  float*wsf=(float*)(shm+LDS_WS)+wid*64;
  const bf16*ksrc=Kh+(long)lane*DM+wid*8;
  const bf16*vsrc=Vh+(long)(16*(wid&3)+(lane>>2))*DM+(wid>>2)*32+(lane&3)*8;
  const unsigned kdst=lds0+LDS_K+wid*1024, vdst=lds0+LDS_V+wid*1024;
  #define DMA_K(t,slot) glds16(ksrc+(long)(t)*KVBLK*DM,(unsigned)__builtin_amdgcn_readfirstlane(kdst+(slot)))
  #define DMA_V(t,slot) glds16(vsrc+(long)(t)*KVBLK*DM,(unsigned)__builtin_amdgcn_readfirstlane(vdst+(slot)))
  const int vb0=(int)(lds0+LDS_V)+((lane>>4)&1)*32+(lane&3)*8+(4*hi+((lane&15)>>2))*64;
  bf16x8 kf[8];
  const lds_cptr shm3=(lds_cptr)shm; const lds_cptr kp0=shm3+LDS_K+hi*1024+r32*16; const lds_cptr vp0=shm3+LDS_V+((lane>>4)&1)*32+(lane&3)*8+(4*hi+((lane&15)>>2))*64;
  const __attribute__((address_space(3))) float*ckl=(const __attribute__((address_space(3))) float*)(shm3+LDS_CK)+4*hi;
  const int NT=(VAR==2)?4:(q0+QB)/KVBLK-t0;
  DMA_K(0,0);DMA_V(0,0);DMA_K(1,SLOTB);
  bf16x8 qr[4];
  #pragma unroll
  for(int d0=0;d0<4;++d0)qr[d0]=*reinterpret_cast<const bf16x8*>(&Qrow[d0*16+hi*8]);
  float cq2=0.f;
  if constexpr(FOX){ __attribute__((address_space(3))) f32x4*ck4=(__attribute__((address_space(3))) f32x4*)(shm3+LDS_CK); const f32x4*g4=(const f32x4*)CK2+t0*16;
    for(int i=tid;i<NT*16;i+=NW*64)ck4[i]=g4[i];
    cq2=CK2[q0+wid*QBLK+r32]; }
  float mhat=0.f,l_reg=0.f;f32x16 o[2];o[0]=f32x16{};o[1]=f32x16{};
  const int qrel=wid*QBLK+r32;
  #define CMASK(P0,P1,t) do{ if constexpr(VAR!=2){ int jb_=(t)-(NT-4); if(jb_>=0)cmask(P0,P1,jb_,qrel,hi); } }while(0)
  #define BASE(t) (FOX ? (cq2-mhat) : -mhat)
  bool resc=false,nmd=true; f32x16 negm=f32x16{}; asm volatile("":"+v"(negm));
  #define RESC() do{ if(resc){ asm volatile("s_waitcnt lgkmcnt(0)":::"memory"); \
      _Pragma("unroll") for(int d_=0;d_<2;++d_) _Pragma("unroll") for(int r=0;r<16;++r)o[d_][r]*=wsf[crow(r,hi)]; } }while(0)
  #define MX3(a,b,c) __builtin_fmaxf(__builtin_fmaxf((a),(b)),(c))
  #define DECIDE(C0,C1) do{ float a=MX3(C0[0],C0[1],C1[0]),b_=MX3(C0[2],C0[3],C1[1]); a=MX3(a,C1[2],C1[3]); \
      _Pragma("unroll") for(int r=4;r<16;r+=4){a=MX3(a,C0[r],C0[r+1]);b_=MX3(b_,C0[r+2],C0[r+3]);a=MX3(a,C1[r],C1[r+1]);b_=MX3(b_,C1[r+2],C1[r+3]);} \
      float rm=__builtin_fmaxf(a,b_); { auto rr=__builtin_amdgcn_permlane32_swap(__float_as_uint(rm),__float_as_uint(rm),false,false); rm=__builtin_fmaxf(__uint_as_float(rr[0]),__uint_as_float(rr[1])); } \
      resc=false; \
      if(__builtin_expect(__any(rm>(float)THRL),0)){ const float dl=(rm>(float)THRL)?rm:0.f; mhat+=dl;     \
        _Pragma("unroll") for(int r=0;r<16;++r){C0[r]-=dl;C1[r]-=dl;} \
        const float f=__builtin_amdgcn_exp2f(-dl); l_reg*=f; if(hi==0)wsf[r32]=f; resc=true; nmd=true; } }while(0)
  f32x16 pA0,pA1,pB0,pB1;
  int sl_prev=0,sl_cur=0,sl_next=SLOTB;
  #define ROT() do{sl_prev=sl_cur;sl_cur=sl_next;sl_next=(sl_next==(NSLOT-1)*SLOTB)?0:sl_next+SLOTB;}while(0)
  DMA_K(2,2*SLOTB);
  WAIT_BAR(3);
  { const float bs=BASE(0); cinit<FOX>(pA0,ckl,bs); cinit<FOX>(pA1,ckl+32,bs);
    const char*kb=shm+LDS_K+hi*1024+r32*16;
    #pragma unroll
    for(int d0=0;d0<4;++d0){
      const bf16x8 b0=*reinterpret_cast<const bf16x8*>(kb+d0*2048);
      const bf16x8 b1=*reinterpret_cast<const bf16x8*>(kb+d0*2048+512);
      pA0=__builtin_amdgcn_mfma_f32_32x32x16_bf16(b0,qr[d0],pA0,0,0,0);pA1=__builtin_amdgcn_mfma_f32_32x32x16_bf16(b1,qr[d0],pA1,0,0,0);}
    CMASK(pA0,pA1,0);
    DECIDE(pA0,pA1); resc=false;
    _Pragma("unroll") for(int r=0;r<16;++r){pA0[r]=__builtin_amdgcn_exp2f(pA0[r]);pA1[r]=__builtin_amdgcn_exp2f(pA1[r]);} }
  WAIT_BAR(0);
  DMA_K(3,0);DMA_V(1,SLOTB);
  ROT();
  kload8(kf,kp0+sl_cur);
  WAIT_BAR(2);
  s16x4 vlo[8],vhi[8]; u32x4 pw0,pw1,pw2,pw3;
  #define PKW(P,B) cvtpk_s(P[B],P[B+1])
  #define PAF(k) __builtin_bit_cast(bf16x8,pw##k)
  #define VFR(i) (bf16x8){vlo[i][0],vlo[i][1],vlo[i][2],vlo[i][3],vhi[i][0],vhi[i][1],vhi[i][2],vhi[i][3]}
  #define PIN(x) asm volatile("":"+v"(x))
  #define GAPA(MF,A0,A1,A2,A3,W0,W1,PW) do{ MF; sacc+=A0; sacc+=A1; sacc+=A2; sacc+=A3; PIN(sacc); W0; W1; PIN(PW); SBAR(); }while(0)
  #define EX(v) __builtin_amdgcn_exp2f(v)
  #define GAPB(MF,X,B) do{ MF; X[B]=EX(X[B]); X[B+1]=EX(X[B+1]); X[B+2]=EX(X[B+2]); X[B+3]=EX(X[B+3]); PIN(X); SBAR(); }while(0)
  #define VRD(i) do{ vlo[i]=vtr(vp_+(((i)>>2)*4096+((i)&3)*1024)); vhi[i]=vtr(vp_+(((i)>>2)*4096+((i)&3)*1024+512)); }while(0)
  #define KRD(G,j) do{ if(G){ kload2(kf,kp0+sl_next,j); SBAR(); } }while(0)
  #define STEP(C0,C1,P0,P1,t,GK,GV,GL) do{ SBAR(); \
    const lds_cptr vp_=vp0+sl_prev; const float bs_=BASE(t); \
    if constexpr(FOX){ cinit<FOX>(C0,ckl+(t)*64,bs_); SBAR(); } \
    else if(nmd){ _Pragma("unroll") for(int r=0;r<16;++r)negm[r]=bs_; asm volatile("":"+v"(negm)); nmd=false; SBAR(); }     \
    VRD(0); SBAR(); float sacc=(P0[0]+P0[1]); \
    GAPA(C0=__builtin_amdgcn_mfma_f32_32x32x16_bf16(kf[0],qr[0],FOX?C0:negm,0,0,0), P0[2],P0[3],P0[4],P0[5],     pw0[0]=PKW(P0,0), pw0[1]=PKW(P0,2), pw0); \
    if constexpr(FOX){ cinit<FOX>(C1,ckl+(t)*64+32,bs_); SBAR(); } \
    VRD(4); SBAR(); GAPA(C1=__builtin_amdgcn_mfma_f32_32x32x16_bf16(kf[1],qr[0],FOX?C1:negm,0,0,0), P0[6],P0[7],P0[8],P0[9],     pw0[2]=PKW(P0,4), pw0[3]=PKW(P0,6), pw0); \
    VRD(1); SBAR(); GAPA(C0=__builtin_amdgcn_mfma_f32_32x32x16_bf16(kf[2],qr[1],C0,0,0,0),   P0[10],P0[11],P0[12],P0[13], pw1[0]=PKW(P0,8), pw1[1]=PKW(P0,10), pw1); \
    VRD(5); SBAR(); GAPA(C1=__builtin_amdgcn_mfma_f32_32x32x16_bf16(kf[3],qr[1],C1,0,0,0),   P0[14],P0[15],P1[0],P1[1],   pw1[2]=PKW(P0,12),pw1[3]=PKW(P0,14), pw1); \
    VRD(2); SBAR(); GAPA(C0=__builtin_amdgcn_mfma_f32_32x32x16_bf16(kf[4],qr[2],C0,0,0,0),   P1[2],P1[3],P1[4],P1[5],     pw2[0]=PKW(P1,0), pw2[1]=PKW(P1,2), pw2); \
    VRD(6); SBAR(); GAPA(C1=__builtin_amdgcn_mfma_f32_32x32x16_bf16(kf[5],qr[2],C1,0,0,0),   P1[6],P1[7],P1[8],P1[9],     pw2[2]=PKW(P1,4), pw2[3]=PKW(P1,6), pw2); \
    VRD(3); SBAR(); GAPA(C0=__builtin_amdgcn_mfma_f32_32x32x16_bf16(kf[6],qr[3],C0,0,0,0),   P1[10],P1[11],P1[12],P1[13], pw3[0]=PKW(P1,8), pw3[1]=PKW(P1,10), pw3); \
    VRD(7); SBAR(); GAPA(C1=__builtin_amdgcn_mfma_f32_32x32x16_bf16(kf[7],qr[3],C1,0,0,0),   P1[14],P1[15],0.f,0.f,       pw3[2]=PKW(P1,12),pw3[3]=PKW(P1,14), pw3); \
    l_reg+=sacc; \
    if(GK){DMA_K((t)+3,sl_cur);} if(GV){DMA_V((t)+1,sl_next);} \
    CMASK(C0,C1,t); \
    DECIDE(C0,C1); \
    SBAR(); \
    GAPB(o[0]=__builtin_amdgcn_mfma_f32_32x32x16_bf16(PAF(0),VFR(0),o[0],0,0,0), C0,0); \
    GAPB(o[1]=__builtin_amdgcn_mfma_f32_32x32x16_bf16(PAF(0),VFR(4),o[1],0,0,0), C0,4); \
    KRD(GL,0); GAPB(o[0]=__builtin_amdgcn_mfma_f32_32x32x16_bf16(PAF(1),VFR(1),o[0],0,0,0), C0,8); \
    KRD(GL,1); GAPB(o[1]=__builtin_amdgcn_mfma_f32_32x32x16_bf16(PAF(1),VFR(5),o[1],0,0,0), C0,12); \
    KRD(GL,2); GAPB(o[0]=__builtin_amdgcn_mfma_f32_32x32x16_bf16(PAF(2),VFR(2),o[0],0,0,0), C1,0); \
    KRD(GL,3); GAPB(o[1]=__builtin_amdgcn_mfma_f32_32x32x16_bf16(PAF(2),VFR(6),o[1],0,0,0), C1,4); \
    GAPB(o[0]=__builtin_amdgcn_mfma_f32_32x32x16_bf16(PAF(3),VFR(3),o[0],0,0,0), C1,8); \
    GAPB(o[1]=__builtin_amdgcn_mfma_f32_32x32x16_bf16(PAF(3),VFR(7),o[1],0,0,0), C1,12); \
    }while(0)
  int t=1;
  #undef CMASK
  #define CMASK(P0,P1,t) do{}while(0)
  for(;t+5<NT;t+=2){
    STEP(pB0,pB1,pA0,pA1,t,true,true,true);     WAIT_BAR(2); RESC(); ROT();
    STEP(pA0,pA1,pB0,pB1,t+1,true,true,true);   WAIT_BAR(2); RESC(); ROT();
  }
  #undef CMASK
  #define CMASK(P0,P1,t) do{ if constexpr(VAR!=2){ int jb_=(t)-(NT-4); if(jb_>=0)cmask(P0,P1,jb_,qrel,hi); } }while(0)
  #define ENDW(tt) do{ if((tt)+3<NT){WAIT_BAR(2);} else if((tt)+2<NT){WAIT_BAR(1);} else {WAIT_BAR(0);} }while(0)
  for(;t+1<NT;t+=2){
    STEP(pB0,pB1,pA0,pA1,t,(t+3<NT),(t+1<NT),(t+1<NT));       ENDW(t);   RESC(); ROT();
    STEP(pA0,pA1,pB0,pB1,t+1,(t+4<NT),(t+2<NT),(t+2<NT));     ENDW(t+1); RESC(); ROT();
  }
  STEP(pB0,pB1,pA0,pA1,NT-1,false,false,false); RESC();
  { float sacc=pB0[0]+pB0[1]; _Pragma("unroll") for(int r=2;r<16;++r)sacc+=pB0[r]; _Pragma("unroll") for(int r=0;r<16;++r)sacc+=pB1[r]; l_reg+=sacc;
    pw0=(u32x4){PKW(pB0,0),PKW(pB0,2),PKW(pB0,4),PKW(pB0,6)};pw1=(u32x4){PKW(pB0,8),PKW(pB0,10),PKW(pB0,12),PKW(pB0,14)};pw2=(u32x4){PKW(pB1,0),PKW(pB1,2),PKW(pB1,4),PKW(pB1,6)};pw3=(u32x4){PKW(pB1,8),PKW(pB1,10),PKW(pB1,12),PKW(pB1,14)};
    SBAR(); pv(o,vb0+sl_cur,PAF(0),PAF(1),PAF(2),PAF(3)); }
  #undef PKW
  #undef PAF
  #undef VFR
  #undef PIN
  #undef MX3
  #undef GAPA
  #undef GAPB
  #undef EX
  #undef VRD
  #undef KRD
  #undef STEP
  #undef ENDW
  #undef DECIDE
  #undef BASE
  {auto rr=__builtin_amdgcn_permlane32_swap(__float_as_uint(l_reg),__float_as_uint(l_reg),false,false);l_reg=__uint_as_float(rr[0])+__uint_as_float(rr[1]);}
  int pslot=0;
  if constexpr(VAR==2){ const unsigned s3=mio.SEL3[qidx]; pslot=((int)(s3&31u)==mio.jblk)?0:(((int)((s3>>5)&31u)==mio.jblk)?1:2); }
  if(hi==0){ wsf[32+r32]=l_reg; if constexpr(VAR==2) wsf[r32]=__int_as_float(qvalid?(qidx*4+pslot):-1); }
  asm volatile("s_waitcnt lgkmcnt(0)":::"memory");
  if constexpr(VAR>=1){ if(hi==0&&qvalid) mio.LSE[(long)qidx*4+((VAR==1)?3:pslot)]=mhat+__builtin_amdgcn_logf(l_reg); }
  float rli[16];
  #pragma unroll
  for(int r=0;r<16;++r)rli[r]=__builtin_amdgcn_rcpf(wsf[32+crow(r,hi)]);
  { bf16*stg=(bf16*)(shm+LDS_OST)+wid*2048;
    #pragma unroll
    for(int r=0;r<16;++r){const int orow=crow(r,hi);
      #pragma unroll
      for(int d0=0;d0<2;++d0)stg[orow*64+d0*32+r32]=__float2bfloat16(o[d0][r]*rli[r]);}
    asm volatile("s_waitcnt lgkmcnt(0)":::"memory");
    if constexpr(VAR==2){
      #pragma unroll
      for(int i=0;i<4;++i){const int row=i*8+(lane>>3),ch=lane&7; const u32x4 v=*(const u32x4*)(stg+row*64+ch*8); const int inf=__float_as_int(wsf[row]);
        if(inf>=0){ bf16*pb=((inf&3)==0)?mio.PART0:(((inf&3)==1)?mio.PART1:mio.PART2); ATTN_STORE16(pb+(long)(inf>>2)*D+ch*8,v); } }
    } else if constexpr(VAR==1){
      bf16*Ow=mio.PART0+(long)(q0+wid*QBLK)*D;
      #pragma unroll
      for(int i=0;i<4;++i){const int row=i*8+(lane>>3),ch=lane&7; const u32x4 v=*(const u32x4*)(stg+row*64+ch*8); ATTN_STORE16(Ow+(long)row*D+ch*8,v);}
    } else {
      bf16*Ow=O+(rowbase+q0+wid*QBLK)*DM+h*D;
      #pragma unroll
      for(int i=0;i<4;++i){const int row=i*8+(lane>>3),ch=lane&7; const u32x4 v=*(const u32x4*)(stg+row*64+ch*8); ATTN_STORE16(Ow+(long)row*DM+ch*8,v);} } }
  asm volatile("s_waitcnt lgkmcnt(0)\n\ts_barrier":::"memory");
  #undef DMA_K
  #undef DMA_V
  #undef CMASK
  #undef RESC
  #undef ROT
}
template<bool OWN> __device__ __forceinline__ void moba4_unit(int b,int h,int qb,int jblk,int cnt,const bf16*Q,const bf16*__restrict__ K,const bf16*__restrict__ V,const MobaIo&mio,char*shm){
  constexpr bool FOX=false; constexpr int THRL=8, VAR=OWN?1:2; constexpr int LK=0,LV=4*SLOTB,LWS=8*SLOTB,LOST=LWS+NW*128*4;
  const int t0=4*jblk; bf16*O=nullptr; const float*CK2=nullptr; (void)O; (void)CK2;
  const int tid=otid(),lane=tid&63,r32=lane&31,hi=lane>>5; const int wid=__builtin_amdgcn_readfirstlane(tid>>6);
  const long rowbase=(long)b*SEQ; const int q0=qb*QB;
  const bf16*Kh=K+(rowbase+(long)t0*KVBLK)*DM+h*D,*Vh=V+(rowbase+(long)t0*KVBLK)*DM+h*D;
  const unsigned lds0=(unsigned)(uintptr_t)shm;
  float*wsf=(float*)(shm+LWS)+wid*128;
  const bf16*ksrc=Kh+(long)lane*DM+wid*8;
  const bf16*vsrc=Vh+(long)(16*(wid&3)+(lane>>2))*DM+(wid>>2)*32+(lane&3)*8;
  const unsigned kdst=lds0+LK+wid*1024, vdst=lds0+LV+wid*1024;
  #define DMA_K(t,slot) glds16(ksrc+(long)(t)*KVBLK*DM,(unsigned)__builtin_amdgcn_readfirstlane(kdst+(slot)))
  #define DMA_V(t,slot) glds16(vsrc+(long)(t)*KVBLK*DM,(unsigned)__builtin_amdgcn_readfirstlane(vdst+(slot)))
  const int vb0=(int)(lds0+LV)+((lane>>4)&1)*32+(lane&3)*8+(4*hi+((lane&15)>>2))*64;
  bf16x8 kf[8];
  const lds_cptr shm3=(lds_cptr)shm; const lds_cptr kp0=shm3+LK+hi*1024+r32*16; const lds_cptr vp0=shm3+LV+((lane>>4)&1)*32+(lane&3)*8+(4*hi+((lane&15)>>2))*64;
  const __attribute__((address_space(3))) float*ckl=(const __attribute__((address_space(3))) float*)(shm3+LWS)+4*hi;
  constexpr int NT=4; const float cq2=0.f; (void)cq2;
  DMA_K(0,0);DMA_V(0,0);DMA_K(1,SLOTB);DMA_V(1,SLOTB);DMA_K(2,2*SLOTB);DMA_V(2,2*SLOTB);DMA_K(3,3*SLOTB);DMA_V(3,3*SLOTB);
  const int nch=OWN?1:(cnt+QB-1)/QB;
  int qidx=q0+wid*QBLK+r32,qnext=0; unsigned s3=0u; bf16x8 qr[4];
  if constexpr(VAR==2){ qidx=(int)mio.QL[min(wid*QBLK+r32,cnt-1)]; s3=mio.SEL3[qidx]; qnext=(int)mio.QL[min(QB+wid*QBLK+r32,cnt-1)]; }
  { const bf16*Qrow=Q+(rowbase+qidx)*DM+h*D;
    #pragma unroll
    for(int d0=0;d0<4;++d0)qr[d0]=*reinterpret_cast<const bf16x8*>(&Qrow[d0*16+hi*8]); }
  for(int c_=0;c_<nch;++c_){
  bool qvalid=true; int pslot=0;
  if constexpr(VAR==2){ qvalid=(c_*QB+wid*QBLK+r32)<cnt; pslot=((int)(s3&31u)==jblk)?0:(((int)((s3>>5)&31u)==jblk)?1:2); }
  wsf[64+lane]=__int_as_float(qvalid?(qidx*4+(OWN?3:pslot)):-1);
  float mhat=0.f,l_reg=0.f;f32x16 o[2];o[0]=f32x16{};o[1]=f32x16{};
  const int qrel=wid*QBLK+r32;
  #define CMASK(P0,P1,t) do{ if constexpr(VAR!=2){ int jb_=(t)-(NT-4); if(jb_>=0)cmask(P0,P1,jb_,qrel,hi); } }while(0)
  #define BASE(t) (FOX ? (cq2-mhat) : -mhat)
  bool resc=false,nmd=true; f32x16 negm=f32x16{}; asm volatile("":"+v"(negm));
  #define RESC() do{ if(resc){ asm volatile("s_waitcnt lgkmcnt(0)":::"memory"); \
      _Pragma("unroll") for(int d_=0;d_<2;++d_) _Pragma("unroll") for(int r=0;r<16;++r)o[d_][r]*=wsf[crow(r,hi)]; } }while(0)
  #define MX3(a,b,c) __builtin_fmaxf(__builtin_fmaxf((a),(b)),(c))
  #define DECIDE(C0,C1) do{ float a=MX3(C0[0],C0[1],C1[0]),b_=MX3(C0[2],C0[3],C1[1]); a=MX3(a,C1[2],C1[3]); \
      _Pragma("unroll") for(int r=4;r<16;r+=4){a=MX3(a,C0[r],C0[r+1]);b_=MX3(b_,C0[r+2],C0[r+3]);a=MX3(a,C1[r],C1[r+1]);b_=MX3(b_,C1[r+2],C1[r+3]);} \
      float rm=__builtin_fmaxf(a,b_); { auto rr=__builtin_amdgcn_permlane32_swap(__float_as_uint(rm),__float_as_uint(rm),false,false); rm=__builtin_fmaxf(__uint_as_float(rr[0]),__uint_as_float(rr[1])); } \
      resc=false; \
      if(__builtin_expect(__any(rm>(float)THRL),0)){ const float dl=(rm>(float)THRL)?rm:0.f; mhat+=dl;     \
        _Pragma("unroll") for(int r=0;r<16;++r){C0[r]-=dl;C1[r]-=dl;} \
        const float f=__builtin_amdgcn_exp2f(-dl); l_reg*=f; if(hi==0)wsf[r32]=f; resc=true; nmd=true; } }while(0)
  f32x16 pA0,pA1,pB0,pB1;
  int sl_prev=0,sl_cur=0,sl_next=SLOTB;
  #define ROT() do{sl_prev=sl_cur;sl_cur=sl_next;sl_next=sl_next+SLOTB;}while(0)
  #define WAIT_NB() asm volatile("s_waitcnt lgkmcnt(0)":::"memory")
  if(c_==0){ WAIT_BAR(0); }
  { const float bs=BASE(0); cinit<FOX>(pA0,ckl,bs); cinit<FOX>(pA1,ckl+32,bs);
    const char*kb=shm+LK+hi*1024+r32*16;
    #pragma unroll
    for(int d0=0;d0<4;++d0){
      const bf16x8 b0=*reinterpret_cast<const bf16x8*>(kb+d0*2048);
      const bf16x8 b1=*reinterpret_cast<const bf16x8*>(kb+d0*2048+512);
      pA0=__builtin_amdgcn_mfma_f32_32x32x16_bf16(b0,qr[d0],pA0,0,0,0);pA1=__builtin_amdgcn_mfma_f32_32x32x16_bf16(b1,qr[d0],pA1,0,0,0);}
    CMASK(pA0,pA1,0);
    DECIDE(pA0,pA1); resc=false;
    _Pragma("unroll") for(int r=0;r<16;++r){pA0[r]=__builtin_amdgcn_exp2f(pA0[r]);pA1[r]=__builtin_amdgcn_exp2f(pA1[r]);} }
  WAIT_NB();
  ROT();
  kload8(kf,kp0+sl_cur);
  WAIT_NB();
  s16x4 vlo[8],vhi[8]; u32x4 pw0,pw1,pw2,pw3;
  #define PKW(P,B) cvtpk_s(P[B],P[B+1])
  #define PAF(k) __builtin_bit_cast(bf16x8,pw##k)
  #define VFR(i) (bf16x8){vlo[i][0],vlo[i][1],vlo[i][2],vlo[i][3],vhi[i][0],vhi[i][1],vhi[i][2],vhi[i][3]}
  #define PIN(x) asm volatile("":"+v"(x))
  #define GAPA(MF,A0,A1,A2,A3,W0,W1,PW) do{ MF; sacc+=A0; sacc+=A1; sacc+=A2; sacc+=A3; PIN(sacc); W0; W1; PIN(PW); SBAR(); }while(0)
  #define EX(v) __builtin_amdgcn_exp2f(v)
  #define GAPB(MF,X,B) do{ MF; X[B]=EX(X[B]); X[B+1]=EX(X[B+1]); X[B+2]=EX(X[B+2]); X[B+3]=EX(X[B+3]); PIN(X); SBAR(); }while(0)
  #define VRD(i) do{ vlo[i]=vtr(vp_+(((i)>>2)*4096+((i)&3)*1024)); vhi[i]=vtr(vp_+(((i)>>2)*4096+((i)&3)*1024+512)); }while(0)
  #define KRD(G,j) do{ if(G){ kload2(kf,kp0+sl_next,j); SBAR(); } }while(0)
  #define STEP(C0,C1,P0,P1,t,GK,GV,GL) do{ SBAR(); \
    const lds_cptr vp_=vp0+sl_prev; const float bs_=BASE(t); \
    if constexpr(FOX){ cinit<FOX>(C0,ckl+(t)*64,bs_); SBAR(); } \
    else if(nmd){ _Pragma("unroll") for(int r=0;r<16;++r)negm[r]=bs_; asm volatile("":"+v"(negm)); nmd=false; SBAR(); }     \
    VRD(0); SBAR(); float sacc=(P0[0]+P0[1]); \
    GAPA(C0=__builtin_amdgcn_mfma_f32_32x32x16_bf16(kf[0],qr[0],FOX?C0:negm,0,0,0), P0[2],P0[3],P0[4],P0[5],     pw0[0]=PKW(P0,0), pw0[1]=PKW(P0,2), pw0); \
    if constexpr(FOX){ cinit<FOX>(C1,ckl+(t)*64+32,bs_); SBAR(); } \
    VRD(4); SBAR(); GAPA(C1=__builtin_amdgcn_mfma_f32_32x32x16_bf16(kf[1],qr[0],FOX?C1:negm,0,0,0), P0[6],P0[7],P0[8],P0[9],     pw0[2]=PKW(P0,4), pw0[3]=PKW(P0,6), pw0); \
    VRD(1); SBAR(); GAPA(C0=__builtin_amdgcn_mfma_f32_32x32x16_bf16(kf[2],qr[1],C0,0,0,0),   P0[10],P0[11],P0[12],P0[13], pw1[0]=PKW(P0,8), pw1[1]=PKW(P0,10), pw1); \
    VRD(5); SBAR(); GAPA(C1=__builtin_amdgcn_mfma_f32_32x32x16_bf16(kf[3],qr[1],C1,0,0,0),   P0[14],P0[15],P1[0],P1[1],   pw1[2]=PKW(P0,12),pw1[3]=PKW(P0,14), pw1); \
    VRD(2); SBAR(); GAPA(C0=__builtin_amdgcn_mfma_f32_32x32x16_bf16(kf[4],qr[2],C0,0,0,0),   P1[2],P1[3],P1[4],P1[5],     pw2[0]=PKW(P1,0), pw2[1]=PKW(P1,2), pw2); \
    VRD(6); SBAR(); GAPA(C1=__builtin_amdgcn_mfma_f32_32x32x16_bf16(kf[5],qr[2],C1,0,0,0),   P1[6],P1[7],P1[8],P1[9],     pw2[2]=PKW(P1,4), pw2[3]=PKW(P1,6), pw2); \
    VRD(3); SBAR(); GAPA(C0=__builtin_amdgcn_mfma_f32_32x32x16_bf16(kf[6],qr[3],C0,0,0,0),   P1[10],P1[11],P1[12],P1[13], pw3[0]=PKW(P1,8), pw3[1]=PKW(P1,10), pw3); \
    VRD(7); SBAR(); GAPA(C1=__builtin_amdgcn_mfma_f32_32x32x16_bf16(kf[7],qr[3],C1,0,0,0),   P1[14],P1[15],0.f,0.f,       pw3[2]=PKW(P1,12),pw3[3]=PKW(P1,14), pw3); \
    l_reg+=sacc; \
    if(GK){DMA_K((t)+3,sl_cur);} if(GV){DMA_V((t)+1,sl_next);} \
    CMASK(C0,C1,t); \
    DECIDE(C0,C1); \
    SBAR(); \
    GAPB(o[0]=__builtin_amdgcn_mfma_f32_32x32x16_bf16(PAF(0),VFR(0),o[0],0,0,0), C0,0); \
    GAPB(o[1]=__builtin_amdgcn_mfma_f32_32x32x16_bf16(PAF(0),VFR(4),o[1],0,0,0), C0,4); \
    KRD(GL,0); GAPB(o[0]=__builtin_amdgcn_mfma_f32_32x32x16_bf16(PAF(1),VFR(1),o[0],0,0,0), C0,8); \
    KRD(GL,1); GAPB(o[1]=__builtin_amdgcn_mfma_f32_32x32x16_bf16(PAF(1),VFR(5),o[1],0,0,0), C0,12); \
    KRD(GL,2); GAPB(o[0]=__builtin_amdgcn_mfma_f32_32x32x16_bf16(PAF(2),VFR(2),o[0],0,0,0), C1,0); \
    KRD(GL,3); GAPB(o[1]=__builtin_amdgcn_mfma_f32_32x32x16_bf16(PAF(2),VFR(6),o[1],0,0,0), C1,4); \
    GAPB(o[0]=__builtin_amdgcn_mfma_f32_32x32x16_bf16(PAF(3),VFR(3),o[0],0,0,0), C1,8); \
    GAPB(o[1]=__builtin_amdgcn_mfma_f32_32x32x16_bf16(PAF(3),VFR(7),o[1],0,0,0), C1,12); \
    }while(0)
  int t=1;
  #undef CMASK
  #define CMASK(P0,P1,t) do{}while(0)
  for(;t+5<NT;t+=2){
    STEP(pB0,pB1,pA0,pA1,t,false,false,true);     WAIT_NB(); RESC(); ROT();
    STEP(pA0,pA1,pB0,pB1,t+1,false,false,true);   WAIT_NB(); RESC(); ROT();
  }
  #undef CMASK
  #define CMASK(P0,P1,t) do{ if constexpr(VAR!=2){ int jb_=(t)-(NT-4); if(jb_>=0)cmask(P0,P1,jb_,qrel,hi); } }while(0)
  #define ENDW(tt) WAIT_NB()
  for(;t+1<NT;t+=2){
    STEP(pB0,pB1,pA0,pA1,t,false,false,(t+1<NT));       ENDW(t);   RESC(); ROT();
    STEP(pA0,pA1,pB0,pB1,t+1,false,false,(t+2<NT));     ENDW(t+1); RESC(); ROT();
  }
  STEP(pB0,pB1,pA0,pA1,NT-1,false,false,false); RESC();
  if constexpr(VAR==2){ if(c_+1<nch){ qidx=qnext; const bf16*Qrow=Q+(rowbase+qidx)*DM+h*D;
      #pragma unroll
      for(int d0=0;d0<4;++d0)qr[d0]=*reinterpret_cast<const bf16x8*>(&Qrow[d0*16+hi*8]);
      s3=mio.SEL3[qidx]; qnext=(int)mio.QL[min((c_+2)*QB+wid*QBLK+r32,cnt-1)]; } }
  { float sacc=pB0[0]+pB0[1]; _Pragma("unroll") for(int r=2;r<16;++r)sacc+=pB0[r]; _Pragma("unroll") for(int r=0;r<16;++r)sacc+=pB1[r]; l_reg+=sacc;
    pw0=(u32x4){PKW(pB0,0),PKW(pB0,2),PKW(pB0,4),PKW(pB0,6)};pw1=(u32x4){PKW(pB0,8),PKW(pB0,10),PKW(pB0,12),PKW(pB0,14)};pw2=(u32x4){PKW(pB1,0),PKW(pB1,2),PKW(pB1,4),PKW(pB1,6)};pw3=(u32x4){PKW(pB1,8),PKW(pB1,10),PKW(pB1,12),PKW(pB1,14)};
    SBAR(); pv(o,vb0+sl_cur,PAF(0),PAF(1),PAF(2),PAF(3)); }
  #undef PKW
  #undef PAF
  #undef VFR
  #undef PIN
  #undef MX3
  #undef GAPA
  #undef GAPB
  #undef EX
  #undef VRD
  #undef KRD
  #undef STEP
  #undef ENDW
  #undef DECIDE
  #undef BASE
  {auto rr=__builtin_amdgcn_permlane32_swap(__float_as_uint(l_reg),__float_as_uint(l_reg),false,false);l_reg=__uint_as_float(rr[0])+__uint_as_float(rr[1]);}
  const int info=__float_as_int(wsf[64+lane]);
  if(hi==0){ wsf[32+r32]=l_reg; if constexpr(VAR==2) wsf[r32]=__int_as_float(info); }
  asm volatile("s_waitcnt lgkmcnt(0)":::"memory");
  if(hi==0&&info>=0) mio.LSE[info]=mhat+__builtin_amdgcn_logf(l_reg);
  float rli[16];
  #pragma unroll
  for(int r=0;r<16;++r)rli[r]=__builtin_amdgcn_rcpf(wsf[32+crow(r,hi)]);
  { bf16*stg=(bf16*)(shm+LOST)+wid*2048;
    #pragma unroll
    for(int r=0;r<16;++r){const int orow=crow(r,hi);
      #pragma unroll
      for(int d0=0;d0<2;++d0)stg[orow*64+d0*32+r32]=__float2bfloat16(o[d0][r]*rli[r]);}
    asm volatile("s_waitcnt lgkmcnt(0)":::"memory");
    if constexpr(VAR==2){
      #pragma unroll
      for(int i=0;i<4;++i){const int row=i*8+(lane>>3),ch=lane&7; const u32x4 v=*(const u32x4*)(stg+row*64+ch*8); const int inf=__float_as_int(wsf[row]);
        if(inf>=0){ bf16*pb=((inf&3)==0)?mio.PART0:(((inf&3)==1)?mio.PART1:mio.PART2); ATTN_STORE16(pb+(long)(inf>>2)*D+ch*8,v); } }
    } else if constexpr(VAR==1){
      bf16*Ow=mio.PART0+(long)(q0+wid*QBLK)*D;
      #pragma unroll
      for(int i=0;i<4;++i){const int row=i*8+(lane>>3),ch=lane&7; const u32x4 v=*(const u32x4*)(stg+row*64+ch*8); ATTN_STORE16(Ow+(long)row*D+ch*8,v);}
    } else {
      bf16*Ow=O+(rowbase+q0+wid*QBLK)*DM+h*D;
      #pragma unroll
      for(int i=0;i<4;++i){const int row=i*8+(lane>>3),ch=lane&7; const u32x4 v=*(const u32x4*)(stg+row*64+ch*8); ATTN_STORE16(Ow+(long)row*DM+ch*8,v);} } }
  asm volatile("s_waitcnt lgkmcnt(0)":::"memory");
  }
  #undef WAIT_NB
  #undef DMA_K
  #undef DMA_V
  #undef CMASK
  #undef RESC
  #undef ROT
}

__device__ __forceinline__ void moba_gate_item(int b,int h,int qb,const bf16*Q,const float*KSUM,unsigned*SEL3,unsigned*CNT,unsigned short*LIST){
  const int tid=otid(),lane=tid&63,r32=lane&31,hi=lane>>5; const int wid=__builtin_amdgcn_readfirstlane(tid>>6);
  const int q=qb*QB+wid*QBLK+r32;
  const bf16*Qrow=Q+((long)b*SEQ+q)*DM+h*D;
  bf16x8 qr[4];
  #pragma unroll
  for(int d0=0;d0<4;++d0)qr[d0]=*reinterpret_cast<const bf16x8*>(&Qrow[d0*16+hi*8]);
  f32x16 ga=f32x16{};
  const float*km=KSUM+r32*64+8*hi;
  #pragma unroll
  for(int ks=0;ks<4;++ks){
    const f32x4 a0=*(const f32x4*)(km+16*ks),a1=*(const f32x4*)(km+16*ks+4),c0=*(const f32x4*)(km+KSUM_P1+16*ks),c1=*(const f32x4*)(km+KSUM_P1+16*ks+4);
    float x[8]; u32x4 fh,fl;
    #pragma unroll
    for(int e=0;e<4;++e){x[e]=a0[e]+c0[e];x[4+e]=a1[e]+c1[e];}
    #pragma unroll
    for(int e=0;e<4;++e){ const unsigned hw=cvtpk_s(x[2*e],x[2*e+1]); fh[e]=hw; fl[e]=cvtpk_s(x[2*e]-__uint_as_float(hw<<16),x[2*e+1]-__uint_as_float(hw&0xffff0000u)); }
    ga=__builtin_amdgcn_mfma_f32_32x32x16_bf16(__builtin_bit_cast(bf16x8,fh),qr[ks],ga,0,0,0);
    ga=__builtin_amdgcn_mfma_f32_32x32x16_bf16(__builtin_bit_cast(bf16x8,fl),qr[ks],ga,0,0,0);
  }
  unsigned t0=0u,t1=0u,t2=0u;
  #define INS3(x) do{ unsigned x_=(x); unsigned m_=max(t0,x_); x_=min(t0,x_); t0=m_; m_=max(t1,x_); x_=min(t1,x_); t1=m_; t2=max(t2,x_); }while(0)
  #pragma unroll
  for(int r=0;r<16;++r){ const int n=(r&3)+8*(r>>2)+4*hi; const unsigned u_=__float_as_uint(ga[r]); const unsigned o_=u_^((unsigned)((int)u_>>31)|0x80000000u);
    const unsigned key=(n<qb)?((o_&~31u)|(unsigned)(31-n)):0u; INS3(key); }
  { const unsigned p0=(unsigned)__shfl_xor((int)t0,32),p1=(unsigned)__shfl_xor((int)t1,32),p2=(unsigned)__shfl_xor((int)t2,32); INS3(p0); INS3(p1); INS3(p2); }
  #undef INS3
  const int n0=t0?(int)(31u-(t0&31u)):-1,n1=t1?(int)(31u-(t1&31u)):-1,n2=t2?(int)(31u-(t2&31u)):-1;
  const unsigned cntv=(t0?1u:0u)+(t1?1u:0u)+(t2?1u:0u);
  if(hi==0)SEL3[q]=(unsigned)(n0&31)|((unsigned)(n1&31)<<5)|((unsigned)(n2&31)<<10)|(cntv<<15);
  unsigned mycnt=0u; int rk0=0,rk1=0,rk2=0; const unsigned long long below=(1ull<<r32)-1ull;
  for(int j=0;j<qb;++j){ const unsigned long long m=__ballot(hi==0&&(n0==j||n1==j||n2==j))&0xffffffffull; const int pc=__builtin_popcountll(m);
    if(lane==j)mycnt=(unsigned)pc; const int rk=__builtin_popcountll(m&below); if(n0==j)rk0=rk; if(n1==j)rk1=rk; if(n2==j)rk2=rk; }
  unsigned basev=0u;
  if(lane<qb&&mycnt)basev=__hip_atomic_fetch_add(CNT+lane,mycnt,__ATOMIC_RELAXED,__HIP_MEMORY_SCOPE_AGENT);
  const unsigned b0=(unsigned)__shfl((int)basev,n0<0?0:n0),b1=(unsigned)__shfl((int)basev,n1<0?0:n1),b2=(unsigned)__shfl((int)basev,n2<0?0:n2);
  if(hi==0){ if(n0>=0)LIST[(long)n0*SEQ+b0+rk0]=(unsigned short)q; if(n1>=0)LIST[(long)n1*SEQ+b1+rk1]=(unsigned short)q; if(n2>=0)LIST[(long)n2*SEQ+b2+rk2]=(unsigned short)q; }
}
#undef SBAR
#undef WAIT_BAR
}

constexpr float FOX_SKIP = 32.0f;
constexpr size_t WS_QCTR = 32 * KiB;
__device__ __forceinline__ void phase_attn(char* lds, volatile LAS unsigned* misc, const P& p) {
    attn::bf16* QKVb = (attn::bf16*)(p.ws + WS_QKV);
    unsigned* qctr = (unsigned*)(p.ws + WS_QCTR); unsigned* MCNT = (unsigned*)(p.ws + WS_MCNT); unsigned* MG1 = (unsigned*)(p.ws + WS_MG1);
    bool g1seen = false; const attn::MobaIo mio0{}; int gpend = 0;
    volatile LAS unsigned* CNL = misc + 64;
    int npub = 0; int nstat = 0;
    for (;;) {
        int up;
        if (nstat < 3) { up = (int)blockIdx.x + 256 * nstat; ++nstat; }
        else {
            if (threadIdx.x == 0) misc[16] = 768u + __hip_atomic_fetch_add(qctr, 1u, __ATOMIC_RELAXED, __HIP_MEMORY_SCOPE_AGENT);
            __syncthreads();
            up = (int)__builtin_amdgcn_readfirstlane((int)misc[16]);
            __syncthreads(); }
        if (gpend && (up >= 512)) {
            asm volatile("s_waitcnt vmcnt(0)" ::: "memory");
            unsigned lastw = 0u;
            if ((threadIdx.x & 63) == 0) lastw = (__hip_atomic_fetch_add((LAS unsigned*)(misc + 18), 1u, __ATOMIC_ACQ_REL, __HIP_MEMORY_SCOPE_WORKGROUP) == 8u * (unsigned)npub + 7u) ? 1u : 0u;
            ++npub;
            if (lastw) { __builtin_amdgcn_fence(__ATOMIC_RELEASE, "agent"); asm volatile("s_waitcnt vmcnt(0)" ::: "memory");
                const unsigned old = __hip_atomic_fetch_add(MG1, (unsigned)gpend, __ATOMIC_RELAXED, __HIP_MEMORY_SCOPE_AGENT);
                if (old + (unsigned)gpend == 512u) { __builtin_amdgcn_fence(__ATOMIC_ACQ_REL, "agent"); asm volatile("s_waitcnt vmcnt(0)" ::: "memory"); __hip_atomic_store(MG1 + 64, 1u, __ATOMIC_RELAXED, __HIP_MEMORY_SCOPE_AGENT); } }
            gpend = 0; }
        if (up >= 2032) break;
        const int u = (up < 512 || up >= 1520) ? up : (up < 768 ? up + 496 : (up < 1264 ? up - 256 : up));
        if (u < 512) {
            const int bh = u & 15, qb = u >> 4;
            attn::moba_gate_item(bh >> 3, bh & 7, qb, QKVb, (const float*)(p.ws + WS_KMP) + (size_t)bh * 32 * 64, (unsigned*)(p.ws + WS_SEL3) + (size_t)bh * S, MCNT + bh * 32, (unsigned short*)(p.ws + WS_MLIST) + (size_t)bh * 32 * S);
            ++gpend;
            continue;
        }
        if (u >= 1008 && u < 1520) {
            const int v = u - 1008, qb = 31 - (v >> 4), bh = v & 15;
            const float* c2 = (const float*)(p.ws + WS_C) + (size_t)bh * S; const int lane = threadIdx.x & 63, nt = 4 * qb + 4;
            const float cq = c2[qb * 256];
            const float* FK = (const float*)(p.ws + WS_FKN) + (size_t)bh * 256; const float* FQ = (const float*)(p.ws + WS_FQN) + ((size_t)bh * 32 + qb) * 4;
#define FOX_KN(t) sqrtf(FK[2 * (t)] + FK[2 * (t) + 1])
            const float qm = sqrtf(fmaxf(FQ[0] + FQ[1], FQ[2] + FQ[3])), ko = fmaxf(fmaxf(FOX_KN(4 * qb), FOX_KN(4 * qb + 1)), fmaxf(FOX_KN(4 * qb + 2), FOX_KN(4 * qb + 3)));
            const float th0 = (lane < nt) ? 1.01f * qm * (FOX_KN(lane) + ko) + FOX_SKIP : 0.f, th1 = (lane + 64 < nt) ? 1.01f * qm * (FOX_KN(lane + 64) + ko) + FOX_SKIP : 0.f;
#undef FOX_KN
            const bool keep0 = (lane < nt) ? (cq - c2[64 * lane + 63] >= -th0) : true, keep1 = (lane + 64 < nt) ? (cq - c2[64 * (lane + 64) + 63] >= -th1) : true;
            const unsigned long long m0 = __ballot(keep0), m1 = __ballot(keep1);
            int first = m0 ? __builtin_ctzll(m0) : 64 + __builtin_ctzll(m1);
            int t0 = first & ~1; if (t0 > nt - 4) t0 = nt - 4;
            t0 = __builtin_amdgcn_readfirstlane(t0);
            attn::attn_unit<true, 24, 0>(bh >> 3, bh & 7, qb, t0, QKVb + SLOT, QKVb + 4 * SLOT, QKVb + 5 * SLOT, QKVb + SLOT, c2, mio0, lds);
            continue;
        }
        if (!g1seen) {
            if (threadIdx.x == 0) { unsigned sp = 0u;
                while (__hip_atomic_load(MG1 + 64, __ATOMIC_RELAXED, __HIP_MEMORY_SCOPE_AGENT) == 0u) { __builtin_amdgcn_s_sleep(8); if (++sp > (1u << 22)) break; }
                __builtin_amdgcn_fence(__ATOMIC_ACQUIRE, "agent"); asm volatile("s_waitcnt vmcnt(0)" ::: "memory"); }
            __syncthreads();
            CNL[threadIdx.x] = __hip_atomic_load(MCNT + threadIdx.x, __ATOMIC_RELAXED, __HIP_MEMORY_SCOPE_AGENT);
            __syncthreads();
            g1seen = true;
        }
        attn::MobaIo mio{};
        if (u < 1008) {
            const int v = u - 512, j = v >> 4, bh = v & 15, cnt = (int)__builtin_amdgcn_readfirstlane((int)CNL[bh * 32 + j]);
            if (cnt == 0) continue;
            mio.QL = (const unsigned short*)(p.ws + WS_MLIST) + ((size_t)bh * 32 + j) * S; mio.SEL3 = (const unsigned*)(p.ws + WS_SEL3) + (size_t)bh * S; mio.LSE = (float*)(p.ws + WS_MLSE) + (size_t)bh * S * 4;
            mio.PART0 = (attn::bf16*)(p.ws + WS_MP0) + (size_t)bh * S * 64; mio.PART1 = (attn::bf16*)(p.ws + WS_MP1) + (size_t)bh * S * 64; mio.PART2 = (attn::bf16*)(p.ws + WS_MP2) + (size_t)bh * S * 64;
            attn::moba4_unit<false>(bh >> 3, bh & 7, 0, j, cnt, QKVb, QKVb + 2 * SLOT, QKVb + 3 * SLOT, mio, lds);
        } else {
            const int v = u - 1520, qb = v >> 4, bh = v & 15;
            mio.LSE = (float*)(p.ws + WS_MLSE) + (size_t)bh * S * 4; mio.PART0 = (attn::bf16*)(p.ws + WS_MP3) + (size_t)bh * S * 64;
            attn::moba4_unit<true>(bh >> 3, bh & 7, qb, qb, 256, QKVb, QKVb + 2 * SLOT, QKVb + 3 * SLOT, mio, lds);
        }
    }
}
__device__ __forceinline__ void phase_moba_combine(const P& p) {
    const int TID = otid();
    bf16_t* OA = (bf16_t*)(p.ws + WS_QKV); const unsigned* SEL3 = (const unsigned*)(p.ws + WS_SEL3); const float* LSE = (const float*)(p.ws + WS_MLSE);
    const bf16_t* P0 = (const bf16_t*)(p.ws + WS_MP0); const bf16_t* P1 = (const bf16_t*)(p.ws + WS_MP1); const bf16_t* P2 = (const bf16_t*)(p.ws + WS_MP2); const bf16_t* P3 = (const bf16_t*)(p.ws + WS_MP3);
    for (int it = blockIdx.x * 512 + TID; it < Bn * NH * S * 8; it += gridDim.x * 512) {
        const int ch = it & 7, bq = it >> 3, bh = bq >> 13, q = bq & (S - 1), b = bh >> 3, h = bh & 7;
        const unsigned n = SEL3[bq] >> 15;
        bf16_t* orow = OA + ((size_t)b * S + q) * 512 + h * 64 + ch * 8;
        const u32x4 own = *(const u32x4*)(P3 + (size_t)bq * 64 + ch * 8);
        if (n == 0u) { *(u32x4*)orow = own; continue; }
        const f32x4 ls = *(const f32x4*)(LSE + (size_t)bq * 4);
        float m = fmaxf(ls[3], ls[0]); if (n > 1u) m = fmaxf(m, ls[1]); if (n > 2u) m = fmaxf(m, ls[2]);
        const float w3 = __builtin_amdgcn_exp2f(ls[3] - m), w0 = __builtin_amdgcn_exp2f(ls[0] - m), w1 = (n > 1u) ? __builtin_amdgcn_exp2f(ls[1] - m) : 0.f, w2 = (n > 2u) ? __builtin_amdgcn_exp2f(ls[2] - m) : 0.f;
        const float rw = 1.f / (w3 + w0 + w1 + w2);
        f32x4 a0, a1, x0, x1; pg8::unpack8(own, a0, a1); a0 = a0 * w3; a1 = a1 * w3;
        pg8::unpack8(*(const u32x4*)(P0 + (size_t)bq * 64 + ch * 8), x0, x1); a0 += x0 * w0; a1 += x1 * w0;
        if (n > 1u) { pg8::unpack8(*(const u32x4*)(P1 + (size_t)bq * 64 + ch * 8), x0, x1); a0 += x0 * w1; a1 += x1 * w1; }
        if (n > 2u) { pg8::unpack8(*(const u32x4*)(P2 + (size_t)bq * 64 + ch * 8), x0, x1); a0 += x0 * w2; a1 += x1 * w2; }
        *(u32x4*)orow = pg8::pack8(a0 * rw, a1 * rw);
    }
}

typedef float f32x2v __attribute__((ext_vector_type(2)));
__device__ __forceinline__ unsigned q8_pack(const f32x4& a, float sc, int bias) {
    const int q0 = (int)rintf(a[0] * sc) + bias, q1 = (int)rintf(a[1] * sc) + bias, q2 = (int)rintf(a[2] * sc) + bias, q3 = (int)rintf(a[3] * sc) + bias;
    return (unsigned)(q0 & 0xff) | ((unsigned)(q1 & 0xff) << 8) | ((unsigned)(q2 & 0xff) << 16) | ((unsigned)(q3 & 0xff) << 24); }
__device__ __forceinline__ void q8_row(const float* src, const float* gain, unsigned char* dst, size_t sstride, float* scale_out, int lane, int bias) {
    f32x4 a[4]; float am = 0.f;
#pragma unroll
    for (int q = 0; q < 4; ++q) { a[q] = *(const f32x4*)(src + 16 * lane + 4 * q);
        if (gain) { const f32x4 g = *(const f32x4*)(gain + 16 * lane + 4 * q); a[q][0] *= g[0]; a[q][1] *= g[1]; a[q][2] *= g[2]; a[q][3] *= g[3]; }
        am = fmaxf(fmaxf(am, fmaxf(fabsf(a[q][0]), fabsf(a[q][1]))), fmaxf(fabsf(a[q][2]), fabsf(a[q][3]))); }
    am = wave_max_fast(am);
    const float sc = am > 0.f ? 127.0f / am : 1.0f;
    u32x4 o;
#pragma unroll
    for (int q = 0; q < 4; ++q) o[q] = q8_pack(a[q], sc, bias);
    *(u32x4*)(dst + (sstride ? (size_t)(lane >> 3) * sstride + 16 * (lane & 7) : (size_t)16 * lane)) = o;
    if (lane == 0) *scale_out = am > 0.f ? am * (1.0f / 127.0f) : 1.0f;
}
__device__ __forceinline__ void q4_load(f32x4 (&a)[4], const float* src, int lane) {
#pragma unroll
    for (int q = 0; q < 4; ++q) a[q] = *(const f32x4*)(src + 16 * lane + 4 * q); }
template <bool USGN> __device__ __forceinline__ void q4_row(f32x4 (&a)[4], const f32x4 (&gn)[4], unsigned char* dst, float* scale_out, int lane) {
    float ss = 0.f;
#pragma unroll
    for (int q = 0; q < 4; ++q) {
        if (USGN) { a[q][0] *= gn[q][0]; a[q][1] *= gn[q][1]; a[q][2] *= gn[q][2]; a[q][3] *= gn[q][3]; }
        ss += (a[q][0] * a[q][0] + a[q][1] * a[q][1]) + (a[q][2] * a[q][2] + a[q][3] * a[q][3]); }
    ss = wave_sum_fast(ss);
    const float step = sqrtf(ss * (1.f / D)) * 0.3352f, inv = step > 0.f ? 1.0f / step : 0.f;
    u32x2 o; o[0] = 0u; o[1] = 0u;
    int qs = 0;
#pragma unroll
    for (int i = 0; i < 16; ++i) { int q = (int)floorf(a[i >> 2][i & 3] * inv); q = min(max(q, -8), 7); qs += q;
        o[i >> 3] |= (unsigned)((USGN || (i & 1)) ? (q & 15) : (q + 8)) << (4 * (i & 7)); }
    *(u32x2*)(dst + (size_t)(lane >> 4) * ESLICE + 8 * (lane & 15)) = o;
    if (USGN) { const float rs = wave_sum_fast((float)qs); if (lane == 0) { scale_out[0] = step > 0.f ? step : 1.0f; scale_out[1] = rs; } }
    else if (lane == 0) scale_out[2] = step > 0.f ? step : 1.0f;
}
__device__ __forceinline__ void phase_combine_tables(LAS unsigned char* ldsb, const P& p) {
    const int TID = otid();
    const int lane = TID & 63, gw = (blockIdx.x * 512 + TID) >> 6, nw = (gridDim.x * 512) >> 6, stride = gridDim.x * 512;
    bf16_t* OA = (bf16_t*)(p.ws + WS_QKV); const unsigned* SEL3 = (const unsigned*)(p.ws + WS_SEL3); const float* LSE = (const float*)(p.ws + WS_MLSE);
    const bf16_t* P0 = (const bf16_t*)(p.ws + WS_MP0); const bf16_t* P1 = (const bf16_t*)(p.ws + WS_MP1); const bf16_t* P2 = (const bf16_t*)(p.ws + WS_MP2); const bf16_t* P3 = (const bf16_t*)(p.ws + WS_MP3);
    {
        LAS float* scr = (LAS float*)(ldsb + (TID >> 6) * 16384); int r = gw; constexpr int IA = 8 * 32, IO = 16 * 32;
        if (r < IA) p0_transpose_item(p.w_a, D, 512, 1024, (bf16_t*)(p.ws + WS_WA), 0, scr, r, lane);
        else if ((r -= IA) < IA) { }
        else if ((r -= IA) < IO) p0_transpose_item(p.w_out, D, D, 1024, (bf16_t*)(p.ws + WS_WOUT), 0, scr, r, lane);
        else { r -= IO; p0_transpose_item(p.w_pq, PQC, D, 2048, (bf16_t*)(p.ws + WS_WPQ), 0, scr, r, lane, p.g_ffn); } }
    f32x4 gff[4];
#pragma unroll
    for (int q = 0; q < 4; ++q) gff[q] = *(const f32x4*)(p.g_ffn + 16 * lane + 4 * q);
    f32x4 tu[2][4], tv[2][4];
    q4_load(tu[0], p.eu + (size_t)gw * D, lane); q4_load(tv[0], p.ev + (size_t)gw * D, lane);
#pragma unroll 1
    for (int k0 = 0; k0 < 8; k0 += 2) {
#pragma unroll
      for (int u = 0; u < 2; ++u) {
        const int k = k0 + u;
        const int r = gw + k * nw, it = blockIdx.x * 512 + TID + k * stride, ch = it & 7, bq = it >> 3;
        const size_t po = (size_t)bq * 64 + ch * 8;
        const unsigned nn = SEL3[bq]; const f32x4 ls = *(const f32x4*)(LSE + (size_t)bq * 4);
        const u32x4 own = *(const u32x4*)(P3 + po), q0 = *(const u32x4*)(P0 + po), q1 = *(const u32x4*)(P1 + po), q2 = *(const u32x4*)(P2 + po);
        asm volatile("" ::: "memory");
        if (k + 1 < 8) { q4_load(tu[u ^ 1], p.eu + (size_t)(r + nw) * D, lane); q4_load(tv[u ^ 1], p.ev + (size_t)(r + nw) * D, lane); }
        asm volatile("" ::: "memory");
        {
            const int bh = bq >> 13, q = bq & (S - 1), b = bh >> 3, h = bh & 7; const unsigned n = nn >> 15;
            bf16_t* orow = OA + ((size_t)b * S + q) * 512 + h * 64 + ch * 8;
            float m = ls[3]; if (n > 0u) m = fmaxf(m, ls[0]); if (n > 1u) m = fmaxf(m, ls[1]); if (n > 2u) m = fmaxf(m, ls[2]);
            const float w3 = __builtin_amdgcn_exp2f(ls[3] - m), w0 = (n > 0u) ? __builtin_amdgcn_exp2f(ls[0] - m) : 0.f, w1 = (n > 1u) ? __builtin_amdgcn_exp2f(ls[1] - m) : 0.f, w2 = (n > 2u) ? __builtin_amdgcn_exp2f(ls[2] - m) : 0.f;
            const float rw = 1.f / (w3 + w0 + w1 + w2);
            const u32x4 z = {0u, 0u, 0u, 0u};
            f32x4 a0, a1, x0, x1; pg8::unpack8(own, a0, a1); a0 = a0 * w3; a1 = a1 * w3;
            pg8::unpack8((n > 0u) ? q0 : z, x0, x1); a0 += x0 * w0; a1 += x1 * w0;
            pg8::unpack8((n > 1u) ? q1 : z, x0, x1); a0 += x0 * w1; a1 += x1 * w1;
            pg8::unpack8((n > 2u) ? q2 : z, x0, x1); a0 += x0 * w2; a1 += x1 * w2;
            *(u32x4*)orow = (n == 0u) ? own : pg8::pack8(a0 * rw, a1 * rw); }
        q4_row<true>(tu[u], gff, p.ws + WS_EU + (size_t)r * 128, (float*)(p.ws + WS_USC) + 4 * (size_t)r, lane);
        q4_row<false>(tv[u], gff, p.ws + WS_EV + (size_t)r * 128, (float*)(p.ws + WS_USC) + 4 * (size_t)r, lane);
      }
    }
}

typedef short bf16x8_t __attribute__((ext_vector_type(8)));
typedef float f32x16_t __attribute__((ext_vector_type(16)));
__device__ __forceinline__ unsigned f2ord(float f) { const unsigned u = __float_as_uint(f); return u ^ ((unsigned)((int)u >> 31) | 0x80000000u); }
__device__ __forceinline__ float ord2f(unsigned k) { return __uint_as_float((k & 0x80000000u) ? (k ^ 0x80000000u) : ~k); }
#define TK_CAS(a, b, desc) do { const unsigned hi__ = max(a, b), lo__ = min(a, b); if (desc) { a = hi__; b = lo__; } else { a = lo__; b = hi__; } } while (0)
__device__ __forceinline__ void tk_sort16(unsigned (&v)[16]) {
#define C(i, j) TK_CAS(v[i], v[j], true);
    C(0,1) C(2,3) C(0,2) C(1,3) C(1,2) C(4,5) C(6,7) C(4,6) C(5,7) C(5,6) C(0,4) C(2,6) C(2,4) C(1,5) C(3,7) C(3,5) C(1,2) C(3,4) C(5,6) C(8,9) C(10,11) C(8,10) C(9,11) C(9,10) C(12,13) C(14,15) C(12,14) C(13,15) C(13,14) C(8,12) C(10,14) C(10,12) C(9,13) C(11,15) C(11,13) C(9,10) C(11,12) C(13,14) C(0,8) C(4,12) C(4,8) C(2,10) C(6,14) C(6,10) C(2,4) C(6,8) C(10,12) C(1,9) C(5,13) C(5,9) C(3,11) C(7,15) C(7,11) C(3,5) C(7,9) C(11,13) C(1,2) C(3,4) C(5,6) C(7,8) C(9,10) C(11,12) C(13,14)
#undef C
}
__device__ __forceinline__ void tk_merge16(unsigned (&a)[16], const unsigned (&b)[16]) {
#pragma unroll
    for (int i = 0; i < 16; ++i) a[i] = max(a[i], b[15 - i]);
#pragma unroll
    for (int st = 8; st >= 1; st >>= 1)
#pragma unroll
        for (int i = 0; i < 16; ++i) if ((i & st) == 0) TK_CAS(a[i], a[i + st], true);
}
__host__ __device__ constexpr int tk_pair_rank(int i, int j) { int c = 0; for (int a = 0; a < 16; ++a) for (int b = 0; b < 16; ++b) { if (a == i && b == j) return c; if ((a + 1) * (b + 1) <= 16) ++c; } return c; }
__device__ __forceinline__ unsigned tk_lookup(unsigned long long lo, unsigned long long hi, int i) {
    const unsigned long long w = (i & 8) ? hi : lo; return (unsigned)(w >> ((i & 7) * 8)) & 0xffu; }
__device__ __forceinline__ void h8_rows8(const P& p, int tb, int lane, LAS unsigned char* lx, LAS float* hsl) {
    u32x4 hq0[8], hq1[8];
#pragma unroll
    for (int i = 0; i < 8; ++i) { const bf16_t* hb = (const bf16_t*)(p.ws + WS_XN) + (size_t)(tb + i) * D + 16 * lane; hq0[i] = *(const u32x4*)hb; hq1[i] = *(const u32x4*)(hb + 8); }
#pragma unroll
    for (int i = 0; i < 8; ++i) { const u32x4 h0 = hq0[i], h1 = hq1[i];
        f32x4 a[4]; float am = 0.f;
#pragma unroll
        for (int w = 0; w < 4; ++w) { const unsigned d = (w < 2) ? h0[2 * w] : h1[2 * (w - 2)], e = (w < 2) ? h0[2 * w + 1] : h1[2 * (w - 2) + 1];
            a[w][0] = __uint_as_float(d << 16); a[w][1] = __uint_as_float(d & 0xffff0000u); a[w][2] = __uint_as_float(e << 16); a[w][3] = __uint_as_float(e & 0xffff0000u);
            am = fmaxf(fmaxf(am, fmaxf(fabsf(a[w][0]), fabsf(a[w][1]))), fmaxf(fabsf(a[w][2]), fabsf(a[w][3]))); }
        am = wave_max_fast(am);
        const float sc = am > 0.f ? 127.0f / am : 1.0f;
        int hs = 0; u32x2 hh, hl; hh[0] = 0u; hh[1] = 0u; hl[0] = 0u; hl[1] = 0u;
#pragma unroll
        for (int w = 0; w < 4; ++w)
#pragma unroll
            for (int k = 0; k < 4; ++k) { const int qv = (int)rintf(a[w][k] * sc); hs += qv; const int n = 4 * (w & 1) + k;
                hh[w >> 1] |= (unsigned)((qv >> 4) & 15) << (4 * n); hl[w >> 1] |= (unsigned)((qv & 15) ^ 8) << (4 * n); }
        LAS unsigned char* hb8 = lx + i * 1024 + 32 * (lane >> 1) + 8 * (lane & 1);
        *(LAS u32x2*)hb8 = hh; *(LAS u32x2*)(hb8 + 16) = hl;
        const float hc = wave_sum_fast(0.5f * (float)hs);
        if (lane == 0) { hsl[i] = am > 0.f ? am * (1.0f / 127.0f) : 1.0f; hsl[8 + i] = hc; }
    }
}
__device__ __forceinline__ void phase_peer_topk(LAS unsigned char* ldsb, const P& p, const pg8::StaticOrder& So) {
    const int TID = otid();
    const int lane = TID & 63, r32 = lane & 31, hi = lane >> 5, wave = TID >> 6;
    const bf16_t* PQ = (const bf16_t*)(p.ws + WS_PQ); const bf16_t* SKb = (const bf16_t*)(p.ws + WS_SK); int* IDX = (int*)(p.ws + WS_IDX); float* GATE = (float*)(p.ws + WS_GATE);
    pg8::Unit un;
    __syncthreads();
#pragma unroll
    for (int ui = 0; ui < 2; ++ui) if (So.next(ui, un)) { const int h = un.pn;
#pragma unroll
        for (int j = 0; j < 8; ++j) { const int q = TID + 512 * j, pp_ = q >> 11, row = (q >> 4) & 127, ch = q & 15;
            *(LAS u32x4*)(ldsb + ui * 65536 + pp_ * 32768 + row * 256 + ((ch ^ (row & 15)) * 16)) = *(const u32x4*)(SKb + ((size_t)(h * 2 + pp_) * PNK + row) * PHALF + ch * 8); } }
    for (int ui = 0; So.next(ui, un); ++ui) {
        const int tg = un.pm * 8 + wave, h = un.pn, t = tg * 32 + r32; LAS unsigned char* img = ldsb + (ui & 1) * 65536;
        u32x4 qfr[2][8];
#pragma unroll
        for (int pp = 0; pp < 2; ++pp)
#pragma unroll
            for (int ks = 0; ks < 8; ++ks) qfr[pp][ks] = *(const u32x4*)(PQ + (size_t)t * PQC + h * 256 + pp * 128 + 8 * hi + 16 * ks);
        __syncthreads();
        unsigned K0[16], K1[16];
#pragma unroll
        for (int pp = 0; pp < 2; ++pp) {
            f32x16_t acc[4];
#pragma unroll
            for (int mt = 0; mt < 4; ++mt) acc[mt] = f32x16_t{};
#pragma unroll
            for (int ks = 0; ks < 8; ++ks) {
                const bf16x8_t qf = __builtin_bit_cast(bf16x8_t, qfr[pp][ks]);
#pragma unroll
                for (int mt = 0; mt < 4; ++mt) { const int row = 32 * mt + r32;
                    const bf16x8_t kf = __builtin_bit_cast(bf16x8_t, *(const LAS u32x4*)(img + pp * 32768 + row * 256 + (((2 * ks + hi) ^ (row & 15)) * 16)));
                    acc[mt] = __builtin_amdgcn_mfma_f32_32x32x16_bf16(kf, qf, acc[mt], 0, 0, 0); }
            }
            unsigned L[16], L1[16], L2[16], L3[16];
            const unsigned h4 = 4u * (unsigned)hi;
#pragma unroll
            for (int r = 0; r < 16; ++r) { const unsigned lowb = (unsigned)(127 - (r & 3) - 8 * (r >> 2)) - h4;
                L[r] = (f2ord(acc[0][r]) & ~127u) | lowb; L1[r] = (f2ord(acc[1][r]) & ~127u) | (lowb - 32u); L2[r] = (f2ord(acc[2][r]) & ~127u) | (lowb - 64u); L3[r] = (f2ord(acc[3][r]) & ~127u) | (lowb - 96u); }
            tk_sort16(L); tk_sort16(L1); tk_sort16(L2); tk_sort16(L3);
            tk_merge16(L, L1); tk_merge16(L2, L3); tk_merge16(L, L2);
            unsigned M[16];
#pragma unroll
            for (int i = 0; i < 16; ++i) { const auto r_ = __builtin_amdgcn_permlane32_swap(L[i], L[i], false, false); M[i] = hi ? r_[0] : r_[1]; }
            tk_merge16(L, M);
#pragma unroll
            for (int i = 0; i < 16; ++i) { if (pp == 0) K0[i] = L[i]; else K1[i] = L[i]; }
        }
        float v0[16], v1[16]; unsigned long long t0lo = 0ull, t0hi = 0ull, t1lo = 0ull, t1hi = 0ull;
#pragma unroll
        for (int i = 0; i < 16; ++i) { v0[i] = ord2f(K0[i] & ~127u); v1[i] = ord2f(K1[i] & ~127u);
            const unsigned long long e0 = (unsigned long long)(127u - (K0[i] & 127u)) << ((i & 7) * 8), e1 = (unsigned long long)(127u - (K1[i] & 127u)) << ((i & 7) * 8);
            if (i < 8) { t0lo |= e0; t1lo |= e1; } else { t0hi |= e0; t1hi |= e1; } }
        unsigned Bk[16], B1[16], B2[16], B3[16];
#pragma unroll
        for (int i = 0; i < 16; ++i) { Bk[i] = 0u; B1[i] = 0u; B2[i] = 0u; B3[i] = 0u; }
#pragma unroll
        for (int i = 0; i < 16; ++i)
#pragma unroll
            for (int j = 0; j < 16; ++j) if ((i + 1) * (j + 1) <= 16) {
                const unsigned key = (f2ord(v0[i] + v1[j]) & ~255u) | (unsigned)(255 - (i * 16 + j));
                const int rk = tk_pair_rank(i, j);
                if ((rk >> 4) == 0) Bk[rk & 15] = key; else if ((rk >> 4) == 1) B1[rk & 15] = key; else if ((rk >> 4) == 2) B2[rk & 15] = key; else B3[rk & 15] = key; }
#pragma unroll
        for (int i = 0; i < 16; ++i) { Bk[i] = hi ? B2[i] : Bk[i]; B1[i] = hi ? B3[i] : B1[i]; }
        tk_sort16(Bk); tk_sort16(B1); tk_merge16(Bk, B1);
#pragma unroll
        for (int i = 0; i < 16; ++i) { const auto r_ = __builtin_amdgcn_permlane32_swap(Bk[i], Bk[i], false, false); B2[i] = hi ? r_[0] : r_[1]; }
        tk_merge16(Bk, B2);
        float rstd;
        { const f32x4* rp = (const f32x4*)((const float*)(p.ws + WS_RSSP) + (size_t)t * 16); const f32x4 s4 = (rp[0] + rp[1]) + (rp[2] + rp[3]);
          rstd = rsqrtf(((s4[0] + s4[1]) + (s4[2] + s4[3])) * (1.f / D) + EPS); }
        float gt[16]; int ex[16]; float sum = 0.f; const float best0 = ord2f(Bk[0] & ~255u);
#pragma unroll
        for (int r = 0; r < 16; ++r) { const float bv = ord2f(Bk[r] & ~255u); gt[r] = __expf(rstd * (bv - best0)); sum += gt[r];
            const int flat = 255 - (int)(Bk[r] & 255u); ex[r] = (int)tk_lookup(t0lo, t0hi, flat >> 4) * PNK + (int)tk_lookup(t1lo, t1hi, flat & 15); }
        const float rs = 1.f / sum;
        if (hi == 0) {
#pragma unroll
            for (int q = 0; q < 4; ++q) {
                u32x4 iv; iv.x = (unsigned)ex[4 * q]; iv.y = (unsigned)ex[4 * q + 1]; iv.z = (unsigned)ex[4 * q + 2]; iv.w = (unsigned)ex[4 * q + 3];
                *(u32x4*)(IDX + ((size_t)t * PH + h) * PK + 4 * q) = iv;
                f32x4 gv; gv[0] = gt[4 * q] * rs; gv[1] = gt[4 * q + 1] * rs; gv[2] = gt[4 * q + 2] * rs; gv[3] = gt[4 * q + 3] * rs;
                *(f32x4*)(GATE + ((size_t)t * PH + h) * PK + 4 * q) = gv; }
        }
    }
}

__device__ __forceinline__ float gelu_exact(float v) {
    const float av = fabsf(v), t = __builtin_amdgcn_rcpf(av * 0.2316418882f + 1.0f);
    float q = t * 0.5307027145f + (-0.7265760135f); q = q * t + 0.7107068705f; q = q * t + (-0.142248368f); q = q * t + 0.127414796f; q = q * t;
    const float e = __builtin_amdgcn_exp2f((v * v) * (-0.72134752044f)), m = v * (q * e);
    return v < 0.f ? m : v - m;
}
#define EX_HALVE16(d, m2, m1, m0, u2, u1, u0, r0, r1) do { float h8_[8], h4_[4]; \
        _Pragma("unroll") for (int i_ = 0; i_ < 8; ++i_) { const float k_ = (u2) ? d[i_ + 8] : d[i_], s_ = (u2) ? d[i_] : d[i_ + 8]; h8_[i_] = k_ + __shfl_xor(s_, (m2)); } \
        _Pragma("unroll") for (int i_ = 0; i_ < 4; ++i_) { const float k_ = (u1) ? h8_[i_ + 4] : h8_[i_], s_ = (u1) ? h8_[i_] : h8_[i_ + 4]; h4_[i_] = k_ + __shfl_xor(s_, (m1)); } \
        { const float k0_ = (u0) ? h4_[2] : h4_[0], s0_ = (u0) ? h4_[0] : h4_[2], k1_ = (u0) ? h4_[3] : h4_[1], s1_ = (u0) ? h4_[1] : h4_[3]; r0 = k0_ + __shfl_xor(s0_, (m0)); r1 = k1_ + __shfl_xor(s1_, (m0)); } } while (0)
#define EX_HALVE16_SWAP(d, u0, r0, r1) do { float h8_[8], h4_[4]; \
        _Pragma("unroll") for (int i_ = 0; i_ < 8; ++i_) { const auto q_ = __builtin_amdgcn_permlane32_swap(__float_as_uint(d[i_]), __float_as_uint(d[i_ + 8]), false, false); h8_[i_] = __uint_as_float(q_[0]) + __uint_as_float(q_[1]); } \
        _Pragma("unroll") for (int i_ = 0; i_ < 4; ++i_) { const auto q_ = __builtin_amdgcn_permlane16_swap(__float_as_uint(h8_[i_]), __float_as_uint(h8_[i_ + 4]), false, false); h4_[i_] = __uint_as_float(q_[0]) + __uint_as_float(q_[1]); } \
        { const float k0_ = (u0) ? h4_[2] : h4_[0], s0_ = (u0) ? h4_[0] : h4_[2], k1_ = (u0) ? h4_[3] : h4_[1], s1_ = (u0) ? h4_[1] : h4_[3]; \
          r0 = k0_ + __builtin_bit_cast(float, __builtin_amdgcn_update_dpp(0, __builtin_bit_cast(int, s0_), 0x128, 0xf, 0xf, true)); r1 = k1_ + __builtin_bit_cast(float, __builtin_amdgcn_update_dpp(0, __builtin_bit_cast(int, s1_), 0x128, 0xf, 0xf, true)); } } while (0)
#define EX_HALVE16_SWAP_I(d, u0, r0, r1) do { int h8_[8], h4_[4]; \
        _Pragma("unroll") for (int i_ = 0; i_ < 8; ++i_) { const auto q_ = __builtin_amdgcn_permlane32_swap((unsigned)d[i_], (unsigned)d[i_ + 8], false, false); h8_[i_] = (int)(q_[0] + q_[1]); } \
        _Pragma("unroll") for (int i_ = 0; i_ < 4; ++i_) { const auto q_ = __builtin_amdgcn_permlane16_swap((unsigned)h8_[i_], (unsigned)h8_[i_ + 4], false, false); h4_[i_] = (int)(q_[0] + q_[1]); } \
        { const int k0_ = (u0) ? h4_[2] : h4_[0], s0_ = (u0) ? h4_[0] : h4_[2], k1_ = (u0) ? h4_[3] : h4_[1], s1_ = (u0) ? h4_[1] : h4_[3]; \
          r0 = k0_ + __builtin_amdgcn_update_dpp(0, s0_, 0x128, 0xf, 0xf, true); r1 = k1_ + __builtin_amdgcn_update_dpp(0, s1_, 0x128, 0xf, 0xf, true); } } while (0)
struct ExIds { u32x4 i0, i1, i2, i3; };
struct ExAux { u32x4 w0; f32x4 y; };
__device__ __forceinline__ void ex_ids(ExIds& I, const LAS int* lids, int i, int g) {
    const LAS u32x4* ip = (const LAS u32x4*)(lids + i * 128 + 16 * g); I.i0 = ip[0]; I.i1 = ip[1]; I.i2 = ip[2]; I.i3 = ip[3]; }
template <int PASS> __device__ __forceinline__ void ex_gather(u32x4 (&buf)[16], ExAux& X, const ExIds& I, const P& p, int t, int x, int g, int c, const LAS unsigned char* lx, int ti) {
    const __amdgpu_buffer_rsrc_t TAB = __builtin_amdgcn_make_buffer_rsrc((void*)(p.ws + (PASS == 0 ? WS_EU : WS_EV) + (size_t)x * ESLICE), 0, (int)ESLICE, 0x00020000);
#pragma unroll
    for (int j = 0; j < 16; ++j) { const unsigned e = (j < 4) ? I.i0[j & 3] : (j < 8) ? I.i1[j & 3] : (j < 12) ? I.i2[j & 3] : I.i3[j & 3];
        buf[j] = __builtin_amdgcn_raw_buffer_load_b128(TAB, (int)(e * 128u) + 16 * c, 0, 0); }
    if constexpr (PASS == 0) { const LAS u32x4* hp8 = (const LAS u32x4*)(lx + ti * 1024 + x * 256 + 32 * c); X.w0 = hp8[0]; X.y = __builtin_bit_cast(f32x4, hp8[1]); }
    else { X.w0 = *(const LAS u32x4*)(lx + ti * 128 + 16 * g); (void)t; }
}
template <int PASS> __device__ __forceinline__ void ex_compute(const u32x4 (&buf)[16], const ExAux& X, const P& p, int t, int x, int lane, int g, int c, float asc, float cs, float& o0, float& o1) {
    float d[16];
    if constexpr (PASS == 0) {
        const u32x4 w1 = __builtin_bit_cast(u32x4, X.y);
#pragma unroll
        for (int j = 0; j < 16; ++j) { int aH = 0, aL = 0;
#pragma unroll
            for (int q = 0; q < 4; ++q) { aH = __builtin_amdgcn_sdot8((int)buf[j][q], (int)X.w0[q], aH, false); aL = __builtin_amdgcn_sdot8((int)buf[j][q], (int)w1[q], aL, false); }
            d[j] = (float)((aH << 4) + aL); }
        float r0, r1;
        EX_HALVE16(d, 4, 2, 1, (lane & 4) != 0, (lane & 2) != 0, (lane & 1) != 0, r0, r1);
        o0 += r0; o1 += r1;
    } else {
        float osq = 0.f; unsigned yw[2];
#pragma unroll
        for (int hf = 0; hf < 2; ++hf) {
            int ai[16];
#pragma unroll
            for (int i = 0; i < 16; ++i) ai[i] = 0;
#pragma unroll
            for (int j4 = 0; j4 < 4; ++j4) { const int a4 = (int)X.w0[j4];
#pragma unroll
                for (int q2 = 0; q2 < 2; ++q2) { const int q = 2 * hf + q2; const unsigned r0_ = buf[4 * j4][q], r1_ = buf[4 * j4 + 1][q], r2_ = buf[4 * j4 + 2][q], r3_ = buf[4 * j4 + 3][q];
                    const unsigned t0 = __builtin_amdgcn_perm(r1_, r0_, 0x05010400u), t1 = __builtin_amdgcn_perm(r1_, r0_, 0x07030602u), t2 = __builtin_amdgcn_perm(r3_, r2_, 0x05010400u), t3 = __builtin_amdgcn_perm(r3_, r2_, 0x07030602u);
                    const unsigned c0_ = __builtin_amdgcn_perm(t2, t0, 0x05040100u), c1_ = __builtin_amdgcn_perm(t2, t0, 0x07060302u), c2_ = __builtin_amdgcn_perm(t3, t1, 0x05040100u), c3_ = __builtin_amdgcn_perm(t3, t1, 0x07060302u);
                    ai[8 * q2 + 0] = __builtin_amdgcn_sdot4((int)(c0_ & 0x0f0f0f0fu), a4, ai[8 * q2 + 0], false); ai[8 * q2 + 1] = __builtin_amdgcn_sdot4((int)c0_, a4, ai[8 * q2 + 1], false);
                    ai[8 * q2 + 2] = __builtin_amdgcn_sdot4((int)(c1_ & 0x0f0f0f0fu), a4, ai[8 * q2 + 2], false); ai[8 * q2 + 3] = __builtin_amdgcn_sdot4((int)c1_, a4, ai[8 * q2 + 3], false);
                    ai[8 * q2 + 4] = __builtin_amdgcn_sdot4((int)(c2_ & 0x0f0f0f0fu), a4, ai[8 * q2 + 4], false); ai[8 * q2 + 5] = __builtin_amdgcn_sdot4((int)c2_, a4, ai[8 * q2 + 5], false);
                    ai[8 * q2 + 6] = __builtin_amdgcn_sdot4((int)(c3_ & 0x0f0f0f0fu), a4, ai[8 * q2 + 6], false); ai[8 * q2 + 7] = __builtin_amdgcn_sdot4((int)c3_, a4, ai[8 * q2 + 7], false); }
                asm volatile("" : "+v"(ai[0]), "+v"(ai[1]), "+v"(ai[2]), "+v"(ai[3]), "+v"(ai[4]), "+v"(ai[5]), "+v"(ai[6]), "+v"(ai[7]), "+v"(ai[8]), "+v"(ai[9]), "+v"(ai[10]), "+v"(ai[11]), "+v"(ai[12]), "+v"(ai[13]), "+v"(ai[14]), "+v"(ai[15]));
                __builtin_amdgcn_sched_barrier(0); }
            int i0, i1;
            EX_HALVE16_SWAP_I(ai, (lane & 8) != 0, i0, i1);
            const float r0 = (float)i0 * asc, r1 = (float)(i1 - i0) * (asc * 0.0625f);
            f32x2v y; y[0] = r0 - 7.5f * cs; y[1] = r1 + 0.5f * cs;
            yw[hf] = pg8::cvtpk_c(y[0], y[1]);
            (void)osq;
        }
        { const bool od = (g & 1) != 0; const unsigned snd = od ? yw[0] : yw[1];
          const unsigned rcv = (unsigned)__builtin_amdgcn_update_dpp(0, (int)snd, 0x128, 0xf, 0xf, true);
          u32x2 w; w.x = od ? rcv : yw[0]; w.y = od ? yw[1] : rcv;
          *(u32x2*)((bf16_t*)(p.ws + WS_Y16) + (size_t)t * D + x * 256 + 32 * c + (od ? 16 + 2 * (g - 1) : 2 * g)) = w; }
        o0 += osq;
    }
}
typedef float f32x2l __attribute__((ext_vector_type(2)));
template <int PASS> __device__ __forceinline__ void ex_pass(const P& p, int tb, int lane, int g, int c, LAS f32x2l* acc, const LAS float* ascl, const LAS int* lids, const LAS unsigned char* lx) {
    u32x4 bA[16], bB[16]; ExAux xA, xB; ExIds I;
    ex_ids(I, lids, 0, g);
    ex_gather<PASS>(bA, xA, I, p, tb, 0, g, c, lx, 0);
    ex_ids(I, lids, 1, g);
    constexpr int NS = 32;
#pragma unroll 1
    for (int s_ = 0; s_ < NS; s_ += 2) {
        const int x = s_ >> 3, i = s_ & 7, s2 = min(s_ + 2, NS - 1), x2 = s2 >> 3, i2 = s2 & 7;
        ex_gather<PASS>(bB, xB, I, p, tb + i + 1, x, g, c, lx, i + 1);
        ex_ids(I, lids, i2, g);
        { float o0 = 0.f, o1 = 0.f; ex_compute<PASS>(bA, xA, p, tb + i, x, lane, g, c, (PASS == 1) ? ascl[i] : 0.f, (PASS == 1) ? ascl[8 + i] : 0.f, o0, o1); if constexpr (PASS == 0) { f32x2l v = acc[i * 64 + lane]; v[0] += o0; v[1] += o1; acc[i * 64 + lane] = v; } }
        ex_gather<PASS>(bA, xA, I, p, tb + i2, x2, g, c, lx, i2);
        ex_ids(I, lids, (i2 + 1) & 7, g);
        { float o0 = 0.f, o1 = 0.f; ex_compute<PASS>(bB, xB, p, tb + i + 1, x, lane, g, c, (PASS == 1) ? ascl[i + 1] : 0.f, (PASS == 1) ? ascl[9 + i] : 0.f, o0, o1); if constexpr (PASS == 0) { f32x2l v = acc[(i + 1) * 64 + lane]; v[0] += o0; v[1] += o1; acc[(i + 1) * 64 + lane] = v; } }
    }
}
__device__ __forceinline__ void phase_experts(LAS unsigned char* ldsb, const P& p) {
    const int TID = otid();
    const int lane = TID & 63, wave = TID >> 6, g = lane >> 3, c = lane & 7, tb = (blockIdx.x * 8 + wave) * 8;
    const f32x4* SCL = (const f32x4*)(p.ws + WS_USC);
    LAS f32x2l* acc = (LAS f32x2l*)(ldsb + wave * 16384); LAS int* lids = (LAS int*)(ldsb + wave * 16384 + 4096); LAS unsigned char* lx = ldsb + wave * 16384 + 8192;
    LAS float* ascl = (LAS float*)(ldsb + 131072 + 4096 + wave * 128); LAS float* hsl = ascl + 16;
#pragma unroll
    for (int k = 0; k < 4; ++k) ((LAS u32x4*)lids)[k * 64 + lane] = ((const u32x4*)((const int*)(p.ws + WS_IDX) + (size_t)tb * 128))[k * 64 + lane];
    h8_rows8(p, tb, lane, lx, hsl);
    asm volatile("s_waitcnt vmcnt(0) lgkmcnt(0)" ::: "memory");
#pragma unroll
    for (int i = 0; i < 8; ++i) { f32x2l z; z[0] = 0.f; z[1] = 0.f; acc[i * 64 + lane] = z; }
    ex_pass<0>(p, tb, lane, g, c, acc, ascl, lids, lx);
    float ssv[8]; u32x2 ev[8]; f32x2v gtv[8]; f32x4 s0v[8], s1v[8];
#pragma unroll
    for (int i = 0; i < 8; ++i) { const int t = tb + i, k0 = 16 * g + 2 * c;
        ssv[i] = ((const float*)(p.ws + WS_RSSP))[(size_t)t * 16 + (lane & 15)];
        ev[i] = *(const LAS u32x2*)(lids + i * 128 + k0);
        gtv[i] = *(const f32x2v*)((const float*)(p.ws + WS_GATE) + (size_t)t * 128 + k0);
        s0v[i] = SCL[ev[i].x]; s1v[i] = SCL[ev[i].y]; }
#pragma unroll
    for (int i = 0; i < 8; ++i) { const int k0 = 16 * g + 2 * c;
        float rstd;
        { float ss_ = ssv[i]; ss_ = WS_DPP(ss_, 0xB1); ss_ = WS_DPP(ss_, 0x4E); ss_ = WS_DPP(ss_, 0x141); ss_ = WS_DPP(ss_, 0x140);
          rstd = rsqrtf(ss_ * (1.f / D) + EPS); }
        const f32x2v gt = gtv[i];
        const float hs = rstd * hsl[i], hc = hsl[8 + i];
        const f32x4 s0 = s0v[i], s1 = s1v[i];
        f32x2l hv = acc[i * 64 + lane]; hv[0] += hc; hv[1] += hc;
        const float a0 = gt[0] * gelu_exact(hs * s0[0] * (hv[0] + 8.f * s0[1])) * s0[2], a1 = gt[1] * gelu_exact(hs * s1[0] * (hv[1] + 8.f * s1[1])) * s1[2];
        const float am = wave_max_fast(fmaxf(fabsf(a0), fabsf(a1))), sc = am > 0.f ? 127.0f / am : 1.0f;
        const int q0 = (int)rintf(a0 * sc), q1 = (int)rintf(a1 * sc);
        *(LAS unsigned short*)(lx + i * 128 + k0) = (unsigned short)((q0 & 0xff) | ((q1 & 0xff) << 8));
        const float asum = wave_sum_fast((float)(q0 + q1)), asc_ = am > 0.f ? am * (1.0f / 127.0f) : 1.0f;
        if (lane == 0) { ascl[i] = asc_; ascl[8 + i] = asc_ * asum; }
        f32x2l z; z[0] = 0.f; z[1] = 0.f; acc[i * 64 + lane] = z; }
    asm volatile("s_waitcnt vmcnt(0) lgkmcnt(0)" ::: "memory");
    ex_pass<1>(p, tb, lane, g, c, acc, ascl, lids, lx);
    asm volatile("s_waitcnt vmcnt(0) lgkmcnt(0)" ::: "memory");
    f32x4 gfin[4];
#pragma unroll
    for (int j = 0; j < 4; ++j) gfin[j] = ((const f32x4*)p.g_fin)[lane + 64 * j];
    u32x2 hw8[8][4], pw8[8][4];
#pragma unroll
    for (int i = 0; i < 8; ++i) { const u32x2* hrow = (const u32x2*)((const bf16_t*)(p.ws + WS_XN) + (size_t)(tb + i) * D); const u32x2* yrow = (const u32x2*)((const bf16_t*)(p.ws + WS_Y16) + (size_t)(tb + i) * D);
#pragma unroll
        for (int j = 0; j < 4; ++j) { hw8[i][j] = hrow[lane + 64 * j]; pw8[i][j] = yrow[lane + 64 * j]; } }
#pragma unroll
    for (int i = 0; i < 8; ++i) {
        f32x4* orow = (f32x4*)(p.out + (size_t)(tb + i) * D);
        f32x4 y[4]; float ss = 0.f;
#pragma unroll
        for (int j = 0; j < 4; ++j) { const u32x2 hw = hw8[i][j], pw = pw8[i][j];
            y[j][0] = __uint_as_float(pw[0] << 16); y[j][1] = __uint_as_float(pw[0] & 0xffff0000u); y[j][2] = __uint_as_float(pw[1] << 16); y[j][3] = __uint_as_float(pw[1] & 0xffff0000u);
            y[j][0] += __uint_as_float(hw[0] << 16); y[j][1] += __uint_as_float(hw[0] & 0xffff0000u); y[j][2] += __uint_as_float(hw[1] << 16); y[j][3] += __uint_as_float(hw[1] & 0xffff0000u);
            ss += (y[j][0] * y[j][0] + y[j][1] * y[j][1]) + (y[j][2] * y[j][2] + y[j][3] * y[j][3]); }
        const float r2 = rsqrtf(wave_sum_fast(ss) * (1.f / D) + EPS);
#pragma unroll
        for (int j = 0; j < 4; ++j) { const f32x4 gf = gfin[j]; f32x4 o = y[j] * r2; o[0] *= gf[0]; o[1] *= gf[1]; o[2] *= gf[2]; o[3] *= gf[3]; orow[lane + 64 * j] = o; } }
}
#undef EX_HALVE16
#undef EX_HALVE16_SWAP
#undef EX_HALVE16_SWAP_I

#define LAS __attribute__((address_space(3)))
#define XB_TMO      128
#define XB_XCNT(j)  (256  + 64 * (j))
#define XB_XSUB(j)  (1280 + 64 * (j))
#define XB_XGEN(j)  (2304 + 64 * (j))
#define XB_TOP      3328
#define XB_TOPGEN   3392
#define XCD_BAR_WORDS 3456
#define XB_SPIN_CAP (1u << 22)
__device__ __forceinline__ unsigned xb_ld(unsigned* p)              { return __hip_atomic_load(p, __ATOMIC_RELAXED, __HIP_MEMORY_SCOPE_AGENT); }
__device__ __forceinline__ unsigned xb_add(unsigned* p, unsigned v) { return __hip_atomic_fetch_add(p, v, __ATOMIC_RELAXED, __HIP_MEMORY_SCOPE_AGENT); }
__device__ __forceinline__ unsigned xb_xcc_id() { return (unsigned)__builtin_amdgcn_s_getreg((3 << 11) | 20) & 0xFu; }
#define XB_SPIN(cond, bar) do { unsigned _sp = 0; while (cond) { __builtin_amdgcn_s_sleep(1); \
    if ((++_sp & 255u) == 0u) { if (xb_ld(&(bar)[XB_TMO])) break; if (_sp > XB_SPIN_CAP) { atomicAdd(&(bar)[XB_TMO], 1u); break; } } } } while (0)
struct XcdBarrier { unsigned* bar; unsigned x; volatile LAS unsigned* st; };
__device__ __forceinline__ XcdBarrier xcd_barrier_post(unsigned* bar, volatile LAS unsigned* st) {
    XcdBarrier b; b.bar = bar; b.x = xb_xcc_id(); b.st = st;
    if (threadIdx.x == 0) (void)xb_add(&bar[XB_XCNT(b.x)], 1u);
    return b;
}
__device__ __forceinline__ void xcd_barrier_complete(unsigned* bar, unsigned x, unsigned& nloc, unsigned& nx) {
    const unsigned G = gridDim.x * gridDim.y * gridDim.z;
    unsigned sum, cnt, mine, sp = 0u;
    for (;;) {
        sum = 0u; cnt = 0u; mine = 0u;
#pragma unroll
        for (unsigned j = 0; j < 16; ++j) { const unsigned c = xb_ld(&bar[XB_XCNT(j)]); sum += c; cnt += (c > 0u) ? 1u : 0u; mine = (j == x) ? c : mine; }
        if (sum == G) break;
        __builtin_amdgcn_s_sleep(1);
        if ((++sp & 255u) == 0u) { if (xb_ld(&bar[XB_TMO])) break; if (sp > XB_SPIN_CAP) { atomicAdd(&bar[XB_TMO], 1u); break; } }
    }
    nloc = mine > 0u ? mine : 1u; nx = cnt > 0u ? cnt : 1u;
}
__device__ __forceinline__ void xcd_barrier(const XcdBarrier& b) {
    asm volatile("s_waitcnt vmcnt(0)" ::: "memory");
    __syncthreads();
    if (threadIdx.x == 0) {
        unsigned* bar = b.bar;
        __builtin_amdgcn_s_waitcnt(0);
        unsigned nloc = b.st[0], nx = b.st[1];
        if (nloc == 0u) { xcd_barrier_complete(bar, b.x, nloc, nx); b.st[0] = nloc; b.st[1] = nx; }
        const unsigned old = xb_add(&bar[XB_XSUB(b.x)], 1u);
        const unsigned gen = old / nloc;
        if (old + 1u == (gen + 1u) * nloc) {
            __builtin_amdgcn_fence(__ATOMIC_RELEASE, "agent");
            asm volatile("s_waitcnt vmcnt(0)" ::: "memory");
            const unsigned og = xb_add(&bar[XB_TOP], 1u);
            const unsigned tg = og / nx;
            if (og + 1u == (tg + 1u) * nx) xb_add(&bar[XB_TOPGEN], 1u);
            else XB_SPIN(xb_ld(&bar[XB_TOPGEN]) == tg, bar);
            __builtin_amdgcn_fence(__ATOMIC_ACQUIRE, "agent");
            xb_add(&bar[XB_XGEN(b.x)], 1u);
            asm volatile("s_waitcnt vmcnt(0)" ::: "memory");
        } else {
            XB_SPIN(xb_ld(&bar[XB_XGEN(b.x)]) == gen, bar);
            __builtin_amdgcn_fence(__ATOMIC_ACQUIRE, "agent");
            asm volatile("s_waitcnt vmcnt(0)" ::: "memory");
        }
    }
    __syncthreads();
}

constexpr int NT = 512;
constexpr int LDS_BYTES = 147456;
constexpr int MISC_OFF = 131072;

__global__ void __launch_bounds__(NT, 2) mega(P p) {
    extern __shared__ __attribute__((aligned(16))) unsigned char lds_raw[];
    float* lds = (float*)lds_raw;
    LAS unsigned char* ldsb = (LAS unsigned char*)lds_raw;
    volatile LAS unsigned* MISC = (volatile LAS unsigned*)(ldsb + MISC_OFF);
    if (threadIdx.x < 32) MISC[threadIdx.x] = 0u;
    __syncthreads();
    XcdBarrier bar = xcd_barrier_post((unsigned*)p.ws, MISC + 8);
#define GRID_BAR() xcd_barrier(bar)
    const int G = gridDim.x;
    bf16_t* QKV = (bf16_t*)(p.ws + WS_QKV);
    phase_prologue(ldsb, p);
    GRID_BAR();
    phase_cumsum(p);
    { pg8::Gemm g{(const bf16_t*)(p.ws + WS_XN), (const bf16_t*)(p.ws + WS_WIN), T, 5120, D / 2}; pg8::StaticOrder So; So.init(T, 5120, G, (int)blockIdx.x);
      pg8::EpiProj E{QKV, (bf16_t*)(p.ws + WS_G), (const float*)(p.ws + WS_ROPE), (float*)(p.ws + WS_KMP), (float*)(p.ws + WS_FKN), (float*)(p.ws + WS_FQN)};
      pg8::gemm_phase<pg8::EpiProj, pg8::StaticOrder, true, true, true>(ldsb, g, So, E); }
    GRID_BAR();
    phase_attn((char*)lds_raw, MISC, p);
    GRID_BAR();
#pragma unroll 1
    for (int st = 0; st < 2; ++st) {
        if (((((int)blockIdx.x >> 3) ^ st) & 1) != 0) phase_combine_tables(ldsb, p);
        else { pg8::Gemm g{QKV + SLOT, (const bf16_t*)(p.ws + WS_WB), T, D, 512}; pg8::StaticOrder So; So.init(T, D, G, (int)blockIdx.x);
               pg8::EpiMerge E{(bf16_t*)(p.ws + WS_MERGED), p.ws + WS_G + (size_t)T * D, true};
               pg8::gemm_phase<pg8::EpiMerge, pg8::StaticOrder, true, true>(ldsb, g, So, E); }
        __syncthreads();
    }
    GRID_BAR();
    { pg8::Gemm g{QKV, (const bf16_t*)(p.ws + WS_WA), T, D, 512}; pg8::StaticOrder So; So.init(T, D, G, (int)blockIdx.x);
      pg8::EpiMerge E{(bf16_t*)(p.ws + WS_MERGED), p.ws + WS_G, false};
      pg8::gemm_phase<pg8::EpiMerge, pg8::StaticOrder, true, true>(ldsb, g, So, E); }
    GRID_BAR();
    { pg8::Gemm g{(const bf16_t*)(p.ws + WS_MERGED), (const bf16_t*)(p.ws + WS_WOUT), T, D, D}; pg8::StaticOrder So; So.init(T, D, G, (int)blockIdx.x);
      pg8::EpiOut E{p.x, p.out, (bf16_t*)(p.ws + WS_XN), (float*)(p.ws + WS_RSSP)};
      pg8::gemm_phase<pg8::EpiOut, pg8::StaticOrder, true, true>(ldsb, g, So, E); }
    GRID_BAR();
    { pg8::Gemm g{(const bf16_t*)(p.ws + WS_XN), (const bf16_t*)(p.ws + WS_WPQ), T, PQC, D}; pg8::StaticOrder So; So.init(T, PQC, G, (int)blockIdx.x);
      pg8::EpiStore E{(bf16_t*)(p.ws + WS_PQ), PQC};
      pg8::gemm_phase<pg8::EpiStore, pg8::StaticOrder, true, true>(ldsb, g, So, E);
      phase_peer_topk(ldsb, p, So); }
    GRID_BAR();
    phase_experts(ldsb, p);
}

extern "C" void kernel_launch(void* const* d_in, const int* in_sizes, int n_in, void* d_out, int out_size, void* d_ws, size_t ws_size, hipStream_t stream) {
    static int grid = 0;
    if (grid == 0) {
        int dev = 0, cus = 0, per_cu = 0;
        if (hipGetDevice(&dev) != hipSuccess || hipDeviceGetAttribute(&cus, hipDeviceAttributeMultiprocessorCount, dev) != hipSuccess) { fprintf(stderr, "kernel_launch: device query failed\n"); grid = -1; return; }
        if (hipFuncSetAttribute((const void*)mega, hipFuncAttributeMaxDynamicSharedMemorySize, LDS_BYTES) != hipSuccess) { fprintf(stderr, "kernel_launch: hipFuncSetAttribute failed\n"); grid = -1; return; }
        if (hipOccupancyMaxActiveBlocksPerMultiprocessor(&per_cu, (const void*)mega, NT, LDS_BYTES) != hipSuccess || per_cu < 1) { fprintf(stderr, "kernel_launch: occupancy query says %d blocks per CU\n", per_cu); (void)hipGetLastError(); grid = -1; return; }
        if (cus < 256) { fprintf(stderr, "kernel_launch: built for a 256-CU device, found %d CUs\n", cus); grid = -1; return; }
        grid = 256;
    }
    if (grid < 0) return;
    (void)hipMemsetAsync(d_ws, 0, CTL_ZERO_BYTES, stream);
    P p{};
    p.x = (const float*)d_in[0]; p.g_mix = (const float*)d_in[1]; p.w_in = (const float*)d_in[2]; p.b_f = (const float*)d_in[3];
    p.w_a = (const float*)d_in[4]; p.w_b = (const float*)d_in[5]; p.w_out = (const float*)d_in[6]; p.g_ffn = (const float*)d_in[7];
    p.w_pq = (const float*)d_in[8]; p.sk = (const float*)d_in[9]; p.eu = (const float*)d_in[10]; p.ev = (const float*)d_in[11]; p.g_fin = (const float*)d_in[12];
    p.out = (float*)d_out; p.ws = (unsigned char*)d_ws;
    hipLaunchKernelGGL(mega, dim3(grid), dim3(NT), LDS_BYTES, stream, p);
}
```
